# Optimizing an MI355X kernel written in HIP

```python
import jax, jax.numpy as jnp
from jax import lax
import numpy as np

D_MODEL = 1024
BATCH = 32
SEQ = 2048
DEPTH = 1

CTX_LEN = 256
GRID_W = 64
D_F = D_MODEL // 2
N_FG = 4
FG = D_F // N_FG
D_M = D_MODEL // 2
N_H = 4
DH = D_M // N_H
CHUNK = 64
CONV_K = 3
N_GATE_KINDS = 4
FORGET_BIAS_LO = 3.0
FORGET_BIAS_HI = 6.0
N_BRANCH = 2
N_EXPERTS = 16
CAP_FACTOR = 2
D_FF_E = D_MODEL
EPS = 1e-6
OFF_F = 0
OFF_QK = OFF_F + D_F
OFF_V = OFF_QK + 2 * D_M
OFF_O = OFF_V + D_M
OFF_G = OFF_O + D_M
OFF_BR = OFF_G + N_GATE_KINDS * N_H
IN_COLS = OFF_BR + N_BRANCH * D_MODEL

kernel_name = 'hybrid_fourier_mlstm_ec_block'


def rmsnorm(x, g):
    xf = x.astype(jnp.float32)
    y = xf * lax.rsqrt(jnp.mean(xf * xf, axis=-1, keepdims=True) + EPS)
    return (y * g.astype(jnp.float32)).astype(x.dtype)


def modulate(h, shift, scale):
    return h * (1 + scale) + shift


def grid_conv(u, w, rows):
    b, l, ch = u.shape
    ug = u.reshape(b, rows, l // rows, ch)
    out = lax.conv_general_dilated(ug, w[:, :, None, :].astype(u.dtype), (1, 1), 'SAME',
                                   dimension_numbers=('NHWC', 'HWIO', 'NHWC'),
                                   feature_group_count=ch)
    return out.reshape(b, l, ch)


def mlstm_inputs(p, rows, w_conv, b_gates):
    b, l, _ = p.shape
    qk = jax.nn.silu(grid_conv(p[..., OFF_QK:OFF_V], w_conv, rows))
    to_heads = lambda a: a.reshape(b, l, N_H, DH).transpose(0, 2, 1, 3).astype(jnp.float32)
    q = to_heads(qk[..., :D_M])
    k = to_heads(qk[..., D_M:]) * (DH ** -0.5)
    v = to_heads(p[..., OFF_V:OFF_O])
    g = (p[..., OFF_G:OFF_BR].astype(jnp.float32).reshape(b, l, N_GATE_KINDS, N_H).transpose(2, 0, 3, 1)
         + b_gates.astype(jnp.float32)[:, None, :, None])
    return q, k, v, g


def zero_state(b):
    return (jnp.zeros((b, N_H, DH, DH), jnp.float32), jnp.zeros((b, N_H, DH), jnp.float32),
            jnp.zeros((b, N_H), jnp.float32))


def mlstm_scan(q, k, v, ig, fl, state):
    b, h, l, dh = q.shape
    nc = l // CHUNK

    def chunks(a):
        return jnp.moveaxis(a.reshape((b, h, nc, CHUNK) + a.shape[3:]), 2, 0)

    tril = jnp.tril(jnp.ones((CHUNK, CHUNK), dtype=bool))

    def step(carry, inp):
        c0, n0, m0 = carry
        qc, kc, vc, ic, fc = inp
        cum = jnp.cumsum(fc, axis=-1)
        logw = jnp.where(tril, cum[..., :, None] - cum[..., None, :] + ic[..., None, :], -jnp.inf)
        inter = cum + m0[..., None]
        m = jnp.maximum(inter, logw.max(-1))
        s = jnp.einsum('bhjd,bhsd->bhjs', qc, kc) * jnp.exp(logw - m[..., None])
        dec = jnp.exp(inter - m)
        num = jnp.einsum('bhjs,bhsd->bhjd', s, vc) + dec[..., None] * jnp.einsum('bhjk,bhkv->bhjv', qc, c0)
        den = s.sum(-1) + dec * jnp.einsum('bhjk,bhk->bhj', qc, n0)
        hc = num / jnp.maximum(jnp.abs(den), jnp.exp(-m))[..., None]
        tot = cum[..., -1]
        a = tot[..., None] - cum + ic
        m_new = jnp.maximum(tot + m0, a.max(-1))
        wa = jnp.exp(a - m_new[..., None])
        dn = jnp.exp(tot + m0 - m_new)
        c_new = dn[..., None, None] * c0 + jnp.einsum('bhs,bhsk,bhsv->bhkv', wa, kc, vc)
        n_new = dn[..., None] * n0 + jnp.einsum('bhs,bhsk->bhk', wa, kc)
        return (c_new, n_new, m_new), hc

    final, hs = lax.scan(step, state, (chunks(q), chunks(k), chunks(v), chunks(ig), chunks(fl)))
    return jnp.moveaxis(hs, 0, 2).reshape(b, h, l, dh), final


def bidir_mlstm(q, k, v, g, init):
    flip = lambda a: jnp.flip(a, axis=2)
    h_f, s_f = mlstm_scan(q, k, v, g[0], jax.nn.log_sigmoid(g[1]), init[0])
    h_b, s_b = mlstm_scan(flip(q), flip(k), flip(v), flip(g[2]), flip(jax.nn.log_sigmoid(g[3])), init[1])
    return h_f + flip(h_b), (s_f, s_b)


def branch_merge(p, h_m, w_fourier, w_mlstm, w_out):
    b, l, _ = p.shape
    u = p[..., OFF_F:OFF_QK].astype(jnp.float32).reshape(b, l, N_FG, FG)
    fu = jnp.fft.fft2(u, axes=(1, 3), norm='ortho').real.astype(p.dtype).reshape(b, l, D_F)
    y_f = fu @ w_fourier
    hm = h_m.transpose(0, 2, 1, 3).reshape(b, l, D_M).astype(p.dtype)
    y_m = (jax.nn.sigmoid(p[..., OFF_O:OFF_G]) * hm) @ w_mlstm
    gates = jax.nn.sigmoid(p[..., OFF_BR:])
    merged = gates[..., :D_MODEL] * y_f + gates[..., D_MODEL:] * y_m
    return merged @ w_out


def expert_choice(h, w_router, w_gate, w_up, w_down):
    b, l, _ = h.shape
    cap = CAP_FACTOR * l // N_EXPERTS
    aff = jax.nn.softmax(jnp.einsum('bld,de->ble', h, w_router).astype(jnp.float32), axis=-1)
    vals, idx = lax.top_k(jnp.swapaxes(aff, 1, 2), cap)
    bidx = jnp.arange(b)[:, None, None]
    xs = h[bidx, idx]
    hid = jax.nn.silu(jnp.einsum('becd,edf->becf', xs, w_gate)) * jnp.einsum('becd,edf->becf', xs, w_up)
    y = jnp.einsum('becf,efd->becd', hid, w_down) * vals[..., None].astype(h.dtype)
    return jnp.zeros_like(h).at[bidx, idx].add(y)


def setup_inputs(seed: int = 0) -> dict:
    key = jax.random.key(seed)
    ks = jax.random.split(key, 20)
    nrm = jax.random.normal
    forget = jnp.linspace(FORGET_BIAS_LO, FORGET_BIAS_HI, N_H)
    zeros_h = jnp.zeros((N_H,))
    gate_base = jnp.stack([zeros_h, forget, zeros_h, forget])
    return {
        'x': nrm(ks[0], (BATCH, SEQ, D_MODEL), jnp.float32),
        'c': nrm(ks[1], (BATCH, D_MODEL), jnp.float32),
        'ctx': nrm(ks[2], (BATCH, CTX_LEN, D_MODEL), jnp.float32),
        'c_ctx': nrm(ks[3], (D_MODEL,), jnp.float32),
        'w_ada': nrm(ks[4], (DEPTH, D_MODEL, 6 * D_MODEL), jnp.float32) * (0.5 * D_MODEL ** -0.5),
        'b_ada': nrm(ks[5], (DEPTH, 6 * D_MODEL), jnp.float32) * 0.02,
        'g_norm1': 1.0 + 0.02 * nrm(ks[6], (DEPTH, D_MODEL), jnp.float32),
        'w_in': nrm(ks[7], (DEPTH, D_MODEL, IN_COLS), jnp.float32) * D_MODEL ** -0.5,
        'b_gates': gate_base[None] + 0.1 * nrm(ks[8], (DEPTH, N_GATE_KINDS, N_H), jnp.float32),
        'w_conv': nrm(ks[9], (DEPTH, CONV_K, CONV_K, 2 * D_M), jnp.float32) * (1.0 / CONV_K),
        'w_fourier': nrm(ks[10], (DEPTH, D_F, D_MODEL), jnp.float32) * D_F ** -0.5,
        'w_mlstm': nrm(ks[11], (DEPTH, D_M, D_MODEL), jnp.float32) * D_M ** -0.5,
        'w_out': nrm(ks[12], (DEPTH, D_MODEL, D_MODEL), jnp.float32) * D_MODEL ** -0.5,
        'g_norm2': 1.0 + 0.02 * nrm(ks[13], (DEPTH, D_MODEL), jnp.float32),
        'w_router': nrm(ks[14], (DEPTH, D_MODEL, N_EXPERTS), jnp.float32) * D_MODEL ** -0.5,
        'w_gate_e': nrm(ks[15], (DEPTH, N_EXPERTS, D_MODEL, D_FF_E), jnp.float32) * D_MODEL ** -0.5,
        'w_up_e': nrm(ks[16], (DEPTH, N_EXPERTS, D_MODEL, D_FF_E), jnp.float32) * D_MODEL ** -0.5,
        'w_down_e': nrm(ks[17], (DEPTH, N_EXPERTS, D_FF_E, D_MODEL), jnp.float32) * D_FF_E ** -0.5,
        'g_final': 1.0 + 0.02 * nrm(ks[18], (D_MODEL,), jnp.float32),
    }


def reference(x, c, ctx, c_ctx, w_ada, b_ada, g_norm1, w_in, b_gates, w_conv, w_fourier, w_mlstm,
              w_out, g_norm2, w_router, w_gate_e, w_up_e, w_down_e, g_final):
    b, seq, _ = x.shape
    rows = seq // GRID_W
    for l in range(DEPTH):
        last = l == DEPTH - 1
        mx = (jax.nn.silu(c) @ w_ada[l] + b_ada[l])[:, None, :]
        sh1, sc1, ga1, sh2, sc2, ga2 = jnp.split(mx, 6, axis=-1)
        mc = jax.nn.silu(c_ctx) @ w_ada[l] + b_ada[l]
        csh1, csc1, cga1, csh2, csc2, cga2 = jnp.split(mc, 6, axis=-1)
        pc = modulate(rmsnorm(ctx, g_norm1[l]), csh1, csc1) @ w_in[l]
        qc, kc, vc, gc = mlstm_inputs(pc, 1, w_conv[l], b_gates[l])
        h_mc, ctx_states = bidir_mlstm(qc, kc, vc, gc, (zero_state(b), zero_state(b)))
        px = modulate(rmsnorm(x, g_norm1[l]), sh1, sc1) @ w_in[l]
        qx, kx, vx, gx = mlstm_inputs(px, rows, w_conv[l], b_gates[l])
        h_mx, _ = bidir_mlstm(qx, kx, vx, gx, ctx_states)
        x = x + ga1 * branch_merge(px, h_mx, w_fourier[l], w_mlstm[l], w_out[l])
        hx2 = modulate(rmsnorm(x, g_norm2[l]), sh2, sc2)
        x = x + ga2 * expert_choice(hx2, w_router[l], w_gate_e[l], w_up_e[l], w_down_e[l])
        if not last:
            ctx = ctx + cga1 * branch_merge(pc, h_mc, w_fourier[l], w_mlstm[l], w_out[l])
            hc2 = modulate(rmsnorm(ctx, g_norm2[l]), csh2, csc2)
            ctx = ctx + cga2 * expert_choice(hc2, w_router[l], w_gate_e[l], w_up_e[l], w_down_e[l])
    return rmsnorm(x, g_final)
```

```cpp
#ifndef MK_XCD_BAR
#define MK_XCD_BAR 0
#endif
#include <hip/hip_runtime.h>
#include <hip/hip_cooperative_groups.h>
#include <cstdio>
#include <cstdint>
namespace cg = cooperative_groups;

#define LAS __attribute__((address_space(3)))
typedef unsigned short bf16;
typedef short bf16x8 __attribute__((ext_vector_type(8)));
typedef short s16x4 __attribute__((ext_vector_type(4)));
typedef float f32x4 __attribute__((ext_vector_type(4)));
typedef float f32x2 __attribute__((ext_vector_type(2)));
typedef unsigned u32x4 __attribute__((ext_vector_type(4)));
typedef unsigned u32x2 __attribute__((ext_vector_type(2)));
typedef __bf16 bf16x2_t __attribute__((ext_vector_type(2)));

__device__ __forceinline__ unsigned pk2(float lo, float hi) { f32x2 v = {lo, hi}; bf16x2_t b = __builtin_convertvector(v, bf16x2_t); return __builtin_bit_cast(unsigned, b); }
__device__ __forceinline__ float bflo(unsigned w) { return __uint_as_float(w << 16); }
__device__ __forceinline__ float bfhi(unsigned w) { return __uint_as_float(w & 0xffff0000u); }
__device__ __forceinline__ float bf1(bf16 b) { return __uint_as_float((unsigned)b << 16); }
__device__ __forceinline__ float silu_f(float v) { return v / (1.f + __expf(-v)); }
__device__ __forceinline__ float sigmoid_f(float v) { return 1.f / (1.f + __expf(-v)); }
__device__ __forceinline__ float log_sigmoid_f(float v) { return fminf(v, 0.f) - log1pf(expf(-fabsf(v))); }
__device__ __forceinline__ float wave_sum(float v) {
#pragma unroll
    for (int o = 1; o < 64; o <<= 1) v += __shfl_xor(v, o);
    return v;
}

#define XB_TMO      128
#define XB_XCNT(j)  (256  + 64 * (j))
#define XB_XSUB(j)  (1280 + 64 * (j))
#define XB_XGEN(j)  (2304 + 64 * (j))
#define XB_TOP      3328
#define XB_TOPGEN   3392
#define XCD_BAR_WORDS 3456
#define XB_SPIN_CAP (1u << 20)
__device__ __forceinline__ unsigned xb_ld(unsigned* p)              { return __hip_atomic_load(p, __ATOMIC_RELAXED, __HIP_MEMORY_SCOPE_AGENT); }
__device__ __forceinline__ unsigned xb_add(unsigned* p, unsigned v) { return __hip_atomic_fetch_add(p, v, __ATOMIC_RELAXED, __HIP_MEMORY_SCOPE_AGENT); }
__device__ __forceinline__ unsigned xb_xcc_id() { return (unsigned)__builtin_amdgcn_s_getreg((3 << 11) | 20) & 0xFu; }
#define XB_SPIN(cond, bar) do { unsigned _sp = 0; while (cond) { __builtin_amdgcn_s_sleep(1); \
    if ((++_sp & 255u) == 0u) { if (xb_ld(&(bar)[XB_TMO])) break; if (_sp > XB_SPIN_CAP) { atomicAdd(&(bar)[XB_TMO], 1u); break; } } } } while (0)
struct XcdBarrier { unsigned* bar; unsigned x; volatile LAS unsigned* st; };
__device__ __forceinline__ XcdBarrier xcd_barrier_post(unsigned* bar, volatile LAS unsigned* st) {
    XcdBarrier b; b.bar = bar; b.x = xb_xcc_id(); b.st = st;
    if (threadIdx.x == 0) (void)xb_add(&bar[XB_XCNT(b.x)], 1u);
    return b;
}
__device__ __forceinline__ void xcd_barrier_complete(unsigned* bar, unsigned x, unsigned& nloc, unsigned& nx) {
    const unsigned G = gridDim.x * gridDim.y * gridDim.z;
    unsigned sum, cnt, mine, sp = 0u;
    for (;;) {
        sum = 0u; cnt = 0u; mine = 0u;
#pragma unroll
        for (unsigned j = 0; j < 16; ++j) { const unsigned c = xb_ld(&bar[XB_XCNT(j)]); sum += c; cnt += (c > 0u) ? 1u : 0u; mine = (j == x) ? c : mine; }
        if (sum == G) break;
        __builtin_amdgcn_s_sleep(1);
        if ((++sp & 255u) == 0u) { if (xb_ld(&bar[XB_TMO])) break; if (sp > XB_SPIN_CAP) { atomicAdd(&bar[XB_TMO], 1u); break; } }
    }
    nloc = mine > 0u ? mine : 1u; nx = cnt > 0u ? cnt : 1u;
}
__device__ __forceinline__ void xcd_barrier(const XcdBarrier& b) {
    asm volatile("s_waitcnt vmcnt(0)" ::: "memory");
    __syncthreads();
    if (threadIdx.x == 0) {
        unsigned* bar = b.bar;
        __builtin_amdgcn_s_waitcnt(0);
        unsigned nloc = b.st[0], nx = b.st[1];
        if (nloc == 0u) { xcd_barrier_complete(bar, b.x, nloc, nx); b.st[0] = nloc; b.st[1] = nx; }
        const unsigned old = xb_add(&bar[XB_XSUB(b.x)], 1u);
        const unsigned gen = old / nloc;
        if (old + 1u == (gen + 1u) * nloc) {
            __builtin_amdgcn_fence(__ATOMIC_RELEASE, "agent");
            asm volatile("s_waitcnt vmcnt(0)" ::: "memory");
            const unsigned og = xb_add(&bar[XB_TOP], 1u);
            const unsigned tg = og / nx;
            if (og + 1u == (tg + 1u) * nx) xb_add(&bar[XB_TOPGEN], 1u);
            else XB_SPIN(xb_ld(&bar[XB_TOPGEN]) == tg, bar);
            __builtin_amdgcn_fence(__ATOMIC_ACQUIRE, "agent");
            xb_add(&bar[XB_XGEN(b.x)], 1u);
            asm volatile("s_waitcnt vmcnt(0)" ::: "memory");
        } else {
            XB_SPIN(xb_ld(&bar[XB_XGEN(b.x)]) == gen, bar);
            __builtin_amdgcn_fence(__ATOMIC_ACQUIRE, "agent");
            asm volatile("s_waitcnt vmcnt(0)" ::: "memory");
        }
    }
    __syncthreads();
}

namespace mg {
constexpr int BM = 256, BK = 64, HALF = 128, HTB = HALF * BK * 2, STAGE_BYTES = 8 * HTB, NXCD = 8, WGM = 8;
__host__ __device__ __forceinline__ int lds_byte(int r, int c) { const int st = (r >> 4) * 2 + (c >> 5), rr = r & 15, cc = c & 31, ob = rr * 64 + cc * 2; return st * 1024 + (ob ^ (((ob >> 9) & 1) << 5)); }
__host__ __device__ __forceinline__ void stage_rc(int b, int& R, int& C) { const int st = b / 1024, sb = b % 1024, swz = sb ^ (((sb >> 9) & 1) << 5); R = (st >> 1) * 16 + swz / 64; C = (st & 1) * 32 + (swz % 64) / 2; }
__host__ __device__ __forceinline__ int perm32(int rho) { const int n = rho >> 4, i = rho & 15; return 8 * (i >> 2) + 4 * n + (i & 3); }

struct Unit { int pm, pn, ty; const char* a; const char* b; const int* gi; };
__device__ __forceinline__ void tile_of(int wgid, int nM, int nN, int& pm, int& pn) {
    const int nwg = nM * nN; { const int q = nwg / NXCD, r = nwg % NXCD, xcd = wgid % NXCD, off = wgid / NXCD; wgid = (xcd < r ? xcd * (q + 1) : r * (q + 1) + (xcd - r) * q) + off; }
    const int nig = WGM * nN, gid = wgid / nig, fm = gid * WGM, gsz = (nM - fm) < WGM ? (nM - fm) : WGM;
    pm = fm + ((wgid % nig) % gsz); pn = (wgid % nig) / gsz;
}

template <class Epi, class Sched, bool GATHER>
__device__ __forceinline__ void gemm_phase(LAS unsigned char* lds, const int K, const Sched& S, const Epi& E) {
    const int tid = threadIdx.x, wid = __builtin_amdgcn_readfirstlane(tid >> 6), lane = tid & 63, wr = wid >> 2, wc = wid & 3, fr = lane & 15, fq = lane >> 4;
    const int nt = K / BK;
    unsigned voffB[2], vAc[2][2], vAn[2][2]; int stR[2], stC[2];
    const size_t kstep = (size_t)(BK * 2);
    const size_t hstep = (size_t)HALF * K * 2;
#pragma unroll
    for (int i = 0; i < 2; ++i) { int R, C; stage_rc(tid * 16 + i * 8192, R, C); stR[i] = R; stC[i] = C; const int Rb = Epi::PERM ? ((R & ~31) + perm32(R & 31)) : R;
        voffB[i] = (unsigned)(Rb * K + C) * 2u; }
    const unsigned ldsw = (unsigned)wid * 1024u;
    const int aoff = lds_byte(wr * 64 + fr, fq * 8), boff = lds_byte(wc * 32 + fr, fq * 8);
#define MG_SA(b, h) (((b) * 2 + (h)) * HTB)
#define MG_SB(b, h) ((4 + (b) * 2 + (h)) * HTB)
#define MG_STAGE(bufoff, gbase, voff) do { _Pragma("unroll") for (int _i = 0; _i < 2; ++_i) \
        __builtin_amdgcn_global_load_lds((const unsigned*)((const char*)(gbase) + (voff)[_i]), (LAS unsigned*)(lds + (bufoff) + ldsw + _i * 8192), 16, 0, 0); } while (0)
#define MG_LDA(dst, b, h) do { _Pragma("unroll") for (int m = 0; m < 4; ++m) _Pragma("unroll") for (int k = 0; k < 2; ++k) dst[m][k] = *(const LAS bf16x8*)(lds + MG_SA(b, h) + aoff + m * 2048 + k * 1024); } while (0)
#define MG_LDB(dst, b, h) do { _Pragma("unroll") for (int n = 0; n < 2; ++n) _Pragma("unroll") for (int k = 0; k < 2; ++k) dst[n][k] = *(const LAS bf16x8*)(lds + MG_SB(b, h) + boff + n * 2048 + k * 1024); } while (0)
#define MG_MMA(ai, bj, At, Bt) do { __builtin_amdgcn_s_setprio(1); _Pragma("unroll") for (int m = 0; m < 4; ++m) _Pragma("unroll") for (int n = 0; n < 2; ++n) _Pragma("unroll") for (int k = 0; k < 2; ++k) \
        acc[ai][bj][m][n] = __builtin_amdgcn_mfma_f32_16x16x32_bf16(Bt[n][k], At[m][k], acc[ai][bj][m][n], 0, 0, 0); __builtin_amdgcn_s_setprio(0); } while (0)
#define MG_WAIT_V(n) asm volatile("s_waitcnt vmcnt(" #n ")" ::: "memory")
#define MG_WAIT_L(n) asm volatile("s_waitcnt lgkmcnt(" #n ")" ::: "memory")
#define MG_BAR __builtin_amdgcn_s_barrier()
#define MG_SCHED __builtin_amdgcn_sched_barrier(0)
#define MG_AOFF(dst, u) do { _Pragma("unroll") for (int _h = 0; _h < 2; ++_h) _Pragma("unroll") for (int _i = 0; _i < 2; ++_i) { \
        if constexpr (GATHER) dst[_h][_i] = ((unsigned)(u).gi[_h * HALF + stR[_i]] * (unsigned)K + (unsigned)stC[_i]) * 2u; \
        else dst[_h][_i] = (unsigned)((_h * HALF + stR[_i]) * K + stC[_i]) * 2u; } } while (0)
    Unit cur, nxt; int ui = 0;
    if (!S.next(0, cur)) return;
    f32x4 acc[2][2][4][2];
#pragma unroll
    for (int a = 0; a < 2; ++a)
#pragma unroll
        for (int b = 0; b < 2; ++b)
#pragma unroll
            for (int m = 0; m < 4; ++m)
#pragma unroll
                for (int n = 0; n < 2; ++n) acc[a][b][m][n] = (f32x4){0.f, 0.f, 0.f, 0.f};
    bf16x8 At[4][2], B0[2][2], B1[2][2];
    const char* cA = cur.a; const char* cB = cur.b;
    MG_AOFF(vAc, cur);
    MG_STAGE(MG_SB(0, 0), cB, voffB); MG_STAGE(MG_SB(0, 1), cB + hstep, voffB); MG_STAGE(MG_SA(0, 0), cA, vAc[0]); MG_STAGE(MG_SA(0, 1), cA, vAc[1]);
    if (wr == 1) MG_BAR;
    MG_WAIT_V(2); MG_BAR;
    MG_STAGE(MG_SB(1, 0), cB + kstep, voffB); MG_STAGE(MG_SA(1, 0), cA + kstep, vAc[0]); MG_STAGE(MG_SB(1, 1), cB + hstep + kstep, voffB);
    MG_WAIT_V(6); MG_BAR;
    for (;;) {
        const bool has_next = S.next(ui + 1, nxt);
        const char* nA = has_next ? nxt.a : cA; const char* nB = has_next ? nxt.b : cB;
        if constexpr (GATHER) { if (has_next) { MG_AOFF(vAn, nxt); } else {
#pragma unroll
            for (int h = 0; h < 2; ++h)
#pragma unroll
                for (int i = 0; i < 2; ++i) vAn[h][i] = vAc[h][i]; } }
        for (int t = 0; t < nt; t += 2) {
            const bool last = (t == nt - 2);
            const char* a1 = cA + (size_t)(t + 1) * kstep;
            const char* a2 = last ? nA : cA + (size_t)(t + 2) * kstep; const char* b2 = last ? nB : cB + (size_t)(t + 2) * kstep;
            const char* a3 = a2 + kstep; const char* b3 = b2 + kstep;
            unsigned vA2[2][2];
#pragma unroll
            for (int h = 0; h < 2; ++h)
#pragma unroll
                for (int i = 0; i < 2; ++i) vA2[h][i] = (GATHER && last) ? vAn[h][i] : vAc[h][i];
            MG_LDB(B0, 0, 0); MG_LDB(B1, 0, 1); MG_SCHED; MG_LDA(At, 0, 0); MG_STAGE(MG_SA(1, 1), a1, vAc[1]);
            MG_WAIT_V(8); MG_WAIT_L(0); MG_BAR; MG_MMA(0, 0, At, B0); MG_MMA(0, 1, At, B1); MG_BAR; MG_SCHED;
            MG_LDA(At, 0, 1); MG_STAGE(MG_SB(0, 0), b2, voffB); MG_STAGE(MG_SB(0, 1), b2 + hstep, voffB); MG_STAGE(MG_SA(0, 0), a2, vA2[0]);
            MG_WAIT_V(8); MG_WAIT_L(0); MG_BAR; MG_MMA(1, 0, At, B0); MG_MMA(1, 1, At, B1); MG_BAR; MG_SCHED;
            MG_LDB(B0, 1, 0); MG_LDB(B1, 1, 1); MG_SCHED; MG_LDA(At, 1, 0); MG_STAGE(MG_SA(0, 1), a2, vA2[1]);
            MG_WAIT_V(8); MG_WAIT_L(0); MG_BAR; MG_MMA(0, 0, At, B0); MG_MMA(0, 1, At, B1); MG_BAR; MG_SCHED;
            MG_LDA(At, 1, 1); MG_STAGE(MG_SB(1, 0), b3, voffB); MG_STAGE(MG_SB(1, 1), b3 + hstep, voffB); MG_STAGE(MG_SA(1, 0), a3, vA2[0]);
            MG_WAIT_V(8); MG_WAIT_L(0); MG_BAR; MG_MMA(1, 0, At, B0); MG_MMA(1, 1, At, B1); MG_BAR; MG_SCHED;
        }
        if (wr == 0) MG_BAR;
        E(acc, cur, wr, wc, fr, fq);
        if (!has_next) break;
#pragma unroll
        for (int a = 0; a < 2; ++a)
#pragma unroll
            for (int b = 0; b < 2; ++b)
#pragma unroll
                for (int m = 0; m < 4; ++m)
#pragma unroll
                    for (int n = 0; n < 2; ++n) acc[a][b][m][n] = (f32x4){0.f, 0.f, 0.f, 0.f};
        cur = nxt; cA = nA; cB = nB; ++ui;
        if constexpr (GATHER) {
#pragma unroll
            for (int h = 0; h < 2; ++h)
#pragma unroll
                for (int i = 0; i < 2; ++i) vAc[h][i] = vAn[h][i]; }
        if (wr == 1) MG_BAR;
    }
    MG_WAIT_V(0);
    MG_BAR;
#undef MG_SA
#undef MG_SB
#undef MG_STAGE
#undef MG_LDA
#undef MG_LDB
#undef MG_MMA
#undef MG_WAIT_V
#undef MG_WAIT_L
#undef MG_BAR
#undef MG_SCHED
#undef MG_AOFF
}
}
constexpr int D = 1024, NB = 32, SEQ = 2048, CL = 256, NTOK = NB * SEQ, NCTX = NB * CL, INC = 4624;
constexpr int NE = 16, CAP = 256;
constexpr int OFF_QK = 512, OFF_V = 1536, OFF_O = 2048, OFF_G = 2560, OFF_BR = 2576;
constexpr float EPS = 1e-6f;
constexpr size_t MiB = 1u << 20;
constexpr size_t WS_CTL = 0, CTL_BYTES = 1 * MiB;
constexpr size_t WS_MOD = 1 * MiB;
constexpr size_t WS_GATES = 2 * MiB;
constexpr size_t WS_AFF = 11 * MiB;
constexpr size_t WS_IDX = 15 * MiB;
constexpr size_t WS_VAL = 15 * MiB + 512 * 1024;
constexpr size_t WS_SLOT = 16 * MiB;
constexpr size_t WS_WTF = 18 * MiB;
constexpr size_t WS_WFT = 20 * MiB;
constexpr size_t WS_WMT = 21 * MiB;
constexpr size_t WS_WOT = 22 * MiB;
constexpr size_t WS_WTM = 24 * MiB;
constexpr size_t WS_TT = 32 * MiB;
constexpr size_t WS_PC = 48 * MiB;
constexpr size_t WS_H = 64 * MiB;
constexpr size_t WS_QK = 64 * MiB;
constexpr size_t WS_KC = 192 * MiB;
constexpr size_t WS_MRG = 64 * MiB;
constexpr size_t WS_WGU = 64 * MiB;
constexpr size_t WS_WD = 128 * MiB;
constexpr size_t WS_AB = 208 * MiB;
constexpr size_t WS_HF = 208 * MiB;
constexpr size_t WS_HB = 272 * MiB;
constexpr size_t WS_HX2 = 208 * MiB;
constexpr size_t WS_FU = 336 * MiB;
constexpr size_t WS_PQK = 400 * MiB;
constexpr size_t WS_HM = 400 * MiB;
constexpr size_t WS_PV = 528 * MiB;
constexpr size_t WS_PO = 592 * MiB;
constexpr size_t WS_PBR = 656 * MiB;
constexpr size_t WS_HID = 400 * MiB;
constexpr size_t WS_Y = 656 * MiB;
constexpr size_t WS_END = 912 * MiB;
constexpr int LDS_BYTES = 147456;

struct Ctx {
    const float *x, *c, *ctx, *c_ctx, *w_ada, *b_ada, *g_norm1, *w_in, *b_gates, *w_conv, *w_fourier, *w_mlstm, *w_out, *g_norm2, *w_router, *w_gate_e, *w_up_e, *w_down_e, *g_final;
    float* out; unsigned char* ws;
};

__device__ __forceinline__ void store_tile_bf16(const f32x4 (&acc)[2][2][4][2], bf16* base, int ldc, bool sig, int wr, int wc, int fr, int fq) {
    bf16* p0 = base + (size_t)(wr * 64 + fr) * ldc + wc * 32 + 8 * fq;
#pragma unroll
    for (int ai = 0; ai < 2; ++ai)
#pragma unroll
        for (int m = 0; m < 4; ++m) { bf16* rowp = p0 + (size_t)(ai * 128 + m * 16) * ldc;
#pragma unroll
            for (int bj = 0; bj < 2; ++bj) { f32x4 v0 = acc[ai][bj][m][0], v1 = acc[ai][bj][m][1];
                if (sig) {
#pragma unroll
                    for (int j = 0; j < 4; ++j) { v0[j] = sigmoid_f(v0[j]); v1[j] = sigmoid_f(v1[j]); } }
                u32x4 w; w.x = pk2(v0[0], v0[1]); w.y = pk2(v0[2], v0[3]); w.z = pk2(v1[0], v1[1]); w.w = pk2(v1[2], v1[3]);
                *(u32x4*)(rowp + bj * 128) = w; } }
}
struct EpiP1 {
    static constexpr bool PERM = true; unsigned char* ws;
    __device__ __forceinline__ void operator()(const f32x4 (&acc)[2][2][4][2], const mg::Unit& u, int wr, int wc, int fr, int fq) const {
        bf16* base; int ldc; bool sig = false;
        if (u.ty == 0) { const size_t r0 = (size_t)u.pm * 256;
            if (u.pn < 4) { base = (bf16*)(ws + WS_PQK) + r0 * 1024 + u.pn * 256; ldc = 1024; }
            else if (u.pn < 6) { base = (bf16*)(ws + WS_PV) + r0 * 512 + (u.pn - 4) * 256; ldc = 512; }
            else if (u.pn < 8) { base = (bf16*)(ws + WS_PO) + r0 * 512 + (u.pn - 6) * 256; ldc = 512; sig = true; }
            else { base = (bf16*)(ws + WS_PBR) + r0 * 2048 + (u.pn - 8) * 256; ldc = 2048; sig = true; }
        } else if (u.ty == 1) { base = (bf16*)(ws + WS_AB) + ((size_t)(u.pn >> 3) * 1024 + (size_t)u.pm * 256) * 2048 + (u.pn & 7) * 256; ldc = 2048; }
        else { base = (bf16*)(ws + WS_PC) + (size_t)u.pm * 256 * 1024 + u.pn * 256; ldc = 1024; }
        store_tile_bf16(acc, base, ldc, sig, wr, wc, fr, fq);
    }
};
struct EpiF2 {
    static constexpr bool PERM = true; unsigned char* ws;
    __device__ __forceinline__ void operator()(const f32x4 (&acc)[2][2][4][2], const mg::Unit& u, int wr, int wc, int fr, int fq) const {
        bf16* base = (bf16*)(ws + WS_FU) + ((size_t)(u.pn >> 1) * 2048 + (size_t)u.pm * 256) * 512 + (u.pn & 1) * 256;
        store_tile_bf16(acc, base, 512, false, wr, wc, fr, fq);
    }
};
struct EpiMerge {
    static constexpr bool PERM = true; unsigned char* ws;
    __device__ __forceinline__ void operator()(const f32x4 (&acc)[2][2][4][2], const mg::Unit& u, int wr, int wc, int fr, int fq) const {
        const size_t row0 = (size_t)u.pm * 256 + wr * 64 + fr; const int col0 = u.pn * 256 + wc * 32 + 8 * fq;
#pragma unroll
        for (int ai = 0; ai < 2; ++ai)
#pragma unroll
            for (int m = 0; m < 4; ++m) { const size_t row = row0 + ai * 128 + m * 16;
                bf16* mp = (bf16*)(ws + WS_MRG) + row * 1024 + col0; const bf16* gp = (const bf16*)(ws + WS_PBR) + row * 2048 + u.ty * 1024 + col0;
#pragma unroll
                for (int bj = 0; bj < 2; ++bj) { const u32x4 g = *(const u32x4*)(gp + bj * 128); const f32x4 v0 = acc[ai][bj][m][0], v1 = acc[ai][bj][m][1];
                    float r[8] = {bflo(g.x) * v0[0], bfhi(g.x) * v0[1], bflo(g.y) * v0[2], bfhi(g.y) * v0[3], bflo(g.z) * v1[0], bfhi(g.z) * v1[1], bflo(g.w) * v1[2], bfhi(g.w) * v1[3]};
                    if (u.ty == 1) { const u32x4 t = *(const u32x4*)(mp + bj * 128);
                        r[0] += bflo(t.x); r[1] += bfhi(t.x); r[2] += bflo(t.y); r[3] += bfhi(t.y); r[4] += bflo(t.z); r[5] += bfhi(t.z); r[6] += bflo(t.w); r[7] += bfhi(t.w); }
                    u32x4 w; w.x = pk2(r[0], r[1]); w.y = pk2(r[2], r[3]); w.z = pk2(r[4], r[5]); w.w = pk2(r[6], r[7]);
                    *(u32x4*)(mp + bj * 128) = w; } }
    }
};
struct EpiOut {
    static constexpr bool PERM = false; const float* x; const float* mod; float* out;
    __device__ __forceinline__ void operator()(const f32x4 (&acc)[2][2][4][2], const mg::Unit& u, int wr, int wc, int fr, int fq) const {
        const size_t row0 = (size_t)u.pm * 256 + wr * 64 + fr; const int col0 = u.pn * 256 + wc * 32 + 4 * fq; const int b = u.pm >> 3;
        f32x4 ga[2][2];
#pragma unroll
        for (int bj = 0; bj < 2; ++bj)
#pragma unroll
            for (int n = 0; n < 2; ++n) ga[bj][n] = *(const f32x4*)(mod + (size_t)b * 6144 + 2048 + col0 + bj * 128 + n * 16);
#pragma unroll
        for (int ai = 0; ai < 2; ++ai)
#pragma unroll
            for (int m = 0; m < 4; ++m) { const size_t off = (row0 + ai * 128 + m * 16) * 1024 + col0;
#pragma unroll
                for (int bj = 0; bj < 2; ++bj)
#pragma unroll
                    for (int n = 0; n < 2; ++n) { const f32x4 xv = *(const f32x4*)(x + off + bj * 128 + n * 16); *(f32x4*)(out + off + bj * 128 + n * 16) = xv + ga[bj][n] * acc[ai][bj][m][n]; } }
    }
};
struct EpiSwiglu {
    static constexpr bool PERM = true; unsigned char* ws;
    __device__ __forceinline__ void operator()(const f32x4 (&acc)[2][2][4][2], const mg::Unit& u, int wr, int wc, int fr, int fq) const {
        bf16* p0 = (bf16*)(ws + WS_HID) + ((size_t)u.pm * 256 + wr * 64 + fr) * 1024 + u.pn * 128 + wc * 32 + 8 * fq;
#pragma unroll
        for (int ai = 0; ai < 2; ++ai)
#pragma unroll
            for (int m = 0; m < 4; ++m) { float r[8];
#pragma unroll
                for (int n = 0; n < 2; ++n)
#pragma unroll
                    for (int j = 0; j < 4; ++j) r[n * 4 + j] = silu_f(acc[ai][0][m][n][j]) * acc[ai][1][m][n][j];
                u32x4 w; w.x = pk2(r[0], r[1]); w.y = pk2(r[2], r[3]); w.z = pk2(r[4], r[5]); w.w = pk2(r[6], r[7]);
                *(u32x4*)(p0 + (size_t)(ai * 128 + m * 16) * 1024) = w; }
    }
};
struct EpiDown {
    static constexpr bool PERM = true; unsigned char* ws;
    __device__ __forceinline__ void operator()(const f32x4 (&acc)[2][2][4][2], const mg::Unit& u, int wr, int wc, int fr, int fq) const {
        const size_t row0 = (size_t)u.pm * 256 + wr * 64 + fr; const float* val = (const float*)(ws + WS_VAL);
        bf16* p0 = (bf16*)(ws + WS_Y) + row0 * 1024 + u.pn * 256 + wc * 32 + 8 * fq;
#pragma unroll
        for (int ai = 0; ai < 2; ++ai)
#pragma unroll
            for (int m = 0; m < 4; ++m) { const float vv = val[row0 + ai * 128 + m * 16]; bf16* rowp = p0 + (size_t)(ai * 128 + m * 16) * 1024;
#pragma unroll
                for (int bj = 0; bj < 2; ++bj) { const f32x4 v0 = acc[ai][bj][m][0] * vv, v1 = acc[ai][bj][m][1] * vv;
                    u32x4 w; w.x = pk2(v0[0], v0[1]); w.y = pk2(v0[2], v0[3]); w.z = pk2(v1[0], v1[1]); w.w = pk2(v1[2], v1[3]);
                    *(u32x4*)(rowp + bj * 128) = w; } }
    }
};

struct SchedP1 {
    unsigned char* ws; int G, c;
    __device__ __forceinline__ bool next(int i, mg::Unit& u) const {
        int L = i * G + c; const char* H = (const char*)(ws + WS_H); u.gi = nullptr;
        if (L < 4096) { mg::tile_of(L, 256, 16, u.pm, u.pn); u.ty = 0; u.a = H + (size_t)u.pm * 256 * 2048; u.b = (const char*)(ws + WS_WTM) + (size_t)u.pn * 256 * 2048; return true; }
        L -= 4096;
        if (L < 1024) { mg::tile_of(L, 4, 256, u.pm, u.pn); u.ty = 1; u.a = (const char*)(ws + WS_WTF) + (size_t)u.pm * 256 * 2048; u.b = H + (size_t)u.pn * 256 * 2048; return true; }
        L -= 1024;
        if (L < 128) { mg::tile_of(L, 32, 4, u.pm, u.pn); u.ty = 2; u.a = H + ((size_t)NTOK + (size_t)u.pm * 256) * 2048; u.b = (const char*)(ws + WS_WTM) + ((size_t)512 + (size_t)u.pn * 256) * 2048; return true; }
        return false;
    }
};
struct SchedF2 {
    unsigned char* ws; int G, c;
    __device__ __forceinline__ bool next(int i, mg::Unit& u) const {
        const int L = i * G + c; if (L >= 512) return false; mg::tile_of(L, 8, 64, u.pm, u.pn); u.ty = 0; u.gi = nullptr;
        u.a = (const char*)(ws + WS_TT) + (size_t)u.pm * 256 * 8192; u.b = (const char*)(ws + WS_AB) + (size_t)u.pn * 256 * 8192; return true;
    }
};
struct SchedMerge {
    unsigned char* ws; int G, c;
    __device__ __forceinline__ bool next(int i, mg::Unit& u) const {
        const int L = (i >> 1) * G + c; if (L >= 1024) return false; mg::tile_of(L, 256, 4, u.pm, u.pn); u.ty = i & 1; u.gi = nullptr;
        u.a = (const char*)(ws + (u.ty ? WS_HM : WS_FU)) + (size_t)u.pm * 256 * 1024; u.b = (const char*)(ws + (u.ty ? WS_WMT : WS_WFT)) + (size_t)u.pn * 256 * 1024; return true;
    }
};
struct SchedOut {
    unsigned char* ws; int G, c;
    __device__ __forceinline__ bool next(int i, mg::Unit& u) const {
        const int L = i * G + c; if (L >= 1024) return false; mg::tile_of(L, 256, 4, u.pm, u.pn); u.ty = 0; u.gi = nullptr;
        u.a = (const char*)(ws + WS_MRG) + (size_t)u.pm * 256 * 2048; u.b = (const char*)(ws + WS_WOT) + (size_t)u.pn * 256 * 2048; return true;
    }
};
struct SchedUp {
    unsigned char* ws; int G, c;
    __device__ __forceinline__ bool next(int i, mg::Unit& u) const {
        const int L = i * G + c; if (L >= 4096) return false; mg::tile_of(L, 512, 8, u.pm, u.pn); u.ty = 0;
        u.a = (const char*)(ws + WS_HX2); u.gi = (const int*)(ws + WS_IDX) + (size_t)u.pm * 256; u.b = (const char*)(ws + WS_WGU) + ((size_t)(u.pm >> 5) * 8 + u.pn) * 256 * 2048; return true;
    }
};
struct SchedDown {
    unsigned char* ws; int G, c;
    __device__ __forceinline__ bool next(int i, mg::Unit& u) const {
        const int L = i * G + c; if (L >= 2048) return false; mg::tile_of(L, 512, 4, u.pm, u.pn); u.ty = 0; u.gi = nullptr;
        u.a = (const char*)(ws + WS_HID) + (size_t)u.pm * 256 * 2048; u.b = (const char*)(ws + WS_WD) + ((size_t)(u.pm >> 5) * 4 + u.pn) * 256 * 2048; return true;
    }
};

__device__ __forceinline__ void transpose_item(const float* W, int ldw, int n0, int k0, bf16* dst, int drow0, int Kd, LAS float* scr, int lane) {
#pragma unroll 8
    for (int i = 0; i < 32; ++i) { const int kk = 2 * i + (lane >> 5); scr[kk * 33 + (lane & 31)] = W[(size_t)(k0 + kk) * ldw + n0 + (lane & 31)]; }
    asm volatile("s_waitcnt lgkmcnt(0)" ::: "memory");
    const int c = lane & 7;
#pragma unroll
    for (int j = 0; j < 4; ++j) { const int n = (lane >> 3) + 8 * j; const LAS float* s = scr + (8 * c) * 33 + n;
        u32x4 o; o.x = pk2(s[0 * 33], s[1 * 33]); o.y = pk2(s[2 * 33], s[3 * 33]); o.z = pk2(s[4 * 33], s[5 * 33]); o.w = pk2(s[6 * 33], s[7 * 33]);
        *(u32x4*)(dst + (size_t)(drow0 + n) * Kd + k0 + 8 * c) = o; }
    asm volatile("s_waitcnt lgkmcnt(0)" ::: "memory");
}

__device__ __forceinline__ void p0_prep(const Ctx& C, LAS unsigned char* lds, int tid, int lane, int wave, int G) {
    const int blk = blockIdx.x;
    for (int item = blk; item < 192; item += G) {
        LAS float* sT = (LAS float*)lds;
        for (int i = tid; i < 33 * 1024; i += 512) { const int r = i >> 10, k = i & 1023; const float v = r < 32 ? C.c[r * 1024 + k] : C.c_ctx[k]; sT[k * 36 + r] = silu_f(v); }
        for (int i = tid; i < 3 * 1024; i += 512) { const int r = 33 + (i >> 10), k = i & 1023; sT[k * 36 + r] = 0.f; }
        __syncthreads();
        const int col0 = item * 32, kg = tid >> 5, j = tid & 31;
        float acc[36];
#pragma unroll
        for (int r = 0; r < 36; ++r) acc[r] = 0.f;
#pragma unroll 4
        for (int kk = 0; kk < 64; ++kk) { const int k = kg * 64 + kk; const float w = C.w_ada[(size_t)k * 6144 + col0 + j];
#pragma unroll
            for (int q = 0; q < 9; ++q) { const f32x4 s4 = *(const LAS f32x4*)(sT + k * 36 + 4 * q); acc[4 * q] += s4[0] * w; acc[4 * q + 1] += s4[1] * w; acc[4 * q + 2] += s4[2] * w; acc[4 * q + 3] += s4[3] * w; } }
        __syncthreads();
        LAS float* red = (LAS float*)lds;
#pragma unroll
        for (int r = 0; r < 33; ++r) red[(kg * 33 + r) * 32 + j] = acc[r];
        __syncthreads();
        float* mod = (float*)(C.ws + WS_MOD);
        for (int o = tid; o < 33 * 32; o += 512) { const int r = o >> 5, jj = o & 31; float s = 0.f;
#pragma unroll
            for (int g = 0; g < 16; ++g) s += red[(g * 33 + r) * 32 + jj];
            mod[(size_t)r * 6144 + col0 + jj] = s + C.b_ada[col0 + jj]; }
        __syncthreads();
    }
    for (int item = blk; item < 256; item += G) {
        LAS float* wl = (LAS float*)lds; LAS float* cs = wl + 16 * 128; LAS float* sn = cs + 128;
        const int g = item >> 6, d0 = (item & 63) * 16;
        for (int i = tid; i < 16 * 128; i += 512) { const int dd = i >> 7, cc = i & 127; wl[i] = C.w_in[(size_t)(d0 + dd) * INC + g * 128 + cc]; }
        if (tid < 128) { cs[tid] = cospif((float)tid * (1.f / 64.f)); sn[tid] = sinpif((float)tid * (1.f / 64.f)); }
        __syncthreads();
        const int rj = tid & 255, j = rj >> 1, ab = rj & 1, half = tid >> 8;
        float acc[8];
#pragma unroll
        for (int i = 0; i < 8; ++i) acc[i] = 0.f;
        const LAS float* tw = ab ? sn : cs;
        for (int cc = 0; cc < 128; ++cc) { const float t = tw[(j * cc) & 127];
#pragma unroll
            for (int i = 0; i < 8; ++i) acc[i] += wl[(half * 8 + i) * 128 + cc] * t; }
        u32x4 o; o.x = pk2(acc[0], acc[1]); o.y = pk2(acc[2], acc[3]); o.z = pk2(acc[4], acc[5]); o.w = pk2(acc[6], acc[7]);
        *(u32x4*)((bf16*)(C.ws + WS_WTF) + (size_t)(g * 256 + rj) * 1024 + d0 + half * 8) = o;
        __syncthreads();
    }
    {
        LAS float* tc = (LAS float*)lds; LAS float* ts = tc + 2048;
        for (int i = tid; i < 2048; i += 512) { const float a = (float)i * (1.f / 1024.f); tc[i] = cospif(a) * (1.f / 512.f); ts[i] = -sinpif(a) * (1.f / 512.f); }
        __syncthreads();
        for (int item = blk; item < 256; item += G)
            for (int rr = 0; rr < 8; ++rr) { const int k = item * 8 + rr; const int lp0 = tid * 8; const LAS float* tb = lp0 < 2048 ? tc : ts; const int l0 = lp0 & 2047; float v[8];
#pragma unroll
                for (int e = 0; e < 8; ++e) v[e] = tb[(k * (l0 + e)) & 2047];
                u32x4 o; o.x = pk2(v[0], v[1]); o.y = pk2(v[2], v[3]); o.z = pk2(v[4], v[5]); o.w = pk2(v[6], v[7]);
                *(u32x4*)((bf16*)(C.ws + WS_TT) + (size_t)k * 4096 + lp0) = o; }
        __syncthreads();
    }
    {
        LAS float* scr = (LAS float*)lds + wave * (64 * 33);
        const int gw = blk * 8 + wave, NGW = G * 8;
        constexpr int I_IN = 16 * 128, I_F = 8 * 32, I_M = 8 * 32, I_O = 16 * 32;
        for (int it = gw; it < I_IN + I_F + I_M + I_O; it += NGW) {
            int r = it;
            if (r < I_IN) { const int kb = r >> 7, nb = r & 127; const int n0 = nb < 64 ? 512 + 32 * nb : 2576 + 32 * (nb - 64);
                transpose_item(C.w_in, INC, n0, kb * 64, (bf16*)(C.ws + WS_WTM), 32 * nb, 1024, scr, lane); continue; }
            r -= I_IN;
            if (r < I_F) { const int kb = r >> 5, nb = r & 31; transpose_item(C.w_fourier, 1024, 32 * nb, kb * 64, (bf16*)(C.ws + WS_WFT), 32 * nb, 512, scr, lane); continue; }
            r -= I_F;
            if (r < I_M) { const int kb = r >> 5, nb = r & 31; transpose_item(C.w_mlstm, 1024, 32 * nb, kb * 64, (bf16*)(C.ws + WS_WMT), 32 * nb, 512, scr, lane); continue; }
            r -= I_M;
            { const int kb = r >> 5, nb = r & 31; transpose_item(C.w_out, 1024, 32 * nb, kb * 64, (bf16*)(C.ws + WS_WOT), 32 * nb, 1024, scr, lane); }
        }
    }
}
__device__ __forceinline__ void convert_experts(const Ctx& C, LAS unsigned char* lds, int lane, int wave, int G) {
    LAS float* scr = (LAS float*)lds + wave * (64 * 33);
    const int gw = blockIdx.x * 8 + wave, NGW = G * 8;
    for (int it = gw; it < 48 * 512; it += NGW) {
        const int mat = it >> 9, r = it & 511, kb = r >> 5, nb = r & 31, e = mat & 15, which = mat >> 4;
        if (which < 2) { const float* W = (which ? C.w_up_e : C.w_gate_e) + (size_t)e * 1024 * 1024; const int n0 = 32 * nb;
            transpose_item(W, 1024, n0, kb * 64, (bf16*)(C.ws + WS_WGU), e * 2048 + (n0 >> 7) * 256 + which * 128 + (n0 & 127), 1024, scr, lane); }
        else transpose_item(C.w_down_e + (size_t)e * 1024 * 1024, 1024, 32 * nb, kb * 64, (bf16*)(C.ws + WS_WD), e * 1024 + 32 * nb, 1024, scr, lane);
    }
}

__device__ __forceinline__ float butterfly64(float (&v)[64], int lane) {
#pragma unroll
    for (int i = 0; i < 32; ++i) { const bool up = lane & 32; const float send = up ? v[i] : v[i + 32], keep = up ? v[i + 32] : v[i]; v[i] = keep + __shfl_xor(send, 32); }
#pragma unroll
    for (int i = 0; i < 16; ++i) { const bool up = lane & 16; const float send = up ? v[i] : v[i + 16], keep = up ? v[i + 16] : v[i]; v[i] = keep + __shfl_xor(send, 16); }
#pragma unroll
    for (int i = 0; i < 8; ++i) { const bool up = lane & 8; const float send = up ? v[i] : v[i + 8], keep = up ? v[i + 8] : v[i]; v[i] = keep + __shfl_xor(send, 8); }
#pragma unroll
    for (int i = 0; i < 4; ++i) { const bool up = lane & 4; const float send = up ? v[i] : v[i + 4], keep = up ? v[i + 4] : v[i]; v[i] = keep + __shfl_xor(send, 4); }
#pragma unroll
    for (int i = 0; i < 2; ++i) { const bool up = lane & 2; const float send = up ? v[i] : v[i + 2], keep = up ? v[i + 2] : v[i]; v[i] = keep + __shfl_xor(send, 2); }
    { const bool up = lane & 1; const float send = up ? v[0] : v[1], keep = up ? v[1] : v[0]; v[0] = keep + __shfl_xor(send, 1); }
    return v[0];
}

__device__ __forceinline__ float rows4_norm_proj(const float* xin, size_t row0, const f32x4 (&gsc)[4], const f32x4 (&sh)[4], bf16* hout, const LAS float* wl, int lane) {
    f32x4 v[4][4]; float ss[4];
#pragma unroll
    for (int r = 0; r < 4; ++r) { ss[r] = 0.f;
#pragma unroll
        for (int j = 0; j < 4; ++j) { v[r][j] = *(const f32x4*)(xin + (row0 + r) * 1024 + 4 * lane + 256 * j); ss[r] += v[r][j][0] * v[r][j][0] + v[r][j][1] * v[r][j][1] + v[r][j][2] * v[r][j][2] + v[r][j][3] * v[r][j][3]; } }
#pragma unroll
    for (int r = 0; r < 4; ++r) { const float rstd = rsqrtf(wave_sum(ss[r]) * (1.f / 1024.f) + EPS);
#pragma unroll
        for (int j = 0; j < 4; ++j) { v[r][j] = v[r][j] * rstd * gsc[j] + sh[j];
            u32x2 w; w.x = pk2(v[r][j][0], v[r][j][1]); w.y = pk2(v[r][j][2], v[r][j][3]); *(u32x2*)(hout + (row0 + r) * 1024 + 4 * lane + 256 * j) = w; } }
    float acc[64];
#pragma unroll
    for (int i = 0; i < 64; ++i) acc[i] = 0.f;
#pragma unroll
    for (int j = 0; j < 4; ++j)
#pragma unroll
        for (int e = 0; e < 4; ++e) { const LAS float* wp = wl + (4 * lane + 256 * j + e) * 16;
#pragma unroll
            for (int q = 0; q < 4; ++q) { const f32x4 w4 = *(const LAS f32x4*)(wp + 4 * q);
#pragma unroll
                for (int r = 0; r < 4; ++r) { const float hv = v[r][j][e]; acc[r * 16 + 4 * q] += hv * w4[0]; acc[r * 16 + 4 * q + 1] += hv * w4[1]; acc[r * 16 + 4 * q + 2] += hv * w4[2]; acc[r * 16 + 4 * q + 3] += hv * w4[3]; } }
            asm volatile("" ::: "memory"); }
    return butterfly64(acc, lane);
}

__device__ __forceinline__ void p1a_norm_gates(const Ctx& C, LAS unsigned char* lds, int tid, int lane, int wave, int G) {
    LAS float* wl = (LAS float*)lds;
    for (int i = tid; i < 1024 * 16; i += 512) wl[i] = C.w_in[(size_t)(i >> 4) * INC + OFF_G + (i & 15)];
    __syncthreads();
    const float* mod = (const float*)(C.ws + WS_MOD); bf16* H = (bf16*)(C.ws + WS_H); float* gates = (float*)(C.ws + WS_GATES);
    const int NGW = G * 8;
    for (int gw = blockIdx.x * 8 + wave; gw < 2048; gw += NGW) {
        f32x4 gsc[4], sh[4];
        {   const int b = gw >> 6; const float* m = mod + (size_t)b * 6144;
#pragma unroll
            for (int j = 0; j < 4; ++j) { const int col = 4 * lane + 256 * j; const f32x4 g = *(const f32x4*)(C.g_norm1 + col), s = *(const f32x4*)(m + 1024 + col); gsc[j] = g * (s + 1.f); sh[j] = *(const f32x4*)(m + col); }
            for (int q = 0; q < 8; ++q) { const size_t row0 = (size_t)gw * 32 + q * 4; const float gv = rows4_norm_proj(C.x, row0, gsc, sh, H, wl, lane); gates[(row0 + (lane >> 4)) * 16 + (lane & 15)] = gv; } }
        {   const float* m = mod + (size_t)32 * 6144;
#pragma unroll
            for (int j = 0; j < 4; ++j) { const int col = 4 * lane + 256 * j; const f32x4 g = *(const f32x4*)(C.g_norm1 + col), s = *(const f32x4*)(m + 1024 + col); gsc[j] = g * (s + 1.f); sh[j] = *(const f32x4*)(m + col); }
            const size_t row0 = (size_t)gw * 4; const float gv = rows4_norm_proj(C.ctx, row0, gsc, sh, H + (size_t)NTOK * 1024, wl, lane); gates[((size_t)NTOK + row0 + (lane >> 4)) * 16 + (lane & 15)] = gv; }
    }
}

__device__ __forceinline__ void conv_item_x(const Ctx& C, int item, int lane) {
    const int hf = item & 1, cb = (item >> 1) & 3, r = (item >> 3) & 31, b = item >> 8;
    const int ch0 = cb * 256 + 4 * lane; const bf16* src = (const bf16*)(C.ws + WS_PQK) + (size_t)b * SEQ * 1024 + ch0; bf16* dst = (bf16*)(C.ws + WS_QK) + (size_t)b * SEQ * 1024 + ch0;
    f32x4 w[3][3];
#pragma unroll
    for (int dy = 0; dy < 3; ++dy)
#pragma unroll
        for (int dx = 0; dx < 3; ++dx) w[dy][dx] = *(const f32x4*)(C.w_conv + (dy * 3 + dx) * 1024 + ch0);
    const float ksc = cb >= 2 ? 0.08838834764831845f : 1.f;
    const int c0 = hf * 32;
    f32x4 win[3][3];
    auto ld = [&](int rr, int cc) -> f32x4 { if (rr < 0 || rr >= 32 || cc < 0 || cc >= 64) return (f32x4){0.f, 0.f, 0.f, 0.f};
        const u32x2 p = *(const u32x2*)(src + (size_t)(rr * 64 + cc) * 1024); return (f32x4){bflo(p.x), bfhi(p.x), bflo(p.y), bfhi(p.y)}; };
#pragma unroll
    for (int dy = 0; dy < 3; ++dy) { win[dy][1] = ld(r + dy - 1, c0 - 1); win[dy][2] = ld(r + dy - 1, c0); }
    for (int cc = c0; cc < c0 + 32; ++cc) {
#pragma unroll
        for (int dy = 0; dy < 3; ++dy) { win[dy][0] = win[dy][1]; win[dy][1] = win[dy][2]; win[dy][2] = ld(r + dy - 1, cc + 1); }
        f32x4 a = {0.f, 0.f, 0.f, 0.f};
#pragma unroll
        for (int dy = 0; dy < 3; ++dy)
#pragma unroll
            for (int dx = 0; dx < 3; ++dx) a += w[dy][dx] * win[dy][dx];
        u32x2 o; o.x = pk2(silu_f(a[0]) * ksc, silu_f(a[1]) * ksc); o.y = pk2(silu_f(a[2]) * ksc, silu_f(a[3]) * ksc);
        *(u32x2*)(dst + (size_t)(r * 64 + cc) * 1024) = o;
    }
}
__device__ __forceinline__ void conv_item_ctx(const Ctx& C, int item, int lane) {
    const int sg = item & 7, cb = (item >> 3) & 1, b = item >> 4;
    const int kc0 = cb * 256 + 4 * lane; const bf16* src = (const bf16*)(C.ws + WS_PC) + (size_t)b * CL * 1024 + kc0; bf16* dst = (bf16*)(C.ws + WS_KC) + (size_t)b * CL * 512 + kc0;
    f32x4 w[3];
#pragma unroll
    for (int dx = 0; dx < 3; ++dx) w[dx] = *(const f32x4*)(C.w_conv + (3 + dx) * 1024 + 512 + kc0);
    auto ld = [&](int cc) -> f32x4 { if (cc < 0 || cc >= CL) return (f32x4){0.f, 0.f, 0.f, 0.f};
        const u32x2 p = *(const u32x2*)(src + (size_t)cc * 1024); return (f32x4){bflo(p.x), bfhi(p.x), bflo(p.y), bfhi(p.y)}; };
    const int c0 = sg * 32; f32x4 w0, w1 = ld(c0 - 1), w2 = ld(c0);
    for (int cc = c0; cc < c0 + 32; ++cc) { w0 = w1; w1 = w2; w2 = ld(cc + 1);
        const f32x4 a = w[0] * w0 + w[1] * w1 + w[2] * w2; const float ksc = 0.08838834764831845f;
        u32x2 o; o.x = pk2(silu_f(a[0]) * ksc, silu_f(a[1]) * ksc); o.y = pk2(silu_f(a[2]) * ksc, silu_f(a[3]) * ksc);
        *(u32x2*)(dst + (size_t)cc * 512) = o; }
}
__device__ __forceinline__ void p2_conv(const Ctx& C, int lane, int wave, int G) {
    const int NGW = G * 8;
    for (int it = blockIdx.x * 8 + wave; it < NB * 256 + NB * 16; it += NGW) { if (it < NB * 256) conv_item_x(C, it, lane); else conv_item_ctx(C, it - NB * 256, lane); }
}

__device__ __forceinline__ void p3b_combine(const Ctx& C, int tid, int G) {
    const u32x4* po = (const u32x4*)(C.ws + WS_PO); const u32x4* hf = (const u32x4*)(C.ws + WS_HF); const u32x4* hb = (const u32x4*)(C.ws + WS_HB); u32x4* hm = (u32x4*)(C.ws + WS_HM);
    const size_t n = (size_t)NTOK * 512 / 8;
    for (size_t i = (size_t)blockIdx.x * 512 + tid; i < n; i += (size_t)G * 512) { const u32x4 o = po[i], a = hf[i], b = hb[i]; u32x4 r;
        r.x = pk2(bflo(o.x) * (bflo(a.x) + bflo(b.x)), bfhi(o.x) * (bfhi(a.x) + bfhi(b.x))); r.y = pk2(bflo(o.y) * (bflo(a.y) + bflo(b.y)), bfhi(o.y) * (bfhi(a.y) + bfhi(b.y)));
        r.z = pk2(bflo(o.z) * (bflo(a.z) + bflo(b.z)), bfhi(o.z) * (bfhi(a.z) + bfhi(b.z))); r.w = pk2(bflo(o.w) * (bflo(a.w) + bflo(b.w)), bfhi(o.w) * (bfhi(a.w) + bfhi(b.w)));
        hm[i] = r; }
}

__device__ __forceinline__ void p6_norm_router(const Ctx& C, LAS unsigned char* lds, int tid, int lane, int wave, int G) {
    LAS float* wl = (LAS float*)lds;
    for (int i = tid; i < 1024 * 16; i += 512) wl[i] = C.w_router[i];
    __syncthreads();
    const float* mod = (const float*)(C.ws + WS_MOD); bf16* HX2 = (bf16*)(C.ws + WS_HX2); float* aff = (float*)(C.ws + WS_AFF);
    const int NGW = G * 8;
    for (int gw = blockIdx.x * 8 + wave; gw < 2048; gw += NGW) {
        f32x4 gsc[4], sh[4]; const int b = gw >> 6; const float* m = mod + (size_t)b * 6144;
#pragma unroll
        for (int j = 0; j < 4; ++j) { const int col = 4 * lane + 256 * j; const f32x4 g = *(const f32x4*)(C.g_norm2 + col), s = *(const f32x4*)(m + 4096 + col); gsc[j] = g * (s + 1.f); sh[j] = *(const f32x4*)(m + 3072 + col); }
        for (int q = 0; q < 8; ++q) { const size_t row0 = (size_t)gw * 32 + q * 4; const float lg = rows4_norm_proj(C.out, row0, gsc, sh, HX2, wl, lane);
            float mx = lg;
#pragma unroll
            for (int o = 1; o < 16; o <<= 1) mx = fmaxf(mx, __shfl_xor(mx, o));
            const float ex = expf(lg - mx); float sm = ex;
#pragma unroll
            for (int o = 1; o < 16; o <<= 1) sm += __shfl_xor(sm, o);
            const size_t t = (row0 + (lane >> 4)) & (SEQ - 1);
            aff[((size_t)b * NE + (lane & 15)) * SEQ + t] = ex / sm; }
    }
}

__device__ __forceinline__ unsigned wave_sum_u(unsigned v) {
#pragma unroll
    for (int o = 1; o < 64; o <<= 1) v += __shfl_xor(v, o);
    return v;
}
__device__ __forceinline__ unsigned wave_excl_scan_u(unsigned v, int lane) { unsigned s = v;
#pragma unroll
    for (int o = 1; o < 64; o <<= 1) { const unsigned t = __shfl_up(s, o); if (lane >= o) s += t; }
    return s - v;
}
__device__ __forceinline__ void topk_item(const Ctx& C, int item, int lane) {
    const int b = item >> 4, e = item & 15; const float* a = (const float*)(C.ws + WS_AFF) + ((size_t)b * NE + e) * SEQ + 32 * lane;
    unsigned key[32];
#pragma unroll
    for (int q = 0; q < 8; ++q) { const u32x4 v = *(const u32x4*)(a + 4 * q); key[4 * q] = v.x; key[4 * q + 1] = v.y; key[4 * q + 2] = v.z; key[4 * q + 3] = v.w; }
    unsigned T = 0u;
    for (int bit = 30; bit >= 0; --bit) { const unsigned cand = T | (1u << bit); unsigned cnt = 0u;
#pragma unroll
        for (int i = 0; i < 32; ++i) cnt += key[i] >= cand ? 1u : 0u;
        if (wave_sum_u(cnt) >= (unsigned)CAP) T = cand; }
    unsigned ngt = 0u, neq = 0u;
#pragma unroll
    for (int i = 0; i < 32; ++i) { ngt += key[i] > T ? 1u : 0u; neq += key[i] == T ? 1u : 0u; }
    const unsigned need = (unsigned)CAP - wave_sum_u(ngt);
    unsigned tie_before = wave_excl_scan_u(neq, lane);
    unsigned nsel = 0u; unsigned selmask = 0u;
#pragma unroll
    for (int i = 0; i < 32; ++i) { bool s = key[i] > T; if (key[i] == T) { s = tie_before < need; ++tie_before; } if (s) { selmask |= 1u << i; ++nsel; } }
    unsigned slot = wave_excl_scan_u(nsel, lane);
    const int pm = e * 32 + b; int* idx = (int*)(C.ws + WS_IDX) + (size_t)pm * CAP; float* val = (float*)(C.ws + WS_VAL) + (size_t)pm * CAP; bf16* sl = (bf16*)(C.ws + WS_SLOT);
#pragma unroll
    for (int i = 0; i < 32; ++i) { const int t = 32 * lane + i; const bool s = (selmask >> i) & 1u;
        if (s) { idx[slot] = b * SEQ + t; val[slot] = __uint_as_float(key[i]); }
        sl[((size_t)b * SEQ + t) * NE + e] = s ? (bf16)slot : (bf16)0xffffu; if (s) ++slot; }
}

__device__ __forceinline__ void p10_final(const Ctx& C, int lane, int wave, int G) {
    const float* mod = (const float*)(C.ws + WS_MOD); const bf16* Y = (const bf16*)(C.ws + WS_Y); const bf16* sl = (const bf16*)(C.ws + WS_SLOT);
    const int NGW = G * 8;
    for (int gw = blockIdx.x * 8 + wave; gw < 2048; gw += NGW) { const int b = gw >> 6; const float* m = mod + (size_t)b * 6144 + 5120;
        f32x4 ga[4], gf[4];
#pragma unroll
        for (int j = 0; j < 4; ++j) { ga[j] = *(const f32x4*)(m + 4 * lane + 256 * j); gf[j] = *(const f32x4*)(C.g_final + 4 * lane + 256 * j); }
        for (int q = 0; q < 32; ++q) { const size_t row = (size_t)gw * 32 + q; f32x4 v[4], a[4];
#pragma unroll
            for (int j = 0; j < 4; ++j) { v[j] = *(const f32x4*)(C.out + row * 1024 + 4 * lane + 256 * j); a[j] = (f32x4){0.f, 0.f, 0.f, 0.f}; }
            const unsigned myslot = lane < NE ? (unsigned)sl[row * NE + lane] : 0xffffu;
            for (int e = 0; e < NE; ++e) { const unsigned s = __builtin_amdgcn_readlane(myslot, e); if (s != 0xffffu) { const bf16* yr = Y + ((size_t)(e * 32 + b) * CAP + s) * 1024 + 4 * lane;
#pragma unroll
                for (int j = 0; j < 4; ++j) { const u32x2 p = *(const u32x2*)(yr + 256 * j); a[j] += (f32x4){bflo(p.x), bfhi(p.x), bflo(p.y), bfhi(p.y)}; } } }
            float ss = 0.f;
#pragma unroll
            for (int j = 0; j < 4; ++j) { v[j] = v[j] + ga[j] * a[j]; ss += v[j][0] * v[j][0] + v[j][1] * v[j][1] + v[j][2] * v[j][2] + v[j][3] * v[j][3]; }
            const float rstd = rsqrtf(wave_sum(ss) * (1.f / 1024.f) + EPS);
#pragma unroll
            for (int j = 0; j < 4; ++j) *(f32x4*)(C.out + row * 1024 + 4 * lane + 256 * j) = v[j] * rstd * gf[j]; }
    }
}
namespace ml {
typedef short v4i16_t __attribute__((ext_vector_type(4)));
constexpr int QS = 0, KS = 16384, VS = 32768, CT = 49152, SS = 81920, SM = 90112;
constexpr int U_ = 0, M_ = 64, DEC_ = 128, EM_ = 192, WA_ = 256, QN_ = 320, RS_ = 384, N_ = 512, SC_ = 640;
__device__ __forceinline__ unsigned off_b(unsigned row, unsigned ch) { return 256u * row + 16u * (ch ^ (((row & 3) << 2) | ((row >> 2) & 3))); }
__device__ __forceinline__ unsigned off_s(unsigned row, unsigned ch) { return 128u * row + 16u * (ch ^ (row & 7)); }
__device__ __forceinline__ bf16x8 rowfrag(const LAS unsigned char* tile, int rb, int ks, int lane) { return *(const LAS bf16x8*)(tile + off_b(16 * rb + (lane & 15), 4 * ks + (lane >> 4))); }
__device__ __forceinline__ bf16x8 trfrag(const LAS unsigned char* tile, int c, int ks, int lane) {
    const unsigned g = lane >> 4, q = (lane & 15) >> 2, p = lane & 3;
    const unsigned a0 = off_b(32 * ks + 8 * g + q, 2 * c + (p >> 1)) + 8 * (p & 1), a1 = off_b(32 * ks + 8 * g + 4 + q, 2 * c + (p >> 1)) + 8 * (p & 1);
    const v4i16_t lo = __builtin_amdgcn_ds_read_tr16_b64_v4i16((LAS v4i16_t*)(tile + a0)), hi = __builtin_amdgcn_ds_read_tr16_b64_v4i16((LAS v4i16_t*)(tile + a1));
    bf16x8 r; r[0] = lo[0]; r[1] = lo[1]; r[2] = lo[2]; r[3] = lo[3]; r[4] = hi[0]; r[5] = hi[1]; r[6] = hi[2]; r[7] = hi[3]; return r;
}
__device__ __forceinline__ float scan_add(float v, int lane, int dir) {
#pragma unroll
    for (int d = 1; d < 64; d <<= 1) { const float t = dir ? __shfl_down(v, d) : __shfl_up(v, d); if (dir ? (lane + d < 64) : (lane >= d)) v += t; }
    return v;
}
__device__ __forceinline__ float scan_max(float v, int lane, int dir) {
#pragma unroll
    for (int d = 1; d < 64; d <<= 1) { const float t = dir ? __shfl_down(v, d) : __shfl_up(v, d); if (dir ? (lane + d < 64) : (lane >= d)) v = fmaxf(v, t); }
    return v;
}
__device__ __forceinline__ void gate_math(float ig, float fg, int lane, int dir, float& m0, LAS float* sm) {
    const float fl = log_sigmoid_f(fg);
    const float cum = scan_add(fl, lane, dir);
    const float u = ig - cum;
    const float pmx = scan_max(u, lane, dir);
    const int endl = dir ? 0 : 63;
    const float tot = __shfl(cum, endl), umax = __shfl(pmx, endl);
    const float M = fmaxf(m0, pmx);
    const float mn = fmaxf(tot + m0, tot + umax);
    sm[U_ + lane] = u; sm[M_ + lane] = M; sm[DEC_ + lane] = expf(m0 - M); sm[EM_ + lane] = expf(-(cum + M)); sm[WA_ + lane] = expf(tot + u - mn);
    if (lane == 0) sm[SC_] = expf(tot + m0 - mn);
    m0 = mn;
}

__device__ __forceinline__ void mlstm_phase(const Ctx& C, LAS unsigned char* lds, int tid, int lane, int wave, int G) {
    LAS float* sm = (LAS float*)(lds + SM);
    const bf16* QK = (const bf16*)(C.ws + WS_QK); const bf16* KC = (const bf16*)(C.ws + WS_KC); const bf16* PV = (const bf16*)(C.ws + WS_PV); const bf16* PC = (const bf16*)(C.ws + WS_PC);
    const float* gates = (const float*)(C.ws + WS_GATES);
    for (int item = blockIdx.x; item < 256; item += G) {
        const int dir = item & 1, h = (item >> 1) & 3, b = item >> 3;
        bf16* Hout = (bf16*)(C.ws + (dir ? WS_HB : WS_HF));
        const int kI = dir ? 2 : 0, kF = dir ? 3 : 1; const float bI = C.b_gates[kI * 4 + h], bF = C.b_gates[kF * 4 + h];
        for (int i = tid; i < 32768 / 16; i += 512) *(LAS u32x4*)(lds + CT + i * 16) = (u32x4){0u, 0u, 0u, 0u};
        if (tid < 128) sm[N_ + tid] = 0.f;
        f32x4 Cacc[8];
#pragma unroll
        for (int t = 0; t < 8; ++t) Cacc[t] = (f32x4){0.f, 0.f, 0.f, 0.f};
        float m0 = 0.f;
        u32x4 pq[2], pk[2], pv[2]; float pig = 0.f, pfg = 0.f;
#define ML_ISSUE(step_) do { const int _st = (step_); const bool _isx = _st >= 4; const int _cc = _isx ? (dir ? 35 - _st : _st - 4) : (dir ? 3 - _st : _st); \
            _Pragma("unroll") for (int _i = 0; _i < 2; ++_i) { const int _idx = tid + 512 * _i, _row = _idx >> 4, _ch = _idx & 15; \
                if (_isx) { const size_t _tok = (size_t)b * SEQ + _cc * 64 + _row; pq[_i] = *(const u32x4*)(QK + _tok * 1024 + h * 128 + _ch * 8); pk[_i] = *(const u32x4*)(QK + _tok * 1024 + 512 + h * 128 + _ch * 8); pv[_i] = *(const u32x4*)(PV + _tok * 512 + h * 128 + _ch * 8); } \
                else { const size_t _tok = (size_t)b * CL + _cc * 64 + _row; pk[_i] = *(const u32x4*)(KC + _tok * 512 + h * 128 + _ch * 8); pv[_i] = *(const u32x4*)(PC + _tok * 1024 + 512 + h * 128 + _ch * 8); pq[_i] = pk[_i]; } } \
            if (wave == 0) { const size_t _tok = _isx ? (size_t)b * SEQ + _cc * 64 + lane : (size_t)NTOK + (size_t)b * CL + _cc * 64 + lane; pig = gates[_tok * 16 + kI * 4 + h] + bI; pfg = gates[_tok * 16 + kF * 4 + h] + bF; } } while (0)
#define ML_COMMIT() do { \
            _Pragma("unroll") for (int _i = 0; _i < 2; ++_i) { const int _idx = tid + 512 * _i, _row = _idx >> 4, _ch = _idx & 15; const unsigned _o = off_b(_row, _ch); \
                *(LAS u32x4*)(lds + QS + _o) = pq[_i]; *(LAS u32x4*)(lds + KS + _o) = pk[_i]; *(LAS u32x4*)(lds + VS + _o) = pv[_i]; } \
            if (wave == 0) gate_math(pig, pfg, lane, dir, m0, sm); } while (0)
        ML_ISSUE(0);
        __syncthreads();
        ML_COMMIT();
        __syncthreads();
        const int g = lane >> 4, li = lane & 15;
        for (int step = 0; step < 36; ++step) {
            const bool isx = step >= 4; const int cc = isx ? (dir ? 35 - step : step - 4) : 0;
            if (!isx && step + 1 < 36) ML_ISSUE(step + 1);
            if (isx) {
                const int jt = wave >> 1, j = 16 * jt + li;
                {   const int jr = tid >> 3, part = tid & 7; float dsum = 0.f;
#pragma unroll
                    for (int c2 = 0; c2 < 2; ++c2) { const u32x4 qv = *(const LAS u32x4*)(lds + QS + off_b(jr, 2 * part + c2)); const LAS float* np = sm + N_ + 16 * part + 8 * c2; const f32x4 n0 = *(const LAS f32x4*)np, n1 = *(const LAS f32x4*)(np + 4);
                        dsum += bflo(qv.x) * n0[0] + bfhi(qv.x) * n0[1] + bflo(qv.y) * n0[2] + bfhi(qv.y) * n0[3] + bflo(qv.z) * n1[0] + bfhi(qv.z) * n1[1] + bflo(qv.w) * n1[2] + bfhi(qv.w) * n1[3]; }
                    dsum += __shfl_xor(dsum, 1); dsum += __shfl_xor(dsum, 2); dsum += __shfl_xor(dsum, 4);
                    if (part == 0) sm[QN_ + jr] = dsum; }
                bf16x8 qf[4];
#pragma unroll
                for (int ks = 0; ks < 4; ++ks) qf[ks] = rowfrag(lds + QS, jt, ks, lane);
                const float Mj = sm[M_ + j]; float rsum = 0.f;
#pragma unroll
                for (int t = 0; t < 2; ++t) { const int st = 2 * (wave & 1) + t; f32x4 sa = {0.f, 0.f, 0.f, 0.f};
#pragma unroll
                    for (int ks = 0; ks < 4; ++ks) sa = __builtin_amdgcn_mfma_f32_16x16x32_bf16(rowfrag(lds + KS, st, ks, lane), qf[ks], sa, 0, 0, 0);
                    const int s0 = 16 * st + 4 * g; const f32x4 u4 = *(const LAS f32x4*)(sm + U_ + s0); float sp[4];
#pragma unroll
                    for (int r = 0; r < 4; ++r) { const int s = s0 + r; const bool keep = dir ? (s >= j) : (s <= j); const float dv = expf(fminf(u4[r] - Mj, 0.f)); sp[r] = keep ? sa[r] * dv : 0.f; rsum += sp[r]; }
                    u32x2 w; w.x = pk2(sp[0], sp[1]); w.y = pk2(sp[2], sp[3]);
                    *(LAS u32x2*)(lds + SS + off_s(j, 2 * st + (g >> 1)) + (g & 1) * 8) = w; }
                rsum += __shfl_xor(rsum, 16); rsum += __shfl_xor(rsum, 32);
                if (g == 0) sm[RS_ + 2 * j + (wave & 1)] = rsum;
                __syncthreads();
                if (step + 1 < 36) ML_ISSUE(step + 1);
                f32x4 oa[4];
#pragma unroll
                for (int t = 0; t < 4; ++t) { const int dvt = 4 * (wave & 1) + t; oa[t] = (f32x4){0.f, 0.f, 0.f, 0.f};
#pragma unroll
                    for (int ks = 0; ks < 4; ++ks) oa[t] = __builtin_amdgcn_mfma_f32_16x16x32_bf16(rowfrag(lds + CT, dvt, ks, lane), rowfrag(lds + QS, jt, ks, lane), oa[t], 0, 0, 0); }
                const float dj = sm[DEC_ + j];
                bf16x8 sf[2];
#pragma unroll
                for (int ks = 0; ks < 2; ++ks) sf[ks] = *(const LAS bf16x8*)(lds + SS + off_s(j, 4 * ks + g));
                const float den = (sm[RS_ + 2 * j] + sm[RS_ + 2 * j + 1]) + dj * sm[QN_ + j];
                const float inv = 1.f / fmaxf(fabsf(den), sm[EM_ + j]);
                const size_t tok = (size_t)b * SEQ + cc * 64 + j;
#pragma unroll
                for (int t = 0; t < 4; ++t) { const int dvt = 4 * (wave & 1) + t; f32x4 o = oa[t] * dj;
#pragma unroll
                    for (int ks = 0; ks < 2; ++ks) o = __builtin_amdgcn_mfma_f32_16x16x32_bf16(trfrag(lds + VS, dvt, ks, lane), sf[ks], o, 0, 0, 0);
                    o = o * inv; u32x2 w; w.x = pk2(o[0], o[1]); w.y = pk2(o[2], o[3]);
                    *(u32x2*)(Hout + tok * 512 + h * 128 + 16 * dvt + 4 * g) = w; }
            }
            {   const float dn = sm[SC_];
                bf16x8 kf[2];
#pragma unroll
                for (int ks = 0; ks < 2; ++ks) { const bf16x8 kr = trfrag(lds + KS, wave, ks, lane); const f32x4 w0 = *(const LAS f32x4*)(sm + WA_ + 32 * ks + 8 * g), w1 = *(const LAS f32x4*)(sm + WA_ + 32 * ks + 8 * g + 4);
                    u32x4 pkd; pkd.x = pk2(bf1((bf16)kr[0]) * w0[0], bf1((bf16)kr[1]) * w0[1]); pkd.y = pk2(bf1((bf16)kr[2]) * w0[2], bf1((bf16)kr[3]) * w0[3]);
                    pkd.z = pk2(bf1((bf16)kr[4]) * w1[0], bf1((bf16)kr[5]) * w1[1]); pkd.w = pk2(bf1((bf16)kr[6]) * w1[2], bf1((bf16)kr[7]) * w1[3]);
                    kf[ks] = __builtin_bit_cast(bf16x8, pkd); }
                {   const int dk = tid >> 2, part = tid & 3; float a = 0.f;
#pragma unroll
                    for (int e = 0; e < 16; ++e) { const int s = 16 * part + e; a += sm[WA_ + s] * bf1(*(const LAS bf16*)(lds + KS + off_b(s, dk >> 3) + (dk & 7) * 2)); }
                    a += __shfl_xor(a, 1); a += __shfl_xor(a, 2);
                    if (part == 0) sm[N_ + dk] = dn * sm[N_ + dk] + a; }
#pragma unroll
                for (int dvt = 0; dvt < 8; ++dvt) { f32x4 c = Cacc[dvt] * dn;
#pragma unroll
                    for (int ks = 0; ks < 2; ++ks) c = __builtin_amdgcn_mfma_f32_16x16x32_bf16(kf[ks], trfrag(lds + VS, dvt, ks, lane), c, 0, 0, 0);
                    Cacc[dvt] = c; }
            }
            __syncthreads();
#pragma unroll
            for (int dvt = 0; dvt < 8; ++dvt) { const f32x4 c = Cacc[dvt]; u32x2 w; w.x = pk2(c[0], c[1]); w.y = pk2(c[2], c[3]);
                *(LAS u32x2*)(lds + CT + off_b(16 * dvt + li, 2 * wave + (g >> 1)) + (g & 1) * 8) = w; }
            if (step + 1 < 36) ML_COMMIT();
            __syncthreads();
        }
    }
}
#undef ML_ISSUE
#undef ML_COMMIT
}
constexpr int N_PHASES = 13;
struct Args { const float* in[19]; float* out; unsigned char* ws; int ph_lo, ph_hi; };
static_assert(sizeof(Args) == 19 * 8 + 8 + 8 + 8, "Args has no padding");

__global__ void __launch_bounds__(512, 2) mk_fwd(Args a) {
    extern __shared__ __attribute__((aligned(16))) unsigned char lds_raw[];
    LAS unsigned char* lds = (LAS unsigned char*)lds_raw;
    const int tid = threadIdx.x, lane = tid & 63, wave = __builtin_amdgcn_readfirstlane(tid >> 6), G = gridDim.x;
    Ctx C;
    C.x = a.in[0]; C.c = a.in[1]; C.ctx = a.in[2]; C.c_ctx = a.in[3]; C.w_ada = a.in[4]; C.b_ada = a.in[5]; C.g_norm1 = a.in[6]; C.w_in = a.in[7]; C.b_gates = a.in[8]; C.w_conv = a.in[9];
    C.w_fourier = a.in[10]; C.w_mlstm = a.in[11]; C.w_out = a.in[12]; C.g_norm2 = a.in[13]; C.w_router = a.in[14]; C.w_gate_e = a.in[15]; C.w_up_e = a.in[16]; C.w_down_e = a.in[17]; C.g_final = a.in[18];
    C.out = a.out; C.ws = a.ws;
    const int lo = a.ph_lo, hi = a.ph_hi;
#if MK_XCD_BAR
    volatile LAS unsigned* bst = (volatile LAS unsigned*)(lds + LDS_BYTES - 16);
    if (tid < 4) bst[tid] = 0u;
    __syncthreads();
    XcdBarrier bar = xcd_barrier_post((unsigned*)(a.ws + WS_CTL) + 4096, bst);
#endif
    int nsync = 0;
#define IN(k) (lo <= (k) && (k) < hi)
#if MK_XCD_BAR
#define SEAM(k) do { if (IN(k) && IN((k) + 1)) { if (nsync == 0) cg::this_grid().sync(); else xcd_barrier(bar); ++nsync; } } while (0)
#else
#define SEAM(k) do { if (IN(k) && IN((k) + 1)) { cg::this_grid().sync(); ++nsync; } } while (0)
#endif
    if (IN(0)) { p0_prep(C, lds, tid, lane, wave, G); }
    SEAM(0);
    if (IN(1)) { p1a_norm_gates(C, lds, tid, lane, wave, G); __syncthreads(); }
    SEAM(1);
    if (IN(2)) { SchedP1 S{C.ws, G, (int)blockIdx.x}; EpiP1 E{C.ws}; mg::gemm_phase<EpiP1, SchedP1, false>(lds, 1024, S, E); }
    SEAM(2);
    if (IN(3)) { SchedF2 S{C.ws, G, (int)blockIdx.x}; EpiF2 E{C.ws}; mg::gemm_phase<EpiF2, SchedF2, false>(lds, 4096, S, E); p2_conv(C, lane, wave, G); }
    SEAM(3);
    if (IN(4)) { ml::mlstm_phase(C, lds, tid, lane, wave, G); }
    SEAM(4);
    if (IN(5)) { p3b_combine(C, tid, G); }
    SEAM(5);
    if (IN(6)) { SchedMerge S{C.ws, G, (int)blockIdx.x}; EpiMerge E{C.ws}; mg::gemm_phase<EpiMerge, SchedMerge, false>(lds, 512, S, E); }
    SEAM(6);
    if (IN(7)) { SchedOut S{C.ws, G, (int)blockIdx.x}; EpiOut E{C.x, (const float*)(C.ws + WS_MOD), C.out}; mg::gemm_phase<EpiOut, SchedOut, false>(lds, 1024, S, E); }
    SEAM(7);
    if (IN(8)) { p6_norm_router(C, lds, tid, lane, wave, G); __syncthreads(); }
    SEAM(8);
    if (IN(9)) { const int NGW = G * 8; for (int it = blockIdx.x * 8 + wave; it < NB * NE; it += NGW) topk_item(C, it, lane); convert_experts(C, lds, lane, wave, G); __syncthreads(); }
    SEAM(9);
    if (IN(10)) { SchedUp S{C.ws, G, (int)blockIdx.x}; EpiSwiglu E{C.ws}; mg::gemm_phase<EpiSwiglu, SchedUp, true>(lds, 1024, S, E); }
    SEAM(10);
    if (IN(11)) { SchedDown S{C.ws, G, (int)blockIdx.x}; EpiDown E{C.ws}; mg::gemm_phase<EpiDown, SchedDown, false>(lds, 1024, S, E); }
    SEAM(11);
    if (IN(12)) { p10_final(C, lane, wave, G); }
#undef IN
#undef SEAM
}

static void mk_launch(void* const* d_in, void* d_out, void* d_ws, hipStream_t stream, int lo, int hi, bool coop) {
    static int grid = 0;
    if (grid == 0) {
        int dev = 0, cus = 0, per_cu = 0;
        (void)hipGetDevice(&dev); (void)hipDeviceGetAttribute(&cus, hipDeviceAttributeMultiprocessorCount, dev);
        (void)hipFuncSetAttribute((const void*)mk_fwd, hipFuncAttributeMaxDynamicSharedMemorySize, LDS_BYTES);
        (void)hipOccupancyMaxActiveBlocksPerMultiprocessor(&per_cu, (const void*)mk_fwd, 512, LDS_BYTES);
        if (per_cu < 1) fprintf(stderr, "mk_launch: occupancy query says %d blocks/CU\n", per_cu);
        grid = cus > 0 ? cus : 256;
    }
    Args a{};
    for (int i = 0; i < 19; ++i) a.in[i] = (const float*)d_in[i];
    a.out = (float*)d_out; a.ws = (unsigned char*)d_ws; a.ph_lo = lo; a.ph_hi = hi;
    if (coop) { void* args[] = {&a}; hipError_t e = hipLaunchCooperativeKernel((const void*)mk_fwd, dim3(grid), dim3(512), args, LDS_BYTES, stream);
        if (e != hipSuccess) fprintf(stderr, "cooperative launch failed: %s (grid %d)\n", hipGetErrorString(e), grid); }
    else hipLaunchKernelGGL(mk_fwd, dim3(grid), dim3(512), LDS_BYTES, stream, a);
}
extern "C" void kernel_launch(void* const* d_in, const int* in_sizes, int n_in, void* d_out, int out_size, void* d_ws, size_t ws_size, hipStream_t stream) {
    (void)hipMemsetAsync((char*)d_ws + WS_CTL, 0, 65536, stream);
    mk_launch(d_in, d_out, d_ws, stream, 0, N_PHASES, true);
}
```

```cpp
#ifndef MK_XCD_BAR
#define MK_XCD_BAR 1
#endif
#include <hip/hip_runtime.h>
#include <hip/hip_cooperative_groups.h>
#include <cstdio>
#include <cstdint>
namespace cg = cooperative_groups;

#define LAS __attribute__((address_space(3)))
typedef unsigned short bf16;
typedef short bf16x8 __attribute__((ext_vector_type(8)));
typedef short s16x4 __attribute__((ext_vector_type(4)));
typedef float f32x4 __attribute__((ext_vector_type(4)));
typedef float f32x2 __attribute__((ext_vector_type(2)));
typedef unsigned u32x4 __attribute__((ext_vector_type(4)));
typedef unsigned u32x2 __attribute__((ext_vector_type(2)));
typedef __bf16 bf16x2_t __attribute__((ext_vector_type(2)));

__device__ __forceinline__ unsigned pk2(float lo, float hi) { f32x2 v = {lo, hi}; bf16x2_t b = __builtin_convertvector(v, bf16x2_t); return __builtin_bit_cast(unsigned, b); }
__device__ __forceinline__ float bflo(unsigned w) { return __uint_as_float(w << 16); }
__device__ __forceinline__ float bfhi(unsigned w) { return __uint_as_float(w & 0xffff0000u); }
__device__ __forceinline__ float bf1(bf16 b) { return __uint_as_float((unsigned)b << 16); }
__device__ __forceinline__ float silu_f(float v) { return v / (1.f + __expf(-v)); }
__device__ __forceinline__ float sigmoid_f(float v) { return 1.f / (1.f + __expf(-v)); }
__device__ __forceinline__ float log_sigmoid_f(float v) { return fminf(v, 0.f) - log1pf(expf(-fabsf(v))); }
__device__ __forceinline__ float wave_sum(float v) {
#pragma unroll
    for (int o = 1; o < 64; o <<= 1) v += __shfl_xor(v, o);
    return v;
}

#define XB_TMO      128
#define XB_XCNT(j)  (256  + 64 * (j))
#define XB_XSUB(j)  (1280 + 64 * (j))
#define XB_XGEN(j)  (2304 + 64 * (j))
#define XB_TOP      3328
#define XB_TOPGEN   3392
#define XCD_BAR_WORDS 3456
#define XB_SPIN_CAP (1u << 20)
__device__ __forceinline__ unsigned xb_ld(unsigned* p)              { return __hip_atomic_load(p, __ATOMIC_RELAXED, __HIP_MEMORY_SCOPE_AGENT); }
__device__ __forceinline__ unsigned xb_add(unsigned* p, unsigned v) { return __hip_atomic_fetch_add(p, v, __ATOMIC_RELAXED, __HIP_MEMORY_SCOPE_AGENT); }
__device__ __forceinline__ unsigned xb_xcc_id() { return (unsigned)__builtin_amdgcn_s_getreg((3 << 11) | 20) & 0xFu; }
#define XB_SPIN(cond, bar) do { unsigned _sp = 0; while (cond) { __builtin_amdgcn_s_sleep(1); \
    if ((++_sp & 255u) == 0u) { if (xb_ld(&(bar)[XB_TMO])) break; if (_sp > XB_SPIN_CAP) { atomicAdd(&(bar)[XB_TMO], 1u); break; } } } } while (0)
struct XcdBarrier { unsigned* bar; unsigned x; volatile LAS unsigned* st; };
__device__ __forceinline__ XcdBarrier xcd_barrier_post(unsigned* bar, volatile LAS unsigned* st) {
    XcdBarrier b; b.bar = bar; b.x = xb_xcc_id(); b.st = st;
    if (threadIdx.x == 0) (void)xb_add(&bar[XB_XCNT(b.x)], 1u);
    return b;
}
__device__ __forceinline__ void xcd_barrier_complete(unsigned* bar, unsigned x, unsigned& nloc, unsigned& nx) {
    const unsigned G = gridDim.x * gridDim.y * gridDim.z;
    unsigned sum, cnt, mine, sp = 0u;
    for (;;) {
        sum = 0u; cnt = 0u; mine = 0u;
#pragma unroll
        for (unsigned j = 0; j < 16; ++j) { const unsigned c = xb_ld(&bar[XB_XCNT(j)]); sum += c; cnt += (c > 0u) ? 1u : 0u; mine = (j == x) ? c : mine; }
        if (sum == G) break;
        __builtin_amdgcn_s_sleep(1);
        if ((++sp & 255u) == 0u) { if (xb_ld(&bar[XB_TMO])) break; if (sp > XB_SPIN_CAP) { atomicAdd(&bar[XB_TMO], 1u); break; } }
    }
    nloc = mine > 0u ? mine : 1u; nx = cnt > 0u ? cnt : 1u;
}
__device__ __forceinline__ void xcd_barrier(const XcdBarrier& b) {
    asm volatile("s_waitcnt vmcnt(0)" ::: "memory");
    __syncthreads();
    if (threadIdx.x == 0) {
        unsigned* bar = b.bar;
        __builtin_amdgcn_s_waitcnt(0);
        unsigned nloc = b.st[0], nx = b.st[1];
        if (nloc == 0u) { xcd_barrier_complete(bar, b.x, nloc, nx); b.st[0] = nloc; b.st[1] = nx; }
        const unsigned old = xb_add(&bar[XB_XSUB(b.x)], 1u);
        const unsigned gen = old / nloc;
        if (old + 1u == (gen + 1u) * nloc) {
            __builtin_amdgcn_fence(__ATOMIC_RELEASE, "agent");
            asm volatile("s_waitcnt vmcnt(0)" ::: "memory");
            const unsigned og = xb_add(&bar[XB_TOP], 1u);
            const unsigned tg = og / nx;
            if (og + 1u == (tg + 1u) * nx) xb_add(&bar[XB_TOPGEN], 1u);
            else XB_SPIN(xb_ld(&bar[XB_TOPGEN]) == tg, bar);
            __builtin_amdgcn_fence(__ATOMIC_ACQUIRE, "agent");
            xb_add(&bar[XB_XGEN(b.x)], 1u);
            asm volatile("s_waitcnt vmcnt(0)" ::: "memory");
        } else {
            XB_SPIN(xb_ld(&bar[XB_XGEN(b.x)]) == gen, bar);
            __builtin_amdgcn_fence(__ATOMIC_ACQUIRE, "agent");
            asm volatile("s_waitcnt vmcnt(0)" ::: "memory");
        }
    }
    __syncthreads();
}

namespace mg {
constexpr int BM = 256, BK = 64, HALF = 128, HTB = HALF * BK * 2, STAGE_BYTES = 8 * HTB, NXCD = 8, WGM = 8;
__host__ __device__ __forceinline__ int lds_byte(int r, int c) { const int st = (r >> 4) * 2 + (c >> 5), rr = r & 15, cc = c & 31, ob = rr * 64 + cc * 2; return st * 1024 + (ob ^ (((ob >> 9) & 1) << 5)); }
__host__ __device__ __forceinline__ void stage_rc(int b, int& R, int& C) { const int st = b / 1024, sb = b % 1024, swz = sb ^ (((sb >> 9) & 1) << 5); R = (st >> 1) * 16 + swz / 64; C = (st & 1) * 32 + (swz % 64) / 2; }
__host__ __device__ __forceinline__ int perm32(int rho) { const int n = rho >> 4, i = rho & 15; return 8 * (i >> 2) + 4 * n + (i & 3); }

struct Unit { int pm, pn, ty; const char* a; const char* b; const int* gi; };
__device__ __forceinline__ void tile_of(int wgid, int nM, int nN, int& pm, int& pn) {
    const int nwg = nM * nN; { const int q = nwg / NXCD, r = nwg % NXCD, xcd = wgid % NXCD, off = wgid / NXCD; wgid = (xcd < r ? xcd * (q + 1) : r * (q + 1) + (xcd - r) * q) + off; }
    const int nig = WGM * nN, gid = wgid / nig, fm = gid * WGM, gsz = (nM - fm) < WGM ? (nM - fm) : WGM;
    pm = fm + ((wgid % nig) % gsz); pn = (wgid % nig) / gsz;
}

template <class Epi, class Sched, bool GATHER>
__device__ __forceinline__ void gemm_phase(LAS unsigned char* lds, const int K, const Sched& S, const Epi& E) {
    const int tid = threadIdx.x, wid = __builtin_amdgcn_readfirstlane(tid >> 6), lane = tid & 63, wr = wid >> 2, wc = wid & 3, fr = lane & 15, fq = lane >> 4;
    const int nt = K / BK;
    unsigned voffB[2], vAc[2][2], vAn[2][2]; int stR[2], stC[2];
    const size_t kstep = (size_t)(BK * 2);
    const size_t hstep = (size_t)HALF * K * 2;
#pragma unroll
    for (int i = 0; i < 2; ++i) { int R, C; stage_rc(tid * 16 + i * 8192, R, C); stR[i] = R; stC[i] = C; const int Rb = Epi::PERM ? ((R & ~31) + perm32(R & 31)) : R;
        voffB[i] = (unsigned)(Rb * K + C) * 2u; }
    const unsigned ldsw = (unsigned)wid * 1024u;
    const int aoff = lds_byte(wr * 64 + fr, fq * 8), boff = lds_byte(wc * 32 + fr, fq * 8);
#define MG_SA(b, h) (((b) * 2 + (h)) * HTB)
#define MG_SB(b, h) ((4 + (b) * 2 + (h)) * HTB)
#define MG_STAGE(bufoff, gbase, voff) do { _Pragma("unroll") for (int _i = 0; _i < 2; ++_i) \
        __builtin_amdgcn_global_load_lds((const unsigned*)((const char*)(gbase) + (voff)[_i]), (LAS unsigned*)(lds + (bufoff) + ldsw + _i * 8192), 16, 0, 0); } while (0)
#define MG_LDA(dst, b, h) do { _Pragma("unroll") for (int m = 0; m < 4; ++m) _Pragma("unroll") for (int k = 0; k < 2; ++k) dst[m][k] = *(const LAS bf16x8*)(lds + MG_SA(b, h) + aoff + m * 2048 + k * 1024); } while (0)
#define MG_LDB(dst, b, h) do { _Pragma("unroll") for (int n = 0; n < 2; ++n) _Pragma("unroll") for (int k = 0; k < 2; ++k) dst[n][k] = *(const LAS bf16x8*)(lds + MG_SB(b, h) + boff + n * 2048 + k * 1024); } while (0)
#define MG_MMA(ai, bj, At, Bt) do { __builtin_amdgcn_s_setprio(1); _Pragma("unroll") for (int m = 0; m < 4; ++m) _Pragma("unroll") for (int n = 0; n < 2; ++n) _Pragma("unroll") for (int k = 0; k < 2; ++k) \
        acc[ai][bj][m][n] = __builtin_amdgcn_mfma_f32_16x16x32_bf16(Bt[n][k], At[m][k], acc[ai][bj][m][n], 0, 0, 0); __builtin_amdgcn_s_setprio(0); } while (0)
#define MG_WAIT_V(n) asm volatile("s_waitcnt vmcnt(" #n ")" ::: "memory")
#define MG_WAIT_L(n) asm volatile("s_waitcnt lgkmcnt(" #n ")" ::: "memory")
#define MG_BAR __builtin_amdgcn_s_barrier()
#define MG_SCHED __builtin_amdgcn_sched_barrier(0)
#define MG_AOFF(dst, u) do { _Pragma("unroll") for (int _h = 0; _h < 2; ++_h) _Pragma("unroll") for (int _i = 0; _i < 2; ++_i) { \
        if constexpr (GATHER) dst[_h][_i] = ((unsigned)(u).gi[_h * HALF + stR[_i]] * (unsigned)K + (unsigned)stC[_i]) * 2u; \
        else dst[_h][_i] = (unsigned)((_h * HALF + stR[_i]) * K + stC[_i]) * 2u; } } while (0)
    Unit cur, nxt; int ui = 0;
    if (!S.next(0, cur)) return;
    f32x4 acc[2][2][4][2];
#pragma unroll
    for (int a = 0; a < 2; ++a)
#pragma unroll
        for (int b = 0; b < 2; ++b)
#pragma unroll
            for (int m = 0; m < 4; ++m)
#pragma unroll
                for (int n = 0; n < 2; ++n) acc[a][b][m][n] = (f32x4){0.f, 0.f, 0.f, 0.f};
    bf16x8 At[4][2], B0[2][2], B1[2][2];
    const char* cA = cur.a; const char* cB = cur.b;
    MG_AOFF(vAc, cur);
    MG_STAGE(MG_SB(0, 0), cB, voffB); MG_STAGE(MG_SB(0, 1), cB + hstep, voffB); MG_STAGE(MG_SA(0, 0), cA, vAc[0]); MG_STAGE(MG_SA(0, 1), cA, vAc[1]);
    if (wr == 1) MG_BAR;
    MG_WAIT_V(2); MG_BAR;
    MG_STAGE(MG_SB(1, 0), cB + kstep, voffB); MG_STAGE(MG_SA(1, 0), cA + kstep, vAc[0]); MG_STAGE(MG_SB(1, 1), cB + hstep + kstep, voffB);
    MG_WAIT_V(6); MG_BAR;
    for (;;) {
        const bool has_next = S.next(ui + 1, nxt);
        const char* nA = has_next ? nxt.a : cA; const char* nB = has_next ? nxt.b : cB;
        if constexpr (GATHER) { if (has_next) { MG_AOFF(vAn, nxt); } else {
#pragma unroll
            for (int h = 0; h < 2; ++h)
#pragma unroll
                for (int i = 0; i < 2; ++i) vAn[h][i] = vAc[h][i]; } }
        for (int t = 0; t < nt; t += 2) {
            const bool last = (t == nt - 2);
            const char* a1 = cA + (size_t)(t + 1) * kstep;
            const char* a2 = last ? nA : cA + (size_t)(t + 2) * kstep; const char* b2 = last ? nB : cB + (size_t)(t + 2) * kstep;
            const char* a3 = a2 + kstep; const char* b3 = b2 + kstep;
            unsigned vA2[2][2];
#pragma unroll
            for (int h = 0; h < 2; ++h)
#pragma unroll
                for (int i = 0; i < 2; ++i) vA2[h][i] = (GATHER && last) ? vAn[h][i] : vAc[h][i];
            MG_LDB(B0, 0, 0); MG_LDB(B1, 0, 1); MG_SCHED; MG_LDA(At, 0, 0); MG_STAGE(MG_SA(1, 1), a1, vAc[1]);
            MG_WAIT_V(8); MG_WAIT_L(0); MG_BAR; MG_MMA(0, 0, At, B0); MG_MMA(0, 1, At, B1); MG_BAR; MG_SCHED;
            MG_LDA(At, 0, 1); MG_STAGE(MG_SB(0, 0), b2, voffB); MG_STAGE(MG_SB(0, 1), b2 + hstep, voffB); MG_STAGE(MG_SA(0, 0), a2, vA2[0]);
            MG_WAIT_V(8); MG_WAIT_L(0); MG_BAR; MG_MMA(1, 0, At, B0); MG_MMA(1, 1, At, B1); MG_BAR; MG_SCHED;
            MG_LDB(B0, 1, 0); MG_LDB(B1, 1, 1); MG_SCHED; MG_LDA(At, 1, 0); MG_STAGE(MG_SA(0, 1), a2, vA2[1]);
            MG_WAIT_V(8); MG_WAIT_L(0); MG_BAR; MG_MMA(0, 0, At, B0); MG_MMA(0, 1, At, B1); MG_BAR; MG_SCHED;
            MG_LDA(At, 1, 1); MG_STAGE(MG_SB(1, 0), b3, voffB); MG_STAGE(MG_SB(1, 1), b3 + hstep, voffB); MG_STAGE(MG_SA(1, 0), a3, vA2[0]);
            MG_WAIT_V(8); MG_WAIT_L(0); MG_BAR; MG_MMA(1, 0, At, B0); MG_MMA(1, 1, At, B1); MG_BAR; MG_SCHED;
        }
        if (wr == 0) MG_BAR;
        E(acc, cur, wr, wc, fr, fq);
        if (!has_next) break;
#pragma unroll
        for (int a = 0; a < 2; ++a)
#pragma unroll
            for (int b = 0; b < 2; ++b)
#pragma unroll
                for (int m = 0; m < 4; ++m)
#pragma unroll
                    for (int n = 0; n < 2; ++n) acc[a][b][m][n] = (f32x4){0.f, 0.f, 0.f, 0.f};
        cur = nxt; cA = nA; cB = nB; ++ui;
        if constexpr (GATHER) {
#pragma unroll
            for (int h = 0; h < 2; ++h)
#pragma unroll
                for (int i = 0; i < 2; ++i) vAc[h][i] = vAn[h][i]; }
        if (wr == 1) MG_BAR;
    }
    MG_WAIT_V(0);
    MG_BAR;
#undef MG_SA
#undef MG_SB
#undef MG_STAGE
#undef MG_LDA
#undef MG_LDB
#undef MG_MMA
#undef MG_WAIT_V
#undef MG_WAIT_L
#undef MG_BAR
#undef MG_SCHED
#undef MG_AOFF
}
}
constexpr int D = 1024, NB = 32, SEQ = 2048, CL = 256, NTOK = NB * SEQ, NCTX = NB * CL, INC = 4624;
constexpr int NE = 16, CAP = 256;
constexpr int OFF_QK = 512, OFF_V = 1536, OFF_O = 2048, OFF_G = 2560, OFF_BR = 2576;
constexpr float EPS = 1e-6f;
constexpr size_t MiB = 1u << 20;
constexpr size_t WS_CTL = 0, CTL_BYTES = 1 * MiB;
constexpr size_t WS_MOD = 1 * MiB;
constexpr size_t WS_GATES = 2 * MiB;
constexpr size_t WS_AFF = 11 * MiB;
constexpr size_t WS_IDX = 15 * MiB;
constexpr size_t WS_VAL = 15 * MiB + 512 * 1024;
constexpr size_t WS_SLOT = 16 * MiB;
constexpr size_t WS_WTF = 18 * MiB;
constexpr size_t WS_WFT = 20 * MiB;
constexpr size_t WS_WMT = 21 * MiB;
constexpr size_t WS_WOT = 22 * MiB;
constexpr size_t WS_WTM = 24 * MiB;
constexpr size_t WS_TT = 32 * MiB;
constexpr size_t WS_PC = 48 * MiB;
constexpr size_t WS_H = 64 * MiB;
constexpr size_t WS_QK = 64 * MiB;
constexpr size_t WS_KC = 192 * MiB;
constexpr size_t WS_MRG = 64 * MiB;
constexpr size_t WS_WGU = 64 * MiB;
constexpr size_t WS_WD = 128 * MiB;
constexpr size_t WS_AB = 208 * MiB;
constexpr size_t WS_HF = 208 * MiB;
constexpr size_t WS_HB = 272 * MiB;
constexpr size_t WS_HX2 = 208 * MiB;
constexpr size_t WS_FU = 336 * MiB;
constexpr size_t WS_PQK = 400 * MiB;
constexpr size_t WS_HM = 400 * MiB;
constexpr size_t WS_PV = 528 * MiB;
constexpr size_t WS_PO = 592 * MiB;
constexpr size_t WS_PBR = 656 * MiB;
constexpr size_t WS_HID = 400 * MiB;
constexpr size_t WS_Y = 656 * MiB;
constexpr size_t WS_END = 912 * MiB;
constexpr int LDS_PHASE_BYTES = 147456, LDS_BYTES = LDS_PHASE_BYTES + 256;

struct Ctx {
    const float *x, *c, *ctx, *c_ctx, *w_ada, *b_ada, *g_norm1, *w_in, *b_gates, *w_conv, *w_fourier, *w_mlstm, *w_out, *g_norm2, *w_router, *w_gate_e, *w_up_e, *w_down_e, *g_final;
    float* out; unsigned char* ws;
};

__device__ __forceinline__ void store_tile_bf16(const f32x4 (&acc)[2][2][4][2], bf16* base, int ldc, bool sig, int wr, int wc, int fr, int fq) {
    bf16* p0 = base + (size_t)(wr * 64 + fr) * ldc + wc * 32 + 8 * fq;
#pragma unroll
    for (int ai = 0; ai < 2; ++ai)
#pragma unroll
        for (int m = 0; m < 4; ++m) { bf16* rowp = p0 + (size_t)(ai * 128 + m * 16) * ldc;
#pragma unroll
            for (int bj = 0; bj < 2; ++bj) { f32x4 v0 = acc[ai][bj][m][0], v1 = acc[ai][bj][m][1];
                if (sig) {
#pragma unroll
                    for (int j = 0; j < 4; ++j) { v0[j] = sigmoid_f(v0[j]); v1[j] = sigmoid_f(v1[j]); } }
                u32x4 w; w.x = pk2(v0[0], v0[1]); w.y = pk2(v0[2], v0[3]); w.z = pk2(v1[0], v1[1]); w.w = pk2(v1[2], v1[3]);
                *(u32x4*)(rowp + bj * 128) = w; } }
}
struct EpiP1 {
    static constexpr bool PERM = true; unsigned char* ws;
    __device__ __forceinline__ void operator()(const f32x4 (&acc)[2][2][4][2], const mg::Unit& u, int wr, int wc, int fr, int fq) const {
        bf16* base; int ldc; bool sig = false;
        if (u.ty == 0) { const size_t r0 = (size_t)u.pm * 256;
            if (u.pn < 4) { base = (bf16*)(ws + WS_PQK) + r0 * 1024 + u.pn * 256; ldc = 1024; }
            else if (u.pn < 6) { base = (bf16*)(ws + WS_PV) + r0 * 512 + (u.pn - 4) * 256; ldc = 512; }
            else if (u.pn < 8) { base = (bf16*)(ws + WS_PO) + r0 * 512 + (u.pn - 6) * 256; ldc = 512; sig = true; }
            else { base = (bf16*)(ws + WS_PBR) + r0 * 2048 + (u.pn - 8) * 256; ldc = 2048; sig = true; }
        } else if (u.ty == 1) { base = (bf16*)(ws + WS_AB) + ((size_t)(u.pn >> 3) * 1024 + (size_t)u.pm * 256) * 2048 + (u.pn & 7) * 256; ldc = 2048; }
        else { base = (bf16*)(ws + WS_PC) + (size_t)u.pm * 256 * 1024 + u.pn * 256; ldc = 1024; }
        store_tile_bf16(acc, base, ldc, sig, wr, wc, fr, fq);
    }
};
struct EpiF2 {
    static constexpr bool PERM = true; unsigned char* ws;
    __device__ __forceinline__ void operator()(const f32x4 (&acc)[2][2][4][2], const mg::Unit& u, int wr, int wc, int fr, int fq) const {
        bf16* base = (bf16*)(ws + WS_FU) + ((size_t)(u.pn >> 1) * 2048 + (size_t)u.pm * 256) * 512 + (u.pn & 1) * 256;
        store_tile_bf16(acc, base, 512, false, wr, wc, fr, fq);
    }
};
struct EpiMerge {
    static constexpr bool PERM = true; unsigned char* ws;
    __device__ __forceinline__ void operator()(const f32x4 (&acc)[2][2][4][2], const mg::Unit& u, int wr, int wc, int fr, int fq) const {
        const size_t row0 = (size_t)u.pm * 256 + wr * 64 + fr; const int col0 = u.pn * 256 + wc * 32 + 8 * fq;
#pragma unroll
        for (int ai = 0; ai < 2; ++ai)
#pragma unroll
            for (int m = 0; m < 4; ++m) { const size_t row = row0 + ai * 128 + m * 16;
                bf16* mp = (bf16*)(ws + WS_MRG) + row * 1024 + col0; const bf16* gp = (const bf16*)(ws + WS_PBR) + row * 2048 + u.ty * 1024 + col0;
#pragma unroll
                for (int bj = 0; bj < 2; ++bj) { const u32x4 g = *(const u32x4*)(gp + bj * 128); const f32x4 v0 = acc[ai][bj][m][0], v1 = acc[ai][bj][m][1];
                    float r[8] = {bflo(g.x) * v0[0], bfhi(g.x) * v0[1], bflo(g.y) * v0[2], bfhi(g.y) * v0[3], bflo(g.z) * v1[0], bfhi(g.z) * v1[1], bflo(g.w) * v1[2], bfhi(g.w) * v1[3]};
                    if (u.ty == 1) { const u32x4 t = *(const u32x4*)(mp + bj * 128);
                        r[0] += bflo(t.x); r[1] += bfhi(t.x); r[2] += bflo(t.y); r[3] += bfhi(t.y); r[4] += bflo(t.z); r[5] += bfhi(t.z); r[6] += bflo(t.w); r[7] += bfhi(t.w); }
                    u32x4 w; w.x = pk2(r[0], r[1]); w.y = pk2(r[2], r[3]); w.z = pk2(r[4], r[5]); w.w = pk2(r[6], r[7]);
                    *(u32x4*)(mp + bj * 128) = w; } }
    }
};
struct EpiOut {
    static constexpr bool PERM = false; const float* x; const float* mod; float* out;
    __device__ __forceinline__ void operator()(const f32x4 (&acc)[2][2][4][2], const mg::Unit& u, int wr, int wc, int fr, int fq) const {
        const size_t row0 = (size_t)u.pm * 256 + wr * 64 + fr; const int col0 = u.pn * 256 + wc * 32 + 4 * fq; const int b = u.pm >> 3;
        f32x4 ga[2][2];
#pragma unroll
        for (int bj = 0; bj < 2; ++bj)
#pragma unroll
            for (int n = 0; n < 2; ++n) ga[bj][n] = *(const f32x4*)(mod + (size_t)b * 6144 + 2048 + col0 + bj * 128 + n * 16);
#pragma unroll
        for (int ai = 0; ai < 2; ++ai)
#pragma unroll
            for (int m = 0; m < 4; ++m) { const size_t off = (row0 + ai * 128 + m * 16) * 1024 + col0;
#pragma unroll
                for (int bj = 0; bj < 2; ++bj)
#pragma unroll
                    for (int n = 0; n < 2; ++n) { const f32x4 xv = *(const f32x4*)(x + off + bj * 128 + n * 16); *(f32x4*)(out + off + bj * 128 + n * 16) = xv + ga[bj][n] * acc[ai][bj][m][n]; } }
    }
};
struct EpiSwiglu {
    static constexpr bool PERM = true; unsigned char* ws;
    __device__ __forceinline__ void operator()(const f32x4 (&acc)[2][2][4][2], const mg::Unit& u, int wr, int wc, int fr, int fq) const {
        bf16* p0 = (bf16*)(ws + WS_HID) + ((size_t)u.pm * 256 + wr * 64 + fr) * 1024 + u.pn * 128 + wc * 32 + 8 * fq;
#pragma unroll
        for (int ai = 0; ai < 2; ++ai)
#pragma unroll
            for (int m = 0; m < 4; ++m) { float r[8];
#pragma unroll
                for (int n = 0; n < 2; ++n)
#pragma unroll
                    for (int j = 0; j < 4; ++j) r[n * 4 + j] = silu_f(acc[ai][0][m][n][j]) * acc[ai][1][m][n][j];
                u32x4 w; w.x = pk2(r[0], r[1]); w.y = pk2(r[2], r[3]); w.z = pk2(r[4], r[5]); w.w = pk2(r[6], r[7]);
                *(u32x4*)(p0 + (size_t)(ai * 128 + m * 16) * 1024) = w; }
    }
};
struct EpiDown {
    static constexpr bool PERM = true; unsigned char* ws;
    __device__ __forceinline__ void operator()(const f32x4 (&acc)[2][2][4][2], const mg::Unit& u, int wr, int wc, int fr, int fq) const {
        const size_t row0 = (size_t)u.pm * 256 + wr * 64 + fr; const float* val = (const float*)(ws + WS_VAL);
        bf16* p0 = (bf16*)(ws + WS_Y) + row0 * 1024 + u.pn * 256 + wc * 32 + 8 * fq;
#pragma unroll
        for (int ai = 0; ai < 2; ++ai)
#pragma unroll
            for (int m = 0; m < 4; ++m) { const float vv = val[row0 + ai * 128 + m * 16]; bf16* rowp = p0 + (size_t)(ai * 128 + m * 16) * 1024;
#pragma unroll
                for (int bj = 0; bj < 2; ++bj) { const f32x4 v0 = acc[ai][bj][m][0] * vv, v1 = acc[ai][bj][m][1] * vv;
                    u32x4 w; w.x = pk2(v0[0], v0[1]); w.y = pk2(v0[2], v0[3]); w.z = pk2(v1[0], v1[1]); w.w = pk2(v1[2], v1[3]);
                    *(u32x4*)(rowp + bj * 128) = w; } }
    }
};

struct SchedP1 {
    unsigned char* ws; int G, c;
    __device__ __forceinline__ bool next(int i, mg::Unit& u) const {
        int L = i * G + c; const char* H = (const char*)(ws + WS_H); u.gi = nullptr;
        if (L < 4096) { mg::tile_of(L, 256, 16, u.pm, u.pn); u.ty = 0; u.a = H + (size_t)u.pm * 256 * 2048; u.b = (const char*)(ws + WS_WTM) + (size_t)u.pn * 256 * 2048; return true; }
        L -= 4096;
        if (L < 1024) { mg::tile_of(L, 4, 256, u.pm, u.pn); u.ty = 1; u.a = (const char*)(ws + WS_WTF) + (size_t)u.pm * 256 * 2048; u.b = H + (size_t)u.pn * 256 * 2048; return true; }
        L -= 1024;
        if (L < 128) { mg::tile_of(L, 32, 4, u.pm, u.pn); u.ty = 2; u.a = H + ((size_t)NTOK + (size_t)u.pm * 256) * 2048; u.b = (const char*)(ws + WS_WTM) + ((size_t)512 + (size_t)u.pn * 256) * 2048; return true; }
        return false;
    }
};
struct SchedF2 {
    unsigned char* ws; int G, c;
    __device__ __forceinline__ bool next(int i, mg::Unit& u) const {
        const int L = i * G + c; if (L >= 512) return false; mg::tile_of(L, 8, 64, u.pm, u.pn); u.ty = 0; u.gi = nullptr;
        u.a = (const char*)(ws + WS_TT) + (size_t)u.pm * 256 * 8192; u.b = (const char*)(ws + WS_AB) + (size_t)u.pn * 256 * 8192; return true;
    }
};
struct SchedMerge {
    unsigned char* ws; int G, c;
    __device__ __forceinline__ bool next(int i, mg::Unit& u) const {
        const int L = (i >> 1) * G + c; if (L >= 1024) return false; mg::tile_of(L, 256, 4, u.pm, u.pn); u.ty = i & 1; u.gi = nullptr;
        u.a = (const char*)(ws + (u.ty ? WS_HM : WS_FU)) + (size_t)u.pm * 256 * 1024; u.b = (const char*)(ws + (u.ty ? WS_WMT : WS_WFT)) + (size_t)u.pn * 256 * 1024; return true;
    }
};
struct SchedOut {
    unsigned char* ws; int G, c;
    __device__ __forceinline__ bool next(int i, mg::Unit& u) const {
        const int L = i * G + c; if (L >= 1024) return false; mg::tile_of(L, 256, 4, u.pm, u.pn); u.ty = 0; u.gi = nullptr;
        u.a = (const char*)(ws + WS_MRG) + (size_t)u.pm * 256 * 2048; u.b = (const char*)(ws + WS_WOT) + (size_t)u.pn * 256 * 2048; return true;
    }
};
struct SchedUp {
    unsigned char* ws; int G, c;
    __device__ __forceinline__ bool next(int i, mg::Unit& u) const {
        const int L = i * G + c; if (L >= 4096) return false; mg::tile_of(L, 512, 8, u.pm, u.pn); u.ty = 0;
        u.a = (const char*)(ws + WS_HX2); u.gi = (const int*)(ws + WS_IDX) + (size_t)u.pm * 256; u.b = (const char*)(ws + WS_WGU) + ((size_t)(u.pm >> 5) * 8 + u.pn) * 256 * 2048; return true;
    }
};
struct SchedDown {
    unsigned char* ws; int G, c;
    __device__ __forceinline__ bool next(int i, mg::Unit& u) const {
        const int L = i * G + c; if (L >= 2048) return false; mg::tile_of(L, 512, 4, u.pm, u.pn); u.ty = 0; u.gi = nullptr;
        u.a = (const char*)(ws + WS_HID) + (size_t)u.pm * 256 * 2048; u.b = (const char*)(ws + WS_WD) + ((size_t)(u.pm >> 5) * 4 + u.pn) * 256 * 2048; return true;
    }
};

__device__ __forceinline__ void transpose_item(const float* W, int ldw, int n0, int k0, bf16* dst, int drow0, int Kd, LAS float* scr, int lane) {
#pragma unroll 8
    for (int i = 0; i < 32; ++i) { const int kk = 2 * i + (lane >> 5); scr[kk * 33 + (lane & 31)] = W[(size_t)(k0 + kk) * ldw + n0 + (lane & 31)]; }
    asm volatile("s_waitcnt lgkmcnt(0)" ::: "memory");
    const int c = lane & 7;
#pragma unroll
    for (int j = 0; j < 4; ++j) { const int n = (lane >> 3) + 8 * j; const LAS float* s = scr + (8 * c) * 33 + n;
        u32x4 o; o.x = pk2(s[0 * 33], s[1 * 33]); o.y = pk2(s[2 * 33], s[3 * 33]); o.z = pk2(s[4 * 33], s[5 * 33]); o.w = pk2(s[6 * 33], s[7 * 33]);
        *(u32x4*)(dst + (size_t)(drow0 + n) * Kd + k0 + 8 * c) = o; }
    asm volatile("s_waitcnt lgkmcnt(0)" ::: "memory");
}

__device__ __forceinline__ void p0_prep(const Ctx& C, LAS unsigned char* lds, int tid, int lane, int wave, int G) {
    const int blk = blockIdx.x;
    for (int item = blk; item < 192; item += G) {
        LAS float* sT = (LAS float*)lds;
        for (int i = tid; i < 33 * 1024; i += 512) { const int r = i >> 10, k = i & 1023; const float v = r < 32 ? C.c[r * 1024 + k] : C.c_ctx[k]; sT[k * 36 + r] = silu_f(v); }
        for (int i = tid; i < 3 * 1024; i += 512) { const int r = 33 + (i >> 10), k = i & 1023; sT[k * 36 + r] = 0.f; }
        __syncthreads();
        const int col0 = item * 32, kg = tid >> 5, j = tid & 31;
        float acc[36];
#pragma unroll
        for (int r = 0; r < 36; ++r) acc[r] = 0.f;
#pragma unroll 4
        for (int kk = 0; kk < 64; ++kk) { const int k = kg * 64 + kk; const float w = C.w_ada[(size_t)k * 6144 + col0 + j];
#pragma unroll
            for (int q = 0; q < 9; ++q) { const f32x4 s4 = *(const LAS f32x4*)(sT + k * 36 + 4 * q); acc[4 * q] += s4[0] * w; acc[4 * q + 1] += s4[1] * w; acc[4 * q + 2] += s4[2] * w; acc[4 * q + 3] += s4[3] * w; } }
        __syncthreads();
        LAS float* red = (LAS float*)lds;
#pragma unroll
        for (int r = 0; r < 33; ++r) red[(kg * 33 + r) * 32 + j] = acc[r];
        __syncthreads();
        float* mod = (float*)(C.ws + WS_MOD);
        for (int o = tid; o < 33 * 32; o += 512) { const int r = o >> 5, jj = o & 31; float s = 0.f;
#pragma unroll
            for (int g = 0; g < 16; ++g) s += red[(g * 33 + r) * 32 + jj];
            mod[(size_t)r * 6144 + col0 + jj] = s + C.b_ada[col0 + jj]; }
        __syncthreads();
    }
    for (int item = blk; item < 256; item += G) {
        LAS float* wl = (LAS float*)lds; LAS float* cs = wl + 16 * 128; LAS float* sn = cs + 128;
        const int g = item >> 6, d0 = (item & 63) * 16;
        for (int i = tid; i < 16 * 128; i += 512) { const int dd = i >> 7, cc = i & 127; wl[i] = C.w_in[(size_t)(d0 + dd) * INC + g * 128 + cc]; }
        if (tid < 128) { cs[tid] = cospif((float)tid * (1.f / 64.f)); sn[tid] = sinpif((float)tid * (1.f / 64.f)); }
        __syncthreads();
        const int rj = tid & 255, j = rj >> 1, ab = rj & 1, half = tid >> 8;
        float acc[8];
#pragma unroll
        for (int i = 0; i < 8; ++i) acc[i] = 0.f;
        const LAS float* tw = ab ? sn : cs;
        for (int cc = 0; cc < 128; ++cc) { const float t = tw[(j * cc) & 127];
#pragma unroll
            for (int i = 0; i < 8; ++i) acc[i] += wl[(half * 8 + i) * 128 + cc] * t; }
        u32x4 o; o.x = pk2(acc[0], acc[1]); o.y = pk2(acc[2], acc[3]); o.z = pk2(acc[4], acc[5]); o.w = pk2(acc[6], acc[7]);
        *(u32x4*)((bf16*)(C.ws + WS_WTF) + (size_t)(g * 256 + rj) * 1024 + d0 + half * 8) = o;
        __syncthreads();
    }
    {
        LAS float* tc = (LAS float*)lds; LAS float* ts = tc + 2048;
        for (int i = tid; i < 2048; i += 512) { const float a = (float)i * (1.f / 1024.f); tc[i] = cospif(a) * (1.f / 512.f); ts[i] = -sinpif(a) * (1.f / 512.f); }
        __syncthreads();
        for (int item = blk; item < 256; item += G)
            for (int rr = 0; rr < 8; ++rr) { const int k = item * 8 + rr; const int lp0 = tid * 8; const LAS float* tb = lp0 < 2048 ? tc : ts; const int l0 = lp0 & 2047; float v[8];
#pragma unroll
                for (int e = 0; e < 8; ++e) v[e] = tb[(k * (l0 + e)) & 2047];
                u32x4 o; o.x = pk2(v[0], v[1]); o.y = pk2(v[2], v[3]); o.z = pk2(v[4], v[5]); o.w = pk2(v[6], v[7]);
                *(u32x4*)((bf16*)(C.ws + WS_TT) + (size_t)k * 4096 + lp0) = o; }
        __syncthreads();
    }
    {
        LAS float* scr = (LAS float*)lds + wave * (64 * 33);
        const int gw = blk * 8 + wave, NGW = G * 8;
        constexpr int I_IN = 16 * 128, I_F = 8 * 32, I_M = 8 * 32, I_O = 16 * 32;
        for (int it = gw; it < I_IN + I_F + I_M + I_O; it += NGW) {
            int r = it;
            if (r < I_IN) { const int kb = r >> 7, nb = r & 127; const int n0 = nb < 64 ? 512 + 32 * nb : 2576 + 32 * (nb - 64);
                transpose_item(C.w_in, INC, n0, kb * 64, (bf16*)(C.ws + WS_WTM), 32 * nb, 1024, scr, lane); continue; }
            r -= I_IN;
            if (r < I_F) { const int kb = r >> 5, nb = r & 31; transpose_item(C.w_fourier, 1024, 32 * nb, kb * 64, (bf16*)(C.ws + WS_WFT), 32 * nb, 512, scr, lane); continue; }
            r -= I_F;
            if (r < I_M) { const int kb = r >> 5, nb = r & 31; transpose_item(C.w_mlstm, 1024, 32 * nb, kb * 64, (bf16*)(C.ws + WS_WMT), 32 * nb, 512, scr, lane); continue; }
            r -= I_M;
            { const int kb = r >> 5, nb = r & 31; transpose_item(C.w_out, 1024, 32 * nb, kb * 64, (bf16*)(C.ws + WS_WOT), 32 * nb, 1024, scr, lane); }
        }
    }
}
__device__ __forceinline__ void convert_experts(const Ctx& C, LAS unsigned char* lds, int lane, int wave, int G) {
    LAS float* scr = (LAS float*)lds + wave * (64 * 33);
    const int gw = blockIdx.x * 8 + wave, NGW = G * 8;
    for (int it = gw; it < 48 * 512; it += NGW) {
        const int mat = it >> 9, r = it & 511, kb = r >> 5, nb = r & 31, e = mat & 15, which = mat >> 4;
        if (which < 2) { const float* W = (which ? C.w_up_e : C.w_gate_e) + (size_t)e * 1024 * 1024; const int n0 = 32 * nb;
            transpose_item(W, 1024, n0, kb * 64, (bf16*)(C.ws + WS_WGU), e * 2048 + (n0 >> 7) * 256 + which * 128 + (n0 & 127), 1024, scr, lane); }
        else transpose_item(C.w_down_e + (size_t)e * 1024 * 1024, 1024, 32 * nb, kb * 64, (bf16*)(C.ws + WS_WD), e * 1024 + 32 * nb, 1024, scr, lane);
    }
}

__device__ __forceinline__ float butterfly64(float (&v)[64], int lane) {
#pragma unroll
    for (int i = 0; i < 32; ++i) { const bool up = lane & 32; const float send = up ? v[i] : v[i + 32], keep = up ? v[i + 32] : v[i]; v[i] = keep + __shfl_xor(send, 32); }
#pragma unroll
    for (int i = 0; i < 16; ++i) { const bool up = lane & 16; const float send = up ? v[i] : v[i + 16], keep = up ? v[i + 16] : v[i]; v[i] = keep + __shfl_xor(send, 16); }
#pragma unroll
    for (int i = 0; i < 8; ++i) { const bool up = lane & 8; const float send = up ? v[i] : v[i + 8], keep = up ? v[i + 8] : v[i]; v[i] = keep + __shfl_xor(send, 8); }
#pragma unroll
    for (int i = 0; i < 4; ++i) { const bool up = lane & 4; const float send = up ? v[i] : v[i + 4], keep = up ? v[i + 4] : v[i]; v[i] = keep + __shfl_xor(send, 4); }
#pragma unroll
    for (int i = 0; i < 2; ++i) { const bool up = lane & 2; const float send = up ? v[i] : v[i + 2], keep = up ? v[i + 2] : v[i]; v[i] = keep + __shfl_xor(send, 2); }
    { const bool up = lane & 1; const float send = up ? v[0] : v[1], keep = up ? v[1] : v[0]; v[0] = keep + __shfl_xor(send, 1); }
    return v[0];
}

__device__ __forceinline__ float rows4_norm_proj(const float* xin, size_t row0, const f32x4 (&gsc)[4], const f32x4 (&sh)[4], bf16* hout, const LAS float* wl, int lane) {
    f32x4 v[4][4]; float ss[4];
#pragma unroll
    for (int r = 0; r < 4; ++r) { ss[r] = 0.f;
#pragma unroll
        for (int j = 0; j < 4; ++j) { v[r][j] = *(const f32x4*)(xin + (row0 + r) * 1024 + 4 * lane + 256 * j); ss[r] += v[r][j][0] * v[r][j][0] + v[r][j][1] * v[r][j][1] + v[r][j][2] * v[r][j][2] + v[r][j][3] * v[r][j][3]; } }
#pragma unroll
    for (int r = 0; r < 4; ++r) { const float rstd = rsqrtf(wave_sum(ss[r]) * (1.f / 1024.f) + EPS);
#pragma unroll
        for (int j = 0; j < 4; ++j) { v[r][j] = v[r][j] * rstd * gsc[j] + sh[j];
            u32x2 w; w.x = pk2(v[r][j][0], v[r][j][1]); w.y = pk2(v[r][j][2], v[r][j][3]); *(u32x2*)(hout + (row0 + r) * 1024 + 4 * lane + 256 * j) = w; } }
    float acc[64];
#pragma unroll
    for (int i = 0; i < 64; ++i) acc[i] = 0.f;
#pragma unroll
    for (int j = 0; j < 4; ++j)
#pragma unroll
        for (int e = 0; e < 4; ++e) { const LAS float* wp = wl + (4 * lane + 256 * j + e) * 16;
#pragma unroll
            for (int q = 0; q < 4; ++q) { const f32x4 w4 = *(const LAS f32x4*)(wp + 4 * q);
#pragma unroll
                for (int r = 0; r < 4; ++r) { const float hv = v[r][j][e]; acc[r * 16 + 4 * q] += hv * w4[0]; acc[r * 16 + 4 * q + 1] += hv * w4[1]; acc[r * 16 + 4 * q + 2] += hv * w4[2]; acc[r * 16 + 4 * q + 3] += hv * w4[3]; } }
            asm volatile("" ::: "memory"); }
    return butterfly64(acc, lane);
}

__device__ __forceinline__ void p1a_norm_gates(const Ctx& C, LAS unsigned char* lds, int tid, int lane, int wave, int G) {
    LAS float* wl = (LAS float*)lds;
    for (int i = tid; i < 1024 * 16; i += 512) wl[i] = C.w_in[(size_t)(i >> 4) * INC + OFF_G + (i & 15)];
    __syncthreads();
    const float* mod = (const float*)(C.ws + WS_MOD); bf16* H = (bf16*)(C.ws + WS_H); float* gates = (float*)(C.ws + WS_GATES);
    const int NGW = G * 8;
    for (int gw = blockIdx.x * 8 + wave; gw < 2048; gw += NGW) {
        f32x4 gsc[4], sh[4];
        {   const int b = gw >> 6; const float* m = mod + (size_t)b * 6144;
#pragma unroll
            for (int j = 0; j < 4; ++j) { const int col = 4 * lane + 256 * j; const f32x4 g = *(const f32x4*)(C.g_norm1 + col), s = *(const f32x4*)(m + 1024 + col); gsc[j] = g * (s + 1.f); sh[j] = *(const f32x4*)(m + col); }
            for (int q = 0; q < 8; ++q) { const size_t row0 = (size_t)gw * 32 + q * 4; const float gv = rows4_norm_proj(C.x, row0, gsc, sh, H, wl, lane); gates[(row0 + (lane >> 4)) * 16 + (lane & 15)] = gv; } }
        {   const float* m = mod + (size_t)32 * 6144;
#pragma unroll
            for (int j = 0; j < 4; ++j) { const int col = 4 * lane + 256 * j; const f32x4 g = *(const f32x4*)(C.g_norm1 + col), s = *(const f32x4*)(m + 1024 + col); gsc[j] = g * (s + 1.f); sh[j] = *(const f32x4*)(m + col); }
            const size_t row0 = (size_t)gw * 4; const float gv = rows4_norm_proj(C.ctx, row0, gsc, sh, H + (size_t)NTOK * 1024, wl, lane); gates[((size_t)NTOK + row0 + (lane >> 4)) * 16 + (lane & 15)] = gv; }
    }
}

__device__ __forceinline__ void conv_item_x(const Ctx& C, int item, int lane) {
    const int hf = item & 1, cb = (item >> 1) & 3, r = (item >> 3) & 31, b = item >> 8;
    const int ch0 = cb * 256 + 4 * lane; const bf16* src = (const bf16*)(C.ws + WS_PQK) + (size_t)b * SEQ * 1024 + ch0; bf16* dst = (bf16*)(C.ws + WS_QK) + (size_t)b * SEQ * 1024 + ch0;
    f32x4 w[3][3];
#pragma unroll
    for (int dy = 0; dy < 3; ++dy)
#pragma unroll
        for (int dx = 0; dx < 3; ++dx) w[dy][dx] = *(const f32x4*)(C.w_conv + (dy * 3 + dx) * 1024 + ch0);
    const float ksc = cb >= 2 ? 0.08838834764831845f : 1.f;
    const int c0 = hf * 32;
    f32x4 win[3][3];
    auto ld = [&](int rr, int cc) -> f32x4 { if (rr < 0 || rr >= 32 || cc < 0 || cc >= 64) return (f32x4){0.f, 0.f, 0.f, 0.f};
        const u32x2 p = *(const u32x2*)(src + (size_t)(rr * 64 + cc) * 1024); return (f32x4){bflo(p.x), bfhi(p.x), bflo(p.y), bfhi(p.y)}; };
#pragma unroll
    for (int dy = 0; dy < 3; ++dy) { win[dy][1] = ld(r + dy - 1, c0 - 1); win[dy][2] = ld(r + dy - 1, c0); }
    for (int cc = c0; cc < c0 + 32; ++cc) {
#pragma unroll
        for (int dy = 0; dy < 3; ++dy) { win[dy][0] = win[dy][1]; win[dy][1] = win[dy][2]; win[dy][2] = ld(r + dy - 1, cc + 1); }
        f32x4 a = {0.f, 0.f, 0.f, 0.f};
#pragma unroll
        for (int dy = 0; dy < 3; ++dy)
#pragma unroll
            for (int dx = 0; dx < 3; ++dx) a += w[dy][dx] * win[dy][dx];
        u32x2 o; o.x = pk2(silu_f(a[0]) * ksc, silu_f(a[1]) * ksc); o.y = pk2(silu_f(a[2]) * ksc, silu_f(a[3]) * ksc);
        *(u32x2*)(dst + (size_t)(r * 64 + cc) * 1024) = o;
    }
}
__device__ __forceinline__ void conv_item_ctx(const Ctx& C, int item, int lane) {
    const int sg = item & 7, cb = (item >> 3) & 1, b = item >> 4;
    const int kc0 = cb * 256 + 4 * lane; const bf16* src = (const bf16*)(C.ws + WS_PC) + (size_t)b * CL * 1024 + kc0; bf16* dst = (bf16*)(C.ws + WS_KC) + (size_t)b * CL * 512 + kc0;
    f32x4 w[3];
#pragma unroll
    for (int dx = 0; dx < 3; ++dx) w[dx] = *(const f32x4*)(C.w_conv + (3 + dx) * 1024 + 512 + kc0);
    auto ld = [&](int cc) -> f32x4 { if (cc < 0 || cc >= CL) return (f32x4){0.f, 0.f, 0.f, 0.f};
        const u32x2 p = *(const u32x2*)(src + (size_t)cc * 1024); return (f32x4){bflo(p.x), bfhi(p.x), bflo(p.y), bfhi(p.y)}; };
    const int c0 = sg * 32; f32x4 w0, w1 = ld(c0 - 1), w2 = ld(c0);
    for (int cc = c0; cc < c0 + 32; ++cc) { w0 = w1; w1 = w2; w2 = ld(cc + 1);
        const f32x4 a = w[0] * w0 + w[1] * w1 + w[2] * w2; const float ksc = 0.08838834764831845f;
        u32x2 o; o.x = pk2(silu_f(a[0]) * ksc, silu_f(a[1]) * ksc); o.y = pk2(silu_f(a[2]) * ksc, silu_f(a[3]) * ksc);
        *(u32x2*)(dst + (size_t)cc * 512) = o; }
}
__device__ __forceinline__ void p2_conv(const Ctx& C, int lane, int wave, int G) {
    const int NGW = G * 8;
    for (int it = blockIdx.x * 8 + wave; it < NB * 256 + NB * 16; it += NGW) { if (it < NB * 256) conv_item_x(C, it, lane); else conv_item_ctx(C, it - NB * 256, lane); }
}

__device__ __forceinline__ void p3b_combine(const Ctx& C, int tid, int G) {
    const u32x4* po = (const u32x4*)(C.ws + WS_PO); const u32x4* hf = (const u32x4*)(C.ws + WS_HF); const u32x4* hb = (const u32x4*)(C.ws + WS_HB); u32x4* hm = (u32x4*)(C.ws + WS_HM);
    const size_t n = (size_t)NTOK * 512 / 8;
    for (size_t i = (size_t)blockIdx.x * 512 + tid; i < n; i += (size_t)G * 512) { const u32x4 o = po[i], a = hf[i], b = hb[i]; u32x4 r;
        r.x = pk2(bflo(o.x) * (bflo(a.x) + bflo(b.x)), bfhi(o.x) * (bfhi(a.x) + bfhi(b.x))); r.y = pk2(bflo(o.y) * (bflo(a.y) + bflo(b.y)), bfhi(o.y) * (bfhi(a.y) + bfhi(b.y)));
        r.z = pk2(bflo(o.z) * (bflo(a.z) + bflo(b.z)), bfhi(o.z) * (bfhi(a.z) + bfhi(b.z))); r.w = pk2(bflo(o.w) * (bflo(a.w) + bflo(b.w)), bfhi(o.w) * (bfhi(a.w) + bfhi(b.w)));
        hm[i] = r; }
}

__device__ __forceinline__ void p6_norm_router(const Ctx& C, LAS unsigned char* lds, int tid, int lane, int wave, int G) {
    LAS float* wl = (LAS float*)lds;
    for (int i = tid; i < 1024 * 16; i += 512) wl[i] = C.w_router[i];
    __syncthreads();
    const float* mod = (const float*)(C.ws + WS_MOD); bf16* HX2 = (bf16*)(C.ws + WS_HX2); float* aff = (float*)(C.ws + WS_AFF);
    const int NGW = G * 8;
    for (int gw = blockIdx.x * 8 + wave; gw < 2048; gw += NGW) {
        f32x4 gsc[4], sh[4]; const int b = gw >> 6; const float* m = mod + (size_t)b * 6144;
#pragma unroll
        for (int j = 0; j < 4; ++j) { const int col = 4 * lane + 256 * j; const f32x4 g = *(const f32x4*)(C.g_norm2 + col), s = *(const f32x4*)(m + 4096 + col); gsc[j] = g * (s + 1.f); sh[j] = *(const f32x4*)(m + 3072 + col); }
        for (int q = 0; q < 8; ++q) { const size_t row0 = (size_t)gw * 32 + q * 4; const float lg = rows4_norm_proj(C.out, row0, gsc, sh, HX2, wl, lane);
            float mx = lg;
#pragma unroll
            for (int o = 1; o < 16; o <<= 1) mx = fmaxf(mx, __shfl_xor(mx, o));
            const float ex = expf(lg - mx); float sm = ex;
#pragma unroll
            for (int o = 1; o < 16; o <<= 1) sm += __shfl_xor(sm, o);
            const size_t t = (row0 + (lane >> 4)) & (SEQ - 1);
            aff[((size_t)b * NE + (lane & 15)) * SEQ + t] = ex / sm; }
    }
}

__device__ __forceinline__ unsigned wave_sum_u(unsigned v) {
#pragma unroll
    for (int o = 1; o < 64; o <<= 1) v += __shfl_xor(v, o);
    return v;
}
__device__ __forceinline__ unsigned wave_excl_scan_u(unsigned v, int lane) { unsigned s = v;
#pragma unroll
    for (int o = 1; o < 64; o <<= 1) { const unsigned t = __shfl_up(s, o); if (lane >= o) s += t; }
    return s - v;
}
__device__ __forceinline__ void topk_item(const Ctx& C, int item, int lane) {
    const int b = item >> 4, e = item & 15; const float* a = (const float*)(C.ws + WS_AFF) + ((size_t)b * NE + e) * SEQ + 32 * lane;
    unsigned key[32];
#pragma unroll
    for (int q = 0; q < 8; ++q) { const u32x4 v = *(const u32x4*)(a + 4 * q); key[4 * q] = v.x; key[4 * q + 1] = v.y; key[4 * q + 2] = v.z; key[4 * q + 3] = v.w; }
    unsigned T = 0u;
    for (int bit = 30; bit >= 0; --bit) { const unsigned cand = T | (1u << bit); unsigned cnt = 0u;
#pragma unroll
        for (int i = 0; i < 32; ++i) cnt += key[i] >= cand ? 1u : 0u;
        if (wave_sum_u(cnt) >= (unsigned)CAP) T = cand; }
    unsigned ngt = 0u, neq = 0u;
#pragma unroll
    for (int i = 0; i < 32; ++i) { ngt += key[i] > T ? 1u : 0u; neq += key[i] == T ? 1u : 0u; }
    const unsigned need = (unsigned)CAP - wave_sum_u(ngt);
    unsigned tie_before = wave_excl_scan_u(neq, lane);
    unsigned nsel = 0u; unsigned selmask = 0u;
#pragma unroll
    for (int i = 0; i < 32; ++i) { bool s = key[i] > T; if (key[i] == T) { s = tie_before < need; ++tie_before; } if (s) { selmask |= 1u << i; ++nsel; } }
    unsigned slot = wave_excl_scan_u(nsel, lane);
    const int pm = e * 32 + b; int* idx = (int*)(C.ws + WS_IDX) + (size_t)pm * CAP; float* val = (float*)(C.ws + WS_VAL) + (size_t)pm * CAP; bf16* sl = (bf16*)(C.ws + WS_SLOT);
#pragma unroll
    for (int i = 0; i < 32; ++i) { const int t = 32 * lane + i; const bool s = (selmask >> i) & 1u;
        if (s) { idx[slot] = b * SEQ + t; val[slot] = __uint_as_float(key[i]); }
        sl[((size_t)b * SEQ + t) * NE + e] = s ? (bf16)slot : (bf16)0xffffu; if (s) ++slot; }
}

__device__ __forceinline__ void p10_final(const Ctx& C, int lane, int wave, int G) {
    const float* mod = (const float*)(C.ws + WS_MOD); const bf16* Y = (const bf16*)(C.ws + WS_Y); const bf16* sl = (const bf16*)(C.ws + WS_SLOT);
    const int NGW = G * 8;
    for (int gw = blockIdx.x * 8 + wave; gw < 2048; gw += NGW) { const int b = gw >> 6; const float* m = mod + (size_t)b * 6144 + 5120;
        f32x4 ga[4], gf[4];
#pragma unroll
        for (int j = 0; j < 4; ++j) { ga[j] = *(const f32x4*)(m + 4 * lane + 256 * j); gf[j] = *(const f32x4*)(C.g_final + 4 * lane + 256 * j); }
        for (int q = 0; q < 32; ++q) { const size_t row = (size_t)gw * 32 + q; f32x4 v[4], a[4];
#pragma unroll
            for (int j = 0; j < 4; ++j) { v[j] = *(const f32x4*)(C.out + row * 1024 + 4 * lane + 256 * j); a[j] = (f32x4){0.f, 0.f, 0.f, 0.f}; }
            const unsigned myslot = lane < NE ? (unsigned)sl[row * NE + lane] : 0xffffu;
            for (int e = 0; e < NE; ++e) { const unsigned s = __builtin_amdgcn_readlane(myslot, e); if (s != 0xffffu) { const bf16* yr = Y + ((size_t)(e * 32 + b) * CAP + s) * 1024 + 4 * lane;
#pragma unroll
                for (int j = 0; j < 4; ++j) { const u32x2 p = *(const u32x2*)(yr + 256 * j); a[j] += (f32x4){bflo(p.x), bfhi(p.x), bflo(p.y), bfhi(p.y)}; } } }
            float ss = 0.f;
#pragma unroll
            for (int j = 0; j < 4; ++j) { v[j] = v[j] + ga[j] * a[j]; ss += v[j][0] * v[j][0] + v[j][1] * v[j][1] + v[j][2] * v[j][2] + v[j][3] * v[j][3]; }
            const float rstd = rsqrtf(wave_sum(ss) * (1.f / 1024.f) + EPS);
#pragma unroll
            for (int j = 0; j < 4; ++j) *(f32x4*)(C.out + row * 1024 + 4 * lane + 256 * j) = v[j] * rstd * gf[j]; }
    }
}
namespace ml {
typedef short v4i16_t __attribute__((ext_vector_type(4)));
constexpr int QS = 0, KS = 16384, VS = 32768, CT = 49152, SS = 81920, SM = 90112;
constexpr int U_ = 0, M_ = 64, DEC_ = 128, EM_ = 192, WA_ = 256, QN_ = 320, RS_ = 384, N_ = 512, SC_ = 640;
__device__ __forceinline__ unsigned off_b(unsigned row, unsigned ch) { return 256u * row + 16u * (ch ^ (((row & 3) << 2) | ((row >> 2) & 3))); }
__device__ __forceinline__ unsigned off_s(unsigned row, unsigned ch) { return 128u * row + 16u * (ch ^ (row & 7)); }
__device__ __forceinline__ bf16x8 rowfrag(const LAS unsigned char* tile, int rb, int ks, int lane) { return *(const LAS bf16x8*)(tile + off_b(16 * rb + (lane & 15), 4 * ks + (lane >> 4))); }
__device__ __forceinline__ bf16x8 trfrag(const LAS unsigned char* tile, int c, int ks, int lane) {
    const unsigned g = lane >> 4, q = (lane & 15) >> 2, p = lane & 3;
    const unsigned a0 = off_b(32 * ks + 8 * g + q, 2 * c + (p >> 1)) + 8 * (p & 1), a1 = off_b(32 * ks + 8 * g + 4 + q, 2 * c + (p >> 1)) + 8 * (p & 1);
    const v4i16_t lo = __builtin_amdgcn_ds_read_tr16_b64_v4i16((LAS v4i16_t*)(tile + a0)), hi = __builtin_amdgcn_ds_read_tr16_b64_v4i16((LAS v4i16_t*)(tile + a1));
    bf16x8 r; r[0] = lo[0]; r[1] = lo[1]; r[2] = lo[2]; r[3] = lo[3]; r[4] = hi[0]; r[5] = hi[1]; r[6] = hi[2]; r[7] = hi[3]; return r;
}
__device__ __forceinline__ float scan_add(float v, int lane, int dir) {
#pragma unroll
    for (int d = 1; d < 64; d <<= 1) { const float t = dir ? __shfl_down(v, d) : __shfl_up(v, d); if (dir ? (lane + d < 64) : (lane >= d)) v += t; }
    return v;
}
__device__ __forceinline__ float scan_max(float v, int lane, int dir) {
#pragma unroll
    for (int d = 1; d < 64; d <<= 1) { const float t = dir ? __shfl_down(v, d) : __shfl_up(v, d); if (dir ? (lane + d < 64) : (lane >= d)) v = fmaxf(v, t); }
    return v;
}
__device__ __forceinline__ void gate_math(float ig, float fg, int lane, int dir, float& m0, LAS float* sm) {
    const float fl = log_sigmoid_f(fg);
    const float cum = scan_add(fl, lane, dir);
    const float u = ig - cum;
    const float pmx = scan_max(u, lane, dir);
    const int endl = dir ? 0 : 63;
    const float tot = __shfl(cum, endl), umax = __shfl(pmx, endl);
    const float M = fmaxf(m0, pmx);
    const float mn = fmaxf(tot + m0, tot + umax);
    sm[U_ + lane] = u; sm[M_ + lane] = M; sm[DEC_ + lane] = expf(m0 - M); sm[EM_ + lane] = expf(-(cum + M)); sm[WA_ + lane] = expf(tot + u - mn);
    if (lane == 0) sm[SC_] = expf(tot + m0 - mn);
    m0 = mn;
}

__device__ __forceinline__ void mlstm_phase(const Ctx& C, LAS unsigned char* lds, int tid, int lane, int wave, int G) {
    LAS float* sm = (LAS float*)(lds + SM);
    const bf16* QK = (const bf16*)(C.ws + WS_QK); const bf16* KC = (const bf16*)(C.ws + WS_KC); const bf16* PV = (const bf16*)(C.ws + WS_PV); const bf16* PC = (const bf16*)(C.ws + WS_PC);
    const float* gates = (const float*)(C.ws + WS_GATES);
    for (int item = blockIdx.x; item < 256; item += G) {
        const int dir = item & 1, h = (item >> 1) & 3, b = item >> 3;
        bf16* Hout = (bf16*)(C.ws + (dir ? WS_HB : WS_HF));
        const int kI = dir ? 2 : 0, kF = dir ? 3 : 1; const float bI = C.b_gates[kI * 4 + h], bF = C.b_gates[kF * 4 + h];
        for (int i = tid; i < 32768 / 16; i += 512) *(LAS u32x4*)(lds + CT + i * 16) = (u32x4){0u, 0u, 0u, 0u};
        if (tid < 128) sm[N_ + tid] = 0.f;
        f32x4 Cacc[8];
#pragma unroll
        for (int t = 0; t < 8; ++t) Cacc[t] = (f32x4){0.f, 0.f, 0.f, 0.f};
        float m0 = 0.f;
        u32x4 pq[2], pk[2], pv[2]; float pig = 0.f, pfg = 0.f;
#define ML_ISSUE(step_) do { const int _st = (step_); const bool _isx = _st >= 4; const int _cc = _isx ? (dir ? 35 - _st : _st - 4) : (dir ? 3 - _st : _st); \
            _Pragma("unroll") for (int _i = 0; _i < 2; ++_i) { const int _idx = tid + 512 * _i, _row = _idx >> 4, _ch = _idx & 15; \
                if (_isx) { const size_t _tok = (size_t)b * SEQ + _cc * 64 + _row; pq[_i] = *(const u32x4*)(QK + _tok * 1024 + h * 128 + _ch * 8); pk[_i] = *(const u32x4*)(QK + _tok * 1024 + 512 + h * 128 + _ch * 8); pv[_i] = *(const u32x4*)(PV + _tok * 512 + h * 128 + _ch * 8); } \
                else { const size_t _tok = (size_t)b * CL + _cc * 64 + _row; pk[_i] = *(const u32x4*)(KC + _tok * 512 + h * 128 + _ch * 8); pv[_i] = *(const u32x4*)(PC + _tok * 1024 + 512 + h * 128 + _ch * 8); pq[_i] = pk[_i]; } } \
            if (wave == 0) { const size_t _tok = _isx ? (size_t)b * SEQ + _cc * 64 + lane : (size_t)NTOK + (size_t)b * CL + _cc * 64 + lane; pig = gates[_tok * 16 + kI * 4 + h] + bI; pfg = gates[_tok * 16 + kF * 4 + h] + bF; } } while (0)
#define ML_COMMIT() do { \
            _Pragma("unroll") for (int _i = 0; _i < 2; ++_i) { const int _idx = tid + 512 * _i, _row = _idx >> 4, _ch = _idx & 15; const unsigned _o = off_b(_row, _ch); \
                *(LAS u32x4*)(lds + QS + _o) = pq[_i]; *(LAS u32x4*)(lds + KS + _o) = pk[_i]; *(LAS u32x4*)(lds + VS + _o) = pv[_i]; } \
            if (wave == 0) gate_math(pig, pfg, lane, dir, m0, sm); } while (0)
        ML_ISSUE(0);
        __syncthreads();
        ML_COMMIT();
        __syncthreads();
        const int g = lane >> 4, li = lane & 15;
        for (int step = 0; step < 36; ++step) {
            const bool isx = step >= 4; const int cc = isx ? (dir ? 35 - step : step - 4) : 0;
            if (!isx && step + 1 < 36) ML_ISSUE(step + 1);
            if (isx) {
                const int jt = wave >> 1, j = 16 * jt + li;
                {   const int jr = tid >> 3, part = tid & 7; float dsum = 0.f;
#pragma unroll
                    for (int c2 = 0; c2 < 2; ++c2) { const u32x4 qv = *(const LAS u32x4*)(lds + QS + off_b(jr, 2 * part + c2)); const LAS float* np = sm + N_ + 16 * part + 8 * c2; const f32x4 n0 = *(const LAS f32x4*)np, n1 = *(const LAS f32x4*)(np + 4);
                        dsum += bflo(qv.x) * n0[0] + bfhi(qv.x) * n0[1] + bflo(qv.y) * n0[2] + bfhi(qv.y) * n0[3] + bflo(qv.z) * n1[0] + bfhi(qv.z) * n1[1] + bflo(qv.w) * n1[2] + bfhi(qv.w) * n1[3]; }
                    dsum += __shfl_xor(dsum, 1); dsum += __shfl_xor(dsum, 2); dsum += __shfl_xor(dsum, 4);
                    if (part == 0) sm[QN_ + jr] = dsum; }
                bf16x8 qf[4];
#pragma unroll
                for (int ks = 0; ks < 4; ++ks) qf[ks] = rowfrag(lds + QS, jt, ks, lane);
                const float Mj = sm[M_ + j]; float rsum = 0.f;
#pragma unroll
                for (int t = 0; t < 2; ++t) { const int st = 2 * (wave & 1) + t; f32x4 sa = {0.f, 0.f, 0.f, 0.f};
#pragma unroll
                    for (int ks = 0; ks < 4; ++ks) sa = __builtin_amdgcn_mfma_f32_16x16x32_bf16(rowfrag(lds + KS, st, ks, lane), qf[ks], sa, 0, 0, 0);
                    const int s0 = 16 * st + 4 * g; const f32x4 u4 = *(const LAS f32x4*)(sm + U_ + s0); float sp[4];
#pragma unroll
                    for (int r = 0; r < 4; ++r) { const int s = s0 + r; const bool keep = dir ? (s >= j) : (s <= j); const float dv = expf(fminf(u4[r] - Mj, 0.f)); sp[r] = keep ? sa[r] * dv : 0.f; rsum += sp[r]; }
                    u32x2 w; w.x = pk2(sp[0], sp[1]); w.y = pk2(sp[2], sp[3]);
                    *(LAS u32x2*)(lds + SS + off_s(j, 2 * st + (g >> 1)) + (g & 1) * 8) = w; }
                rsum += __shfl_xor(rsum, 16); rsum += __shfl_xor(rsum, 32);
                if (g == 0) sm[RS_ + 2 * j + (wave & 1)] = rsum;
                __syncthreads();
                if (step + 1 < 36) ML_ISSUE(step + 1);
                f32x4 oa[4];
#pragma unroll
                for (int t = 0; t < 4; ++t) { const int dvt = 4 * (wave & 1) + t; oa[t] = (f32x4){0.f, 0.f, 0.f, 0.f};
#pragma unroll
                    for (int ks = 0; ks < 4; ++ks) oa[t] = __builtin_amdgcn_mfma_f32_16x16x32_bf16(rowfrag(lds + CT, dvt, ks, lane), rowfrag(lds + QS, jt, ks, lane), oa[t], 0, 0, 0); }
                const float dj = sm[DEC_ + j];
                bf16x8 sf[2];
#pragma unroll
                for (int ks = 0; ks < 2; ++ks) sf[ks] = *(const LAS bf16x8*)(lds + SS + off_s(j, 4 * ks + g));
                const float den = (sm[RS_ + 2 * j] + sm[RS_ + 2 * j + 1]) + dj * sm[QN_ + j];
                const float inv = 1.f / fmaxf(fabsf(den), sm[EM_ + j]);
                const size_t tok = (size_t)b * SEQ + cc * 64 + j;
#pragma unroll
                for (int t = 0; t < 4; ++t) { const int dvt = 4 * (wave & 1) + t; f32x4 o = oa[t] * dj;
#pragma unroll
                    for (int ks = 0; ks < 2; ++ks) o = __builtin_amdgcn_mfma_f32_16x16x32_bf16(trfrag(lds + VS, dvt, ks, lane), sf[ks], o, 0, 0, 0);
                    o = o * inv; u32x2 w; w.x = pk2(o[0], o[1]); w.y = pk2(o[2], o[3]);
                    *(u32x2*)(Hout + tok * 512 + h * 128 + 16 * dvt + 4 * g) = w; }
            }
            {   const float dn = sm[SC_];
                bf16x8 kf[2];
#pragma unroll
                for (int ks = 0; ks < 2; ++ks) { const bf16x8 kr = trfrag(lds + KS, wave, ks, lane); const f32x4 w0 = *(const LAS f32x4*)(sm + WA_ + 32 * ks + 8 * g), w1 = *(const LAS f32x4*)(sm + WA_ + 32 * ks + 8 * g + 4);
                    u32x4 pkd; pkd.x = pk2(bf1((bf16)kr[0]) * w0[0], bf1((bf16)kr[1]) * w0[1]); pkd.y = pk2(bf1((bf16)kr[2]) * w0[2], bf1((bf16)kr[3]) * w0[3]);
                    pkd.z = pk2(bf1((bf16)kr[4]) * w1[0], bf1((bf16)kr[5]) * w1[1]); pkd.w = pk2(bf1((bf16)kr[6]) * w1[2], bf1((bf16)kr[7]) * w1[3]);
                    kf[ks] = __builtin_bit_cast(bf16x8, pkd); }
                {   const int dk = tid >> 2, part = tid & 3; float a = 0.f;
#pragma unroll
                    for (int e = 0; e < 16; ++e) { const int s = 16 * part + e; a += sm[WA_ + s] * bf1(*(const LAS bf16*)(lds + KS + off_b(s, dk >> 3) + (dk & 7) * 2)); }
                    a += __shfl_xor(a, 1); a += __shfl_xor(a, 2);
                    if (part == 0) sm[N_ + dk] = dn * sm[N_ + dk] + a; }
#pragma unroll
                for (int dvt = 0; dvt < 8; ++dvt) { f32x4 c = Cacc[dvt] * dn;
#pragma unroll
                    for (int ks = 0; ks < 2; ++ks) c = __builtin_amdgcn_mfma_f32_16x16x32_bf16(kf[ks], trfrag(lds + VS, dvt, ks, lane), c, 0, 0, 0);
                    Cacc[dvt] = c; }
            }
            __syncthreads();
#pragma unroll
            for (int dvt = 0; dvt < 8; ++dvt) { const f32x4 c = Cacc[dvt]; u32x2 w; w.x = pk2(c[0], c[1]); w.y = pk2(c[2], c[3]);
                *(LAS u32x2*)(lds + CT + off_b(16 * dvt + li, 2 * wave + (g >> 1)) + (g & 1) * 8) = w; }
            if (step + 1 < 36) ML_COMMIT();
            __syncthreads();
        }
    }
}
#undef ML_ISSUE
#undef ML_COMMIT
}
constexpr int N_PHASES = 13;
struct Args { const float* in[19]; float* out; unsigned char* ws; int ph_lo, ph_hi; };
static_assert(sizeof(Args) == 19 * 8 + 8 + 8 + 8, "Args has no padding");

__global__ void __launch_bounds__(512, 2) mk_fwd(Args a) {
    extern __shared__ __attribute__((aligned(16))) unsigned char lds_raw[];
    LAS unsigned char* lds = (LAS unsigned char*)lds_raw;
    const int tid = threadIdx.x, lane = tid & 63, wave = __builtin_amdgcn_readfirstlane(tid >> 6), G = gridDim.x;
    Ctx C;
    C.x = a.in[0]; C.c = a.in[1]; C.ctx = a.in[2]; C.c_ctx = a.in[3]; C.w_ada = a.in[4]; C.b_ada = a.in[5]; C.g_norm1 = a.in[6]; C.w_in = a.in[7]; C.b_gates = a.in[8]; C.w_conv = a.in[9];
    C.w_fourier = a.in[10]; C.w_mlstm = a.in[11]; C.w_out = a.in[12]; C.g_norm2 = a.in[13]; C.w_router = a.in[14]; C.w_gate_e = a.in[15]; C.w_up_e = a.in[16]; C.w_down_e = a.in[17]; C.g_final = a.in[18];
    C.out = a.out; C.ws = a.ws;
    const int lo = a.ph_lo, hi = a.ph_hi;
#if MK_XCD_BAR
    volatile LAS unsigned* bst = (volatile LAS unsigned*)(lds + LDS_PHASE_BYTES);
    if (tid < 4) bst[tid] = 0u;
    __syncthreads();
    XcdBarrier bar = xcd_barrier_post((unsigned*)(a.ws + WS_CTL) + 4096, bst);
#endif
    int nsync = 0;
#define IN(k) (lo <= (k) && (k) < hi)
#if MK_XCD_BAR
#define GRIDBAR() do { if (nsync == 0) cg::this_grid().sync(); else xcd_barrier(bar); ++nsync; } while (0)
#else
#define GRIDBAR() do { cg::this_grid().sync(); ++nsync; } while (0)
#endif
#define SEAM(k) do { if (IN(k) && IN((k) + 1)) GRIDBAR(); } while (0)
#ifndef PROBE_PH
#define PROBE_PH -1
#endif
#define PHASE(k, ...) do { if (IN(k)) { __VA_ARGS__ if ((k) == PROBE_PH) { GRIDBAR(); __VA_ARGS__ } } SEAM(k); } while (0)
    PHASE(0, { p0_prep(C, lds, tid, lane, wave, G); });
    PHASE(1, { p1a_norm_gates(C, lds, tid, lane, wave, G); __syncthreads(); });
    PHASE(2, { SchedP1 S{C.ws, G, (int)blockIdx.x}; EpiP1 E{C.ws}; mg::gemm_phase<EpiP1, SchedP1, false>(lds, 1024, S, E); });
    PHASE(3, { SchedF2 S{C.ws, G, (int)blockIdx.x}; EpiF2 E{C.ws}; mg::gemm_phase<EpiF2, SchedF2, false>(lds, 4096, S, E); p2_conv(C, lane, wave, G); });
    PHASE(4, { ml::mlstm_phase(C, lds, tid, lane, wave, G); });
    PHASE(5, { p3b_combine(C, tid, G); });
    PHASE(6, { SchedMerge S{C.ws, G, (int)blockIdx.x}; EpiMerge E{C.ws}; mg::gemm_phase<EpiMerge, SchedMerge, false>(lds, 512, S, E); });
    PHASE(7, { SchedOut S{C.ws, G, (int)blockIdx.x}; EpiOut E{C.x, (const float*)(C.ws + WS_MOD), C.out}; mg::gemm_phase<EpiOut, SchedOut, false>(lds, 1024, S, E); });
    PHASE(8, { p6_norm_router(C, lds, tid, lane, wave, G); __syncthreads(); });
    PHASE(9, { const int NGW = G * 8; for (int it = blockIdx.x * 8 + wave; it < NB * NE; it += NGW) topk_item(C, it, lane); convert_experts(C, lds, lane, wave, G); __syncthreads(); });
    PHASE(10, { SchedUp S{C.ws, G, (int)blockIdx.x}; EpiSwiglu E{C.ws}; mg::gemm_phase<EpiSwiglu, SchedUp, true>(lds, 1024, S, E); });
    PHASE(11, { SchedDown S{C.ws, G, (int)blockIdx.x}; EpiDown E{C.ws}; mg::gemm_phase<EpiDown, SchedDown, false>(lds, 1024, S, E); });
    if (IN(12)) { p10_final(C, lane, wave, G); }
#undef PHASE
#undef IN
#undef SEAM
#undef GRIDBAR
}

static void mk_launch(void* const* d_in, void* d_out, void* d_ws, hipStream_t stream, int lo, int hi, bool coop) {
    static int grid = 0;
    if (grid == 0) {
        int dev = 0, cus = 0, per_cu = 0;
        (void)hipGetDevice(&dev); (void)hipDeviceGetAttribute(&cus, hipDeviceAttributeMultiprocessorCount, dev);
        (void)hipFuncSetAttribute((const void*)mk_fwd, hipFuncAttributeMaxDynamicSharedMemorySize, LDS_BYTES);
        (void)hipOccupancyMaxActiveBlocksPerMultiprocessor(&per_cu, (const void*)mk_fwd, 512, LDS_BYTES);
        if (per_cu < 1) fprintf(stderr, "mk_launch: occupancy query says %d blocks/CU\n", per_cu);
        grid = cus > 0 ? cus : 256;
    }
    Args a{};
    for (int i = 0; i < 19; ++i) a.in[i] = (const float*)d_in[i];
    a.out = (float*)d_out; a.ws = (unsigned char*)d_ws; a.ph_lo = lo; a.ph_hi = hi;
    if (coop) { void* args[] = {&a}; hipError_t e = hipLaunchCooperativeKernel((const void*)mk_fwd, dim3(grid), dim3(512), args, LDS_BYTES, stream);
        if (e != hipSuccess) fprintf(stderr, "cooperative launch failed: %s (grid %d)\n", hipGetErrorString(e), grid); }
    else hipLaunchKernelGGL(mk_fwd, dim3(grid), dim3(512), LDS_BYTES, stream, a);
}
extern "C" void kernel_launch(void* const* d_in, const int* in_sizes, int n_in, void* d_out, int out_size, void* d_ws, size_t ws_size, hipStream_t stream) {
    (void)hipMemsetAsync((char*)d_ws + WS_CTL, 0, 65536, stream);
    mk_launch(d_in, d_out, d_ws, stream, 0, N_PHASES, true);
}
```

```cpp
#ifndef MK_XCD_BAR
#define MK_XCD_BAR 1
#endif
#include <hip/hip_runtime.h>
#include <hip/hip_cooperative_groups.h>
#include <cstdio>
#include <cstdint>
namespace cg = cooperative_groups;

#define LAS __attribute__((address_space(3)))
typedef unsigned short bf16;
typedef short bf16x8 __attribute__((ext_vector_type(8)));
typedef short s16x4 __attribute__((ext_vector_type(4)));
typedef float f32x4 __attribute__((ext_vector_type(4)));
typedef float f32x2 __attribute__((ext_vector_type(2)));
typedef unsigned u32x4 __attribute__((ext_vector_type(4)));
typedef unsigned u32x2 __attribute__((ext_vector_type(2)));
typedef __bf16 bf16x2_t __attribute__((ext_vector_type(2)));

__device__ __forceinline__ unsigned pk2(float lo, float hi) { f32x2 v = {lo, hi}; bf16x2_t b = __builtin_convertvector(v, bf16x2_t); return __builtin_bit_cast(unsigned, b); }
__device__ __forceinline__ float bflo(unsigned w) { return __uint_as_float(w << 16); }
__device__ __forceinline__ float bfhi(unsigned w) { return __uint_as_float(w & 0xffff0000u); }
__device__ __forceinline__ float bf1(bf16 b) { return __uint_as_float((unsigned)b << 16); }
__device__ __forceinline__ float silu_f(float v) { return v / (1.f + __expf(-v)); }
__device__ __forceinline__ float sigmoid_f(float v) { return 1.f / (1.f + __expf(-v)); }
__device__ __forceinline__ float log_sigmoid_f(float v) { return fminf(v, 0.f) - log1pf(expf(-fabsf(v))); }
__device__ __forceinline__ float wave_sum(float v) {
#pragma unroll
    for (int o = 1; o < 64; o <<= 1) v += __shfl_xor(v, o);
    return v;
}

#define XB_TMO      128
#define XB_XCNT(j)  (256  + 64 * (j))
#define XB_XSUB(j)  (1280 + 64 * (j))
#define XB_XGEN(j)  (2304 + 64 * (j))
#define XB_TOP      3328
#define XB_TOPGEN   3392
#define XCD_BAR_WORDS 3456
#define XB_SPIN_CAP (1u << 20)
__device__ __forceinline__ unsigned xb_ld(unsigned* p)              { return __hip_atomic_load(p, __ATOMIC_RELAXED, __HIP_MEMORY_SCOPE_AGENT); }
__device__ __forceinline__ unsigned xb_add(unsigned* p, unsigned v) { return __hip_atomic_fetch_add(p, v, __ATOMIC_RELAXED, __HIP_MEMORY_SCOPE_AGENT); }
__device__ __forceinline__ unsigned xb_xcc_id() { return (unsigned)__builtin_amdgcn_s_getreg((3 << 11) | 20) & 0xFu; }
#define XB_SPIN(cond, bar) do { unsigned _sp = 0; while (cond) { __builtin_amdgcn_s_sleep(1); \
    if ((++_sp & 255u) == 0u) { if (xb_ld(&(bar)[XB_TMO])) break; if (_sp > XB_SPIN_CAP) { atomicAdd(&(bar)[XB_TMO], 1u); break; } } } } while (0)
struct XcdBarrier { unsigned* bar; unsigned x; volatile LAS unsigned* st; };
__device__ __forceinline__ XcdBarrier xcd_barrier_post(unsigned* bar, volatile LAS unsigned* st) {
    XcdBarrier b; b.bar = bar; b.x = xb_xcc_id(); b.st = st;
    if (threadIdx.x == 0) (void)xb_add(&bar[XB_XCNT(b.x)], 1u);
    return b;
}
__device__ __forceinline__ void xcd_barrier_complete(unsigned* bar, unsigned x, unsigned& nloc, unsigned& nx) {
    const unsigned G = gridDim.x * gridDim.y * gridDim.z;
    unsigned sum, cnt, mine, sp = 0u;
    for (;;) {
        sum = 0u; cnt = 0u; mine = 0u;
#pragma unroll
        for (unsigned j = 0; j < 16; ++j) { const unsigned c = xb_ld(&bar[XB_XCNT(j)]); sum += c; cnt += (c > 0u) ? 1u : 0u; mine = (j == x) ? c : mine; }
        if (sum == G) break;
        __builtin_amdgcn_s_sleep(1);
        if ((++sp & 255u) == 0u) { if (xb_ld(&bar[XB_TMO])) break; if (sp > XB_SPIN_CAP) { atomicAdd(&bar[XB_TMO], 1u); break; } }
    }
    nloc = mine > 0u ? mine : 1u; nx = cnt > 0u ? cnt : 1u;
}
__device__ __forceinline__ void xcd_barrier(const XcdBarrier& b) {
    asm volatile("s_waitcnt vmcnt(0)" ::: "memory");
    __syncthreads();
    if (threadIdx.x == 0) {
        unsigned* bar = b.bar;
        __builtin_amdgcn_s_waitcnt(0);
        unsigned nloc = b.st[0], nx = b.st[1];
        if (nloc == 0u) { xcd_barrier_complete(bar, b.x, nloc, nx); b.st[0] = nloc; b.st[1] = nx; }
        const unsigned old = xb_add(&bar[XB_XSUB(b.x)], 1u);
        const unsigned gen = old / nloc;
        if (old + 1u == (gen + 1u) * nloc) {
            __builtin_amdgcn_fence(__ATOMIC_RELEASE, "agent");
            asm volatile("s_waitcnt vmcnt(0)" ::: "memory");
            const unsigned og = xb_add(&bar[XB_TOP], 1u);
            const unsigned tg = og / nx;
            if (og + 1u == (tg + 1u) * nx) xb_add(&bar[XB_TOPGEN], 1u);
            else XB_SPIN(xb_ld(&bar[XB_TOPGEN]) == tg, bar);
            __builtin_amdgcn_fence(__ATOMIC_ACQUIRE, "agent");
            xb_add(&bar[XB_XGEN(b.x)], 1u);
            asm volatile("s_waitcnt vmcnt(0)" ::: "memory");
        } else {
            XB_SPIN(xb_ld(&bar[XB_XGEN(b.x)]) == gen, bar);
            __builtin_amdgcn_fence(__ATOMIC_ACQUIRE, "agent");
            asm volatile("s_waitcnt vmcnt(0)" ::: "memory");
        }
    }
    __syncthreads();
}

namespace mg {
constexpr int BM = 256, BK = 64, HALF = 128, HTB = HALF * BK * 2, STAGE_BYTES = 8 * HTB, NXCD = 8, WGM = 8;
__host__ __device__ __forceinline__ int lds_byte(int r, int c) { const int st = (r >> 4) * 2 + (c >> 5), rr = r & 15, cc = c & 31, ob = rr * 64 + cc * 2; return st * 1024 + (ob ^ (((ob >> 9) & 1) << 5)); }
__host__ __device__ __forceinline__ void stage_rc(int b, int& R, int& C) { const int st = b / 1024, sb = b % 1024, swz = sb ^ (((sb >> 9) & 1) << 5); R = (st >> 1) * 16 + swz / 64; C = (st & 1) * 32 + (swz % 64) / 2; }
__host__ __device__ __forceinline__ int perm32(int rho) { const int n = rho >> 4, i = rho & 15; return 8 * (i >> 2) + 4 * n + (i & 3); }

struct Unit { int pm, pn, ty; const char* a; const char* b; const int* gi; };
__device__ __forceinline__ void tile_of(int wgid, int nM, int nN, int& pm, int& pn) {
    const int nwg = nM * nN; { const int q = nwg / NXCD, r = nwg % NXCD, xcd = wgid % NXCD, off = wgid / NXCD; wgid = (xcd < r ? xcd * (q + 1) : r * (q + 1) + (xcd - r) * q) + off; }
    const int nig = WGM * nN, gid = wgid / nig, fm = gid * WGM, gsz = (nM - fm) < WGM ? (nM - fm) : WGM;
    pm = fm + ((wgid % nig) % gsz); pn = (wgid % nig) / gsz;
}

template <class Epi, class Sched, bool GATHER>
__device__ __forceinline__ void gemm_phase(LAS unsigned char* lds, const int K, const Sched& S, const Epi& E) {
    const int tid = threadIdx.x, wid = __builtin_amdgcn_readfirstlane(tid >> 6), lane = tid & 63, wr = wid >> 2, wc = wid & 3, fr = lane & 15, fq = lane >> 4;
    const int nt = K / BK;
    unsigned voffB[2], vAc[2][2], vAn[2][2]; int stR[2], stC[2];
    const size_t kstep = (size_t)(BK * 2);
    const size_t hstep = (size_t)HALF * K * 2;
#pragma unroll
    for (int i = 0; i < 2; ++i) { int R, C; stage_rc(tid * 16 + i * 8192, R, C); stR[i] = R; stC[i] = C; const int Rb = Epi::PERM ? ((R & ~31) + perm32(R & 31)) : R;
        voffB[i] = (unsigned)(Rb * K + C) * 2u; }
    const unsigned ldsw = (unsigned)wid * 1024u;
    const int aoff = lds_byte(wr * 64 + fr, fq * 8), boff = lds_byte(wc * 32 + fr, fq * 8);
#define MG_SA(b, h) (((b) * 2 + (h)) * HTB)
#define MG_SB(b, h) ((4 + (b) * 2 + (h)) * HTB)
#define MG_STAGE(bufoff, gbase, voff) do { _Pragma("unroll") for (int _i = 0; _i < 2; ++_i) \
        __builtin_amdgcn_global_load_lds((const unsigned*)((const char*)(gbase) + (voff)[_i]), (LAS unsigned*)(lds + (bufoff) + ldsw + _i * 8192), 16, 0, 0); } while (0)
#define MG_LDA(dst, b, h) do { _Pragma("unroll") for (int m = 0; m < 4; ++m) _Pragma("unroll") for (int k = 0; k < 2; ++k) dst[m][k] = *(const LAS bf16x8*)(lds + MG_SA(b, h) + aoff + m * 2048 + k * 1024); } while (0)
#define MG_LDB(dst, b, h) do { _Pragma("unroll") for (int n = 0; n < 2; ++n) _Pragma("unroll") for (int k = 0; k < 2; ++k) dst[n][k] = *(const LAS bf16x8*)(lds + MG_SB(b, h) + boff + n * 2048 + k * 1024); } while (0)
#define MG_MMA(ai, bj, At, Bt) do { __builtin_amdgcn_s_setprio(1); _Pragma("unroll") for (int m = 0; m < 4; ++m) _Pragma("unroll") for (int n = 0; n < 2; ++n) _Pragma("unroll") for (int k = 0; k < 2; ++k) \
        acc[ai][bj][m][n] = __builtin_amdgcn_mfma_f32_16x16x32_bf16(Bt[n][k], At[m][k], acc[ai][bj][m][n], 0, 0, 0); __builtin_amdgcn_s_setprio(0); } while (0)
#define MG_WAIT_V(n) asm volatile("s_waitcnt vmcnt(" #n ")" ::: "memory")
#define MG_WAIT_L(n) asm volatile("s_waitcnt lgkmcnt(" #n ")" ::: "memory")
#define MG_BAR __builtin_amdgcn_s_barrier()
#define MG_SCHED __builtin_amdgcn_sched_barrier(0)
#define MG_AOFF(dst, u) do { _Pragma("unroll") for (int _h = 0; _h < 2; ++_h) _Pragma("unroll") for (int _i = 0; _i < 2; ++_i) { \
        if constexpr (GATHER) dst[_h][_i] = ((unsigned)(u).gi[_h * HALF + stR[_i]] * (unsigned)K + (unsigned)stC[_i]) * 2u; \
        else dst[_h][_i] = (unsigned)((_h * HALF + stR[_i]) * K + stC[_i]) * 2u; } } while (0)
    Unit cur, nxt; int ui = 0;
    if (!S.next(0, cur)) return;
    f32x4 acc[2][2][4][2];
#pragma unroll
    for (int a = 0; a < 2; ++a)
#pragma unroll
        for (int b = 0; b < 2; ++b)
#pragma unroll
            for (int m = 0; m < 4; ++m)
#pragma unroll
                for (int n = 0; n < 2; ++n) acc[a][b][m][n] = (f32x4){0.f, 0.f, 0.f, 0.f};
    bf16x8 At[4][2], B0[2][2], B1[2][2];
    const char* cA = cur.a; const char* cB = cur.b;
    MG_AOFF(vAc, cur);
    MG_STAGE(MG_SB(0, 0), cB, voffB); MG_STAGE(MG_SB(0, 1), cB + hstep, voffB); MG_STAGE(MG_SA(0, 0), cA, vAc[0]); MG_STAGE(MG_SA(0, 1), cA, vAc[1]);
    if (wr == 1) MG_BAR;
    MG_WAIT_V(2); MG_BAR;
    MG_STAGE(MG_SB(1, 0), cB + kstep, voffB); MG_STAGE(MG_SA(1, 0), cA + kstep, vAc[0]); MG_STAGE(MG_SB(1, 1), cB + hstep + kstep, voffB);
    MG_WAIT_V(6); MG_BAR;
    for (;;) {
        const bool has_next = S.next(ui + 1, nxt);
        const char* nA = has_next ? nxt.a : cA; const char* nB = has_next ? nxt.b : cB;
        if constexpr (GATHER) { if (has_next) { MG_AOFF(vAn, nxt); } else {
#pragma unroll
            for (int h = 0; h < 2; ++h)
#pragma unroll
                for (int i = 0; i < 2; ++i) vAn[h][i] = vAc[h][i]; } }
        for (int t = 0; t < nt; t += 2) {
            const bool last = (t == nt - 2);
            const char* a1 = cA + (size_t)(t + 1) * kstep;
            const char* a2 = last ? nA : cA + (size_t)(t + 2) * kstep; const char* b2 = last ? nB : cB + (size_t)(t + 2) * kstep;
            const char* a3 = a2 + kstep; const char* b3 = b2 + kstep;
            unsigned vA2[2][2];
#pragma unroll
            for (int h = 0; h < 2; ++h)
#pragma unroll
                for (int i = 0; i < 2; ++i) vA2[h][i] = (GATHER && last) ? vAn[h][i] : vAc[h][i];
            MG_LDB(B0, 0, 0); MG_LDB(B1, 0, 1); MG_SCHED; MG_LDA(At, 0, 0); MG_STAGE(MG_SA(1, 1), a1, vAc[1]);
            MG_WAIT_V(8); MG_WAIT_L(0); MG_BAR; MG_MMA(0, 0, At, B0); MG_MMA(0, 1, At, B1); MG_BAR; MG_SCHED;
            MG_LDA(At, 0, 1); MG_STAGE(MG_SB(0, 0), b2, voffB); MG_STAGE(MG_SB(0, 1), b2 + hstep, voffB); MG_STAGE(MG_SA(0, 0), a2, vA2[0]);
            MG_WAIT_V(8); MG_WAIT_L(0); MG_BAR; MG_MMA(1, 0, At, B0); MG_MMA(1, 1, At, B1); MG_BAR; MG_SCHED;
            MG_LDB(B0, 1, 0); MG_LDB(B1, 1, 1); MG_SCHED; MG_LDA(At, 1, 0); MG_STAGE(MG_SA(0, 1), a2, vA2[1]);
            MG_WAIT_V(8); MG_WAIT_L(0); MG_BAR; MG_MMA(0, 0, At, B0); MG_MMA(0, 1, At, B1); MG_BAR; MG_SCHED;
            MG_LDA(At, 1, 1); MG_STAGE(MG_SB(1, 0), b3, voffB); MG_STAGE(MG_SB(1, 1), b3 + hstep, voffB); MG_STAGE(MG_SA(1, 0), a3, vA2[0]);
            MG_WAIT_V(8); MG_WAIT_L(0); MG_BAR; MG_MMA(1, 0, At, B0); MG_MMA(1, 1, At, B1); MG_BAR; MG_SCHED;
        }
        if (wr == 0) MG_BAR;
        E(acc, cur, wr, wc, fr, fq);
        if (!has_next) break;
#pragma unroll
        for (int a = 0; a < 2; ++a)
#pragma unroll
            for (int b = 0; b < 2; ++b)
#pragma unroll
                for (int m = 0; m < 4; ++m)
#pragma unroll
                    for (int n = 0; n < 2; ++n) acc[a][b][m][n] = (f32x4){0.f, 0.f, 0.f, 0.f};
        cur = nxt; cA = nA; cB = nB; ++ui;
        if constexpr (GATHER) {
#pragma unroll
            for (int h = 0; h < 2; ++h)
#pragma unroll
                for (int i = 0; i < 2; ++i) vAc[h][i] = vAn[h][i]; }
        if (wr == 1) MG_BAR;
    }
    MG_WAIT_V(0);
    MG_BAR;
#undef MG_SA
#undef MG_SB
#undef MG_STAGE
#undef MG_LDA
#undef MG_LDB
#undef MG_MMA
#undef MG_WAIT_V
#undef MG_WAIT_L
#undef MG_BAR
#undef MG_SCHED
#undef MG_AOFF
}
}
constexpr int D = 1024, NB = 32, SEQ = 2048, CL = 256, NTOK = NB * SEQ, NCTX = NB * CL, INC = 4624;
constexpr int NE = 16, CAP = 256;
constexpr int OFF_QK = 512, OFF_V = 1536, OFF_O = 2048, OFF_G = 2560, OFF_BR = 2576;
constexpr float EPS = 1e-6f;
constexpr size_t MiB = 1u << 20;
constexpr size_t WS_CTL = 0, CTL_BYTES = 1 * MiB;
constexpr size_t WS_MOD = 1 * MiB;
constexpr size_t WS_GATES = 2 * MiB;
constexpr size_t WS_AFF = 11 * MiB;
constexpr size_t WS_IDX = 15 * MiB;
constexpr size_t WS_VAL = 15 * MiB + 512 * 1024;
constexpr size_t WS_SLOT = 16 * MiB;
constexpr size_t WS_WTF = 18 * MiB;
constexpr size_t WS_WFT = 20 * MiB;
constexpr size_t WS_WMT = 21 * MiB;
constexpr size_t WS_WOT = 22 * MiB;
constexpr size_t WS_WTM = 24 * MiB;
constexpr size_t WS_TT = 32 * MiB;
constexpr size_t WS_PC = 48 * MiB;
constexpr size_t WS_H = 64 * MiB;
constexpr size_t WS_QK = 64 * MiB;
constexpr size_t WS_KC = 192 * MiB;
constexpr size_t WS_MRG = 64 * MiB;
constexpr size_t WS_WGU = 64 * MiB;
constexpr size_t WS_WD = 128 * MiB;
constexpr size_t WS_AB = 208 * MiB;
constexpr size_t WS_HF = 208 * MiB;
constexpr size_t WS_HB = 272 * MiB;
constexpr size_t WS_HX2 = 208 * MiB;
constexpr size_t WS_FU = 336 * MiB;
constexpr size_t WS_PQK = 400 * MiB;
constexpr size_t WS_HM = 400 * MiB;
constexpr size_t WS_PV = 528 * MiB;
constexpr size_t WS_PO = 592 * MiB;
constexpr size_t WS_PBR = 656 * MiB;
constexpr size_t WS_HID = 400 * MiB;
constexpr size_t WS_Y = 656 * MiB;
constexpr size_t WS_END = 912 * MiB;
constexpr int LDS_PHASE_BYTES = 147456, LDS_BYTES = LDS_PHASE_BYTES + 256;

struct Ctx {
    const float *x, *c, *ctx, *c_ctx, *w_ada, *b_ada, *g_norm1, *w_in, *b_gates, *w_conv, *w_fourier, *w_mlstm, *w_out, *g_norm2, *w_router, *w_gate_e, *w_up_e, *w_down_e, *g_final;
    float* out; unsigned char* ws;
};

__device__ __forceinline__ void store_tile_bf16(const f32x4 (&acc)[2][2][4][2], bf16* base, int ldc, bool sig, int wr, int wc, int fr, int fq) {
    bf16* p0 = base + (size_t)(wr * 64 + fr) * ldc + wc * 32 + 8 * fq;
#pragma unroll
    for (int ai = 0; ai < 2; ++ai)
#pragma unroll
        for (int m = 0; m < 4; ++m) { bf16* rowp = p0 + (size_t)(ai * 128 + m * 16) * ldc;
#pragma unroll
            for (int bj = 0; bj < 2; ++bj) { f32x4 v0 = acc[ai][bj][m][0], v1 = acc[ai][bj][m][1];
                if (sig) {
#pragma unroll
                    for (int j = 0; j < 4; ++j) { v0[j] = sigmoid_f(v0[j]); v1[j] = sigmoid_f(v1[j]); } }
                u32x4 w; w.x = pk2(v0[0], v0[1]); w.y = pk2(v0[2], v0[3]); w.z = pk2(v1[0], v1[1]); w.w = pk2(v1[2], v1[3]);
                *(u32x4*)(rowp + bj * 128) = w; } }
}
struct EpiP1 {
    static constexpr bool PERM = true; unsigned char* ws;
    __device__ __forceinline__ void operator()(const f32x4 (&acc)[2][2][4][2], const mg::Unit& u, int wr, int wc, int fr, int fq) const {
        bf16* base; int ldc; bool sig = false;
        if (u.ty == 0) { const size_t r0 = (size_t)u.pm * 256;
            if (u.pn < 4) { base = (bf16*)(ws + WS_PQK) + r0 * 1024 + u.pn * 256; ldc = 1024; }
            else if (u.pn < 6) { base = (bf16*)(ws + WS_PV) + r0 * 512 + (u.pn - 4) * 256; ldc = 512; }
            else if (u.pn < 8) { base = (bf16*)(ws + WS_PO) + r0 * 512 + (u.pn - 6) * 256; ldc = 512; sig = true; }
            else { base = (bf16*)(ws + WS_PBR) + r0 * 2048 + (u.pn - 8) * 256; ldc = 2048; sig = true; }
        } else if (u.ty == 1) { base = (bf16*)(ws + WS_AB) + ((size_t)(u.pn >> 3) * 1024 + (size_t)u.pm * 256) * 2048 + (u.pn & 7) * 256; ldc = 2048; }
        else { base = (bf16*)(ws + WS_PC) + (size_t)u.pm * 256 * 1024 + u.pn * 256; ldc = 1024; }
        store_tile_bf16(acc, base, ldc, sig, wr, wc, fr, fq);
    }
};
struct EpiF2 {
    static constexpr bool PERM = true; unsigned char* ws;
    __device__ __forceinline__ void operator()(const f32x4 (&acc)[2][2][4][2], const mg::Unit& u, int wr, int wc, int fr, int fq) const {
        bf16* base = (bf16*)(ws + WS_FU) + ((size_t)(u.pn >> 1) * 2048 + (size_t)u.pm * 256) * 512 + (u.pn & 1) * 256;
        store_tile_bf16(acc, base, 512, false, wr, wc, fr, fq);
    }
};
struct EpiMerge {
    static constexpr bool PERM = true; unsigned char* ws;
    __device__ __forceinline__ void operator()(const f32x4 (&acc)[2][2][4][2], const mg::Unit& u, int wr, int wc, int fr, int fq) const {
        const size_t row0 = (size_t)u.pm * 256 + wr * 64 + fr; const int col0 = u.pn * 256 + wc * 32 + 8 * fq;
#pragma unroll
        for (int ai = 0; ai < 2; ++ai)
#pragma unroll
            for (int m = 0; m < 4; ++m) { const size_t row = row0 + ai * 128 + m * 16;
                bf16* mp = (bf16*)(ws + WS_MRG) + row * 1024 + col0; const bf16* gp = (const bf16*)(ws + WS_PBR) + row * 2048 + u.ty * 1024 + col0;
#pragma unroll
                for (int bj = 0; bj < 2; ++bj) { const u32x4 g = *(const u32x4*)(gp + bj * 128); const f32x4 v0 = acc[ai][bj][m][0], v1 = acc[ai][bj][m][1];
                    float r[8] = {bflo(g.x) * v0[0], bfhi(g.x) * v0[1], bflo(g.y) * v0[2], bfhi(g.y) * v0[3], bflo(g.z) * v1[0], bfhi(g.z) * v1[1], bflo(g.w) * v1[2], bfhi(g.w) * v1[3]};
                    if (u.ty == 1) { const u32x4 t = *(const u32x4*)(mp + bj * 128);
                        r[0] += bflo(t.x); r[1] += bfhi(t.x); r[2] += bflo(t.y); r[3] += bfhi(t.y); r[4] += bflo(t.z); r[5] += bfhi(t.z); r[6] += bflo(t.w); r[7] += bfhi(t.w); }
                    u32x4 w; w.x = pk2(r[0], r[1]); w.y = pk2(r[2], r[3]); w.z = pk2(r[4], r[5]); w.w = pk2(r[6], r[7]);
                    *(u32x4*)(mp + bj * 128) = w; } }
    }
};
struct EpiOut {
    static constexpr bool PERM = false; const float* x; const float* mod; float* out;
    __device__ __forceinline__ void operator()(const f32x4 (&acc)[2][2][4][2], const mg::Unit& u, int wr, int wc, int fr, int fq) const {
        const size_t row0 = (size_t)u.pm * 256 + wr * 64 + fr; const int col0 = u.pn * 256 + wc * 32 + 4 * fq; const int b = u.pm >> 3;
        f32x4 ga[2][2];
#pragma unroll
        for (int bj = 0; bj < 2; ++bj)
#pragma unroll
            for (int n = 0; n < 2; ++n) ga[bj][n] = *(const f32x4*)(mod + (size_t)b * 6144 + 2048 + col0 + bj * 128 + n * 16);
#pragma unroll
        for (int ai = 0; ai < 2; ++ai)
#pragma unroll
            for (int m = 0; m < 4; ++m) { const size_t off = (row0 + ai * 128 + m * 16) * 1024 + col0;
#pragma unroll
                for (int bj = 0; bj < 2; ++bj)
#pragma unroll
                    for (int n = 0; n < 2; ++n) { const f32x4 xv = *(const f32x4*)(x + off + bj * 128 + n * 16); *(f32x4*)(out + off + bj * 128 + n * 16) = xv + ga[bj][n] * acc[ai][bj][m][n]; } }
    }
};
struct EpiSwiglu {
    static constexpr bool PERM = true; unsigned char* ws;
    __device__ __forceinline__ void operator()(const f32x4 (&acc)[2][2][4][2], const mg::Unit& u, int wr, int wc, int fr, int fq) const {
        bf16* p0 = (bf16*)(ws + WS_HID) + ((size_t)u.pm * 256 + wr * 64 + fr) * 1024 + u.pn * 128 + wc * 32 + 8 * fq;
#pragma unroll
        for (int ai = 0; ai < 2; ++ai)
#pragma unroll
            for (int m = 0; m < 4; ++m) { float r[8];
#pragma unroll
                for (int n = 0; n < 2; ++n)
#pragma unroll
                    for (int j = 0; j < 4; ++j) r[n * 4 + j] = silu_f(acc[ai][0][m][n][j]) * acc[ai][1][m][n][j];
                u32x4 w; w.x = pk2(r[0], r[1]); w.y = pk2(r[2], r[3]); w.z = pk2(r[4], r[5]); w.w = pk2(r[6], r[7]);
                *(u32x4*)(p0 + (size_t)(ai * 128 + m * 16) * 1024) = w; }
    }
};
struct EpiDown {
    static constexpr bool PERM = true; unsigned char* ws;
    __device__ __forceinline__ void operator()(const f32x4 (&acc)[2][2][4][2], const mg::Unit& u, int wr, int wc, int fr, int fq) const {
        const size_t row0 = (size_t)u.pm * 256 + wr * 64 + fr; const float* val = (const float*)(ws + WS_VAL);
        bf16* p0 = (bf16*)(ws + WS_Y) + row0 * 1024 + u.pn * 256 + wc * 32 + 8 * fq;
#pragma unroll
        for (int ai = 0; ai < 2; ++ai)
#pragma unroll
            for (int m = 0; m < 4; ++m) { const float vv = val[row0 + ai * 128 + m * 16]; bf16* rowp = p0 + (size_t)(ai * 128 + m * 16) * 1024;
#pragma unroll
                for (int bj = 0; bj < 2; ++bj) { const f32x4 v0 = acc[ai][bj][m][0] * vv, v1 = acc[ai][bj][m][1] * vv;
                    u32x4 w; w.x = pk2(v0[0], v0[1]); w.y = pk2(v0[2], v0[3]); w.z = pk2(v1[0], v1[1]); w.w = pk2(v1[2], v1[3]);
                    *(u32x4*)(rowp + bj * 128) = w; } }
    }
};

struct SchedP1 {
    unsigned char* ws; int G, c;
    __device__ __forceinline__ bool next(int i, mg::Unit& u) const {
        int L = i * G + c; const char* H = (const char*)(ws + WS_H); u.gi = nullptr;
        if (L < 4096) { mg::tile_of(L, 256, 16, u.pm, u.pn); u.ty = 0; u.a = H + (size_t)u.pm * 256 * 2048; u.b = (const char*)(ws + WS_WTM) + (size_t)u.pn * 256 * 2048; return true; }
        L -= 4096;
        if (L < 1024) { mg::tile_of(L, 4, 256, u.pm, u.pn); u.ty = 1; u.a = (const char*)(ws + WS_WTF) + (size_t)u.pm * 256 * 2048; u.b = H + (size_t)u.pn * 256 * 2048; return true; }
        L -= 1024;
        if (L < 128) { mg::tile_of(L, 32, 4, u.pm, u.pn); u.ty = 2; u.a = H + ((size_t)NTOK + (size_t)u.pm * 256) * 2048; u.b = (const char*)(ws + WS_WTM) + ((size_t)512 + (size_t)u.pn * 256) * 2048; return true; }
        return false;
    }
};
struct SchedF2 {
    unsigned char* ws; int G, c;
    __device__ __forceinline__ bool next(int i, mg::Unit& u) const {
        const int L = i * G + c; if (L >= 512) return false; mg::tile_of(L, 8, 64, u.pm, u.pn); u.ty = 0; u.gi = nullptr;
        u.a = (const char*)(ws + WS_TT) + (size_t)u.pm * 256 * 8192; u.b = (const char*)(ws + WS_AB) + (size_t)u.pn * 256 * 8192; return true;
    }
};
struct SchedMerge {
    unsigned char* ws; int G, c;
    __device__ __forceinline__ bool next(int i, mg::Unit& u) const {
        const int L = (i >> 1) * G + c; if (L >= 1024) return false; mg::tile_of(L, 256, 4, u.pm, u.pn); u.ty = i & 1; u.gi = nullptr;
        u.a = (const char*)(ws + (u.ty ? WS_HM : WS_FU)) + (size_t)u.pm * 256 * 1024; u.b = (const char*)(ws + (u.ty ? WS_WMT : WS_WFT)) + (size_t)u.pn * 256 * 1024; return true;
    }
};
struct SchedOut {
    unsigned char* ws; int G, c;
    __device__ __forceinline__ bool next(int i, mg::Unit& u) const {
        const int L = i * G + c; if (L >= 1024) return false; mg::tile_of(L, 256, 4, u.pm, u.pn); u.ty = 0; u.gi = nullptr;
        u.a = (const char*)(ws + WS_MRG) + (size_t)u.pm * 256 * 2048; u.b = (const char*)(ws + WS_WOT) + (size_t)u.pn * 256 * 2048; return true;
    }
};
struct SchedUp {
    unsigned char* ws; int G, c;
    __device__ __forceinline__ bool next(int i, mg::Unit& u) const {
        const int L = i * G + c; if (L >= 4096) return false; mg::tile_of(L, 512, 8, u.pm, u.pn); u.ty = 0;
        u.a = (const char*)(ws + WS_HX2); u.gi = (const int*)(ws + WS_IDX) + (size_t)u.pm * 256; u.b = (const char*)(ws + WS_WGU) + ((size_t)(u.pm >> 5) * 8 + u.pn) * 256 * 2048; return true;
    }
};
struct SchedDown {
    unsigned char* ws; int G, c;
    __device__ __forceinline__ bool next(int i, mg::Unit& u) const {
        const int L = i * G + c; if (L >= 2048) return false; mg::tile_of(L, 512, 4, u.pm, u.pn); u.ty = 0; u.gi = nullptr;
        u.a = (const char*)(ws + WS_HID) + (size_t)u.pm * 256 * 2048; u.b = (const char*)(ws + WS_WD) + ((size_t)(u.pm >> 5) * 4 + u.pn) * 256 * 2048; return true;
    }
};

__device__ __forceinline__ void transpose_item(const float* W, int ldw, int n0, int k0, bf16* dst, int drow0, int Kd, LAS float* scr, int lane) {
#pragma unroll 8
    for (int i = 0; i < 32; ++i) { const int kk = 2 * i + (lane >> 5); scr[kk * 33 + (lane & 31)] = W[(size_t)(k0 + kk) * ldw + n0 + (lane & 31)]; }
    asm volatile("s_waitcnt lgkmcnt(0)" ::: "memory");
    const int c = lane & 7;
#pragma unroll
    for (int j = 0; j < 4; ++j) { const int n = (lane >> 3) + 8 * j; const LAS float* s = scr + (8 * c) * 33 + n;
        u32x4 o; o.x = pk2(s[0 * 33], s[1 * 33]); o.y = pk2(s[2 * 33], s[3 * 33]); o.z = pk2(s[4 * 33], s[5 * 33]); o.w = pk2(s[6 * 33], s[7 * 33]);
        *(u32x4*)(dst + (size_t)(drow0 + n) * Kd + k0 + 8 * c) = o; }
    asm volatile("s_waitcnt lgkmcnt(0)" ::: "memory");
}

__device__ __forceinline__ void p0_prep(const Ctx& C, LAS unsigned char* lds, int tid, int lane, int wave, int G) {
    const int blk = blockIdx.x;
    for (int item = blk; item < 192; item += G) {
        LAS float* sT = (LAS float*)lds;
        for (int i = tid; i < 33 * 1024; i += 512) { const int r = i >> 10, k = i & 1023; const float v = r < 32 ? C.c[r * 1024 + k] : C.c_ctx[k]; sT[k * 36 + r] = silu_f(v); }
        for (int i = tid; i < 3 * 1024; i += 512) { const int r = 33 + (i >> 10), k = i & 1023; sT[k * 36 + r] = 0.f; }
        __syncthreads();
        const int col0 = item * 32, kg = tid >> 5, j = tid & 31;
        float acc[36];
#pragma unroll
        for (int r = 0; r < 36; ++r) acc[r] = 0.f;
#pragma unroll 4
        for (int kk = 0; kk < 64; ++kk) { const int k = kg * 64 + kk; const float w = C.w_ada[(size_t)k * 6144 + col0 + j];
#pragma unroll
            for (int q = 0; q < 9; ++q) { const f32x4 s4 = *(const LAS f32x4*)(sT + k * 36 + 4 * q); acc[4 * q] += s4[0] * w; acc[4 * q + 1] += s4[1] * w; acc[4 * q + 2] += s4[2] * w; acc[4 * q + 3] += s4[3] * w; } }
        __syncthreads();
        LAS float* red = (LAS float*)lds;
#pragma unroll
        for (int r = 0; r < 33; ++r) red[(kg * 33 + r) * 32 + j] = acc[r];
        __syncthreads();
        float* mod = (float*)(C.ws + WS_MOD);
        for (int o = tid; o < 33 * 32; o += 512) { const int r = o >> 5, jj = o & 31; float s = 0.f;
#pragma unroll
            for (int g = 0; g < 16; ++g) s += red[(g * 33 + r) * 32 + jj];
            mod[(size_t)r * 6144 + col0 + jj] = s + C.b_ada[col0 + jj]; }
        __syncthreads();
    }
    for (int item = blk; item < 256; item += G) {
        LAS float* wl = (LAS float*)lds; LAS float* cs = wl + 16 * 128; LAS float* sn = cs + 128;
        const int g = item >> 6, d0 = (item & 63) * 16;
        for (int i = tid; i < 16 * 128; i += 512) { const int dd = i >> 7, cc = i & 127; wl[i] = C.w_in[(size_t)(d0 + dd) * INC + g * 128 + cc]; }
        if (tid < 128) { cs[tid] = cospif((float)tid * (1.f / 64.f)); sn[tid] = sinpif((float)tid * (1.f / 64.f)); }
        __syncthreads();
        const int rj = tid & 255, j = rj >> 1, ab = rj & 1, half = tid >> 8;
        float acc[8];
#pragma unroll
        for (int i = 0; i < 8; ++i) acc[i] = 0.f;
        const LAS float* tw = ab ? sn : cs;
        for (int cc = 0; cc < 128; ++cc) { const float t = tw[(j * cc) & 127];
#pragma unroll
            for (int i = 0; i < 8; ++i) acc[i] += wl[(half * 8 + i) * 128 + cc] * t; }
        u32x4 o; o.x = pk2(acc[0], acc[1]); o.y = pk2(acc[2], acc[3]); o.z = pk2(acc[4], acc[5]); o.w = pk2(acc[6], acc[7]);
        *(u32x4*)((bf16*)(C.ws + WS_WTF) + (size_t)(g * 256 + rj) * 1024 + d0 + half * 8) = o;
        __syncthreads();
    }
    {
        LAS float* tc = (LAS float*)lds; LAS float* ts = tc + 2048;
        for (int i = tid; i < 2048; i += 512) { const float a = (float)i * (1.f / 1024.f); tc[i] = cospif(a) * (1.f / 512.f); ts[i] = -sinpif(a) * (1.f / 512.f); }
        __syncthreads();
        for (int item = blk; item < 256; item += G)
            for (int rr = 0; rr < 8; ++rr) { const int k = item * 8 + rr; const int lp0 = tid * 8; const LAS float* tb = lp0 < 2048 ? tc : ts; const int l0 = lp0 & 2047; float v[8];
#pragma unroll
                for (int e = 0; e < 8; ++e) v[e] = tb[(k * (l0 + e)) & 2047];
                u32x4 o; o.x = pk2(v[0], v[1]); o.y = pk2(v[2], v[3]); o.z = pk2(v[4], v[5]); o.w = pk2(v[6], v[7]);
                *(u32x4*)((bf16*)(C.ws + WS_TT) + (size_t)k * 4096 + lp0) = o; }
        __syncthreads();
    }
    {
        LAS float* scr = (LAS float*)lds + wave * (64 * 33);
        const int gw = blk * 8 + wave, NGW = G * 8;
        constexpr int I_IN = 16 * 128, I_F = 8 * 32, I_M = 8 * 32, I_O = 16 * 32;
        for (int it = gw; it < I_IN + I_F + I_M + I_O; it += NGW) {
            int r = it;
            if (r < I_IN) { const int kb = r >> 7, nb = r & 127; const int n0 = nb < 64 ? 512 + 32 * nb : 2576 + 32 * (nb - 64);
                transpose_item(C.w_in, INC, n0, kb * 64, (bf16*)(C.ws + WS_WTM), 32 * nb, 1024, scr, lane); continue; }
            r -= I_IN;
            if (r < I_F) { const int kb = r >> 5, nb = r & 31; transpose_item(C.w_fourier, 1024, 32 * nb, kb * 64, (bf16*)(C.ws + WS_WFT), 32 * nb, 512, scr, lane); continue; }
            r -= I_F;
            if (r < I_M) { const int kb = r >> 5, nb = r & 31; transpose_item(C.w_mlstm, 1024, 32 * nb, kb * 64, (bf16*)(C.ws + WS_WMT), 32 * nb, 512, scr, lane); continue; }
            r -= I_M;
            { const int kb = r >> 5, nb = r & 31; transpose_item(C.w_out, 1024, 32 * nb, kb * 64, (bf16*)(C.ws + WS_WOT), 32 * nb, 1024, scr, lane); }
        }
    }
}
__device__ __forceinline__ void convert_experts(const Ctx& C, LAS unsigned char* lds, int lane, int wave, int G, int rep) {
    LAS float* scr = (LAS float*)lds + wave * (64 * 33);
    const int gw = blockIdx.x * 8 + wave, NGW = G * 8;
    for (int it0 = gw; it0 < 48 * 512 * rep; it0 += NGW) { const int it = it0 % (48 * 512);
        const int mat = it >> 9, r = it & 511, kb = r >> 5, nb = r & 31, e = mat & 15, which = mat >> 4;
        if (which < 2) { const float* W = (which ? C.w_up_e : C.w_gate_e) + (size_t)e * 1024 * 1024; const int n0 = 32 * nb;
            transpose_item(W, 1024, n0, kb * 64, (bf16*)(C.ws + WS_WGU), e * 2048 + (n0 >> 7) * 256 + which * 128 + (n0 & 127), 1024, scr, lane); }
        else transpose_item(C.w_down_e + (size_t)e * 1024 * 1024, 1024, 32 * nb, kb * 64, (bf16*)(C.ws + WS_WD), e * 1024 + 32 * nb, 1024, scr, lane);
    }
}

__device__ __forceinline__ float butterfly64(float (&v)[64], int lane) {
#pragma unroll
    for (int i = 0; i < 32; ++i) { const bool up = lane & 32; const float send = up ? v[i] : v[i + 32], keep = up ? v[i + 32] : v[i]; v[i] = keep + __shfl_xor(send, 32); }
#pragma unroll
    for (int i = 0; i < 16; ++i) { const bool up = lane & 16; const float send = up ? v[i] : v[i + 16], keep = up ? v[i + 16] : v[i]; v[i] = keep + __shfl_xor(send, 16); }
#pragma unroll
    for (int i = 0; i < 8; ++i) { const bool up = lane & 8; const float send = up ? v[i] : v[i + 8], keep = up ? v[i + 8] : v[i]; v[i] = keep + __shfl_xor(send, 8); }
#pragma unroll
    for (int i = 0; i < 4; ++i) { const bool up = lane & 4; const float send = up ? v[i] : v[i + 4], keep = up ? v[i + 4] : v[i]; v[i] = keep + __shfl_xor(send, 4); }
#pragma unroll
    for (int i = 0; i < 2; ++i) { const bool up = lane & 2; const float send = up ? v[i] : v[i + 2], keep = up ? v[i + 2] : v[i]; v[i] = keep + __shfl_xor(send, 2); }
    { const bool up = lane & 1; const float send = up ? v[0] : v[1], keep = up ? v[1] : v[0]; v[0] = keep + __shfl_xor(send, 1); }
    return v[0];
}

__device__ __forceinline__ float rows4_norm_proj(const float* xin, size_t row0, const f32x4 (&gsc)[4], const f32x4 (&sh)[4], bf16* hout, const LAS float* wl, int lane) {
    f32x4 v[4][4]; float ss[4];
#pragma unroll
    for (int r = 0; r < 4; ++r) { ss[r] = 0.f;
#pragma unroll
        for (int j = 0; j < 4; ++j) { v[r][j] = *(const f32x4*)(xin + (row0 + r) * 1024 + 4 * lane + 256 * j); ss[r] += v[r][j][0] * v[r][j][0] + v[r][j][1] * v[r][j][1] + v[r][j][2] * v[r][j][2] + v[r][j][3] * v[r][j][3]; } }
#pragma unroll
    for (int r = 0; r < 4; ++r) { const float rstd = rsqrtf(wave_sum(ss[r]) * (1.f / 1024.f) + EPS);
#pragma unroll
        for (int j = 0; j < 4; ++j) { v[r][j] = v[r][j] * rstd * gsc[j] + sh[j];
            u32x2 w; w.x = pk2(v[r][j][0], v[r][j][1]); w.y = pk2(v[r][j][2], v[r][j][3]); *(u32x2*)(hout + (row0 + r) * 1024 + 4 * lane + 256 * j) = w; } }
    float acc[64];
#pragma unroll
    for (int i = 0; i < 64; ++i) acc[i] = 0.f;
#pragma unroll
    for (int j = 0; j < 4; ++j)
#pragma unroll
        for (int e = 0; e < 4; ++e) { const LAS float* wp = wl + ((j * 4 + e) * 4) * 256 + lane * 4;
#pragma unroll
            for (int q = 0; q < 4; ++q) { const f32x4 w4 = *(const LAS f32x4*)(wp + q * 256);
#pragma unroll
                for (int r = 0; r < 4; ++r) { const float hv = v[r][j][e]; acc[r * 16 + 4 * q] += hv * w4[0]; acc[r * 16 + 4 * q + 1] += hv * w4[1]; acc[r * 16 + 4 * q + 2] += hv * w4[2]; acc[r * 16 + 4 * q + 3] += hv * w4[3]; } }
            asm volatile("" ::: "memory"); }
    return butterfly64(acc, lane);
}

__device__ __forceinline__ void p1a_norm_gates(const Ctx& C, LAS unsigned char* lds, int tid, int lane, int wave, int G, int rep2) {
    LAS float* wl = (LAS float*)lds;
    for (int i = tid; i < 1024 * 16; i += 512) { const int col = i >> 4, gc = i & 15; wl[(((((col >> 8) * 4 + (col & 3)) * 4 + (gc >> 2)) * 64 + ((col >> 2) & 63)) * 4) + (gc & 3)] = C.w_in[(size_t)col * INC + OFF_G + gc]; }
    __syncthreads();
    const float* mod = (const float*)(C.ws + WS_MOD); bf16* H = (bf16*)(C.ws + WS_H); float* gates = (float*)(C.ws + WS_GATES);
    const int NGW = G * 8;
    for (int gw0 = blockIdx.x * 8 + wave; gw0 < 2048 * (1 + rep2); gw0 += NGW) { const int gw = gw0 & 2047;
        f32x4 gsc[4], sh[4];
        {   const int b = gw >> 6; const float* m = mod + (size_t)b * 6144;
#pragma unroll
            for (int j = 0; j < 4; ++j) { const int col = 4 * lane + 256 * j; const f32x4 g = *(const f32x4*)(C.g_norm1 + col), s = *(const f32x4*)(m + 1024 + col); gsc[j] = g * (s + 1.f); sh[j] = *(const f32x4*)(m + col); }
            for (int q = 0; q < 8; ++q) { const size_t row0 = (size_t)gw * 32 + q * 4; const float gv = rows4_norm_proj(C.x, row0, gsc, sh, H, wl, lane); gates[(row0 + (lane >> 4)) * 16 + (lane & 15)] = gv; } }
        {   const float* m = mod + (size_t)32 * 6144;
#pragma unroll
            for (int j = 0; j < 4; ++j) { const int col = 4 * lane + 256 * j; const f32x4 g = *(const f32x4*)(C.g_norm1 + col), s = *(const f32x4*)(m + 1024 + col); gsc[j] = g * (s + 1.f); sh[j] = *(const f32x4*)(m + col); }
            const size_t row0 = (size_t)gw * 4; const float gv = rows4_norm_proj(C.ctx, row0, gsc, sh, H + (size_t)NTOK * 1024, wl, lane); gates[((size_t)NTOK + row0 + (lane >> 4)) * 16 + (lane & 15)] = gv; }
    }
}

__device__ __forceinline__ f32x4 unpk4(u32x2 p) { return (f32x4){bflo(p.x), bfhi(p.x), bflo(p.y), bfhi(p.y)}; }
__device__ __forceinline__ void conv_item_x(const Ctx& C, int item, int lane) {
    const int qt = item & 3, cb = (item >> 2) & 3, r = (item >> 4) & 31, b = item >> 9;
    const int ch0 = cb * 256 + 4 * lane; const bf16* src = (const bf16*)(C.ws + WS_PQK) + (size_t)b * SEQ * 1024 + ch0; bf16* dst = (bf16*)(C.ws + WS_QK) + (size_t)b * SEQ * 1024 + ch0;
    const int c0 = qt * 16;
    u32x2 raw[3][18];
#pragma unroll
    for (int dy = 0; dy < 3; ++dy) { const int rr = r + dy - 1; const bool rok = rr >= 0 && rr < 32;
#pragma unroll
        for (int i = 0; i < 18; ++i) { const int cc = c0 - 1 + i; raw[dy][i] = (rok && cc >= 0 && cc < 64) ? *(const u32x2*)(src + (size_t)(rr * 64 + cc) * 1024) : (u32x2){0u, 0u}; } }
    f32x4 w[3][3];
#pragma unroll
    for (int dy = 0; dy < 3; ++dy)
#pragma unroll
        for (int dx = 0; dx < 3; ++dx) w[dy][dx] = *(const f32x4*)(C.w_conv + (dy * 3 + dx) * 1024 + ch0);
    const float ksc = cb >= 2 ? 0.08838834764831845f : 1.f;
#pragma unroll
    for (int i = 0; i < 16; ++i) { f32x4 a = {0.f, 0.f, 0.f, 0.f};
#pragma unroll
        for (int dy = 0; dy < 3; ++dy)
#pragma unroll
            for (int dx = 0; dx < 3; ++dx) a += w[dy][dx] * unpk4(raw[dy][i + dx]);
        u32x2 o; o.x = pk2(silu_f(a[0]) * ksc, silu_f(a[1]) * ksc); o.y = pk2(silu_f(a[2]) * ksc, silu_f(a[3]) * ksc);
        *(u32x2*)(dst + (size_t)(r * 64 + c0 + i) * 1024) = o; }
}
__device__ __forceinline__ void conv_item_ctx(const Ctx& C, int item, int lane) {
    const int sg = item & 15, cb = (item >> 4) & 1, b = item >> 5;
    const int kc0 = cb * 256 + 4 * lane; const bf16* src = (const bf16*)(C.ws + WS_PC) + (size_t)b * CL * 1024 + kc0; bf16* dst = (bf16*)(C.ws + WS_KC) + (size_t)b * CL * 512 + kc0;
    const int c0 = sg * 16;
    u32x2 raw[18];
#pragma unroll
    for (int i = 0; i < 18; ++i) { const int cc = c0 - 1 + i; raw[i] = (cc >= 0 && cc < CL) ? *(const u32x2*)(src + (size_t)cc * 1024) : (u32x2){0u, 0u}; }
    f32x4 w[3];
#pragma unroll
    for (int dx = 0; dx < 3; ++dx) w[dx] = *(const f32x4*)(C.w_conv + (3 + dx) * 1024 + 512 + kc0);
    const float ksc = 0.08838834764831845f;
#pragma unroll
    for (int i = 0; i < 16; ++i) { const f32x4 a = w[0] * unpk4(raw[i]) + w[1] * unpk4(raw[i + 1]) + w[2] * unpk4(raw[i + 2]);
        u32x2 o; o.x = pk2(silu_f(a[0]) * ksc, silu_f(a[1]) * ksc); o.y = pk2(silu_f(a[2]) * ksc, silu_f(a[3]) * ksc);
        *(u32x2*)(dst + (size_t)(c0 + i) * 512) = o; }
}
__device__ __forceinline__ void p2_conv(const Ctx& C, int lane, int wave, int G, int rep2) {
    const int NGW = G * 8;
    for (int it0 = blockIdx.x * 8 + wave; it0 < (NB * 512 + NB * 32) * (1 + rep2); it0 += NGW) { const int it = it0 % (NB * 512 + NB * 32); if (it < NB * 512) conv_item_x(C, it, lane); else conv_item_ctx(C, it - NB * 512, lane); }
}

__device__ __forceinline__ void p3b_combine(const Ctx& C, int tid, int G, int rep2) {
    const u32x4* po = (const u32x4*)(C.ws + WS_PO); const u32x4* hf = (const u32x4*)(C.ws + WS_HF); const u32x4* hb = (const u32x4*)(C.ws + WS_HB); u32x4* hm = (u32x4*)(C.ws + WS_HM);
    const size_t n = (size_t)NTOK * 512 / 8;
    for (size_t i0 = (size_t)blockIdx.x * 512 + tid; i0 < n * (1 + rep2); i0 += (size_t)G * 512) { const size_t i = i0 >= n ? i0 - n : i0; const u32x4 o = po[i], a = hf[i], b = hb[i]; u32x4 r;
        r.x = pk2(bflo(o.x) * (bflo(a.x) + bflo(b.x)), bfhi(o.x) * (bfhi(a.x) + bfhi(b.x))); r.y = pk2(bflo(o.y) * (bflo(a.y) + bflo(b.y)), bfhi(o.y) * (bfhi(a.y) + bfhi(b.y)));
        r.z = pk2(bflo(o.z) * (bflo(a.z) + bflo(b.z)), bfhi(o.z) * (bfhi(a.z) + bfhi(b.z))); r.w = pk2(bflo(o.w) * (bflo(a.w) + bflo(b.w)), bfhi(o.w) * (bfhi(a.w) + bfhi(b.w)));
        hm[i] = r; }
}

__device__ __forceinline__ void p6_norm_router(const Ctx& C, LAS unsigned char* lds, int tid, int lane, int wave, int G, int rep2) {
    LAS float* wl = (LAS float*)lds;
    for (int i = tid; i < 1024 * 16; i += 512) { const int col = i >> 4, gc = i & 15; wl[(((((col >> 8) * 4 + (col & 3)) * 4 + (gc >> 2)) * 64 + ((col >> 2) & 63)) * 4) + (gc & 3)] = C.w_router[i]; }
    __syncthreads();
    const float* mod = (const float*)(C.ws + WS_MOD); bf16* HX2 = (bf16*)(C.ws + WS_HX2); float* aff = (float*)(C.ws + WS_AFF);
    const int NGW = G * 8;
    for (int gw0 = blockIdx.x * 8 + wave; gw0 < 2048 * (1 + rep2); gw0 += NGW) { const int gw = gw0 & 2047;
        f32x4 gsc[4], sh[4]; const int b = gw >> 6; const float* m = mod + (size_t)b * 6144;
#pragma unroll
        for (int j = 0; j < 4; ++j) { const int col = 4 * lane + 256 * j; const f32x4 g = *(const f32x4*)(C.g_norm2 + col), s = *(const f32x4*)(m + 4096 + col); gsc[j] = g * (s + 1.f); sh[j] = *(const f32x4*)(m + 3072 + col); }
        for (int q = 0; q < 8; ++q) { const size_t row0 = (size_t)gw * 32 + q * 4; const float lg = rows4_norm_proj(C.out, row0, gsc, sh, HX2, wl, lane);
            float mx = lg;
#pragma unroll
            for (int o = 1; o < 16; o <<= 1) mx = fmaxf(mx, __shfl_xor(mx, o));
            const float ex = expf(lg - mx); float sm = ex;
#pragma unroll
            for (int o = 1; o < 16; o <<= 1) sm += __shfl_xor(sm, o);
            const size_t t = (row0 + (lane >> 4)) & (SEQ - 1);
            aff[((size_t)b * NE + (lane & 15)) * SEQ + t] = ex / sm; }
    }
}

__device__ __forceinline__ unsigned wave_sum_u(unsigned v) {
#pragma unroll
    for (int o = 1; o < 64; o <<= 1) v += __shfl_xor(v, o);
    return v;
}
__device__ __forceinline__ unsigned wave_excl_scan_u(unsigned v, int lane) { unsigned s = v;
#pragma unroll
    for (int o = 1; o < 64; o <<= 1) { const unsigned t = __shfl_up(s, o); if (lane >= o) s += t; }
    return s - v;
}
__device__ __forceinline__ void topk_item(const Ctx& C, int item, int lane) {
    const int b = item >> 4, e = item & 15; const float* a = (const float*)(C.ws + WS_AFF) + ((size_t)b * NE + e) * SEQ + 32 * lane;
    unsigned key[32];
#pragma unroll
    for (int q = 0; q < 8; ++q) { const u32x4 v = *(const u32x4*)(a + 4 * q); key[4 * q] = v.x; key[4 * q + 1] = v.y; key[4 * q + 2] = v.z; key[4 * q + 3] = v.w; }
    unsigned T = 0u;
    for (int bit = 30; bit >= 0; --bit) { const unsigned cand = T | (1u << bit); unsigned cnt = 0u;
#pragma unroll
        for (int i = 0; i < 32; ++i) cnt += key[i] >= cand ? 1u : 0u;
        if (wave_sum_u(cnt) >= (unsigned)CAP) T = cand; }
    unsigned ngt = 0u, neq = 0u;
#pragma unroll
    for (int i = 0; i < 32; ++i) { ngt += key[i] > T ? 1u : 0u; neq += key[i] == T ? 1u : 0u; }
    const unsigned need = (unsigned)CAP - wave_sum_u(ngt);
    unsigned tie_before = wave_excl_scan_u(neq, lane);
    unsigned nsel = 0u; unsigned selmask = 0u;
#pragma unroll
    for (int i = 0; i < 32; ++i) { bool s = key[i] > T; if (key[i] == T) { s = tie_before < need; ++tie_before; } if (s) { selmask |= 1u << i; ++nsel; } }
    unsigned slot = wave_excl_scan_u(nsel, lane);
    const int pm = e * 32 + b; int* idx = (int*)(C.ws + WS_IDX) + (size_t)pm * CAP; float* val = (float*)(C.ws + WS_VAL) + (size_t)pm * CAP; bf16* sl = (bf16*)(C.ws + WS_SLOT);
#pragma unroll
    for (int i = 0; i < 32; ++i) { const int t = 32 * lane + i; const bool s = (selmask >> i) & 1u;
        if (s) { idx[slot] = b * SEQ + t; val[slot] = __uint_as_float(key[i]); }
        sl[((size_t)b * SEQ + t) * NE + e] = s ? (bf16)slot : (bf16)0xffffu; if (s) ++slot; }
}

__device__ __forceinline__ void p10_final(const Ctx& C, int lane, int wave, int G) {
    const float* mod = (const float*)(C.ws + WS_MOD); const bf16* Y = (const bf16*)(C.ws + WS_Y); const bf16* sl = (const bf16*)(C.ws + WS_SLOT);
    const int NGW = G * 8;
    for (int gw = blockIdx.x * 8 + wave; gw < 2048; gw += NGW) { const int b = gw >> 6; const float* m = mod + (size_t)b * 6144 + 5120;
        f32x4 ga[4], gf[4];
#pragma unroll
        for (int j = 0; j < 4; ++j) { ga[j] = *(const f32x4*)(m + 4 * lane + 256 * j); gf[j] = *(const f32x4*)(C.g_final + 4 * lane + 256 * j); }
        for (int q = 0; q < 32; ++q) { const size_t row = (size_t)gw * 32 + q; f32x4 v[4], a[4];
#pragma unroll
            for (int j = 0; j < 4; ++j) { v[j] = *(const f32x4*)(C.out + row * 1024 + 4 * lane + 256 * j); a[j] = (f32x4){0.f, 0.f, 0.f, 0.f}; }
            const unsigned myslot = lane < NE ? (unsigned)sl[row * NE + lane] : 0xffffu;
            for (int e = 0; e < NE; ++e) { const unsigned s = __builtin_amdgcn_readlane(myslot, e); if (s != 0xffffu) { const bf16* yr = Y + ((size_t)(e * 32 + b) * CAP + s) * 1024 + 4 * lane;
#pragma unroll
                for (int j = 0; j < 4; ++j) { const u32x2 p = *(const u32x2*)(yr + 256 * j); a[j] += (f32x4){bflo(p.x), bfhi(p.x), bflo(p.y), bfhi(p.y)}; } } }
            float ss = 0.f;
#pragma unroll
            for (int j = 0; j < 4; ++j) { v[j] = v[j] + ga[j] * a[j]; ss += v[j][0] * v[j][0] + v[j][1] * v[j][1] + v[j][2] * v[j][2] + v[j][3] * v[j][3]; }
            const float rstd = rsqrtf(wave_sum(ss) * (1.f / 1024.f) + EPS);
#pragma unroll
            for (int j = 0; j < 4; ++j) *(f32x4*)(C.out + row * 1024 + 4 * lane + 256 * j) = v[j] * rstd * gf[j]; }
    }
}
namespace ml {
typedef short v4i16_t __attribute__((ext_vector_type(4)));
constexpr int QS = 0, KS = 16384, VS = 32768, CT = 49152, SS = 81920, SM = 90112;
constexpr int U_ = 0, M_ = 64, DEC_ = 128, EM_ = 192, WA_ = 256, QN_ = 320, RS_ = 384, N_ = 512, SC_ = 640;
__device__ __forceinline__ unsigned off_b(unsigned row, unsigned ch) { return 256u * row + 16u * (ch ^ (((row & 3) << 2) | ((row >> 2) & 3))); }
__device__ __forceinline__ unsigned off_s(unsigned row, unsigned ch) { return 128u * row + 16u * (ch ^ (row & 7)); }
__device__ __forceinline__ bf16x8 rowfrag(const LAS unsigned char* tile, int rb, int ks, int lane) { return *(const LAS bf16x8*)(tile + off_b(16 * rb + (lane & 15), 4 * ks + (lane >> 4))); }
__device__ __forceinline__ bf16x8 trfrag(const LAS unsigned char* tile, int c, int ks, int lane) {
    const unsigned g = lane >> 4, q = (lane & 15) >> 2, p = lane & 3;
    const unsigned a0 = off_b(32 * ks + 8 * g + q, 2 * c + (p >> 1)) + 8 * (p & 1), a1 = off_b(32 * ks + 8 * g + 4 + q, 2 * c + (p >> 1)) + 8 * (p & 1);
    const v4i16_t lo = __builtin_amdgcn_ds_read_tr16_b64_v4i16((LAS v4i16_t*)(tile + a0)), hi = __builtin_amdgcn_ds_read_tr16_b64_v4i16((LAS v4i16_t*)(tile + a1));
    bf16x8 r; r[0] = lo[0]; r[1] = lo[1]; r[2] = lo[2]; r[3] = lo[3]; r[4] = hi[0]; r[5] = hi[1]; r[6] = hi[2]; r[7] = hi[3]; return r;
}
__device__ __forceinline__ float scan_add(float v, int lane, int dir) {
#pragma unroll
    for (int d = 1; d < 64; d <<= 1) { const float t = dir ? __shfl_down(v, d) : __shfl_up(v, d); if (dir ? (lane + d < 64) : (lane >= d)) v += t; }
    return v;
}
__device__ __forceinline__ float scan_max(float v, int lane, int dir) {
#pragma unroll
    for (int d = 1; d < 64; d <<= 1) { const float t = dir ? __shfl_down(v, d) : __shfl_up(v, d); if (dir ? (lane + d < 64) : (lane >= d)) v = fmaxf(v, t); }
    return v;
}
__device__ __forceinline__ void gate_math(float ig, float fg, int lane, int dir, float& m0, LAS float* sm) {
    const float fl = log_sigmoid_f(fg);
    const float cum = scan_add(fl, lane, dir);
    const float u = ig - cum;
    const float pmx = scan_max(u, lane, dir);
    const int endl = dir ? 0 : 63;
    const float tot = __shfl(cum, endl), umax = __shfl(pmx, endl);
    const float M = fmaxf(m0, pmx);
    const float mn = fmaxf(tot + m0, tot + umax);
    sm[U_ + lane] = u; sm[M_ + lane] = M; sm[DEC_ + lane] = expf(m0 - M); sm[EM_ + lane] = expf(-(cum + M)); sm[WA_ + lane] = expf(tot + u - mn);
    if (lane == 0) sm[SC_] = expf(tot + m0 - mn);
    m0 = mn;
}

__device__ __forceinline__ void mlstm_phase(const Ctx& C, LAS unsigned char* lds, int tid, int lane, int wave, int G, int rep2) {
    LAS float* sm = (LAS float*)(lds + SM);
    const bf16* QK = (const bf16*)(C.ws + WS_QK); const bf16* KC = (const bf16*)(C.ws + WS_KC); const bf16* PV = (const bf16*)(C.ws + WS_PV); const bf16* PC = (const bf16*)(C.ws + WS_PC);
    const float* gates = (const float*)(C.ws + WS_GATES);
    for (int item0 = blockIdx.x; item0 < 256 * (1 + rep2); item0 += G) { const int item = item0 & 255;
        const int dir = item & 1, h = (item >> 1) & 3, b = item >> 3;
        bf16* Hout = (bf16*)(C.ws + (dir ? WS_HB : WS_HF));
        const int kI = dir ? 2 : 0, kF = dir ? 3 : 1; const float bI = C.b_gates[kI * 4 + h], bF = C.b_gates[kF * 4 + h];
        for (int i = tid; i < 32768 / 16; i += 512) *(LAS u32x4*)(lds + CT + i * 16) = (u32x4){0u, 0u, 0u, 0u};
        if (tid < 128) sm[N_ + tid] = 0.f;
        f32x4 Cacc[8];
#pragma unroll
        for (int t = 0; t < 8; ++t) Cacc[t] = (f32x4){0.f, 0.f, 0.f, 0.f};
        float m0 = 0.f;
        u32x4 pq[2], pk[2], pv[2]; float pig = 0.f, pfg = 0.f;
#define ML_ISSUE(step_) do { const int _st = (step_); const bool _isx = _st >= 4; const int _cc = _isx ? (dir ? 35 - _st : _st - 4) : (dir ? 3 - _st : _st); \
            _Pragma("unroll") for (int _i = 0; _i < 2; ++_i) { const int _idx = tid + 512 * _i, _row = _idx >> 4, _ch = _idx & 15; \
                if (_isx) { const size_t _tok = (size_t)b * SEQ + _cc * 64 + _row; pq[_i] = *(const u32x4*)(QK + _tok * 1024 + h * 128 + _ch * 8); pk[_i] = *(const u32x4*)(QK + _tok * 1024 + 512 + h * 128 + _ch * 8); pv[_i] = *(const u32x4*)(PV + _tok * 512 + h * 128 + _ch * 8); } \
                else { const size_t _tok = (size_t)b * CL + _cc * 64 + _row; pk[_i] = *(const u32x4*)(KC + _tok * 512 + h * 128 + _ch * 8); pv[_i] = *(const u32x4*)(PC + _tok * 1024 + 512 + h * 128 + _ch * 8); pq[_i] = pk[_i]; } } \
            if (wave == 0) { const size_t _tok = _isx ? (size_t)b * SEQ + _cc * 64 + lane : (size_t)NTOK + (size_t)b * CL + _cc * 64 + lane; pig = gates[_tok * 16 + kI * 4 + h] + bI; pfg = gates[_tok * 16 + kF * 4 + h] + bF; } } while (0)
#define ML_COMMIT() do { \
            _Pragma("unroll") for (int _i = 0; _i < 2; ++_i) { const int _idx = tid + 512 * _i, _row = _idx >> 4, _ch = _idx & 15; const unsigned _o = off_b(_row, _ch); \
                *(LAS u32x4*)(lds + QS + _o) = pq[_i]; *(LAS u32x4*)(lds + KS + _o) = pk[_i]; *(LAS u32x4*)(lds + VS + _o) = pv[_i]; } \
            if (wave == 0) gate_math(pig, pfg, lane, dir, m0, sm); } while (0)
        ML_ISSUE(0);
        __syncthreads();
        ML_COMMIT();
        __syncthreads();
        const int g = lane >> 4, li = lane & 15;
        for (int step = 0; step < 36; ++step) {
            const bool isx = step >= 4; const int cc = isx ? (dir ? 35 - step : step - 4) : 0;
            if (!isx && step + 1 < 36) ML_ISSUE(step + 1);
            if (isx) {
                const int jt = wave >> 1, j = 16 * jt + li;
                {   const int jr = tid >> 3, part = tid & 7; float dsum = 0.f;
#pragma unroll
                    for (int c2 = 0; c2 < 2; ++c2) { const u32x4 qv = *(const LAS u32x4*)(lds + QS + off_b(jr, 2 * part + c2)); const LAS float* np = sm + N_ + 16 * part + 8 * c2; const f32x4 n0 = *(const LAS f32x4*)np, n1 = *(const LAS f32x4*)(np + 4);
                        dsum += bflo(qv.x) * n0[0] + bfhi(qv.x) * n0[1] + bflo(qv.y) * n0[2] + bfhi(qv.y) * n0[3] + bflo(qv.z) * n1[0] + bfhi(qv.z) * n1[1] + bflo(qv.w) * n1[2] + bfhi(qv.w) * n1[3]; }
                    dsum += __shfl_xor(dsum, 1); dsum += __shfl_xor(dsum, 2); dsum += __shfl_xor(dsum, 4);
                    if (part == 0) sm[QN_ + jr] = dsum; }
                bf16x8 qf[4];
#pragma unroll
                for (int ks = 0; ks < 4; ++ks) qf[ks] = rowfrag(lds + QS, jt, ks, lane);
                const float Mj = sm[M_ + j]; float rsum = 0.f;
#pragma unroll
                for (int t = 0; t < 2; ++t) { const int st = 2 * (wave & 1) + t; f32x4 sa = {0.f, 0.f, 0.f, 0.f};
#pragma unroll
                    for (int ks = 0; ks < 4; ++ks) sa = __builtin_amdgcn_mfma_f32_16x16x32_bf16(rowfrag(lds + KS, st, ks, lane), qf[ks], sa, 0, 0, 0);
                    const int s0 = 16 * st + 4 * g; const f32x4 u4 = *(const LAS f32x4*)(sm + U_ + s0); float sp[4];
#pragma unroll
                    for (int r = 0; r < 4; ++r) { const int s = s0 + r; const bool keep = dir ? (s >= j) : (s <= j); const float dv = expf(fminf(u4[r] - Mj, 0.f)); sp[r] = keep ? sa[r] * dv : 0.f; rsum += sp[r]; }
                    u32x2 w; w.x = pk2(sp[0], sp[1]); w.y = pk2(sp[2], sp[3]);
                    *(LAS u32x2*)(lds + SS + off_s(j, 2 * st + (g >> 1)) + (g & 1) * 8) = w; }
                rsum += __shfl_xor(rsum, 16); rsum += __shfl_xor(rsum, 32);
                if (g == 0) sm[RS_ + 2 * j + (wave & 1)] = rsum;
                __syncthreads();
                if (step + 1 < 36) ML_ISSUE(step + 1);
                f32x4 oa[4];
#pragma unroll
                for (int t = 0; t < 4; ++t) { const int dvt = 4 * (wave & 1) + t; oa[t] = (f32x4){0.f, 0.f, 0.f, 0.f};
#pragma unroll
                    for (int ks = 0; ks < 4; ++ks) oa[t] = __builtin_amdgcn_mfma_f32_16x16x32_bf16(rowfrag(lds + CT, dvt, ks, lane), rowfrag(lds + QS, jt, ks, lane), oa[t], 0, 0, 0); }
                const float dj = sm[DEC_ + j];
                bf16x8 sf[2];
#pragma unroll
                for (int ks = 0; ks < 2; ++ks) sf[ks] = *(const LAS bf16x8*)(lds + SS + off_s(j, 4 * ks + g));
                const float den = (sm[RS_ + 2 * j] + sm[RS_ + 2 * j + 1]) + dj * sm[QN_ + j];
                const float inv = 1.f / fmaxf(fabsf(den), sm[EM_ + j]);
                const size_t tok = (size_t)b * SEQ + cc * 64 + j;
#pragma unroll
                for (int t = 0; t < 4; ++t) { const int dvt = 4 * (wave & 1) + t; f32x4 o = oa[t] * dj;
#pragma unroll
                    for (int ks = 0; ks < 2; ++ks) o = __builtin_amdgcn_mfma_f32_16x16x32_bf16(trfrag(lds + VS, dvt, ks, lane), sf[ks], o, 0, 0, 0);
                    o = o * inv; u32x2 w; w.x = pk2(o[0], o[1]); w.y = pk2(o[2], o[3]);
                    *(u32x2*)(Hout + tok * 512 + h * 128 + 16 * dvt + 4 * g) = w; }
            }
            {   const float dn = sm[SC_];
                bf16x8 kf[2];
#pragma unroll
                for (int ks = 0; ks < 2; ++ks) { const bf16x8 kr = trfrag(lds + KS, wave, ks, lane); const f32x4 w0 = *(const LAS f32x4*)(sm + WA_ + 32 * ks + 8 * g), w1 = *(const LAS f32x4*)(sm + WA_ + 32 * ks + 8 * g + 4);
                    u32x4 pkd; pkd.x = pk2(bf1((bf16)kr[0]) * w0[0], bf1((bf16)kr[1]) * w0[1]); pkd.y = pk2(bf1((bf16)kr[2]) * w0[2], bf1((bf16)kr[3]) * w0[3]);
                    pkd.z = pk2(bf1((bf16)kr[4]) * w1[0], bf1((bf16)kr[5]) * w1[1]); pkd.w = pk2(bf1((bf16)kr[6]) * w1[2], bf1((bf16)kr[7]) * w1[3]);
                    kf[ks] = __builtin_bit_cast(bf16x8, pkd); }
                {   const int dk = tid >> 2, part = tid & 3; float a = 0.f;
#pragma unroll
                    for (int e = 0; e < 16; ++e) { const int s = 16 * part + e; a += sm[WA_ + s] * bf1(*(const LAS bf16*)(lds + KS + off_b(s, dk >> 3) + (dk & 7) * 2)); }
                    a += __shfl_xor(a, 1); a += __shfl_xor(a, 2);
                    if (part == 0) sm[N_ + dk] = dn * sm[N_ + dk] + a; }
#pragma unroll
                for (int dvt = 0; dvt < 8; ++dvt) { f32x4 c = Cacc[dvt] * dn;
#pragma unroll
                    for (int ks = 0; ks < 2; ++ks) c = __builtin_amdgcn_mfma_f32_16x16x32_bf16(kf[ks], trfrag(lds + VS, dvt, ks, lane), c, 0, 0, 0);
                    Cacc[dvt] = c; }
            }
            __syncthreads();
#pragma unroll
            for (int dvt = 0; dvt < 8; ++dvt) { const f32x4 c = Cacc[dvt]; u32x2 w; w.x = pk2(c[0], c[1]); w.y = pk2(c[2], c[3]);
                *(LAS u32x2*)(lds + CT + off_b(16 * dvt + li, 2 * wave + (g >> 1)) + (g & 1) * 8) = w; }
            if (step + 1 < 36) ML_COMMIT();
            __syncthreads();
        }
    }
}
#undef ML_ISSUE
#undef ML_COMMIT
}
constexpr int N_PHASES = 13;
#ifndef PROBE_PH
#define PROBE_PH 0
#endif
struct Args { const float* in[19]; float* out; unsigned char* ws; int ph_lo, ph_hi, probe, pad; };
static_assert(sizeof(Args) == 19 * 8 + 8 + 8 + 16, "Args has no padding");

__global__ void __launch_bounds__(512, 2) mk_fwd(Args a) {
    extern __shared__ __attribute__((aligned(16))) unsigned char lds_raw[];
    LAS unsigned char* lds = (LAS unsigned char*)lds_raw;
    const int tid = threadIdx.x, lane = tid & 63, wave = __builtin_amdgcn_readfirstlane(tid >> 6), G = gridDim.x;
    Ctx C;
    C.x = a.in[0]; C.c = a.in[1]; C.ctx = a.in[2]; C.c_ctx = a.in[3]; C.w_ada = a.in[4]; C.b_ada = a.in[5]; C.g_norm1 = a.in[6]; C.w_in = a.in[7]; C.b_gates = a.in[8]; C.w_conv = a.in[9];
    C.w_fourier = a.in[10]; C.w_mlstm = a.in[11]; C.w_out = a.in[12]; C.g_norm2 = a.in[13]; C.w_router = a.in[14]; C.w_gate_e = a.in[15]; C.w_up_e = a.in[16]; C.w_down_e = a.in[17]; C.g_final = a.in[18];
    C.out = a.out; C.ws = a.ws;
    const int lo = a.ph_lo, hi = a.ph_hi;
#if MK_XCD_BAR
    volatile LAS unsigned* bst = (volatile LAS unsigned*)(lds + LDS_PHASE_BYTES);
    if (tid < 4) bst[tid] = 0u;
    __syncthreads();
    XcdBarrier bar = xcd_barrier_post((unsigned*)(a.ws + WS_CTL) + 4096, bst);
#endif
    int nsync = 0;
#define IN(k) (lo <= (k) && (k) < hi)
#if MK_XCD_BAR
#define GRIDBAR() do { if (nsync == 0) cg::this_grid().sync(); else xcd_barrier(bar); ++nsync; } while (0)
#else
#define GRIDBAR() do { cg::this_grid().sync(); ++nsync; } while (0)
#endif
#define SEAM(k) do { if (IN(k) && IN((k) + 1)) GRIDBAR(); } while (0)
#define PHASE(k, ...) do { if (IN(k)) { __VA_ARGS__ } SEAM(k); } while (0)
    PHASE(0, { p0_prep(C, lds, tid, lane, wave, G); });
    PHASE(1, { p1a_norm_gates(C, lds, tid, lane, wave, G, (a.probe >> 1) & 1); __syncthreads(); });
    PHASE(2, { SchedP1 S{C.ws, G, (int)blockIdx.x}; EpiP1 E{C.ws}; mg::gemm_phase<EpiP1, SchedP1, false>(lds, 1024, S, E); });
    PHASE(3, { SchedF2 S{C.ws, G, (int)blockIdx.x}; EpiF2 E{C.ws}; mg::gemm_phase<EpiF2, SchedF2, false>(lds, 4096, S, E); p2_conv(C, lane, wave, G, (a.probe >> 13) & 1); });
    PHASE(4, { ml::mlstm_phase(C, lds, tid, lane, wave, G, (a.probe >> 4) & 1); });
    PHASE(5, { p3b_combine(C, tid, G, (a.probe >> 5) & 1); });
    PHASE(6, { SchedMerge S{C.ws, G, (int)blockIdx.x}; EpiMerge E{C.ws}; mg::gemm_phase<EpiMerge, SchedMerge, false>(lds, 512, S, E); });
    PHASE(7, { SchedOut S{C.ws, G, (int)blockIdx.x}; EpiOut E{C.x, (const float*)(C.ws + WS_MOD), C.out}; mg::gemm_phase<EpiOut, SchedOut, false>(lds, 1024, S, E); });
    PHASE(8, { p6_norm_router(C, lds, tid, lane, wave, G, (a.probe >> 8) & 1); __syncthreads(); });
    PHASE(9, { const int NGW = G * 8; const int rp9 = 1 + ((a.probe >> 9) & 1); for (int it = blockIdx.x * 8 + wave; it < NB * NE * rp9; it += NGW) topk_item(C, it % (NB * NE), lane); convert_experts(C, lds, lane, wave, G, rp9); __syncthreads(); });
    PHASE(10, { SchedUp S{C.ws, G, (int)blockIdx.x}; EpiSwiglu E{C.ws}; mg::gemm_phase<EpiSwiglu, SchedUp, true>(lds, 1024, S, E); });
    PHASE(11, { SchedDown S{C.ws, G, (int)blockIdx.x}; EpiDown E{C.ws}; mg::gemm_phase<EpiDown, SchedDown, false>(lds, 1024, S, E); });
    if (IN(12)) { p10_final(C, lane, wave, G); }
#undef PHASE
#undef PHASE_L
#undef IN
#undef SEAM
#undef GRIDBAR
}

static void mk_launch(void* const* d_in, void* d_out, void* d_ws, hipStream_t stream, int lo, int hi, bool coop) {
    static int grid = 0;
    if (grid == 0) {
        int dev = 0, cus = 0, per_cu = 0;
        (void)hipGetDevice(&dev); (void)hipDeviceGetAttribute(&cus, hipDeviceAttributeMultiprocessorCount, dev);
        (void)hipFuncSetAttribute((const void*)mk_fwd, hipFuncAttributeMaxDynamicSharedMemorySize, LDS_BYTES);
        (void)hipOccupancyMaxActiveBlocksPerMultiprocessor(&per_cu, (const void*)mk_fwd, 512, LDS_BYTES);
        if (per_cu < 1) fprintf(stderr, "mk_launch: occupancy query says %d blocks/CU\n", per_cu);
        grid = cus > 0 ? cus : 256;
    }
    Args a{};
    for (int i = 0; i < 19; ++i) a.in[i] = (const float*)d_in[i];
    a.out = (float*)d_out; a.ws = (unsigned char*)d_ws; a.ph_lo = lo; a.ph_hi = hi; a.probe = PROBE_PH; a.pad = 0;
    if (coop) { void* args[] = {&a}; hipError_t e = hipLaunchCooperativeKernel((const void*)mk_fwd, dim3(grid), dim3(512), args, LDS_BYTES, stream);
        if (e != hipSuccess) fprintf(stderr, "cooperative launch failed: %s (grid %d)\n", hipGetErrorString(e), grid); }
    else hipLaunchKernelGGL(mk_fwd, dim3(grid), dim3(512), LDS_BYTES, stream, a);
}
extern "C" void kernel_launch(void* const* d_in, const int* in_sizes, int n_in, void* d_out, int out_size, void* d_ws, size_t ws_size, hipStream_t stream) {
    (void)hipMemsetAsync((char*)d_ws + WS_CTL, 0, 65536, stream);
    mk_launch(d_in, d_out, d_ws, stream, 0, N_PHASES, true);
}
```

```cpp
#ifndef MK_XCD_BAR
#define MK_XCD_BAR 1
#endif
#include <hip/hip_runtime.h>
#include <hip/hip_cooperative_groups.h>
#include <cstdio>
#include <cstdint>
namespace cg = cooperative_groups;

#define LAS __attribute__((address_space(3)))
typedef unsigned short bf16;
typedef short bf16x8 __attribute__((ext_vector_type(8)));
typedef short s16x4 __attribute__((ext_vector_type(4)));
typedef float f32x4 __attribute__((ext_vector_type(4)));
typedef float f32x2 __attribute__((ext_vector_type(2)));
typedef unsigned u32x4 __attribute__((ext_vector_type(4)));
typedef unsigned u32x2 __attribute__((ext_vector_type(2)));
typedef __bf16 bf16x2_t __attribute__((ext_vector_type(2)));
typedef int v8i_t __attribute__((ext_vector_type(8)));
typedef int v4i_t __attribute__((ext_vector_type(4)));

__device__ __forceinline__ unsigned pk2(float lo, float hi) { f32x2 v = {lo, hi}; bf16x2_t b = __builtin_convertvector(v, bf16x2_t); return __builtin_bit_cast(unsigned, b); }
__device__ __forceinline__ float bflo(unsigned w) { return __uint_as_float(w << 16); }
__device__ __forceinline__ float bfhi(unsigned w) { return __uint_as_float(w & 0xffff0000u); }
__device__ __forceinline__ float bf1(bf16 b) { return __uint_as_float((unsigned)b << 16); }
__device__ __forceinline__ float silu_f(float v) { return v / (1.f + __expf(-v)); }
__device__ __forceinline__ float sigmoid_f(float v) { return 1.f / (1.f + __expf(-v)); }
__device__ __forceinline__ float log_sigmoid_f(float v) { return fminf(v, 0.f) - log1pf(expf(-fabsf(v))); }
__device__ __forceinline__ float wave_sum(float v) {
#pragma unroll
    for (int o = 1; o < 64; o <<= 1) v += __shfl_xor(v, o);
    return v;
}

#define XB_TMO      128
#define XB_XCNT(j)  (256  + 64 * (j))
#define XB_XSUB(j)  (1280 + 64 * (j))
#define XB_XGEN(j)  (2304 + 64 * (j))
#define XB_TOP      3328
#define XB_TOPGEN   3392
#define XCD_BAR_WORDS 3456
#define XB_SPIN_CAP (1u << 20)
__device__ __forceinline__ unsigned xb_ld(unsigned* p)              { return __hip_atomic_load(p, __ATOMIC_RELAXED, __HIP_MEMORY_SCOPE_AGENT); }
__device__ __forceinline__ unsigned xb_add(unsigned* p, unsigned v) { return __hip_atomic_fetch_add(p, v, __ATOMIC_RELAXED, __HIP_MEMORY_SCOPE_AGENT); }
__device__ __forceinline__ unsigned xb_xcc_id() { return (unsigned)__builtin_amdgcn_s_getreg((3 << 11) | 20) & 0xFu; }
#define XB_SPIN(cond, bar) do { unsigned _sp = 0; while (cond) { __builtin_amdgcn_s_sleep(1); \
    if ((++_sp & 255u) == 0u) { if (xb_ld(&(bar)[XB_TMO])) break; if (_sp > XB_SPIN_CAP) { atomicAdd(&(bar)[XB_TMO], 1u); break; } } } } while (0)
struct XcdBarrier { unsigned* bar; unsigned x; volatile LAS unsigned* st; };
__device__ __forceinline__ XcdBarrier xcd_barrier_post(unsigned* bar, volatile LAS unsigned* st) {
    XcdBarrier b; b.bar = bar; b.x = xb_xcc_id(); b.st = st;
    if (threadIdx.x == 0) (void)xb_add(&bar[XB_XCNT(b.x)], 1u);
    return b;
}
__device__ __forceinline__ void xcd_barrier_complete(unsigned* bar, unsigned x, unsigned& nloc, unsigned& nx) {
    const unsigned G = gridDim.x * gridDim.y * gridDim.z;
    unsigned sum, cnt, mine, sp = 0u;
    for (;;) {
        sum = 0u; cnt = 0u; mine = 0u;
#pragma unroll
        for (unsigned j = 0; j < 16; ++j) { const unsigned c = xb_ld(&bar[XB_XCNT(j)]); sum += c; cnt += (c > 0u) ? 1u : 0u; mine = (j == x) ? c : mine; }
        if (sum == G) break;
        __builtin_amdgcn_s_sleep(1);
        if ((++sp & 255u) == 0u) { if (xb_ld(&bar[XB_TMO])) break; if (sp > XB_SPIN_CAP) { atomicAdd(&bar[XB_TMO], 1u); break; } }
    }
    nloc = mine > 0u ? mine : 1u; nx = cnt > 0u ? cnt : 1u;
}
__device__ __forceinline__ void xcd_barrier(const XcdBarrier& b) {
    asm volatile("s_waitcnt vmcnt(0)" ::: "memory");
    __syncthreads();
    if (threadIdx.x == 0) {
        unsigned* bar = b.bar;
        __builtin_amdgcn_s_waitcnt(0);
        unsigned nloc = b.st[0], nx = b.st[1];
        if (nloc == 0u) { xcd_barrier_complete(bar, b.x, nloc, nx); b.st[0] = nloc; b.st[1] = nx; }
        const unsigned old = xb_add(&bar[XB_XSUB(b.x)], 1u);
        const unsigned gen = old / nloc;
        if (old + 1u == (gen + 1u) * nloc) {
            __builtin_amdgcn_fence(__ATOMIC_RELEASE, "agent");
            asm volatile("s_waitcnt vmcnt(0)" ::: "memory");
            const unsigned og = xb_add(&bar[XB_TOP], 1u);
            const unsigned tg = og / nx;
            if (og + 1u == (tg + 1u) * nx) xb_add(&bar[XB_TOPGEN], 1u);
            else XB_SPIN(xb_ld(&bar[XB_TOPGEN]) == tg, bar);
            __builtin_amdgcn_fence(__ATOMIC_ACQUIRE, "agent");
            xb_add(&bar[XB_XGEN(b.x)], 1u);
            asm volatile("s_waitcnt vmcnt(0)" ::: "memory");
        } else {
            XB_SPIN(xb_ld(&bar[XB_XGEN(b.x)]) == gen, bar);
            __builtin_amdgcn_fence(__ATOMIC_ACQUIRE, "agent");
            asm volatile("s_waitcnt vmcnt(0)" ::: "memory");
        }
    }
    __syncthreads();
}

namespace mg {
template <bool F8> struct Frag { bf16x8 k[2]; };
template <> struct Frag<true> { v8i_t v; };
constexpr int BM = 256, BK = 64, HALF = 128, HTB = HALF * BK * 2, STAGE_BYTES = 8 * HTB, NXCD = 8, WGM = 8;
__host__ __device__ __forceinline__ int lds_byte(int r, int c) { const int st = (r >> 4) * 2 + (c >> 5), rr = r & 15, cc = c & 31, ob = rr * 64 + cc * 2; return st * 1024 + (ob ^ (((ob >> 9) & 1) << 5)); }
__host__ __device__ __forceinline__ void stage_rc(int b, int& R, int& C) { const int st = b / 1024, sb = b % 1024, swz = sb ^ (((sb >> 9) & 1) << 5); R = (st >> 1) * 16 + swz / 64; C = (st & 1) * 32 + (swz % 64) / 2; }
__host__ __device__ __forceinline__ int perm32(int rho) { const int n = rho >> 4, i = rho & 15; return 8 * (i >> 2) + 4 * n + (i & 3); }

struct Unit { int pm, pn, ty; const char* a; const char* b; const int* gi; };
__device__ __forceinline__ void tile_of(int wgid, int nM, int nN, int& pm, int& pn) {
    const int nwg = nM * nN; { const int q = nwg / NXCD, r = nwg % NXCD, xcd = wgid % NXCD, off = wgid / NXCD; wgid = (xcd < r ? xcd * (q + 1) : r * (q + 1) + (xcd - r) * q) + off; }
    const int nig = WGM * nN, gid = wgid / nig, fm = gid * WGM, gsz = (nM - fm) < WGM ? (nM - fm) : WGM;
    pm = fm + ((wgid % nig) % gsz); pn = (wgid % nig) / gsz;
}

template <class Epi, class Sched, bool GATHER, bool FP8 = false>
__device__ __forceinline__ void gemm_phase(LAS unsigned char* lds, const int K, const Sched& S, const Epi& E) {
    const int tid = threadIdx.x, wid = __builtin_amdgcn_readfirstlane(tid >> 6), lane = tid & 63, wr = wid >> 2, wc = wid & 3, fr = lane & 15, fq = lane >> 4;
    const int KB = FP8 ? K : 2 * K;
    const int nt = KB / (BK * 2);
    unsigned voffB[2], vAc[2][2]; int stR[2], stC[2]; int gnx[2][2];
    const size_t kstep = (size_t)(BK * 2);
    const size_t hstep = (size_t)HALF * KB;
#pragma unroll
    for (int i = 0; i < 2; ++i) { int R, C; stage_rc(tid * 16 + i * 8192, R, C); stR[i] = R; stC[i] = C; const int Rb = Epi::PERM ? ((R & ~31) + perm32(R & 31)) : R;
        voffB[i] = (unsigned)(Rb * KB + 2 * C); }
    const unsigned ldsw = (unsigned)wid * 1024u;
    const int aoff = lds_byte(wr * 64 + fr, fq * (FP8 ? 16 : 8)), boff = lds_byte(wc * 32 + fr, fq * (FP8 ? 16 : 8));
#define MG_SA(b, h) (((b) * 2 + (h)) * HTB)
#define MG_SB(b, h) ((4 + (b) * 2 + (h)) * HTB)
#define MG_STAGE(bufoff, gbase, voff) do { const char* _gb = (const char*)(gbase); asm volatile("" : "+s"(_gb));     \
        _Pragma("unroll") for (int _i = 0; _i < 2; ++_i) { unsigned _vo = (voff)[_i]; asm volatile("" : "+v"(_vo)); \
        __builtin_amdgcn_global_load_lds((const unsigned*)(_gb + _vo), (LAS unsigned*)(lds + (bufoff) + ldsw + _i * 8192), 16, 0, 0); } } while (0)
#define MG_LD16(off_) (*(const LAS v4i_t*)(lds + (off_)))
#define MG_LDA(dst, b, h) do { _Pragma("unroll") for (int m = 0; m < 4; ++m) { const int _o = MG_SA(b, h) + aoff + m * 2048; \
        if constexpr (FP8) dst[m].v = __builtin_shufflevector(MG_LD16(_o), MG_LD16(_o + 16), 0, 1, 2, 3, 4, 5, 6, 7); \
        else { dst[m].k[0] = __builtin_bit_cast(bf16x8, MG_LD16(_o)); dst[m].k[1] = __builtin_bit_cast(bf16x8, MG_LD16(_o + 1024)); } } } while (0)
#define MG_LDB(dst, b, h) do { _Pragma("unroll") for (int n = 0; n < 2; ++n) { const int _o = MG_SB(b, h) + boff + n * 2048; \
        if constexpr (FP8) dst[n].v = __builtin_shufflevector(MG_LD16(_o), MG_LD16(_o + 16), 0, 1, 2, 3, 4, 5, 6, 7); \
        else { dst[n].k[0] = __builtin_bit_cast(bf16x8, MG_LD16(_o)); dst[n].k[1] = __builtin_bit_cast(bf16x8, MG_LD16(_o + 1024)); } } } while (0)
#define MG_MMA(ai, bj, At, Bt) do { __builtin_amdgcn_s_setprio(1); _Pragma("unroll") for (int m = 0; m < 4; ++m) _Pragma("unroll") for (int n = 0; n < 2; ++n) { \
        if constexpr (FP8) acc[ai][bj][m][n] = __builtin_amdgcn_mfma_scale_f32_16x16x128_f8f6f4(Bt[n].v, At[m].v, acc[ai][bj][m][n], 0, 0, 0, 0, 0, 0); \
        else { _Pragma("unroll") for (int k = 0; k < 2; ++k) acc[ai][bj][m][n] = __builtin_amdgcn_mfma_f32_16x16x32_bf16(Bt[n].k[k], At[m].k[k], acc[ai][bj][m][n], 0, 0, 0); } } \
        __builtin_amdgcn_s_setprio(0); } while (0)
#define MG_WAIT_V(n) asm volatile("s_waitcnt vmcnt(" #n ")" ::: "memory")
#define MG_WAIT_L(n) asm volatile("s_waitcnt lgkmcnt(" #n ")" ::: "memory")
#define MG_BAR __builtin_amdgcn_s_barrier()
#define MG_SCHED __builtin_amdgcn_sched_barrier(0)
#define MG_AOFF(dst, u) do { _Pragma("unroll") for (int _h = 0; _h < 2; ++_h) _Pragma("unroll") for (int _i = 0; _i < 2; ++_i) { \
        if constexpr (GATHER) dst[_h][_i] = (unsigned)(u).gi[_h * HALF + stR[_i]] * (unsigned)KB + 2u * (unsigned)stC[_i]; \
        else dst[_h][_i] = (unsigned)((_h * HALF + stR[_i]) * KB + 2 * stC[_i]); } } while (0)
    Unit cur, nxt; int ui = 0;
    if (!S.next(0, cur)) return;
    f32x4 acc[2][2][4][2];
#pragma unroll
    for (int a = 0; a < 2; ++a)
#pragma unroll
        for (int b = 0; b < 2; ++b)
#pragma unroll
            for (int m = 0; m < 4; ++m)
#pragma unroll
                for (int n = 0; n < 2; ++n) acc[a][b][m][n] = (f32x4){0.f, 0.f, 0.f, 0.f};
    Frag<FP8> At[4], B0[2], B1[2];
    const char* cA = cur.a; const char* cB = cur.b;
    MG_AOFF(vAc, cur);
    MG_STAGE(MG_SB(0, 0), cB, voffB); MG_STAGE(MG_SB(0, 1), cB + hstep, voffB); MG_STAGE(MG_SA(0, 0), cA, vAc[0]); MG_STAGE(MG_SA(0, 1), cA, vAc[1]);
    if (wr == 1) MG_BAR;
    MG_WAIT_V(2); MG_BAR;
    MG_STAGE(MG_SB(1, 0), cB + kstep, voffB); MG_STAGE(MG_SA(1, 0), cA + kstep, vAc[0]); MG_STAGE(MG_SB(1, 1), cB + hstep + kstep, voffB);
    MG_WAIT_V(6); MG_BAR;
    for (;;) {
        const bool has_next = S.next(ui + 1, nxt);
        const char* nA = has_next ? nxt.a : cA; const char* nB = has_next ? nxt.b : cB;
        if constexpr (GATHER) { if (has_next) {
#pragma unroll
            for (int h = 0; h < 2; ++h)
#pragma unroll
                for (int i = 0; i < 2; ++i) gnx[h][i] = nxt.gi[h * HALF + stR[i]]; } }
#pragma unroll 1
        for (int t = 0; t < nt; t += 2) {
            const bool last = (t == nt - 2);
            const char* a1 = cA + (size_t)(t + 1) * kstep;
            const char* a2 = last ? nA : cA + (size_t)(t + 2) * kstep; const char* b2 = last ? nB : cB + (size_t)(t + 2) * kstep;
            const char* a3 = a2 + kstep; const char* b3 = b2 + kstep;
            MG_LDB(B0, 0, 0); MG_LDB(B1, 0, 1); MG_SCHED; MG_LDA(At, 0, 0); MG_STAGE(MG_SA(1, 1), a1, vAc[1]);
            if constexpr (GATHER) { if (last && has_next) {
#pragma unroll
                for (int h = 0; h < 2; ++h)
#pragma unroll
                    for (int i = 0; i < 2; ++i) vAc[h][i] = (unsigned)gnx[h][i] * (unsigned)KB + 2u * (unsigned)stC[i]; } }
            MG_WAIT_V(8); MG_WAIT_L(0); MG_BAR; MG_MMA(0, 0, At, B0); MG_MMA(0, 1, At, B1); MG_BAR; MG_SCHED;
            MG_LDA(At, 0, 1); MG_STAGE(MG_SB(0, 0), b2, voffB); MG_STAGE(MG_SB(0, 1), b2 + hstep, voffB); MG_STAGE(MG_SA(0, 0), a2, vAc[0]);
            MG_WAIT_V(8); MG_WAIT_L(0); MG_BAR; MG_MMA(1, 0, At, B0); MG_MMA(1, 1, At, B1); MG_BAR; MG_SCHED;
            MG_LDB(B0, 1, 0); MG_LDB(B1, 1, 1); MG_SCHED; MG_LDA(At, 1, 0); MG_STAGE(MG_SA(0, 1), a2, vAc[1]);
            MG_WAIT_V(8); MG_WAIT_L(0); MG_BAR; MG_MMA(0, 0, At, B0); MG_MMA(0, 1, At, B1); MG_BAR; MG_SCHED;
            MG_LDA(At, 1, 1); MG_STAGE(MG_SB(1, 0), b3, voffB); MG_STAGE(MG_SB(1, 1), b3 + hstep, voffB); MG_STAGE(MG_SA(1, 0), a3, vAc[0]);
            MG_WAIT_V(8); MG_WAIT_L(0); MG_BAR; MG_MMA(1, 0, At, B0); MG_MMA(1, 1, At, B1); MG_BAR; MG_SCHED;
        }
        if (wr == 0) MG_BAR;
        { int fr_ = fr, fq_ = fq; asm volatile("" : "+v"(fr_), "+v"(fq_));
          E(acc, cur, wr, wc, fr_, fq_); }
        if (!has_next) break;
#pragma unroll
        for (int a = 0; a < 2; ++a)
#pragma unroll
            for (int b = 0; b < 2; ++b)
#pragma unroll
                for (int m = 0; m < 4; ++m)
#pragma unroll
                    for (int n = 0; n < 2; ++n) acc[a][b][m][n] = (f32x4){0.f, 0.f, 0.f, 0.f};
        cur = nxt; cA = nA; cB = nB; ++ui;
        if (wr == 1) MG_BAR;
    }
    MG_WAIT_V(0);
    MG_BAR;
#undef MG_SA
#undef MG_SB
#undef MG_STAGE
#undef MG_LDA
#undef MG_LDB
#undef MG_MMA
#undef MG_LD16
#undef MG_WAIT_V
#undef MG_WAIT_L
#undef MG_BAR
#undef MG_SCHED
#undef MG_AOFF
}
}
constexpr int D = 1024, NB = 32, SEQ = 2048, CL = 256, NTOK = NB * SEQ, NCTX = NB * CL, INC = 4624;
constexpr int NE = 16, CAP = 256;
constexpr int OFF_QK = 512, OFF_V = 1536, OFF_O = 2048, OFF_G = 2560, OFF_BR = 2576;
constexpr float EPS = 1e-6f;
constexpr size_t MiB = 1u << 20;
constexpr size_t WS_CTL = 0, CTL_BYTES = 1 * MiB;
constexpr size_t WS_MOD = 1 * MiB;
constexpr size_t WS_GATES = 2 * MiB;
constexpr size_t WS_AFF = 11 * MiB;
constexpr size_t WS_IDX = 15 * MiB;
constexpr size_t WS_VAL = 15 * MiB + 512 * 1024;
constexpr size_t WS_SLOT = 16 * MiB;
constexpr size_t WS_WTF = 18 * MiB;
constexpr size_t WS_WFT = 20 * MiB;
constexpr size_t WS_WMT = 21 * MiB;
constexpr size_t WS_WOT = 22 * MiB;
constexpr size_t WS_WTM = 24 * MiB;
constexpr size_t WS_TT = 32 * MiB;
constexpr size_t WS_PC = 48 * MiB;
constexpr size_t WS_H = 64 * MiB;
constexpr size_t WS_QK = 64 * MiB;
constexpr size_t WS_KC = 192 * MiB;
constexpr size_t WS_MRG = 64 * MiB;
constexpr size_t WS_WGU = 64 * MiB;
constexpr size_t WS_WD = 128 * MiB;
constexpr size_t WS_AB = 208 * MiB;
constexpr size_t WS_HF = 208 * MiB;
constexpr size_t WS_HB = 272 * MiB;
constexpr size_t WS_HX2 = 208 * MiB;
constexpr size_t WS_FU = 336 * MiB;
constexpr size_t WS_PQK = 400 * MiB;
constexpr size_t WS_HM = 400 * MiB;
constexpr size_t WS_PV = 528 * MiB;
constexpr size_t WS_PO = 592 * MiB;
constexpr size_t WS_PBR = 656 * MiB;
constexpr size_t WS_HID = 400 * MiB;
constexpr size_t WS_Y = 656 * MiB;
constexpr size_t WS_IDENT = 912 * MiB;
constexpr size_t WS_END = 913 * MiB;
constexpr int LDS_PHASE_BYTES = 147456, LDS_BYTES = LDS_PHASE_BYTES + 256;

__device__ __forceinline__ unsigned pk4_fp8(float a, float b, float c, float d) { int w = __builtin_amdgcn_cvt_pk_fp8_f32(a, b, 0, false); w = __builtin_amdgcn_cvt_pk_fp8_f32(c, d, w, true); return (unsigned)w; }
constexpr float W8_SCALE = 32.f, W8_INV = 1.f / 32.f;
struct Ctx {
    const float *x, *c, *ctx, *c_ctx, *w_ada, *b_ada, *g_norm1, *w_in, *b_gates, *w_conv, *w_fourier, *w_mlstm, *w_out, *g_norm2, *w_router, *w_gate_e, *w_up_e, *w_down_e, *g_final;
    float* out; unsigned char* ws;
};

__device__ __forceinline__ void store_tile_bf16(const f32x4 (&acc)[2][2][4][2], bf16* base, int ldc, bool sig, int wr, int wc, int fr, int fq) {
    bf16* p0 = base + (size_t)(wr * 64 + fr) * ldc + wc * 32 + 8 * fq;
#pragma unroll
    for (int ai = 0; ai < 2; ++ai)
#pragma unroll
        for (int m = 0; m < 4; ++m) { bf16* rowp = p0 + (size_t)(ai * 128 + m * 16) * ldc;
#pragma unroll
            for (int bj = 0; bj < 2; ++bj) { f32x4 v0 = acc[ai][bj][m][0], v1 = acc[ai][bj][m][1];
                if (sig) {
#pragma unroll
                    for (int j = 0; j < 4; ++j) { v0[j] = sigmoid_f(v0[j]); v1[j] = sigmoid_f(v1[j]); } }
                u32x4 w; w.x = pk2(v0[0], v0[1]); w.y = pk2(v0[2], v0[3]); w.z = pk2(v1[0], v1[1]); w.w = pk2(v1[2], v1[3]);
                *(u32x4*)(rowp + bj * 128) = w; } }
}
struct EpiP1 {
    static constexpr bool PERM = true; unsigned char* ws;
    __device__ __forceinline__ void operator()(const f32x4 (&acc)[2][2][4][2], const mg::Unit& u, int wr, int wc, int fr, int fq) const {
        bf16* base; int ldc; bool sig = false;
        if (u.ty == 0) { const size_t r0 = (size_t)u.pm * 256;
            if (u.pn < 4) { base = (bf16*)(ws + WS_PQK) + r0 * 1024 + u.pn * 256; ldc = 1024; }
            else if (u.pn < 6) { base = (bf16*)(ws + WS_PV) + r0 * 512 + (u.pn - 4) * 256; ldc = 512; }
            else if (u.pn < 8) { base = (bf16*)(ws + WS_PO) + r0 * 512 + (u.pn - 6) * 256; ldc = 512; sig = true; }
            else { base = (bf16*)(ws + WS_PBR) + r0 * 2048 + (u.pn - 8) * 256; ldc = 2048; sig = true; }
        } else if (u.ty == 1) { base = (bf16*)(ws + WS_AB) + ((size_t)(u.pn >> 3) * 1024 + (size_t)u.pm * 256) * 2048 + (u.pn & 7) * 256; ldc = 2048; }
        else { base = (bf16*)(ws + WS_PC) + (size_t)u.pm * 256 * 1024 + u.pn * 256; ldc = 1024; }
        store_tile_bf16(acc, base, ldc, sig, wr, wc, fr, fq);
    }
};
struct EpiF2 {
    static constexpr bool PERM = true; unsigned char* ws;
    __device__ __forceinline__ void operator()(const f32x4 (&acc)[2][2][4][2], const mg::Unit& u, int wr, int wc, int fr, int fq) const {
        bf16* base = (bf16*)(ws + WS_FU) + ((size_t)(u.pn >> 1) * 2048 + (size_t)u.pm * 256) * 512 + (u.pn & 1) * 256;
        store_tile_bf16(acc, base, 512, false, wr, wc, fr, fq);
    }
};
struct EpiMerge {
    static constexpr bool PERM = true; unsigned char* ws;
    __device__ __forceinline__ void operator()(const f32x4 (&acc)[2][2][4][2], const mg::Unit& u, int wr, int wc, int fr, int fq) const {
        const size_t row0 = (size_t)u.pm * 256 + wr * 64 + fr; const int col0 = u.pn * 256 + wc * 32 + 8 * fq;
#pragma unroll
        for (int ai = 0; ai < 2; ++ai)
#pragma unroll
            for (int m = 0; m < 4; ++m) { const size_t row = row0 + ai * 128 + m * 16;
                bf16* mp = (bf16*)(ws + WS_MRG) + row * 1024 + col0; const bf16* gp = (const bf16*)(ws + WS_PBR) + row * 2048 + u.ty * 1024 + col0;
#pragma unroll
                for (int bj = 0; bj < 2; ++bj) { const u32x4 g = *(const u32x4*)(gp + bj * 128); const f32x4 v0 = acc[ai][bj][m][0], v1 = acc[ai][bj][m][1];
                    float r[8] = {bflo(g.x) * v0[0], bfhi(g.x) * v0[1], bflo(g.y) * v0[2], bfhi(g.y) * v0[3], bflo(g.z) * v1[0], bfhi(g.z) * v1[1], bflo(g.w) * v1[2], bfhi(g.w) * v1[3]};
                    if (u.ty == 1) { const u32x4 t = *(const u32x4*)(mp + bj * 128);
                        r[0] += bflo(t.x); r[1] += bfhi(t.x); r[2] += bflo(t.y); r[3] += bfhi(t.y); r[4] += bflo(t.z); r[5] += bfhi(t.z); r[6] += bflo(t.w); r[7] += bfhi(t.w); }
                    u32x4 w; w.x = pk2(r[0], r[1]); w.y = pk2(r[2], r[3]); w.z = pk2(r[4], r[5]); w.w = pk2(r[6], r[7]);
                    *(u32x4*)(mp + bj * 128) = w; } }
    }
};
struct EpiOut {
    static constexpr bool PERM = false; const float* x; const float* mod; float* out;
    __device__ __forceinline__ void operator()(const f32x4 (&acc)[2][2][4][2], const mg::Unit& u, int wr, int wc, int fr, int fq) const {
        const size_t row0 = (size_t)u.pm * 256 + wr * 64 + fr; const int col0 = u.pn * 256 + wc * 32 + 4 * fq; const int b = u.pm >> 3;
        f32x4 ga[2][2];
#pragma unroll
        for (int bj = 0; bj < 2; ++bj)
#pragma unroll
            for (int n = 0; n < 2; ++n) ga[bj][n] = *(const f32x4*)(mod + (size_t)b * 6144 + 2048 + col0 + bj * 128 + n * 16);
#pragma unroll
        for (int ai = 0; ai < 2; ++ai)
#pragma unroll
            for (int m = 0; m < 4; ++m) { const size_t off = (row0 + ai * 128 + m * 16) * 1024 + col0;
#pragma unroll
                for (int bj = 0; bj < 2; ++bj)
#pragma unroll
                    for (int n = 0; n < 2; ++n) { const f32x4 xv = *(const f32x4*)(x + off + bj * 128 + n * 16); *(f32x4*)(out + off + bj * 128 + n * 16) = xv + ga[bj][n] * acc[ai][bj][m][n]; } }
    }
};
struct EpiSwiglu {
    static constexpr bool PERM = true; unsigned char* ws;
    __device__ __forceinline__ void operator()(const f32x4 (&acc)[2][2][4][2], const mg::Unit& u, int wr, int wc, int fr, int fq) const {
        unsigned char* p0 = ws + WS_HID + ((size_t)u.pm * 256 + wr * 64 + fr) * 1024 + u.pn * 128 + wc * 32 + 8 * fq;
#pragma unroll
        for (int ai = 0; ai < 2; ++ai)
#pragma unroll
            for (int m = 0; m < 4; ++m) { float r[8];
#pragma unroll
                for (int n = 0; n < 2; ++n)
#pragma unroll
                    for (int j = 0; j < 4; ++j) r[n * 4 + j] = silu_f(acc[ai][0][m][n][j] * W8_INV) * (acc[ai][1][m][n][j] * W8_INV);
                u32x2 w; w.x = pk4_fp8(r[0], r[1], r[2], r[3]); w.y = pk4_fp8(r[4], r[5], r[6], r[7]);
                *(u32x2*)(p0 + (size_t)(ai * 128 + m * 16) * 1024) = w; }
    }
};
struct EpiDown {
    static constexpr bool PERM = true; unsigned char* ws;
    __device__ __forceinline__ void operator()(const f32x4 (&acc)[2][2][4][2], const mg::Unit& u, int wr, int wc, int fr, int fq) const {
        const size_t row0 = (size_t)u.pm * 256 + wr * 64 + fr; const float* val = (const float*)(ws + WS_VAL);
        bf16* p0 = (bf16*)(ws + WS_Y) + row0 * 1024 + u.pn * 256 + wc * 32 + 8 * fq;
#pragma unroll
        for (int ai = 0; ai < 2; ++ai)
#pragma unroll
            for (int m = 0; m < 4; ++m) { const float vv = val[row0 + ai * 128 + m * 16] * W8_INV; bf16* rowp = p0 + (size_t)(ai * 128 + m * 16) * 1024;
#pragma unroll
                for (int bj = 0; bj < 2; ++bj) { const f32x4 v0 = acc[ai][bj][m][0] * vv, v1 = acc[ai][bj][m][1] * vv;
                    u32x4 w; w.x = pk2(v0[0], v0[1]); w.y = pk2(v0[2], v0[3]); w.z = pk2(v1[0], v1[1]); w.w = pk2(v1[2], v1[3]);
                    *(u32x4*)(rowp + bj * 128) = w; } }
    }
};

struct SchedP1 {
    unsigned char* ws; int G, c;
    __device__ __forceinline__ bool next(int i, mg::Unit& u) const {
        int L = i * G + c; const char* H = (const char*)(ws + WS_H); u.gi = nullptr;
        if (L < 4096) { mg::tile_of(L, 256, 16, u.pm, u.pn); u.ty = 0; u.a = H + (size_t)u.pm * 256 * 2048; u.b = (const char*)(ws + WS_WTM) + (size_t)u.pn * 256 * 2048; return true; }
        L -= 4096;
        if (L < 1024) { mg::tile_of(L, 4, 256, u.pm, u.pn); u.ty = 1; u.a = (const char*)(ws + WS_WTF) + (size_t)u.pm * 256 * 2048; u.b = H + (size_t)u.pn * 256 * 2048; return true; }
        L -= 1024;
        if (L < 128) { mg::tile_of(L, 32, 4, u.pm, u.pn); u.ty = 2; u.a = H + ((size_t)NTOK + (size_t)u.pm * 256) * 2048; u.b = (const char*)(ws + WS_WTM) + ((size_t)512 + (size_t)u.pn * 256) * 2048; return true; }
        return false;
    }
};
struct SchedF2 {
    unsigned char* ws; int G, c;
    __device__ __forceinline__ bool next(int i, mg::Unit& u) const {
        const int L = i * G + c; if (L >= 512) return false; mg::tile_of(L, 8, 64, u.pm, u.pn); u.ty = 0; u.gi = nullptr;
        u.a = (const char*)(ws + WS_TT) + (size_t)u.pm * 256 * 8192; u.b = (const char*)(ws + WS_AB) + (size_t)u.pn * 256 * 8192; return true;
    }
};
struct SchedMerge {
    unsigned char* ws; int G, c;
    __device__ __forceinline__ bool next(int i, mg::Unit& u) const {
        const int L = (i >> 1) * G + c; if (L >= 1024) return false; mg::tile_of(L, 256, 4, u.pm, u.pn); u.ty = i & 1; u.gi = nullptr;
        u.a = (const char*)(ws + (u.ty ? WS_HM : WS_FU)) + (size_t)u.pm * 256 * 1024; u.b = (const char*)(ws + (u.ty ? WS_WMT : WS_WFT)) + (size_t)u.pn * 256 * 1024; return true;
    }
};
struct SchedOut {
    unsigned char* ws; int G, c;
    __device__ __forceinline__ bool next(int i, mg::Unit& u) const {
        const int L = i * G + c; if (L >= 1024) return false; mg::tile_of(L, 256, 4, u.pm, u.pn); u.ty = 0; u.gi = nullptr;
        u.a = (const char*)(ws + WS_MRG) + (size_t)u.pm * 256 * 2048; u.b = (const char*)(ws + WS_WOT) + (size_t)u.pn * 256 * 2048; return true;
    }
};
struct SchedUp {
    unsigned char* ws; int G, c;
    __device__ __forceinline__ bool next(int i, mg::Unit& u) const {
        const int L = i * G + c; if (L >= 4096) return false; mg::tile_of(L, 512, 8, u.pm, u.pn); u.ty = 0;
        u.a = (const char*)(ws + WS_HX2); u.gi = (const int*)(ws + WS_IDX) + (size_t)u.pm * 256; u.b = (const char*)(ws + WS_WGU) + ((size_t)(u.pm >> 5) * 8 + u.pn) * 256 * 1024; return true;
    }
};
struct SchedDown {
    unsigned char* ws; int G, c;
    __device__ __forceinline__ bool next(int i, mg::Unit& u) const {
        const int L = i * G + c; if (L >= 2048) return false; mg::tile_of(L, 512, 4, u.pm, u.pn); u.ty = 0;
        u.a = (const char*)(ws + WS_HID); u.gi = (const int*)(ws + WS_IDENT) + (size_t)u.pm * 256; u.b = (const char*)(ws + WS_WD) + ((size_t)(u.pm >> 5) * 4 + u.pn) * 256 * 1024; return true;
    }
};

__device__ __forceinline__ void transpose_item(const float* W, int ldw, int n0, int k0, bf16* dst, int drow0, int Kd, LAS float* scr, int lane) {
#pragma unroll 8
    for (int i = 0; i < 32; ++i) { const int kk = 2 * i + (lane >> 5); scr[kk * 33 + (lane & 31)] = W[(size_t)(k0 + kk) * ldw + n0 + (lane & 31)]; }
    asm volatile("s_waitcnt lgkmcnt(0)" ::: "memory");
    const int c = lane & 7;
#pragma unroll
    for (int j = 0; j < 4; ++j) { const int n = (lane >> 3) + 8 * j; const LAS float* s = scr + (8 * c) * 33 + n;
        u32x4 o; o.x = pk2(s[0 * 33], s[1 * 33]); o.y = pk2(s[2 * 33], s[3 * 33]); o.z = pk2(s[4 * 33], s[5 * 33]); o.w = pk2(s[6 * 33], s[7 * 33]);
        *(u32x4*)(dst + (size_t)(drow0 + n) * Kd + k0 + 8 * c) = o; }
    asm volatile("s_waitcnt lgkmcnt(0)" ::: "memory");
}

__device__ __forceinline__ void transpose_item8(const float* W, int ldw, int n0, int k0, unsigned char* dst, int drow0, int Kd, LAS float* scr, int lane) {
#pragma unroll 8
    for (int i = 0; i < 32; ++i) { const int kk = 2 * i + (lane >> 5); scr[kk * 33 + (lane & 31)] = W[(size_t)(k0 + kk) * ldw + n0 + (lane & 31)] * W8_SCALE; }
    asm volatile("s_waitcnt lgkmcnt(0)" ::: "memory");
    const int c = lane & 7;
#pragma unroll
    for (int j = 0; j < 4; ++j) { const int n = (lane >> 3) + 8 * j; const LAS float* s = scr + (8 * c) * 33 + n;
        u32x2 o; o.x = pk4_fp8(s[0 * 33], s[1 * 33], s[2 * 33], s[3 * 33]); o.y = pk4_fp8(s[4 * 33], s[5 * 33], s[6 * 33], s[7 * 33]);
        *(u32x2*)(dst + (size_t)(drow0 + n) * Kd + k0 + 8 * c) = o; }
    asm volatile("s_waitcnt lgkmcnt(0)" ::: "memory");
}

__device__ __forceinline__ void p0_prep(const Ctx& C, LAS unsigned char* lds, int tid, int lane, int wave, int G) {
    const int blk = blockIdx.x;
    for (int item = blk; item < 192; item += G) {
        LAS float* sT = (LAS float*)lds;
        for (int i = tid; i < 33 * 1024; i += 512) { const int r = i >> 10, k = i & 1023; const float v = r < 32 ? C.c[r * 1024 + k] : C.c_ctx[k]; sT[k * 36 + r] = silu_f(v); }
        for (int i = tid; i < 3 * 1024; i += 512) { const int r = 33 + (i >> 10), k = i & 1023; sT[k * 36 + r] = 0.f; }
        __syncthreads();
        const int col0 = item * 32, kg = tid >> 5, j = tid & 31;
        float acc[36];
#pragma unroll
        for (int r = 0; r < 36; ++r) acc[r] = 0.f;
#pragma unroll 4
        for (int kk = 0; kk < 64; ++kk) { const int k = kg * 64 + kk; const float w = C.w_ada[(size_t)k * 6144 + col0 + j];
#pragma unroll
            for (int q = 0; q < 9; ++q) { const f32x4 s4 = *(const LAS f32x4*)(sT + k * 36 + 4 * q); acc[4 * q] += s4[0] * w; acc[4 * q + 1] += s4[1] * w; acc[4 * q + 2] += s4[2] * w; acc[4 * q + 3] += s4[3] * w; } }
        __syncthreads();
        LAS float* red = (LAS float*)lds;
#pragma unroll
        for (int r = 0; r < 33; ++r) red[(kg * 33 + r) * 32 + j] = acc[r];
        __syncthreads();
        float* mod = (float*)(C.ws + WS_MOD);
        for (int o = tid; o < 33 * 32; o += 512) { const int r = o >> 5, jj = o & 31; float s = 0.f;
#pragma unroll
            for (int g = 0; g < 16; ++g) s += red[(g * 33 + r) * 32 + jj];
            mod[(size_t)r * 6144 + col0 + jj] = s + C.b_ada[col0 + jj]; }
        __syncthreads();
    }
    for (int item = blk; item < 256; item += G) {
        LAS float* wl = (LAS float*)lds; LAS float* cs = wl + 16 * 128; LAS float* sn = cs + 128;
        const int g = item >> 6, d0 = (item & 63) * 16;
        for (int i = tid; i < 16 * 128; i += 512) { const int dd = i >> 7, cc = i & 127; wl[i] = C.w_in[(size_t)(d0 + dd) * INC + g * 128 + cc]; }
        if (tid < 128) { cs[tid] = cospif((float)tid * (1.f / 64.f)); sn[tid] = sinpif((float)tid * (1.f / 64.f)); }
        __syncthreads();
        const int rj = tid & 255, j = rj >> 1, ab = rj & 1, half = tid >> 8;
        float acc[8];
#pragma unroll
        for (int i = 0; i < 8; ++i) acc[i] = 0.f;
        const LAS float* tw = ab ? sn : cs;
        for (int cc = 0; cc < 128; ++cc) { const float t = tw[(j * cc) & 127];
#pragma unroll
            for (int i = 0; i < 8; ++i) acc[i] += wl[(half * 8 + i) * 128 + cc] * t; }
        u32x4 o; o.x = pk2(acc[0], acc[1]); o.y = pk2(acc[2], acc[3]); o.z = pk2(acc[4], acc[5]); o.w = pk2(acc[6], acc[7]);
        *(u32x4*)((bf16*)(C.ws + WS_WTF) + (size_t)(g * 256 + rj) * 1024 + d0 + half * 8) = o;
        __syncthreads();
    }
    {
        LAS float* tc = (LAS float*)lds; LAS float* ts = tc + 2048;
        for (int i = tid; i < 2048; i += 512) { const float a = (float)i * (1.f / 1024.f); tc[i] = cospif(a) * (1.f / 512.f); ts[i] = -sinpif(a) * (1.f / 512.f); }
        __syncthreads();
        for (int item = blk; item < 256; item += G)
            for (int rr = 0; rr < 8; ++rr) { const int k = item * 8 + rr; const int lp0 = tid * 8; const LAS float* tb = lp0 < 2048 ? tc : ts; const int l0 = lp0 & 2047; float v[8];
#pragma unroll
                for (int e = 0; e < 8; ++e) v[e] = tb[(k * (l0 + e)) & 2047];
                u32x4 o; o.x = pk2(v[0], v[1]); o.y = pk2(v[2], v[3]); o.z = pk2(v[4], v[5]); o.w = pk2(v[6], v[7]);
                *(u32x4*)((bf16*)(C.ws + WS_TT) + (size_t)k * 4096 + lp0) = o; }
        __syncthreads();
    }
    {
        LAS float* scr = (LAS float*)lds + wave * (64 * 33);
        const int gw = blk * 8 + wave, NGW = G * 8;
        constexpr int I_IN = 16 * 128, I_F = 8 * 32, I_M = 8 * 32, I_O = 16 * 32;
        for (int it = gw; it < I_IN + I_F + I_M + I_O; it += NGW) {
            int r = it;
            if (r < I_IN) { const int kb = r >> 7, nb = r & 127; const int n0 = nb < 64 ? 512 + 32 * nb : 2576 + 32 * (nb - 64);
                transpose_item(C.w_in, INC, n0, kb * 64, (bf16*)(C.ws + WS_WTM), 32 * nb, 1024, scr, lane); continue; }
            r -= I_IN;
            if (r < I_F) { const int kb = r >> 5, nb = r & 31; transpose_item(C.w_fourier, 1024, 32 * nb, kb * 64, (bf16*)(C.ws + WS_WFT), 32 * nb, 512, scr, lane); continue; }
            r -= I_F;
            if (r < I_M) { const int kb = r >> 5, nb = r & 31; transpose_item(C.w_mlstm, 1024, 32 * nb, kb * 64, (bf16*)(C.ws + WS_WMT), 32 * nb, 512, scr, lane); continue; }
            r -= I_M;
            { const int kb = r >> 5, nb = r & 31; transpose_item(C.w_out, 1024, 32 * nb, kb * 64, (bf16*)(C.ws + WS_WOT), 32 * nb, 1024, scr, lane); }
        }
    }
}
__device__ __forceinline__ void convert_experts(const Ctx& C, LAS unsigned char* lds, int lane, int wave, int G, int rep) {
    LAS float* scr = (LAS float*)lds + wave * (64 * 33);
    const int gw = blockIdx.x * 8 + wave, NGW = G * 8;
    for (int it0 = gw; it0 < 48 * 512 * rep; it0 += NGW) { const int it = it0 % (48 * 512);
        const int mat = it >> 9, r = it & 511, kb = r >> 5, nb = r & 31, e = mat & 15, which = mat >> 4;
        if (which < 2) { const float* W = (which ? C.w_up_e : C.w_gate_e) + (size_t)e * 1024 * 1024; const int n0 = 32 * nb;
            transpose_item8(W, 1024, n0, kb * 64, C.ws + WS_WGU, e * 2048 + (n0 >> 7) * 256 + which * 128 + (n0 & 127), 1024, scr, lane); }
        else transpose_item8(C.w_down_e + (size_t)e * 1024 * 1024, 1024, 32 * nb, kb * 64, C.ws + WS_WD, e * 1024 + 32 * nb, 1024, scr, lane);
    }
}

__device__ __forceinline__ float butterfly64(float (&v)[64], int lane) {
#pragma unroll
    for (int i = 0; i < 32; ++i) { const bool up = lane & 32; const float send = up ? v[i] : v[i + 32], keep = up ? v[i + 32] : v[i]; v[i] = keep + __shfl_xor(send, 32); }
#pragma unroll
    for (int i = 0; i < 16; ++i) { const bool up = lane & 16; const float send = up ? v[i] : v[i + 16], keep = up ? v[i + 16] : v[i]; v[i] = keep + __shfl_xor(send, 16); }
#pragma unroll
    for (int i = 0; i < 8; ++i) { const bool up = lane & 8; const float send = up ? v[i] : v[i + 8], keep = up ? v[i + 8] : v[i]; v[i] = keep + __shfl_xor(send, 8); }
#pragma unroll
    for (int i = 0; i < 4; ++i) { const bool up = lane & 4; const float send = up ? v[i] : v[i + 4], keep = up ? v[i + 4] : v[i]; v[i] = keep + __shfl_xor(send, 4); }
#pragma unroll
    for (int i = 0; i < 2; ++i) { const bool up = lane & 2; const float send = up ? v[i] : v[i + 2], keep = up ? v[i + 2] : v[i]; v[i] = keep + __shfl_xor(send, 2); }
    { const bool up = lane & 1; const float send = up ? v[0] : v[1], keep = up ? v[1] : v[0]; v[0] = keep + __shfl_xor(send, 1); }
    return v[0];
}

template <bool OUT8> __device__ __forceinline__ float rows4_norm_proj(const float* xin, size_t row0, const f32x4 (&gsc)[4], const f32x4 (&sh)[4], bf16* hout, const LAS float* wl, int lane) {
    f32x4 v[4][4]; float ss[4];
#pragma unroll
    for (int r = 0; r < 4; ++r) { ss[r] = 0.f;
#pragma unroll
        for (int j = 0; j < 4; ++j) { v[r][j] = *(const f32x4*)(xin + (row0 + r) * 1024 + 4 * lane + 256 * j); ss[r] += v[r][j][0] * v[r][j][0] + v[r][j][1] * v[r][j][1] + v[r][j][2] * v[r][j][2] + v[r][j][3] * v[r][j][3]; } }
#pragma unroll
    for (int r = 0; r < 4; ++r) { const float rstd = rsqrtf(wave_sum(ss[r]) * (1.f / 1024.f) + EPS);
#pragma unroll
        for (int j = 0; j < 4; ++j) { v[r][j] = v[r][j] * rstd * gsc[j] + sh[j];
            if constexpr (OUT8) *(unsigned*)((unsigned char*)hout + (row0 + r) * 1024 + 4 * lane + 256 * j) = pk4_fp8(v[r][j][0], v[r][j][1], v[r][j][2], v[r][j][3]);
            else { u32x2 w; w.x = pk2(v[r][j][0], v[r][j][1]); w.y = pk2(v[r][j][2], v[r][j][3]); *(u32x2*)(hout + (row0 + r) * 1024 + 4 * lane + 256 * j) = w; } } }
    float acc[64];
#pragma unroll
    for (int i = 0; i < 64; ++i) acc[i] = 0.f;
#pragma unroll
    for (int j = 0; j < 4; ++j)
#pragma unroll
        for (int e = 0; e < 4; ++e) { const LAS float* wp = wl + ((j * 4 + e) * 4) * 256 + lane * 4;
#pragma unroll
            for (int q = 0; q < 4; ++q) { const f32x4 w4 = *(const LAS f32x4*)(wp + q * 256);
#pragma unroll
                for (int r = 0; r < 4; ++r) { const float hv = v[r][j][e]; acc[r * 16 + 4 * q] += hv * w4[0]; acc[r * 16 + 4 * q + 1] += hv * w4[1]; acc[r * 16 + 4 * q + 2] += hv * w4[2]; acc[r * 16 + 4 * q + 3] += hv * w4[3]; } }
            asm volatile("" ::: "memory"); }
    return butterfly64(acc, lane);
}

__device__ __forceinline__ void p1a_norm_gates(const Ctx& C, LAS unsigned char* lds, int tid, int lane, int wave, int G, int rep2) {
    LAS float* wl = (LAS float*)lds;
    for (int i = tid; i < 1024 * 16; i += 512) { const int col = i >> 4, gc = i & 15; wl[(((((col >> 8) * 4 + (col & 3)) * 4 + (gc >> 2)) * 64 + ((col >> 2) & 63)) * 4) + (gc & 3)] = C.w_in[(size_t)col * INC + OFF_G + gc]; }
    __syncthreads();
    const float* mod = (const float*)(C.ws + WS_MOD); bf16* H = (bf16*)(C.ws + WS_H); float* gates = (float*)(C.ws + WS_GATES);
    const int NGW = G * 8;
    for (int gw0 = blockIdx.x * 8 + wave; gw0 < 2048 * (1 + rep2); gw0 += NGW) { const int gw = gw0 & 2047;
        f32x4 gsc[4], sh[4];
        {   const int b = gw >> 6; const float* m = mod + (size_t)b * 6144;
#pragma unroll
            for (int j = 0; j < 4; ++j) { const int col = 4 * lane + 256 * j; const f32x4 g = *(const f32x4*)(C.g_norm1 + col), s = *(const f32x4*)(m + 1024 + col); gsc[j] = g * (s + 1.f); sh[j] = *(const f32x4*)(m + col); }
            for (int q = 0; q < 8; ++q) { const size_t row0 = (size_t)gw * 32 + q * 4; const float gv = rows4_norm_proj<false>(C.x, row0, gsc, sh, H, wl, lane); gates[(row0 + (lane >> 4)) * 16 + (lane & 15)] = gv; } }
        {   const float* m = mod + (size_t)32 * 6144;
#pragma unroll
            for (int j = 0; j < 4; ++j) { const int col = 4 * lane + 256 * j; const f32x4 g = *(const f32x4*)(C.g_norm1 + col), s = *(const f32x4*)(m + 1024 + col); gsc[j] = g * (s + 1.f); sh[j] = *(const f32x4*)(m + col); }
            const size_t row0 = (size_t)gw * 4; const float gv = rows4_norm_proj<false>(C.ctx, row0, gsc, sh, H + (size_t)NTOK * 1024, wl, lane); gates[((size_t)NTOK + row0 + (lane >> 4)) * 16 + (lane & 15)] = gv; }
    }
}

__device__ __forceinline__ f32x4 unpk4(u32x2 p) { return (f32x4){bflo(p.x), bfhi(p.x), bflo(p.y), bfhi(p.y)}; }
__device__ __forceinline__ void conv_item_x(const Ctx& C, int item, int lane) {
    const int qt = item & 3, cb = (item >> 2) & 3, r = (item >> 4) & 31, b = item >> 9;
    const int ch0 = cb * 256 + 4 * lane; const bf16* src = (const bf16*)(C.ws + WS_PQK) + (size_t)b * SEQ * 1024 + ch0; bf16* dst = (bf16*)(C.ws + WS_QK) + (size_t)b * SEQ * 1024 + ch0;
    const int c0 = qt * 16;
    u32x2 raw[3][18];
#pragma unroll
    for (int dy = 0; dy < 3; ++dy) { const int rr = r + dy - 1; const bool rok = rr >= 0 && rr < 32;
#pragma unroll
        for (int i = 0; i < 18; ++i) { const int cc = c0 - 1 + i; raw[dy][i] = (rok && cc >= 0 && cc < 64) ? *(const u32x2*)(src + (size_t)(rr * 64 + cc) * 1024) : (u32x2){0u, 0u}; } }
    f32x4 w[3][3];
#pragma unroll
    for (int dy = 0; dy < 3; ++dy)
#pragma unroll
        for (int dx = 0; dx < 3; ++dx) w[dy][dx] = *(const f32x4*)(C.w_conv + (dy * 3 + dx) * 1024 + ch0);
    const float ksc = cb >= 2 ? 0.08838834764831845f : 1.f;
#pragma unroll
    for (int i = 0; i < 16; ++i) { f32x4 a = {0.f, 0.f, 0.f, 0.f};
#pragma unroll
        for (int dy = 0; dy < 3; ++dy)
#pragma unroll
            for (int dx = 0; dx < 3; ++dx) a += w[dy][dx] * unpk4(raw[dy][i + dx]);
        u32x2 o; o.x = pk2(silu_f(a[0]) * ksc, silu_f(a[1]) * ksc); o.y = pk2(silu_f(a[2]) * ksc, silu_f(a[3]) * ksc);
        *(u32x2*)(dst + (size_t)(r * 64 + c0 + i) * 1024) = o; }
}
__device__ __forceinline__ void conv_item_ctx(const Ctx& C, int item, int lane) {
    const int sg = item & 15, cb = (item >> 4) & 1, b = item >> 5;
    const int kc0 = cb * 256 + 4 * lane; const bf16* src = (const bf16*)(C.ws + WS_PC) + (size_t)b * CL * 1024 + kc0; bf16* dst = (bf16*)(C.ws + WS_KC) + (size_t)b * CL * 512 + kc0;
    const int c0 = sg * 16;
    u32x2 raw[18];
#pragma unroll
    for (int i = 0; i < 18; ++i) { const int cc = c0 - 1 + i; raw[i] = (cc >= 0 && cc < CL) ? *(const u32x2*)(src + (size_t)cc * 1024) : (u32x2){0u, 0u}; }
    f32x4 w[3];
#pragma unroll
    for (int dx = 0; dx < 3; ++dx) w[dx] = *(const f32x4*)(C.w_conv + (3 + dx) * 1024 + 512 + kc0);
    const float ksc = 0.08838834764831845f;
#pragma unroll
    for (int i = 0; i < 16; ++i) { const f32x4 a = w[0] * unpk4(raw[i]) + w[1] * unpk4(raw[i + 1]) + w[2] * unpk4(raw[i + 2]);
        u32x2 o; o.x = pk2(silu_f(a[0]) * ksc, silu_f(a[1]) * ksc); o.y = pk2(silu_f(a[2]) * ksc, silu_f(a[3]) * ksc);
        *(u32x2*)(dst + (size_t)(c0 + i) * 512) = o; }
}
__device__ __forceinline__ void p2_conv(const Ctx& C, int lane, int wave, int G, int rep2) {
    const int NGW = G * 8;
    for (int it0 = blockIdx.x * 8 + wave; it0 < (NB * 512 + NB * 32) * (1 + rep2); it0 += NGW) { const int it = it0 % (NB * 512 + NB * 32); if (it < NB * 512) conv_item_x(C, it, lane); else conv_item_ctx(C, it - NB * 512, lane); }
}

__device__ __forceinline__ void p3b_combine(const Ctx& C, int tid, int G, int rep2) {
    const u32x4* po = (const u32x4*)(C.ws + WS_PO); const u32x4* hf = (const u32x4*)(C.ws + WS_HF); const u32x4* hb = (const u32x4*)(C.ws + WS_HB); u32x4* hm = (u32x4*)(C.ws + WS_HM);
    const size_t n = (size_t)NTOK * 512 / 8;
    for (size_t i0 = (size_t)blockIdx.x * 512 + tid; i0 < n * (1 + rep2); i0 += (size_t)G * 512) { const size_t i = i0 >= n ? i0 - n : i0; const u32x4 o = po[i], a = hf[i], b = hb[i]; u32x4 r;
        r.x = pk2(bflo(o.x) * (bflo(a.x) + bflo(b.x)), bfhi(o.x) * (bfhi(a.x) + bfhi(b.x))); r.y = pk2(bflo(o.y) * (bflo(a.y) + bflo(b.y)), bfhi(o.y) * (bfhi(a.y) + bfhi(b.y)));
        r.z = pk2(bflo(o.z) * (bflo(a.z) + bflo(b.z)), bfhi(o.z) * (bfhi(a.z) + bfhi(b.z))); r.w = pk2(bflo(o.w) * (bflo(a.w) + bflo(b.w)), bfhi(o.w) * (bfhi(a.w) + bfhi(b.w)));
        hm[i] = r; }
}

__device__ __forceinline__ void p6_norm_router(const Ctx& C, LAS unsigned char* lds, int tid, int lane, int wave, int G, int rep2) {
    LAS float* wl = (LAS float*)lds;
    for (int i = tid; i < 1024 * 16; i += 512) { const int col = i >> 4, gc = i & 15; wl[(((((col >> 8) * 4 + (col & 3)) * 4 + (gc >> 2)) * 64 + ((col >> 2) & 63)) * 4) + (gc & 3)] = C.w_router[i]; }
    __syncthreads();
    const float* mod = (const float*)(C.ws + WS_MOD); bf16* HX2 = (bf16*)(C.ws + WS_HX2); float* aff = (float*)(C.ws + WS_AFF);
    const int NGW = G * 8;
    for (int gw0 = blockIdx.x * 8 + wave; gw0 < 2048 * (1 + rep2); gw0 += NGW) { const int gw = gw0 & 2047;
        f32x4 gsc[4], sh[4]; const int b = gw >> 6; const float* m = mod + (size_t)b * 6144;
#pragma unroll
        for (int j = 0; j < 4; ++j) { const int col = 4 * lane + 256 * j; const f32x4 g = *(const f32x4*)(C.g_norm2 + col), s = *(const f32x4*)(m + 4096 + col); gsc[j] = g * (s + 1.f); sh[j] = *(const f32x4*)(m + 3072 + col); }
        for (int q = 0; q < 8; ++q) { const size_t row0 = (size_t)gw * 32 + q * 4; const float lg = rows4_norm_proj<true>(C.out, row0, gsc, sh, HX2, wl, lane);
            float mx = lg;
#pragma unroll
            for (int o = 1; o < 16; o <<= 1) mx = fmaxf(mx, __shfl_xor(mx, o));
            const float ex = expf(lg - mx); float sm = ex;
#pragma unroll
            for (int o = 1; o < 16; o <<= 1) sm += __shfl_xor(sm, o);
            const size_t t = (row0 + (lane >> 4)) & (SEQ - 1);
            aff[((size_t)b * NE + (lane & 15)) * SEQ + t] = ex / sm; }
    }
}

__device__ __forceinline__ unsigned wave_sum_u(unsigned v) {
#pragma unroll
    for (int o = 1; o < 64; o <<= 1) v += __shfl_xor(v, o);
    return v;
}
__device__ __forceinline__ unsigned wave_excl_scan_u(unsigned v, int lane) { unsigned s = v;
#pragma unroll
    for (int o = 1; o < 64; o <<= 1) { const unsigned t = __shfl_up(s, o); if (lane >= o) s += t; }
    return s - v;
}
__device__ __forceinline__ void topk_item(const Ctx& C, int item, int lane) {
    const int b = item >> 4, e = item & 15; const float* a = (const float*)(C.ws + WS_AFF) + ((size_t)b * NE + e) * SEQ + 32 * lane;
    unsigned key[32];
#pragma unroll
    for (int q = 0; q < 8; ++q) { const u32x4 v = *(const u32x4*)(a + 4 * q); key[4 * q] = v.x; key[4 * q + 1] = v.y; key[4 * q + 2] = v.z; key[4 * q + 3] = v.w; }
    unsigned T = 0u;
    for (int bit = 30; bit >= 0; --bit) { const unsigned cand = T | (1u << bit); unsigned cnt = 0u;
#pragma unroll
        for (int i = 0; i < 32; ++i) cnt += key[i] >= cand ? 1u : 0u;
        if (wave_sum_u(cnt) >= (unsigned)CAP) T = cand; }
    unsigned ngt = 0u, neq = 0u;
#pragma unroll
    for (int i = 0; i < 32; ++i) { ngt += key[i] > T ? 1u : 0u; neq += key[i] == T ? 1u : 0u; }
    const unsigned need = (unsigned)CAP - wave_sum_u(ngt);
    unsigned tie_before = wave_excl_scan_u(neq, lane);
    unsigned nsel = 0u; unsigned selmask = 0u;
#pragma unroll
    for (int i = 0; i < 32; ++i) { bool s = key[i] > T; if (key[i] == T) { s = tie_before < need; ++tie_before; } if (s) { selmask |= 1u << i; ++nsel; } }
    unsigned slot = wave_excl_scan_u(nsel, lane);
    const int pm = e * 32 + b; int* idx = (int*)(C.ws + WS_IDX) + (size_t)pm * CAP; float* val = (float*)(C.ws + WS_VAL) + (size_t)pm * CAP; bf16* sl = (bf16*)(C.ws + WS_SLOT);
#pragma unroll
    for (int i = 0; i < 32; ++i) { const int t = 32 * lane + i; const bool s = (selmask >> i) & 1u;
        if (s) { idx[slot] = b * SEQ + t; val[slot] = __uint_as_float(key[i]); }
        sl[((size_t)b * SEQ + t) * NE + e] = s ? (bf16)slot : (bf16)0xffffu; if (s) ++slot; }
}

__device__ __forceinline__ void p10_final(const Ctx& C, int lane, int wave, int G) {
    const float* mod = (const float*)(C.ws + WS_MOD); const bf16* Y = (const bf16*)(C.ws + WS_Y); const bf16* sl = (const bf16*)(C.ws + WS_SLOT);
    const int NGW = G * 8;
    for (int gw = blockIdx.x * 8 + wave; gw < 2048; gw += NGW) { const int b = gw >> 6; const float* m = mod + (size_t)b * 6144 + 5120;
        f32x4 ga[4], gf[4];
#pragma unroll
        for (int j = 0; j < 4; ++j) { ga[j] = *(const f32x4*)(m + 4 * lane + 256 * j); gf[j] = *(const f32x4*)(C.g_final + 4 * lane + 256 * j); }
        for (int q = 0; q < 32; ++q) { const size_t row = (size_t)gw * 32 + q; f32x4 v[4], a[4];
#pragma unroll
            for (int j = 0; j < 4; ++j) { v[j] = *(const f32x4*)(C.out + row * 1024 + 4 * lane + 256 * j); a[j] = (f32x4){0.f, 0.f, 0.f, 0.f}; }
            const unsigned myslot = lane < NE ? (unsigned)sl[row * NE + lane] : 0xffffu;
            for (int e = 0; e < NE; ++e) { const unsigned s = __builtin_amdgcn_readlane(myslot, e); if (s != 0xffffu) { const bf16* yr = Y + ((size_t)(e * 32 + b) * CAP + s) * 1024 + 4 * lane;
#pragma unroll
                for (int j = 0; j < 4; ++j) { const u32x2 p = *(const u32x2*)(yr + 256 * j); a[j] += (f32x4){bflo(p.x), bfhi(p.x), bflo(p.y), bfhi(p.y)}; } } }
            float ss = 0.f;
#pragma unroll
            for (int j = 0; j < 4; ++j) { v[j] = v[j] + ga[j] * a[j]; ss += v[j][0] * v[j][0] + v[j][1] * v[j][1] + v[j][2] * v[j][2] + v[j][3] * v[j][3]; }
            const float rstd = rsqrtf(wave_sum(ss) * (1.f / 1024.f) + EPS);
#pragma unroll
            for (int j = 0; j < 4; ++j) *(f32x4*)(C.out + row * 1024 + 4 * lane + 256 * j) = v[j] * rstd * gf[j]; }
    }
}
namespace ml {
typedef short v4i16_t __attribute__((ext_vector_type(4)));
constexpr int QS = 0, KS = 16384, VS = 32768, CT = 49152, SS = 81920, SM = 90112;
constexpr int U_ = 0, M_ = 64, DEC_ = 128, EM_ = 192, WA_ = 256, QN_ = 320, RS_ = 384, N_ = 512, SC_ = 640;
__device__ __forceinline__ unsigned off_b(unsigned row, unsigned ch) { return 256u * row + 16u * (ch ^ (((row & 3) << 2) | ((row >> 2) & 3))); }
__device__ __forceinline__ unsigned off_s(unsigned row, unsigned ch) { return 128u * row + 16u * (ch ^ (row & 7)); }
__device__ __forceinline__ bf16x8 rowfrag(const LAS unsigned char* tile, int rb, int ks, int lane) { return *(const LAS bf16x8*)(tile + off_b(16 * rb + (lane & 15), 4 * ks + (lane >> 4))); }
__device__ __forceinline__ bf16x8 trfrag(const LAS unsigned char* tile, int c, int ks, int lane) {
    const unsigned g = lane >> 4, q = (lane & 15) >> 2, p = lane & 3;
    const unsigned a0 = off_b(32 * ks + 8 * g + q, 2 * c + (p >> 1)) + 8 * (p & 1), a1 = off_b(32 * ks + 8 * g + 4 + q, 2 * c + (p >> 1)) + 8 * (p & 1);
    const v4i16_t lo = __builtin_amdgcn_ds_read_tr16_b64_v4i16((LAS v4i16_t*)(tile + a0)), hi = __builtin_amdgcn_ds_read_tr16_b64_v4i16((LAS v4i16_t*)(tile + a1));
    bf16x8 r; r[0] = lo[0]; r[1] = lo[1]; r[2] = lo[2]; r[3] = lo[3]; r[4] = hi[0]; r[5] = hi[1]; r[6] = hi[2]; r[7] = hi[3]; return r;
}
__device__ __forceinline__ float scan_add(float v, int lane, int dir) {
#pragma unroll
    for (int d = 1; d < 64; d <<= 1) { const float t = dir ? __shfl_down(v, d) : __shfl_up(v, d); if (dir ? (lane + d < 64) : (lane >= d)) v += t; }
    return v;
}
__device__ __forceinline__ float scan_max(float v, int lane, int dir) {
#pragma unroll
    for (int d = 1; d < 64; d <<= 1) { const float t = dir ? __shfl_down(v, d) : __shfl_up(v, d); if (dir ? (lane + d < 64) : (lane >= d)) v = fmaxf(v, t); }
    return v;
}
__device__ __forceinline__ void gate_math(float ig, float fg, int lane, int dir, float& m0, LAS float* sm) {
    const float fl = log_sigmoid_f(fg);
    const float cum = scan_add(fl, lane, dir);
    const float u = ig - cum;
    const float pmx = scan_max(u, lane, dir);
    const int endl = dir ? 0 : 63;
    const float tot = __shfl(cum, endl), umax = __shfl(pmx, endl);
    const float M = fmaxf(m0, pmx);
    const float mn = fmaxf(tot + m0, tot + umax);
    sm[U_ + lane] = u; sm[M_ + lane] = M; sm[DEC_ + lane] = expf(m0 - M); sm[EM_ + lane] = expf(-(cum + M)); sm[WA_ + lane] = expf(tot + u - mn);
    if (lane == 0) sm[SC_] = expf(tot + m0 - mn);
    m0 = mn;
}

__device__ __forceinline__ void mlstm_phase(const Ctx& C, LAS unsigned char* lds, int tid, int lane, int wave, int G, int rep2) {
    LAS float* sm = (LAS float*)(lds + SM);
    const bf16* QK = (const bf16*)(C.ws + WS_QK); const bf16* KC = (const bf16*)(C.ws + WS_KC); const bf16* PV = (const bf16*)(C.ws + WS_PV); const bf16* PC = (const bf16*)(C.ws + WS_PC);
    const float* gates = (const float*)(C.ws + WS_GATES);
    for (int item0 = blockIdx.x; item0 < 256 * (1 + rep2); item0 += G) { const int item = item0 & 255;
        const int dir = item & 1, h = (item >> 1) & 3, b = item >> 3;
        bf16* Hout = (bf16*)(C.ws + (dir ? WS_HB : WS_HF));
        const int kI = dir ? 2 : 0, kF = dir ? 3 : 1; const float bI = C.b_gates[kI * 4 + h], bF = C.b_gates[kF * 4 + h];
        for (int i = tid; i < 32768 / 16; i += 512) *(LAS u32x4*)(lds + CT + i * 16) = (u32x4){0u, 0u, 0u, 0u};
        if (tid < 128) sm[N_ + tid] = 0.f;
        f32x4 Cacc[8];
#pragma unroll
        for (int t = 0; t < 8; ++t) Cacc[t] = (f32x4){0.f, 0.f, 0.f, 0.f};
        float m0 = 0.f;
        u32x4 pq[2], pk[2], pv[2]; float pig = 0.f, pfg = 0.f;
#define ML_ISSUE(step_) do { const int _st = (step_); const bool _isx = _st >= 4; const int _cc = _isx ? (dir ? 35 - _st : _st - 4) : (dir ? 3 - _st : _st); \
            _Pragma("unroll") for (int _i = 0; _i < 2; ++_i) { const int _idx = tid + 512 * _i, _row = _idx >> 4, _ch = _idx & 15; \
                if (_isx) { const size_t _tok = (size_t)b * SEQ + _cc * 64 + _row; pq[_i] = *(const u32x4*)(QK + _tok * 1024 + h * 128 + _ch * 8); pk[_i] = *(const u32x4*)(QK + _tok * 1024 + 512 + h * 128 + _ch * 8); pv[_i] = *(const u32x4*)(PV + _tok * 512 + h * 128 + _ch * 8); } \
                else { const size_t _tok = (size_t)b * CL + _cc * 64 + _row; pk[_i] = *(const u32x4*)(KC + _tok * 512 + h * 128 + _ch * 8); pv[_i] = *(const u32x4*)(PC + _tok * 1024 + 512 + h * 128 + _ch * 8); pq[_i] = pk[_i]; } } \
            if (wave == 0) { const size_t _tok = _isx ? (size_t)b * SEQ + _cc * 64 + lane : (size_t)NTOK + (size_t)b * CL + _cc * 64 + lane; pig = gates[_tok * 16 + kI * 4 + h] + bI; pfg = gates[_tok * 16 + kF * 4 + h] + bF; } } while (0)
#define ML_COMMIT() do { \
            _Pragma("unroll") for (int _i = 0; _i < 2; ++_i) { const int _idx = tid + 512 * _i, _row = _idx >> 4, _ch = _idx & 15; const unsigned _o = off_b(_row, _ch); \
                *(LAS u32x4*)(lds + QS + _o) = pq[_i]; *(LAS u32x4*)(lds + KS + _o) = pk[_i]; *(LAS u32x4*)(lds + VS + _o) = pv[_i]; } \
            if (wave == 0) gate_math(pig, pfg, lane, dir, m0, sm); } while (0)
        ML_ISSUE(0);
        __syncthreads();
        ML_COMMIT();
        __syncthreads();
        const int g = lane >> 4, li = lane & 15;
        for (int step = 0; step < 36; ++step) {
            const bool isx = step >= 4; const int cc = isx ? (dir ? 35 - step : step - 4) : 0;
            if (!isx && step + 1 < 36) ML_ISSUE(step + 1);
            if (isx) {
                const int jt = wave >> 1, j = 16 * jt + li;
                {   const int jr = tid >> 3, part = tid & 7; float dsum = 0.f;
#pragma unroll
                    for (int c2 = 0; c2 < 2; ++c2) { const u32x4 qv = *(const LAS u32x4*)(lds + QS + off_b(jr, 2 * part + c2)); const LAS float* np = sm + N_ + 16 * part + 8 * c2; const f32x4 n0 = *(const LAS f32x4*)np, n1 = *(const LAS f32x4*)(np + 4);
                        dsum += bflo(qv.x) * n0[0] + bfhi(qv.x) * n0[1] + bflo(qv.y) * n0[2] + bfhi(qv.y) * n0[3] + bflo(qv.z) * n1[0] + bfhi(qv.z) * n1[1] + bflo(qv.w) * n1[2] + bfhi(qv.w) * n1[3]; }
                    dsum += __shfl_xor(dsum, 1); dsum += __shfl_xor(dsum, 2); dsum += __shfl_xor(dsum, 4);
                    if (part == 0) sm[QN_ + jr] = dsum; }
                bf16x8 qf[4];
#pragma unroll
                for (int ks = 0; ks < 4; ++ks) qf[ks] = rowfrag(lds + QS, jt, ks, lane);
                const float Mj = sm[M_ + j]; float rsum = 0.f;
#pragma unroll
                for (int t = 0; t < 2; ++t) { const int st = 2 * (wave & 1) + t; f32x4 sa = {0.f, 0.f, 0.f, 0.f};
#pragma unroll
                    for (int ks = 0; ks < 4; ++ks) sa = __builtin_amdgcn_mfma_f32_16x16x32_bf16(rowfrag(lds + KS, st, ks, lane), qf[ks], sa, 0, 0, 0);
                    const int s0 = 16 * st + 4 * g; const f32x4 u4 = *(const LAS f32x4*)(sm + U_ + s0); float sp[4];
#pragma unroll
                    for (int r = 0; r < 4; ++r) { const int s = s0 + r; const bool keep = dir ? (s >= j) : (s <= j); const float dv = expf(fminf(u4[r] - Mj, 0.f)); sp[r] = keep ? sa[r] * dv : 0.f; rsum += sp[r]; }
                    u32x2 w; w.x = pk2(sp[0], sp[1]); w.y = pk2(sp[2], sp[3]);
                    *(LAS u32x2*)(lds + SS + off_s(j, 2 * st + (g >> 1)) + (g & 1) * 8) = w; }
                rsum += __shfl_xor(rsum, 16); rsum += __shfl_xor(rsum, 32);
                if (g == 0) sm[RS_ + 2 * j + (wave & 1)] = rsum;
                __syncthreads();
                if (step + 1 < 36) ML_ISSUE(step + 1);
                f32x4 oa[4];
#pragma unroll
                for (int t = 0; t < 4; ++t) { const int dvt = 4 * (wave & 1) + t; oa[t] = (f32x4){0.f, 0.f, 0.f, 0.f};
#pragma unroll
                    for (int ks = 0; ks < 4; ++ks) oa[t] = __builtin_amdgcn_mfma_f32_16x16x32_bf16(rowfrag(lds + CT, dvt, ks, lane), rowfrag(lds + QS, jt, ks, lane), oa[t], 0, 0, 0); }
                const float dj = sm[DEC_ + j];
                bf16x8 sf[2];
#pragma unroll
                for (int ks = 0; ks < 2; ++ks) sf[ks] = *(const LAS bf16x8*)(lds + SS + off_s(j, 4 * ks + g));
                const float den = (sm[RS_ + 2 * j] + sm[RS_ + 2 * j + 1]) + dj * sm[QN_ + j];
                const float inv = 1.f / fmaxf(fabsf(den), sm[EM_ + j]);
                const size_t tok = (size_t)b * SEQ + cc * 64 + j;
#pragma unroll
                for (int t = 0; t < 4; ++t) { const int dvt = 4 * (wave & 1) + t; f32x4 o = oa[t] * dj;
#pragma unroll
                    for (int ks = 0; ks < 2; ++ks) o = __builtin_amdgcn_mfma_f32_16x16x32_bf16(trfrag(lds + VS, dvt, ks, lane), sf[ks], o, 0, 0, 0);
                    o = o * inv; u32x2 w; w.x = pk2(o[0], o[1]); w.y = pk2(o[2], o[3]);
                    *(u32x2*)(Hout + tok * 512 + h * 128 + 16 * dvt + 4 * g) = w; }
            }
            {   const float dn = sm[SC_];
                bf16x8 kf[2];
#pragma unroll
                for (int ks = 0; ks < 2; ++ks) { const bf16x8 kr = trfrag(lds + KS, wave, ks, lane); const f32x4 w0 = *(const LAS f32x4*)(sm + WA_ + 32 * ks + 8 * g), w1 = *(const LAS f32x4*)(sm + WA_ + 32 * ks + 8 * g + 4);
                    u32x4 pkd; pkd.x = pk2(bf1((bf16)kr[0]) * w0[0], bf1((bf16)kr[1]) * w0[1]); pkd.y = pk2(bf1((bf16)kr[2]) * w0[2], bf1((bf16)kr[3]) * w0[3]);
                    pkd.z = pk2(bf1((bf16)kr[4]) * w1[0], bf1((bf16)kr[5]) * w1[1]); pkd.w = pk2(bf1((bf16)kr[6]) * w1[2], bf1((bf16)kr[7]) * w1[3]);
                    kf[ks] = __builtin_bit_cast(bf16x8, pkd); }
                {   const int dk = tid >> 2, part = tid & 3; float a = 0.f;
#pragma unroll
                    for (int e = 0; e < 16; ++e) { const int s = 16 * part + e; a += sm[WA_ + s] * bf1(*(const LAS bf16*)(lds + KS + off_b(s, dk >> 3) + (dk & 7) * 2)); }
                    a += __shfl_xor(a, 1); a += __shfl_xor(a, 2);
                    if (part == 0) sm[N_ + dk] = dn * sm[N_ + dk] + a; }
#pragma unroll
                for (int dvt = 0; dvt < 8; ++dvt) { f32x4 c = Cacc[dvt] * dn;
#pragma unroll
                    for (int ks = 0; ks < 2; ++ks) c = __builtin_amdgcn_mfma_f32_16x16x32_bf16(kf[ks], trfrag(lds + VS, dvt, ks, lane), c, 0, 0, 0);
                    Cacc[dvt] = c; }
            }
            __syncthreads();
#pragma unroll
            for (int dvt = 0; dvt < 8; ++dvt) { const f32x4 c = Cacc[dvt]; u32x2 w; w.x = pk2(c[0], c[1]); w.y = pk2(c[2], c[3]);
                *(LAS u32x2*)(lds + CT + off_b(16 * dvt + li, 2 * wave + (g >> 1)) + (g & 1) * 8) = w; }
            if (step + 1 < 36) ML_COMMIT();
            __syncthreads();
        }
    }
}
#undef ML_ISSUE
#undef ML_COMMIT
}
constexpr int N_PHASES = 13;
#ifndef PROBE_PH
#define PROBE_PH 0
#endif
struct Args { const float* in[19]; float* out; unsigned char* ws; int ph_lo, ph_hi, probe, pad; };
static_assert(sizeof(Args) == 19 * 8 + 8 + 8 + 16, "Args has no padding");

__global__ void __launch_bounds__(512, 2) mk_fwd(Args a) {
    extern __shared__ __attribute__((aligned(16))) unsigned char lds_raw[];
    LAS unsigned char* lds = (LAS unsigned char*)lds_raw;
    const int tid = threadIdx.x, lane = tid & 63, wave = __builtin_amdgcn_readfirstlane(tid >> 6), G = gridDim.x;
    Ctx C;
    C.x = a.in[0]; C.c = a.in[1]; C.ctx = a.in[2]; C.c_ctx = a.in[3]; C.w_ada = a.in[4]; C.b_ada = a.in[5]; C.g_norm1 = a.in[6]; C.w_in = a.in[7]; C.b_gates = a.in[8]; C.w_conv = a.in[9];
    C.w_fourier = a.in[10]; C.w_mlstm = a.in[11]; C.w_out = a.in[12]; C.g_norm2 = a.in[13]; C.w_router = a.in[14]; C.w_gate_e = a.in[15]; C.w_up_e = a.in[16]; C.w_down_e = a.in[17]; C.g_final = a.in[18];
    C.out = a.out; C.ws = a.ws;
    const int lo = a.ph_lo, hi = a.ph_hi;
#if MK_XCD_BAR
    volatile LAS unsigned* bst = (volatile LAS unsigned*)(lds + LDS_PHASE_BYTES);
    if (tid < 4) bst[tid] = 0u;
    __syncthreads();
    XcdBarrier bar = xcd_barrier_post((unsigned*)(a.ws + WS_CTL) + 4096, bst);
#endif
    int nsync = 0;
#define IN(k) (lo <= (k) && (k) < hi)
#if MK_XCD_BAR
#define GRIDBAR() do { if (nsync == 0) cg::this_grid().sync(); else xcd_barrier(bar); ++nsync; } while (0)
#else
#define GRIDBAR() do { cg::this_grid().sync(); ++nsync; } while (0)
#endif
#define SEAM(k) do { if (IN(k) && IN((k) + 1)) GRIDBAR(); } while (0)
#define PHASE(k, ...) do { if (IN(k)) { __VA_ARGS__ } SEAM(k); } while (0)
    PHASE(0, { for (int _r = 0; _r < 1 + (a.probe & 1); ++_r) { p0_prep(C, lds, tid, lane, wave, G); __syncthreads(); } });
    PHASE(1, { p1a_norm_gates(C, lds, tid, lane, wave, G, (a.probe >> 1) & 1); __syncthreads(); });
    PHASE(2, { SchedP1 S{C.ws, G, (int)blockIdx.x}; EpiP1 E{C.ws}; mg::gemm_phase<EpiP1, SchedP1, false>(lds, 1024, S, E); });
    PHASE(3, { SchedF2 S{C.ws, G, (int)blockIdx.x}; EpiF2 E{C.ws}; mg::gemm_phase<EpiF2, SchedF2, false>(lds, 4096, S, E); p2_conv(C, lane, wave, G, (a.probe >> 13) & 1); });
    PHASE(4, { ml::mlstm_phase(C, lds, tid, lane, wave, G, (a.probe >> 4) & 1); });
    PHASE(5, { p3b_combine(C, tid, G, (a.probe >> 5) & 1); });
    PHASE(6, { SchedMerge S{C.ws, G, (int)blockIdx.x}; EpiMerge E{C.ws}; mg::gemm_phase<EpiMerge, SchedMerge, false>(lds, 512, S, E); });
    PHASE(7, { SchedOut S{C.ws, G, (int)blockIdx.x}; EpiOut E{C.x, (const float*)(C.ws + WS_MOD), C.out}; mg::gemm_phase<EpiOut, SchedOut, false>(lds, 1024, S, E); });
    PHASE(8, { p6_norm_router(C, lds, tid, lane, wave, G, (a.probe >> 8) & 1); __syncthreads(); });
    PHASE(9, { const int NGW = G * 8; const int rp9 = 1 + ((a.probe >> 9) & 1); for (int it = blockIdx.x * 8 + wave; it < NB * NE * rp9; it += NGW) topk_item(C, it % (NB * NE), lane); convert_experts(C, lds, lane, wave, G, rp9); for (int i = blockIdx.x * 512 + tid; i < NE * NB * CAP; i += G * 512) ((int*)(C.ws + WS_IDENT))[i] = i; __syncthreads(); });
    PHASE(10, { SchedUp S{C.ws, G, (int)blockIdx.x}; EpiSwiglu E{C.ws}; mg::gemm_phase<EpiSwiglu, SchedUp, true, true>(lds, 1024, S, E); });
    PHASE(11, { SchedDown S{C.ws, G, (int)blockIdx.x}; EpiDown E{C.ws}; mg::gemm_phase<EpiDown, SchedDown, true, true>(lds, 1024, S, E); });
    if (IN(12)) { p10_final(C, lane, wave, G); }
#undef PHASE
#undef PHASE_L
#undef IN
#undef SEAM
#undef GRIDBAR
}

static void mk_launch(void* const* d_in, void* d_out, void* d_ws, hipStream_t stream, int lo, int hi, bool coop) {
    static int grid = 0;
    if (grid == 0) {
        int dev = 0, cus = 0, per_cu = 0;
        (void)hipGetDevice(&dev); (void)hipDeviceGetAttribute(&cus, hipDeviceAttributeMultiprocessorCount, dev);
        (void)hipFuncSetAttribute((const void*)mk_fwd, hipFuncAttributeMaxDynamicSharedMemorySize, LDS_BYTES);
        (void)hipOccupancyMaxActiveBlocksPerMultiprocessor(&per_cu, (const void*)mk_fwd, 512, LDS_BYTES);
        if (per_cu < 1) fprintf(stderr, "mk_launch: occupancy query says %d blocks/CU\n", per_cu);
        grid = cus > 0 ? cus : 256;
    }
    Args a{};
    for (int i = 0; i < 19; ++i) a.in[i] = (const float*)d_in[i];
    a.out = (float*)d_out; a.ws = (unsigned char*)d_ws; a.ph_lo = lo; a.ph_hi = hi; a.probe = PROBE_PH; a.pad = 0;
    if (coop) { void* args[] = {&a}; hipError_t e = hipLaunchCooperativeKernel((const void*)mk_fwd, dim3(grid), dim3(512), args, LDS_BYTES, stream);
        if (e != hipSuccess) fprintf(stderr, "cooperative launch failed: %s (grid %d)\n", hipGetErrorString(e), grid); }
    else hipLaunchKernelGGL(mk_fwd, dim3(grid), dim3(512), LDS_BYTES, stream, a);
}
extern "C" void kernel_launch(void* const* d_in, const int* in_sizes, int n_in, void* d_out, int out_size, void* d_ws, size_t ws_size, hipStream_t stream) {
    (void)hipMemsetAsync((char*)d_ws + WS_CTL, 0, 65536, stream);
    mk_launch(d_in, d_out, d_ws, stream, 0, N_PHASES, true);
}
```

```cpp
#ifndef MK_XCD_BAR
#define MK_XCD_BAR 1
#endif
#include <hip/hip_runtime.h>
#include <hip/hip_cooperative_groups.h>
#include <cstdio>
#include <cstdint>
namespace cg = cooperative_groups;

#define LAS __attribute__((address_space(3)))
typedef unsigned short bf16;
typedef short bf16x8 __attribute__((ext_vector_type(8)));
typedef short s16x4 __attribute__((ext_vector_type(4)));
typedef float f32x4 __attribute__((ext_vector_type(4)));
typedef float f32x2 __attribute__((ext_vector_type(2)));
typedef unsigned u32x4 __attribute__((ext_vector_type(4)));
typedef unsigned u32x2 __attribute__((ext_vector_type(2)));
typedef __bf16 bf16x2_t __attribute__((ext_vector_type(2)));
typedef int v8i_t __attribute__((ext_vector_type(8)));
typedef int v4i_t __attribute__((ext_vector_type(4)));

__device__ __forceinline__ unsigned pk2(float lo, float hi) { f32x2 v = {lo, hi}; bf16x2_t b = __builtin_convertvector(v, bf16x2_t); return __builtin_bit_cast(unsigned, b); }
__device__ __forceinline__ float bflo(unsigned w) { return __uint_as_float(w << 16); }
__device__ __forceinline__ float bfhi(unsigned w) { return __uint_as_float(w & 0xffff0000u); }
__device__ __forceinline__ float bf1(bf16 b) { return __uint_as_float((unsigned)b << 16); }
__device__ __forceinline__ float silu_f(float v) { return v * __builtin_amdgcn_rcpf(1.f + __expf(-v)); }
__device__ __forceinline__ float sigmoid_f(float v) { return __builtin_amdgcn_rcpf(1.f + __expf(-v)); }
__device__ __forceinline__ float log_sigmoid_f(float v) { return fminf(v, 0.f) - log1pf(expf(-fabsf(v))); }
__device__ __forceinline__ float wave_sum(float v) {
#pragma unroll
    for (int o = 1; o < 64; o <<= 1) v += __shfl_xor(v, o);
    return v;
}

#define XB_TMO      128
#define XB_XCNT(j)  (256  + 64 * (j))
#define XB_XSUB(j)  (1280 + 64 * (j))
#define XB_XGEN(j)  (2304 + 64 * (j))
#define XB_TOP      3328
#define XB_TOPGEN   3392
#define XCD_BAR_WORDS 3456
#define XB_SPIN_CAP (1u << 20)
__device__ __forceinline__ unsigned xb_ld(unsigned* p)              { return __hip_atomic_load(p, __ATOMIC_RELAXED, __HIP_MEMORY_SCOPE_AGENT); }
__device__ __forceinline__ unsigned xb_add(unsigned* p, unsigned v) { return __hip_atomic_fetch_add(p, v, __ATOMIC_RELAXED, __HIP_MEMORY_SCOPE_AGENT); }
__device__ __forceinline__ unsigned xb_xcc_id() { return (unsigned)__builtin_amdgcn_s_getreg((3 << 11) | 20) & 0xFu; }
#define XB_SPIN(cond, bar) do { unsigned _sp = 0; while (cond) { __builtin_amdgcn_s_sleep(1); \
    if ((++_sp & 255u) == 0u) { if (xb_ld(&(bar)[XB_TMO])) break; if (_sp > XB_SPIN_CAP) { atomicAdd(&(bar)[XB_TMO], 1u); break; } } } } while (0)
struct XcdBarrier { unsigned* bar; unsigned x; volatile LAS unsigned* st; };
__device__ __forceinline__ XcdBarrier xcd_barrier_post(unsigned* bar, volatile LAS unsigned* st) {
    XcdBarrier b; b.bar = bar; b.x = xb_xcc_id(); b.st = st;
    if (threadIdx.x == 0) (void)xb_add(&bar[XB_XCNT(b.x)], 1u);
    return b;
}
__device__ __forceinline__ void xcd_barrier_complete(unsigned* bar, unsigned x, unsigned& nloc, unsigned& nx) {
    const unsigned G = gridDim.x * gridDim.y * gridDim.z;
    unsigned sum, cnt, mine, sp = 0u;
    for (;;) {
        sum = 0u; cnt = 0u; mine = 0u;
#pragma unroll
        for (unsigned j = 0; j < 16; ++j) { const unsigned c = xb_ld(&bar[XB_XCNT(j)]); sum += c; cnt += (c > 0u) ? 1u : 0u; mine = (j == x) ? c : mine; }
        if (sum == G) break;
        __builtin_amdgcn_s_sleep(1);
        if ((++sp & 255u) == 0u) { if (xb_ld(&bar[XB_TMO])) break; if (sp > XB_SPIN_CAP) { atomicAdd(&bar[XB_TMO], 1u); break; } }
    }
    nloc = mine > 0u ? mine : 1u; nx = cnt > 0u ? cnt : 1u;
}
__device__ __forceinline__ void xcd_barrier(const XcdBarrier& b) {
    asm volatile("s_waitcnt vmcnt(0)" ::: "memory");
    __syncthreads();
    if (threadIdx.x == 0) {
        unsigned* bar = b.bar;
        __builtin_amdgcn_s_waitcnt(0);
        unsigned nloc = b.st[0], nx = b.st[1];
        if (nloc == 0u) { xcd_barrier_complete(bar, b.x, nloc, nx); b.st[0] = nloc; b.st[1] = nx; }
        const unsigned old = xb_add(&bar[XB_XSUB(b.x)], 1u);
        const unsigned gen = old / nloc;
        if (old + 1u == (gen + 1u) * nloc) {
            __builtin_amdgcn_fence(__ATOMIC_RELEASE, "agent");
            asm volatile("s_waitcnt vmcnt(0)" ::: "memory");
            const unsigned og = xb_add(&bar[XB_TOP], 1u);
            const unsigned tg = og / nx;
            if (og + 1u == (tg + 1u) * nx) xb_add(&bar[XB_TOPGEN], 1u);
            else XB_SPIN(xb_ld(&bar[XB_TOPGEN]) == tg, bar);
            __builtin_amdgcn_fence(__ATOMIC_ACQUIRE, "agent");
            xb_add(&bar[XB_XGEN(b.x)], 1u);
            asm volatile("s_waitcnt vmcnt(0)" ::: "memory");
        } else {
            XB_SPIN(xb_ld(&bar[XB_XGEN(b.x)]) == gen, bar);
            __builtin_amdgcn_fence(__ATOMIC_ACQUIRE, "agent");
            asm volatile("s_waitcnt vmcnt(0)" ::: "memory");
        }
    }
    __syncthreads();
}

namespace mg {
template <bool F8> struct Frag { bf16x8 k[2]; };
template <> struct Frag<true> { v8i_t v; };
constexpr int BM = 256, BK = 64, HALF = 128, HTB = HALF * BK * 2, STAGE_BYTES = 8 * HTB, NXCD = 8, WGM = 8;
__host__ __device__ __forceinline__ int lds_byte(int r, int c) { const int st = (r >> 4) * 2 + (c >> 5), rr = r & 15, cc = c & 31, ob = rr * 64 + cc * 2; return st * 1024 + (ob ^ (((ob >> 9) & 1) << 5)); }
__host__ __device__ __forceinline__ void stage_rc(int b, int& R, int& C) { const int st = b / 1024, sb = b % 1024, swz = sb ^ (((sb >> 9) & 1) << 5); R = (st >> 1) * 16 + swz / 64; C = (st & 1) * 32 + (swz % 64) / 2; }
__host__ __device__ __forceinline__ int perm32(int rho) { const int n = rho >> 4, i = rho & 15; return 8 * (i >> 2) + 4 * n + (i & 3); }

struct Unit { int pm, pn, ty; const char* a; const char* b; const int* gi; };
__device__ __forceinline__ void tile_of(int wgid, int nM, int nN, int& pm, int& pn) {
    const int nwg = nM * nN; { const int q = nwg / NXCD, r = nwg % NXCD, xcd = wgid % NXCD, off = wgid / NXCD; wgid = (xcd < r ? xcd * (q + 1) : r * (q + 1) + (xcd - r) * q) + off; }
    const int nig = WGM * nN, gid = wgid / nig, fm = gid * WGM, gsz = (nM - fm) < WGM ? (nM - fm) : WGM;
    pm = fm + ((wgid % nig) % gsz); pn = (wgid % nig) / gsz;
}

template <class Epi, class Sched, bool GATHER, bool FP8 = false>
__device__ __forceinline__ void gemm_phase(LAS unsigned char* lds, const int K, const Sched& S, const Epi& E) {
    const int tid = threadIdx.x, wid = __builtin_amdgcn_readfirstlane(tid >> 6), lane = tid & 63, wr = wid >> 2, wc = wid & 3, fr = lane & 15, fq = lane >> 4;
    const int KB = FP8 ? K : 2 * K;
    const int nt = KB / (BK * 2);
    unsigned voffB[2], vAc[2][2]; int stR[2], stC[2]; int gnx[2][2];
    const size_t kstep = (size_t)(BK * 2);
    const size_t hstep = (size_t)HALF * KB;
#pragma unroll
    for (int i = 0; i < 2; ++i) { int R, C; stage_rc(tid * 16 + i * 8192, R, C); stR[i] = R; stC[i] = C; const int Rb = Epi::PERM ? ((R & ~31) + perm32(R & 31)) : R;
        voffB[i] = (unsigned)(Rb * KB + 2 * C); }
    const unsigned ldsw = (unsigned)wid * 1024u;
    const int aoff = lds_byte(wr * 64 + fr, fq * (FP8 ? 16 : 8)), boff = lds_byte(wc * 32 + fr, fq * (FP8 ? 16 : 8));
#define MG_SA(b, h) (((b) * 2 + (h)) * HTB)
#define MG_SB(b, h) ((4 + (b) * 2 + (h)) * HTB)
#define MG_STAGE(bufoff, gbase, voff) do { const char* _gb = (const char*)(gbase); asm volatile("" : "+s"(_gb));     \
        _Pragma("unroll") for (int _i = 0; _i < 2; ++_i) { unsigned _vo = (voff)[_i]; asm volatile("" : "+v"(_vo)); \
        __builtin_amdgcn_global_load_lds((const unsigned*)(_gb + _vo), (LAS unsigned*)(lds + (bufoff) + ldsw + _i * 8192), 16, 0, 0); } } while (0)
#define MG_LD16(off_) (*(const LAS v4i_t*)(lds + (off_)))
#define MG_LDA(dst, b, h) do { _Pragma("unroll") for (int m = 0; m < 4; ++m) { const int _o = MG_SA(b, h) + aoff + m * 2048; \
        if constexpr (FP8) dst[m].v = __builtin_shufflevector(MG_LD16(_o), MG_LD16(_o + 16), 0, 1, 2, 3, 4, 5, 6, 7); \
        else { dst[m].k[0] = __builtin_bit_cast(bf16x8, MG_LD16(_o)); dst[m].k[1] = __builtin_bit_cast(bf16x8, MG_LD16(_o + 1024)); } } } while (0)
#define MG_LDB(dst, b, h) do { _Pragma("unroll") for (int n = 0; n < 2; ++n) { const int _o = MG_SB(b, h) + boff + n * 2048; \
        if constexpr (FP8) dst[n].v = __builtin_shufflevector(MG_LD16(_o), MG_LD16(_o + 16), 0, 1, 2, 3, 4, 5, 6, 7); \
        else { dst[n].k[0] = __builtin_bit_cast(bf16x8, MG_LD16(_o)); dst[n].k[1] = __builtin_bit_cast(bf16x8, MG_LD16(_o + 1024)); } } } while (0)
#define MG_MMA(ai, bj, At, Bt) do { __builtin_amdgcn_s_setprio(1); _Pragma("unroll") for (int m = 0; m < 4; ++m) _Pragma("unroll") for (int n = 0; n < 2; ++n) { \
        if constexpr (FP8) acc[ai][bj][m][n] = __builtin_amdgcn_mfma_scale_f32_16x16x128_f8f6f4(Bt[n].v, At[m].v, acc[ai][bj][m][n], 0, 0, 0, 0, 0, 0); \
        else { _Pragma("unroll") for (int k = 0; k < 2; ++k) acc[ai][bj][m][n] = __builtin_amdgcn_mfma_f32_16x16x32_bf16(Bt[n].k[k], At[m].k[k], acc[ai][bj][m][n], 0, 0, 0); } } \
        __builtin_amdgcn_s_setprio(0); } while (0)
#define MG_WAIT_V(n) asm volatile("s_waitcnt vmcnt(" #n ")" ::: "memory")
#define MG_WAIT_L(n) asm volatile("s_waitcnt lgkmcnt(" #n ")" ::: "memory")
#define MG_BAR __builtin_amdgcn_s_barrier()
#define MG_SCHED __builtin_amdgcn_sched_barrier(0)
#define MG_AOFF(dst, u) do { _Pragma("unroll") for (int _h = 0; _h < 2; ++_h) _Pragma("unroll") for (int _i = 0; _i < 2; ++_i) { \
        if constexpr (GATHER) dst[_h][_i] = (unsigned)(u).gi[_h * HALF + stR[_i]] * (unsigned)KB + 2u * (unsigned)stC[_i]; \
        else dst[_h][_i] = (unsigned)((_h * HALF + stR[_i]) * KB + 2 * stC[_i]); } } while (0)
    Unit cur, nxt; int ui = 0;
    if (!S.next(0, cur)) return;
    f32x4 acc[2][2][4][2];
#pragma unroll
    for (int a = 0; a < 2; ++a)
#pragma unroll
        for (int b = 0; b < 2; ++b)
#pragma unroll
            for (int m = 0; m < 4; ++m)
#pragma unroll
                for (int n = 0; n < 2; ++n) acc[a][b][m][n] = (f32x4){0.f, 0.f, 0.f, 0.f};
    Frag<FP8> At[4], B0[2], B1[2];
    const char* cA = cur.a; const char* cB = cur.b;
    MG_AOFF(vAc, cur);
    MG_STAGE(MG_SB(0, 0), cB, voffB); MG_STAGE(MG_SB(0, 1), cB + hstep, voffB); MG_STAGE(MG_SA(0, 0), cA, vAc[0]); MG_STAGE(MG_SA(0, 1), cA, vAc[1]);
    if (wr == 1) MG_BAR;
    MG_WAIT_V(2); MG_BAR;
    MG_STAGE(MG_SB(1, 0), cB + kstep, voffB); MG_STAGE(MG_SA(1, 0), cA + kstep, vAc[0]); MG_STAGE(MG_SB(1, 1), cB + hstep + kstep, voffB);
    MG_WAIT_V(6); MG_BAR;
    for (;;) {
        const bool has_next = S.next(ui + 1, nxt);
        const char* nA = has_next ? nxt.a : cA; const char* nB = has_next ? nxt.b : cB;
        if constexpr (GATHER) { if (has_next) {
#pragma unroll
            for (int h = 0; h < 2; ++h)
#pragma unroll
                for (int i = 0; i < 2; ++i) gnx[h][i] = nxt.gi[h * HALF + stR[i]]; } }
#pragma unroll 1
        for (int t = 0; t < nt; t += 2) {
            const bool last = (t == nt - 2);
            const char* a1 = cA + (size_t)(t + 1) * kstep;
            const char* a2 = last ? nA : cA + (size_t)(t + 2) * kstep; const char* b2 = last ? nB : cB + (size_t)(t + 2) * kstep;
            const char* a3 = a2 + kstep; const char* b3 = b2 + kstep;
            MG_LDB(B0, 0, 0); MG_LDB(B1, 0, 1); MG_SCHED; MG_LDA(At, 0, 0); MG_STAGE(MG_SA(1, 1), a1, vAc[1]);
            if constexpr (GATHER) { if (last && has_next) {
#pragma unroll
                for (int h = 0; h < 2; ++h)
#pragma unroll
                    for (int i = 0; i < 2; ++i) vAc[h][i] = (unsigned)gnx[h][i] * (unsigned)KB + 2u * (unsigned)stC[i]; } }
            MG_WAIT_V(8); MG_WAIT_L(0); MG_BAR; MG_MMA(0, 0, At, B0); MG_MMA(0, 1, At, B1); MG_BAR; MG_SCHED;
            MG_LDA(At, 0, 1); MG_STAGE(MG_SB(0, 0), b2, voffB); MG_STAGE(MG_SB(0, 1), b2 + hstep, voffB); MG_STAGE(MG_SA(0, 0), a2, vAc[0]);
            MG_WAIT_V(8); MG_WAIT_L(0); MG_BAR; MG_MMA(1, 0, At, B0); MG_MMA(1, 1, At, B1); MG_BAR; MG_SCHED;
            MG_LDB(B0, 1, 0); MG_LDB(B1, 1, 1); MG_SCHED; MG_LDA(At, 1, 0); MG_STAGE(MG_SA(0, 1), a2, vAc[1]);
            MG_WAIT_V(8); MG_WAIT_L(0); MG_BAR; MG_MMA(0, 0, At, B0); MG_MMA(0, 1, At, B1); MG_BAR; MG_SCHED;
            MG_LDA(At, 1, 1); MG_STAGE(MG_SB(1, 0), b3, voffB); MG_STAGE(MG_SB(1, 1), b3 + hstep, voffB); MG_STAGE(MG_SA(1, 0), a3, vAc[0]);
            MG_WAIT_V(8); MG_WAIT_L(0); MG_BAR; MG_MMA(1, 0, At, B0); MG_MMA(1, 1, At, B1); MG_BAR; MG_SCHED;
        }
        if (wr == 0) MG_BAR;
        { int fr_ = fr, fq_ = fq; asm volatile("" : "+v"(fr_), "+v"(fq_));
          E(acc, cur, wr, wc, fr_, fq_); }
        if (!has_next) break;
#pragma unroll
        for (int a = 0; a < 2; ++a)
#pragma unroll
            for (int b = 0; b < 2; ++b)
#pragma unroll
                for (int m = 0; m < 4; ++m)
#pragma unroll
                    for (int n = 0; n < 2; ++n) acc[a][b][m][n] = (f32x4){0.f, 0.f, 0.f, 0.f};
        cur = nxt; cA = nA; cB = nB; ++ui;
        if (wr == 1) MG_BAR;
    }
    MG_WAIT_V(0);
    MG_BAR;
#undef MG_SA
#undef MG_SB
#undef MG_STAGE
#undef MG_LDA
#undef MG_LDB
#undef MG_MMA
#undef MG_LD16
#undef MG_WAIT_V
#undef MG_WAIT_L
#undef MG_BAR
#undef MG_SCHED
#undef MG_AOFF
}
}
constexpr int D = 1024, NB = 32, SEQ = 2048, CL = 256, NTOK = NB * SEQ, NCTX = NB * CL, INC = 4624;
constexpr int NE = 16, CAP = 256;
constexpr int OFF_QK = 512, OFF_V = 1536, OFF_O = 2048, OFF_G = 2560, OFF_BR = 2576;
constexpr float EPS = 1e-6f;
constexpr size_t MiB = 1u << 20;
constexpr size_t WS_CTL = 0, CTL_BYTES = 1 * MiB;
constexpr size_t WS_MOD = 1 * MiB;
constexpr size_t WS_GATES = 2 * MiB;
constexpr size_t WS_AFF = 11 * MiB;
constexpr size_t WS_IDX = 15 * MiB;
constexpr size_t WS_VAL = 15 * MiB + 512 * 1024;
constexpr size_t WS_SLOT = 16 * MiB;
constexpr size_t WS_WTF = 18 * MiB;
constexpr size_t WS_WFT = 20 * MiB;
constexpr size_t WS_WMT = 21 * MiB;
constexpr size_t WS_WOT = 22 * MiB;
constexpr size_t WS_WTM = 24 * MiB;
constexpr size_t WS_TT = 32 * MiB;
constexpr size_t WS_PC = 48 * MiB;
constexpr size_t WS_H = 64 * MiB;
constexpr size_t WS_QK = 64 * MiB;
constexpr size_t WS_KC = 192 * MiB;
constexpr size_t WS_MRG = 64 * MiB;
constexpr size_t WS_WGU = 64 * MiB;
constexpr size_t WS_WD = 128 * MiB;
constexpr size_t WS_AB = 208 * MiB;
constexpr size_t WS_HF = 208 * MiB;
constexpr size_t WS_HB = 272 * MiB;
constexpr size_t WS_HX2 = 208 * MiB;
constexpr size_t WS_FU = 336 * MiB;
constexpr size_t WS_PQK = 400 * MiB;
constexpr size_t WS_HM = 400 * MiB;
constexpr size_t WS_PV = 528 * MiB;
constexpr size_t WS_PO = 592 * MiB;
constexpr size_t WS_PBR = 656 * MiB;
constexpr size_t WS_HID = 400 * MiB;
constexpr size_t WS_Y = 656 * MiB;
constexpr size_t WS_IDENT = 912 * MiB;
constexpr size_t WS_END = 913 * MiB;
constexpr int LDS_PHASE_BYTES = 147456, LDS_BYTES = LDS_PHASE_BYTES + 256;

__device__ __forceinline__ unsigned pk4_fp8(float a, float b, float c, float d) { int w = __builtin_amdgcn_cvt_pk_fp8_f32(a, b, 0, false); w = __builtin_amdgcn_cvt_pk_fp8_f32(c, d, w, true); return (unsigned)w; }
constexpr float W8_SCALE = 32.f, W8_INV = 1.f / 32.f;
struct Ctx {
    const float *x, *c, *ctx, *c_ctx, *w_ada, *b_ada, *g_norm1, *w_in, *b_gates, *w_conv, *w_fourier, *w_mlstm, *w_out, *g_norm2, *w_router, *w_gate_e, *w_up_e, *w_down_e, *g_final;
    float* out; unsigned char* ws;
};

__device__ __forceinline__ void store_tile_bf16(const f32x4 (&acc)[2][2][4][2], bf16* base, int ldc, bool sig, int wr, int wc, int fr, int fq) {
    bf16* p0 = base + (size_t)(wr * 64 + fr) * ldc + wc * 32 + 8 * fq;
#pragma unroll
    for (int ai = 0; ai < 2; ++ai)
#pragma unroll
        for (int m = 0; m < 4; ++m) { bf16* rowp = p0 + (size_t)(ai * 128 + m * 16) * ldc;
#pragma unroll
            for (int bj = 0; bj < 2; ++bj) { f32x4 v0 = acc[ai][bj][m][0], v1 = acc[ai][bj][m][1];
                if (sig) {
#pragma unroll
                    for (int j = 0; j < 4; ++j) { v0[j] = sigmoid_f(v0[j]); v1[j] = sigmoid_f(v1[j]); } }
                u32x4 w; w.x = pk2(v0[0], v0[1]); w.y = pk2(v0[2], v0[3]); w.z = pk2(v1[0], v1[1]); w.w = pk2(v1[2], v1[3]);
                *(u32x4*)(rowp + bj * 128) = w; } }
}
struct EpiP1 {
    static constexpr bool PERM = true; unsigned char* ws;
    __device__ __forceinline__ void operator()(const f32x4 (&acc)[2][2][4][2], const mg::Unit& u, int wr, int wc, int fr, int fq) const {
        bf16* base; int ldc; bool sig = false;
        if (u.ty == 0) { const size_t r0 = (size_t)u.pm * 256;
            if (u.pn < 4) { base = (bf16*)(ws + WS_PQK) + r0 * 1024 + u.pn * 256; ldc = 1024; }
            else if (u.pn < 6) { base = (bf16*)(ws + WS_PV) + r0 * 512 + (u.pn - 4) * 256; ldc = 512; }
            else if (u.pn < 8) { base = (bf16*)(ws + WS_PO) + r0 * 512 + (u.pn - 6) * 256; ldc = 512; sig = true; }
            else { base = (bf16*)(ws + WS_PBR) + r0 * 2048 + (u.pn - 8) * 256; ldc = 2048; sig = true; }
        } else if (u.ty == 1) { base = (bf16*)(ws + WS_AB) + ((size_t)(u.pn >> 3) * 1024 + (size_t)u.pm * 256) * 2048 + (u.pn & 7) * 256; ldc = 2048; }
        else { base = (bf16*)(ws + WS_PC) + (size_t)u.pm * 256 * 1024 + u.pn * 256; ldc = 1024; }
        store_tile_bf16(acc, base, ldc, sig, wr, wc, fr, fq);
    }
};
struct EpiF2 {
    static constexpr bool PERM = true; unsigned char* ws;
    __device__ __forceinline__ void operator()(const f32x4 (&acc)[2][2][4][2], const mg::Unit& u, int wr, int wc, int fr, int fq) const {
        bf16* base = (bf16*)(ws + WS_FU) + ((size_t)(u.pn >> 1) * 2048 + (size_t)u.pm * 256) * 512 + (u.pn & 1) * 256;
        store_tile_bf16(acc, base, 512, false, wr, wc, fr, fq);
    }
};
struct EpiMerge {
    static constexpr bool PERM = true; unsigned char* ws;
    __device__ __forceinline__ void operator()(const f32x4 (&acc)[2][2][4][2], const mg::Unit& u, int wr, int wc, int fr, int fq) const {
        const size_t row0 = (size_t)u.pm * 256 + wr * 64 + fr; const int col0 = u.pn * 256 + wc * 32 + 8 * fq;
#pragma unroll
        for (int ai = 0; ai < 2; ++ai)
#pragma unroll
            for (int m = 0; m < 4; ++m) { const size_t row = row0 + ai * 128 + m * 16;
                bf16* mp = (bf16*)(ws + WS_MRG) + row * 1024 + col0; const bf16* gp = (const bf16*)(ws + WS_PBR) + row * 2048 + u.ty * 1024 + col0;
#pragma unroll
                for (int bj = 0; bj < 2; ++bj) { const u32x4 g = *(const u32x4*)(gp + bj * 128); const f32x4 v0 = acc[ai][bj][m][0], v1 = acc[ai][bj][m][1];
                    float r[8] = {bflo(g.x) * v0[0], bfhi(g.x) * v0[1], bflo(g.y) * v0[2], bfhi(g.y) * v0[3], bflo(g.z) * v1[0], bfhi(g.z) * v1[1], bflo(g.w) * v1[2], bfhi(g.w) * v1[3]};
                    if (u.ty == 1) { const u32x4 t = *(const u32x4*)(mp + bj * 128);
                        r[0] += bflo(t.x); r[1] += bfhi(t.x); r[2] += bflo(t.y); r[3] += bfhi(t.y); r[4] += bflo(t.z); r[5] += bfhi(t.z); r[6] += bflo(t.w); r[7] += bfhi(t.w); }
                    u32x4 w; w.x = pk2(r[0], r[1]); w.y = pk2(r[2], r[3]); w.z = pk2(r[4], r[5]); w.w = pk2(r[6], r[7]);
                    *(u32x4*)(mp + bj * 128) = w; } }
    }
};
struct EpiOut {
    static constexpr bool PERM = false; const float* x; const float* mod; float* out;
    __device__ __forceinline__ void operator()(const f32x4 (&acc)[2][2][4][2], const mg::Unit& u, int wr, int wc, int fr, int fq) const {
        const size_t row0 = (size_t)u.pm * 256 + wr * 64 + fr; const int col0 = u.pn * 256 + wc * 32 + 4 * fq; const int b = u.pm >> 3;
        f32x4 ga[2][2];
#pragma unroll
        for (int bj = 0; bj < 2; ++bj)
#pragma unroll
            for (int n = 0; n < 2; ++n) ga[bj][n] = *(const f32x4*)(mod + (size_t)b * 6144 + 2048 + col0 + bj * 128 + n * 16);
#pragma unroll
        for (int ai = 0; ai < 2; ++ai)
#pragma unroll
            for (int m = 0; m < 4; ++m) { const size_t off = (row0 + ai * 128 + m * 16) * 1024 + col0;
#pragma unroll
                for (int bj = 0; bj < 2; ++bj)
#pragma unroll
                    for (int n = 0; n < 2; ++n) { const f32x4 xv = *(const f32x4*)(x + off + bj * 128 + n * 16); *(f32x4*)(out + off + bj * 128 + n * 16) = xv + ga[bj][n] * acc[ai][bj][m][n]; } }
    }
};
struct EpiSwiglu {
    static constexpr bool PERM = true; unsigned char* ws;
    __device__ __forceinline__ void operator()(const f32x4 (&acc)[2][2][4][2], const mg::Unit& u, int wr, int wc, int fr, int fq) const {
        unsigned char* p0 = ws + WS_HID + ((size_t)u.pm * 256 + wr * 64 + fr) * 1024 + u.pn * 128 + wc * 32 + 8 * fq;
#pragma unroll
        for (int ai = 0; ai < 2; ++ai)
#pragma unroll
            for (int m = 0; m < 4; ++m) { float r[8];
#pragma unroll
                for (int n = 0; n < 2; ++n)
#pragma unroll
                    for (int j = 0; j < 4; ++j) r[n * 4 + j] = silu_f(acc[ai][0][m][n][j] * W8_INV) * (acc[ai][1][m][n][j] * W8_INV);
                u32x2 w; w.x = pk4_fp8(r[0], r[1], r[2], r[3]); w.y = pk4_fp8(r[4], r[5], r[6], r[7]);
                *(u32x2*)(p0 + (size_t)(ai * 128 + m * 16) * 1024) = w; }
    }
};
struct EpiDown {
    static constexpr bool PERM = true; unsigned char* ws;
    __device__ __forceinline__ void operator()(const f32x4 (&acc)[2][2][4][2], const mg::Unit& u, int wr, int wc, int fr, int fq) const {
        const size_t row0 = (size_t)u.pm * 256 + wr * 64 + fr; const float* val = (const float*)(ws + WS_VAL);
        bf16* p0 = (bf16*)(ws + WS_Y) + row0 * 1024 + u.pn * 256 + wc * 32 + 8 * fq;
#pragma unroll
        for (int ai = 0; ai < 2; ++ai)
#pragma unroll
            for (int m = 0; m < 4; ++m) { const float vv = val[row0 + ai * 128 + m * 16] * W8_INV; bf16* rowp = p0 + (size_t)(ai * 128 + m * 16) * 1024;
#pragma unroll
                for (int bj = 0; bj < 2; ++bj) { const f32x4 v0 = acc[ai][bj][m][0] * vv, v1 = acc[ai][bj][m][1] * vv;
                    u32x4 w; w.x = pk2(v0[0], v0[1]); w.y = pk2(v0[2], v0[3]); w.z = pk2(v1[0], v1[1]); w.w = pk2(v1[2], v1[3]);
                    *(u32x4*)(rowp + bj * 128) = w; } }
    }
};

struct SchedP1 {
    unsigned char* ws; int G, c, nrep;
    __device__ __forceinline__ bool next(int i, mg::Unit& u) const {
        int L = i * G + c; if (L >= 5248 * nrep) return false; L %= 5248; const char* H = (const char*)(ws + WS_H); u.gi = nullptr;
        if (L < 4096) { mg::tile_of(L, 256, 16, u.pm, u.pn); u.ty = 0; u.a = H + (size_t)u.pm * 256 * 2048; u.b = (const char*)(ws + WS_WTM) + (size_t)u.pn * 256 * 2048; return true; }
        L -= 4096;
        if (L < 1024) { mg::tile_of(L, 4, 256, u.pm, u.pn); u.ty = 1; u.a = (const char*)(ws + WS_WTF) + (size_t)u.pm * 256 * 2048; u.b = H + (size_t)u.pn * 256 * 2048; return true; }
        L -= 1024;
        if (L < 128) { mg::tile_of(L, 32, 4, u.pm, u.pn); u.ty = 2; u.a = H + ((size_t)NTOK + (size_t)u.pm * 256) * 2048; u.b = (const char*)(ws + WS_WTM) + ((size_t)512 + (size_t)u.pn * 256) * 2048; return true; }
        return false;
    }
};
struct SchedF2 {
    unsigned char* ws; int G, c, nrep;
    __device__ __forceinline__ bool next(int i, mg::Unit& u) const {
        int L = i * G + c; if (L >= 512 * nrep) return false; L %= 512; mg::tile_of(L, 8, 64, u.pm, u.pn); u.ty = 0; u.gi = nullptr;
        u.a = (const char*)(ws + WS_TT) + (size_t)u.pm * 256 * 8192; u.b = (const char*)(ws + WS_AB) + (size_t)u.pn * 256 * 8192; return true;
    }
};
struct SchedMerge {
    unsigned char* ws; int G, c, nrep;
    __device__ __forceinline__ bool next(int i, mg::Unit& u) const {
        int L = (i >> 1) * G + c; if (L >= 1024 * nrep) return false; L %= 1024; mg::tile_of(L, 256, 4, u.pm, u.pn); u.ty = i & 1; u.gi = nullptr;
        u.a = (const char*)(ws + (u.ty ? WS_HM : WS_FU)) + (size_t)u.pm * 256 * 1024; u.b = (const char*)(ws + (u.ty ? WS_WMT : WS_WFT)) + (size_t)u.pn * 256 * 1024; return true;
    }
};
struct SchedOut {
    unsigned char* ws; int G, c, nrep;
    __device__ __forceinline__ bool next(int i, mg::Unit& u) const {
        int L = i * G + c; if (L >= 1024 * nrep) return false; L %= 1024; mg::tile_of(L, 256, 4, u.pm, u.pn); u.ty = 0; u.gi = nullptr;
        u.a = (const char*)(ws + WS_MRG) + (size_t)u.pm * 256 * 2048; u.b = (const char*)(ws + WS_WOT) + (size_t)u.pn * 256 * 2048; return true;
    }
};
struct SchedUp {
    unsigned char* ws; int G, c, nrep;
    __device__ __forceinline__ bool next(int i, mg::Unit& u) const {
        int L = i * G + c; if (L >= 4096 * nrep) return false; L %= 4096; mg::tile_of(L, 512, 8, u.pm, u.pn); u.ty = 0;
        u.a = (const char*)(ws + WS_HX2); u.gi = (const int*)(ws + WS_IDX) + (size_t)u.pm * 256; u.b = (const char*)(ws + WS_WGU) + ((size_t)(u.pm >> 5) * 8 + u.pn) * 256 * 1024; return true;
    }
};
struct SchedDown {
    unsigned char* ws; int G, c, nrep;
    __device__ __forceinline__ bool next(int i, mg::Unit& u) const {
        int L = i * G + c; if (L >= 2048 * nrep) return false; L %= 2048; mg::tile_of(L, 512, 4, u.pm, u.pn); u.ty = 0;
        u.a = (const char*)(ws + WS_HID); u.gi = (const int*)(ws + WS_IDENT) + (size_t)u.pm * 256; u.b = (const char*)(ws + WS_WD) + ((size_t)(u.pm >> 5) * 4 + u.pn) * 256 * 1024; return true;
    }
};

__device__ __forceinline__ void transpose_item(const float* W, int ldw, int n0, int k0, bf16* dst, int drow0, int Kd, LAS float* scr, int lane) {
#pragma unroll 8
    for (int i = 0; i < 32; ++i) { const int kk = 2 * i + (lane >> 5); scr[kk * 33 + (lane & 31)] = W[(size_t)(k0 + kk) * ldw + n0 + (lane & 31)]; }
    asm volatile("s_waitcnt lgkmcnt(0)" ::: "memory");
    const int c = lane & 7;
#pragma unroll
    for (int j = 0; j < 4; ++j) { const int n = (lane >> 3) + 8 * j; const LAS float* s = scr + (8 * c) * 33 + n;
        u32x4 o; o.x = pk2(s[0 * 33], s[1 * 33]); o.y = pk2(s[2 * 33], s[3 * 33]); o.z = pk2(s[4 * 33], s[5 * 33]); o.w = pk2(s[6 * 33], s[7 * 33]);
        *(u32x4*)(dst + (size_t)(drow0 + n) * Kd + k0 + 8 * c) = o; }
    asm volatile("s_waitcnt lgkmcnt(0)" ::: "memory");
}

__device__ __forceinline__ void transpose_item8(const float* W, int ldw, int n0, int k0, unsigned char* dst, int drow0, int Kd, LAS float* scr, int lane) {
#pragma unroll 8
    for (int i = 0; i < 32; ++i) { const int kk = 2 * i + (lane >> 5); scr[kk * 33 + (lane & 31)] = W[(size_t)(k0 + kk) * ldw + n0 + (lane & 31)] * W8_SCALE; }
    asm volatile("s_waitcnt lgkmcnt(0)" ::: "memory");
    const int c = lane & 7;
#pragma unroll
    for (int j = 0; j < 4; ++j) { const int n = (lane >> 3) + 8 * j; const LAS float* s = scr + (8 * c) * 33 + n;
        u32x2 o; o.x = pk4_fp8(s[0 * 33], s[1 * 33], s[2 * 33], s[3 * 33]); o.y = pk4_fp8(s[4 * 33], s[5 * 33], s[6 * 33], s[7 * 33]);
        *(u32x2*)(dst + (size_t)(drow0 + n) * Kd + k0 + 8 * c) = o; }
    asm volatile("s_waitcnt lgkmcnt(0)" ::: "memory");
}

__device__ __forceinline__ void p0_prep(const Ctx& C, LAS unsigned char* lds, int tid, int lane, int wave, int G) {
    const int blk = blockIdx.x;
    for (int item = blk; item < 192; item += G) {
        LAS float* sT = (LAS float*)lds;
        for (int i = tid; i < 33 * 1024; i += 512) { const int r = i >> 10, k = i & 1023; const float v = r < 32 ? C.c[r * 1024 + k] : C.c_ctx[k]; sT[k * 36 + r] = silu_f(v); }
        for (int i = tid; i < 3 * 1024; i += 512) { const int r = 33 + (i >> 10), k = i & 1023; sT[k * 36 + r] = 0.f; }
        __syncthreads();
        const int col0 = item * 32, kg = tid >> 5, j = tid & 31;
        float acc[36];
#pragma unroll
        for (int r = 0; r < 36; ++r) acc[r] = 0.f;
#pragma unroll 4
        for (int kk = 0; kk < 64; ++kk) { const int k = kg * 64 + kk; const float w = C.w_ada[(size_t)k * 6144 + col0 + j];
#pragma unroll
            for (int q = 0; q < 9; ++q) { const f32x4 s4 = *(const LAS f32x4*)(sT + k * 36 + 4 * q); acc[4 * q] += s4[0] * w; acc[4 * q + 1] += s4[1] * w; acc[4 * q + 2] += s4[2] * w; acc[4 * q + 3] += s4[3] * w; } }
        __syncthreads();
        LAS float* red = (LAS float*)lds;
#pragma unroll
        for (int r = 0; r < 33; ++r) red[(kg * 33 + r) * 32 + j] = acc[r];
        __syncthreads();
        float* mod = (float*)(C.ws + WS_MOD);
        for (int o = tid; o < 33 * 32; o += 512) { const int r = o >> 5, jj = o & 31; float s = 0.f;
#pragma unroll
            for (int g = 0; g < 16; ++g) s += red[(g * 33 + r) * 32 + jj];
            mod[(size_t)r * 6144 + col0 + jj] = s + C.b_ada[col0 + jj]; }
        __syncthreads();
    }
    for (int item = blk; item < 256; item += G) {
        LAS float* wl = (LAS float*)lds; LAS float* cs = wl + 16 * 128; LAS float* sn = cs + 128;
        const int g = item >> 6, d0 = (item & 63) * 16;
        for (int i = tid; i < 16 * 128; i += 512) { const int dd = i >> 7, cc = i & 127; wl[i] = C.w_in[(size_t)(d0 + dd) * INC + g * 128 + cc]; }
        if (tid < 128) { cs[tid] = cospif((float)tid * (1.f / 64.f)); sn[tid] = sinpif((float)tid * (1.f / 64.f)); }
        __syncthreads();
        const int rj = tid & 255, j = rj >> 1, ab = rj & 1, half = tid >> 8;
        float acc[8];
#pragma unroll
        for (int i = 0; i < 8; ++i) acc[i] = 0.f;
        const LAS float* tw = ab ? sn : cs;
        for (int cc = 0; cc < 128; ++cc) { const float t = tw[(j * cc) & 127];
#pragma unroll
            for (int i = 0; i < 8; ++i) acc[i] += wl[(half * 8 + i) * 128 + cc] * t; }
        u32x4 o; o.x = pk2(acc[0], acc[1]); o.y = pk2(acc[2], acc[3]); o.z = pk2(acc[4], acc[5]); o.w = pk2(acc[6], acc[7]);
        *(u32x4*)((bf16*)(C.ws + WS_WTF) + (size_t)(g * 256 + rj) * 1024 + d0 + half * 8) = o;
        __syncthreads();
    }
    {
        LAS float* tc = (LAS float*)lds; LAS float* ts = tc + 2048;
        for (int i = tid; i < 2048; i += 512) { const float a = (float)i * (1.f / 1024.f); tc[i] = cospif(a) * (1.f / 512.f); ts[i] = -sinpif(a) * (1.f / 512.f); }
        __syncthreads();
        for (int item = blk; item < 256; item += G)
            for (int rr = 0; rr < 8; ++rr) { const int k = item * 8 + rr; const int lp0 = tid * 8; const LAS float* tb = lp0 < 2048 ? tc : ts; const int l0 = lp0 & 2047; float v[8];
#pragma unroll
                for (int e = 0; e < 8; ++e) v[e] = tb[(k * (l0 + e)) & 2047];
                u32x4 o; o.x = pk2(v[0], v[1]); o.y = pk2(v[2], v[3]); o.z = pk2(v[4], v[5]); o.w = pk2(v[6], v[7]);
                *(u32x4*)((bf16*)(C.ws + WS_TT) + (size_t)k * 4096 + lp0) = o; }
        __syncthreads();
    }
    {
        LAS float* scr = (LAS float*)lds + wave * (64 * 33);
        const int gw = blk * 8 + wave, NGW = G * 8;
        constexpr int I_IN = 16 * 128, I_F = 8 * 32, I_M = 8 * 32, I_O = 16 * 32;
        for (int it = gw; it < I_IN + I_F + I_M + I_O; it += NGW) {
            int r = it;
            if (r < I_IN) { const int kb = r >> 7, nb = r & 127; const int n0 = nb < 64 ? 512 + 32 * nb : 2576 + 32 * (nb - 64);
                transpose_item(C.w_in, INC, n0, kb * 64, (bf16*)(C.ws + WS_WTM), 32 * nb, 1024, scr, lane); continue; }
            r -= I_IN;
            if (r < I_F) { const int kb = r >> 5, nb = r & 31; transpose_item(C.w_fourier, 1024, 32 * nb, kb * 64, (bf16*)(C.ws + WS_WFT), 32 * nb, 512, scr, lane); continue; }
            r -= I_F;
            if (r < I_M) { const int kb = r >> 5, nb = r & 31; transpose_item(C.w_mlstm, 1024, 32 * nb, kb * 64, (bf16*)(C.ws + WS_WMT), 32 * nb, 512, scr, lane); continue; }
            r -= I_M;
            { const int kb = r >> 5, nb = r & 31; transpose_item(C.w_out, 1024, 32 * nb, kb * 64, (bf16*)(C.ws + WS_WOT), 32 * nb, 1024, scr, lane); }
        }
    }
}
__device__ __forceinline__ void convert_experts(const Ctx& C, LAS unsigned char* lds, int lane, int wave, int G, int rep) {
    LAS float* scr = (LAS float*)lds + wave * (64 * 33);
    const int gw = blockIdx.x * 8 + wave, NGW = G * 8;
    for (int it0 = gw; it0 < 48 * 512 * rep; it0 += NGW) { const int it = it0 % (48 * 512);
        const int mat = it >> 9, r = it & 511, kb = r >> 5, nb = r & 31, e = mat & 15, which = mat >> 4;
        if (which < 2) { const float* W = (which ? C.w_up_e : C.w_gate_e) + (size_t)e * 1024 * 1024; const int n0 = 32 * nb;
            transpose_item8(W, 1024, n0, kb * 64, C.ws + WS_WGU, e * 2048 + (n0 >> 7) * 256 + which * 128 + (n0 & 127), 1024, scr, lane); }
        else transpose_item8(C.w_down_e + (size_t)e * 1024 * 1024, 1024, 32 * nb, kb * 64, C.ws + WS_WD, e * 1024 + 32 * nb, 1024, scr, lane);
    }
}

__device__ __forceinline__ float butterfly64(float (&v)[64], int lane) {
#pragma unroll
    for (int i = 0; i < 32; ++i) { const bool up = lane & 32; const float send = up ? v[i] : v[i + 32], keep = up ? v[i + 32] : v[i]; v[i] = keep + __shfl_xor(send, 32); }
#pragma unroll
    for (int i = 0; i < 16; ++i) { const bool up = lane & 16; const float send = up ? v[i] : v[i + 16], keep = up ? v[i + 16] : v[i]; v[i] = keep + __shfl_xor(send, 16); }
#pragma unroll
    for (int i = 0; i < 8; ++i) { const bool up = lane & 8; const float send = up ? v[i] : v[i + 8], keep = up ? v[i + 8] : v[i]; v[i] = keep + __shfl_xor(send, 8); }
#pragma unroll
    for (int i = 0; i < 4; ++i) { const bool up = lane & 4; const float send = up ? v[i] : v[i + 4], keep = up ? v[i + 4] : v[i]; v[i] = keep + __shfl_xor(send, 4); }
#pragma unroll
    for (int i = 0; i < 2; ++i) { const bool up = lane & 2; const float send = up ? v[i] : v[i + 2], keep = up ? v[i + 2] : v[i]; v[i] = keep + __shfl_xor(send, 2); }
    { const bool up = lane & 1; const float send = up ? v[0] : v[1], keep = up ? v[1] : v[0]; v[0] = keep + __shfl_xor(send, 1); }
    return v[0];
}

template <bool OUT8> __device__ __forceinline__ float rows4_norm_proj(const float* xin, size_t row0, const f32x4 (&gsc)[4], const f32x4 (&sh)[4], bf16* hout, const LAS float* wl, int lane) {
    f32x4 v[4][4]; float ss[4];
#pragma unroll
    for (int r = 0; r < 4; ++r) { ss[r] = 0.f;
#pragma unroll
        for (int j = 0; j < 4; ++j) { v[r][j] = *(const f32x4*)(xin + (row0 + r) * 1024 + 4 * lane + 256 * j); ss[r] += v[r][j][0] * v[r][j][0] + v[r][j][1] * v[r][j][1] + v[r][j][2] * v[r][j][2] + v[r][j][3] * v[r][j][3]; } }
#pragma unroll
    for (int r = 0; r < 4; ++r) { const float rstd = rsqrtf(wave_sum(ss[r]) * (1.f / 1024.f) + EPS);
#pragma unroll
        for (int j = 0; j < 4; ++j) { v[r][j] = v[r][j] * rstd * gsc[j] + sh[j];
            if constexpr (OUT8) *(unsigned*)((unsigned char*)hout + (row0 + r) * 1024 + 4 * lane + 256 * j) = pk4_fp8(v[r][j][0], v[r][j][1], v[r][j][2], v[r][j][3]);
            else { u32x2 w; w.x = pk2(v[r][j][0], v[r][j][1]); w.y = pk2(v[r][j][2], v[r][j][3]); *(u32x2*)(hout + (row0 + r) * 1024 + 4 * lane + 256 * j) = w; } } }
    float acc[64];
#pragma unroll
    for (int i = 0; i < 64; ++i) acc[i] = 0.f;
#pragma unroll
    for (int j = 0; j < 4; ++j)
#pragma unroll
        for (int e = 0; e < 4; ++e) { const LAS float* wp = wl + ((j * 4 + e) * 4) * 256 + lane * 4;
#pragma unroll
            for (int q = 0; q < 4; ++q) { const f32x4 w4 = *(const LAS f32x4*)(wp + q * 256);
#pragma unroll
                for (int r = 0; r < 4; ++r) { const float hv = v[r][j][e]; acc[r * 16 + 4 * q] += hv * w4[0]; acc[r * 16 + 4 * q + 1] += hv * w4[1]; acc[r * 16 + 4 * q + 2] += hv * w4[2]; acc[r * 16 + 4 * q + 3] += hv * w4[3]; } }
            asm volatile("" ::: "memory"); }
    return butterfly64(acc, lane);
}

__device__ __forceinline__ void p1a_norm_gates(const Ctx& C, LAS unsigned char* lds, int tid, int lane, int wave, int G, int rep2) {
    LAS float* wl = (LAS float*)lds;
    for (int i = tid; i < 1024 * 16; i += 512) { const int col = i >> 4, gc = i & 15; wl[(((((col >> 8) * 4 + (col & 3)) * 4 + (gc >> 2)) * 64 + ((col >> 2) & 63)) * 4) + (gc & 3)] = C.w_in[(size_t)col * INC + OFF_G + gc]; }
    __syncthreads();
    const float* mod = (const float*)(C.ws + WS_MOD); bf16* H = (bf16*)(C.ws + WS_H); float* gates = (float*)(C.ws + WS_GATES);
    const int NGW = G * 8;
    for (int gw0 = blockIdx.x * 8 + wave; gw0 < 2048 * (1 + rep2); gw0 += NGW) { const int gw = gw0 & 2047;
        f32x4 gsc[4], sh[4];
        {   const int b = gw >> 6; const float* m = mod + (size_t)b * 6144;
#pragma unroll
            for (int j = 0; j < 4; ++j) { const int col = 4 * lane + 256 * j; const f32x4 g = *(const f32x4*)(C.g_norm1 + col), s = *(const f32x4*)(m + 1024 + col); gsc[j] = g * (s + 1.f); sh[j] = *(const f32x4*)(m + col); }
            for (int q = 0; q < 8; ++q) { const size_t row0 = (size_t)gw * 32 + q * 4; const float gv = rows4_norm_proj<false>(C.x, row0, gsc, sh, H, wl, lane); gates[(row0 + (lane >> 4)) * 16 + (lane & 15)] = gv; } }
        {   const float* m = mod + (size_t)32 * 6144;
#pragma unroll
            for (int j = 0; j < 4; ++j) { const int col = 4 * lane + 256 * j; const f32x4 g = *(const f32x4*)(C.g_norm1 + col), s = *(const f32x4*)(m + 1024 + col); gsc[j] = g * (s + 1.f); sh[j] = *(const f32x4*)(m + col); }
            const size_t row0 = (size_t)gw * 4; const float gv = rows4_norm_proj<false>(C.ctx, row0, gsc, sh, H + (size_t)NTOK * 1024, wl, lane); gates[((size_t)NTOK + row0 + (lane >> 4)) * 16 + (lane & 15)] = gv; }
    }
}

__device__ __forceinline__ f32x4 unpk4(u32x2 p) { return (f32x4){bflo(p.x), bfhi(p.x), bflo(p.y), bfhi(p.y)}; }
__device__ __forceinline__ void conv_item_x(const Ctx& C, int item, int lane) {
    const int qt = item & 3, cb = (item >> 2) & 3, r = (item >> 4) & 31, b = item >> 9;
    const int ch0 = cb * 256 + 4 * lane; const bf16* src = (const bf16*)(C.ws + WS_PQK) + (size_t)b * SEQ * 1024 + ch0; bf16* dst = (bf16*)(C.ws + WS_QK) + (size_t)b * SEQ * 1024 + ch0;
    const int c0 = qt * 16;
    u32x2 raw[3][18];
#pragma unroll
    for (int dy = 0; dy < 3; ++dy) { const int rr = r + dy - 1; const bool rok = rr >= 0 && rr < 32;
#pragma unroll
        for (int i = 0; i < 18; ++i) { const int cc = c0 - 1 + i; raw[dy][i] = (rok && cc >= 0 && cc < 64) ? *(const u32x2*)(src + (size_t)(rr * 64 + cc) * 1024) : (u32x2){0u, 0u}; } }
    f32x4 w[3][3];
#pragma unroll
    for (int dy = 0; dy < 3; ++dy)
#pragma unroll
        for (int dx = 0; dx < 3; ++dx) w[dy][dx] = *(const f32x4*)(C.w_conv + (dy * 3 + dx) * 1024 + ch0);
    const float ksc = cb >= 2 ? 0.08838834764831845f : 1.f;
#pragma unroll
    for (int i = 0; i < 16; ++i) { f32x4 a = {0.f, 0.f, 0.f, 0.f};
#pragma unroll
        for (int dy = 0; dy < 3; ++dy)
#pragma unroll
            for (int dx = 0; dx < 3; ++dx) a += w[dy][dx] * unpk4(raw[dy][i + dx]);
        u32x2 o; o.x = pk2(silu_f(a[0]) * ksc, silu_f(a[1]) * ksc); o.y = pk2(silu_f(a[2]) * ksc, silu_f(a[3]) * ksc);
        *(u32x2*)(dst + (size_t)(r * 64 + c0 + i) * 1024) = o; }
}
__device__ __forceinline__ void conv_item_ctx(const Ctx& C, int item, int lane) {
    const int sg = item & 15, cb = (item >> 4) & 1, b = item >> 5;
    const int kc0 = cb * 256 + 4 * lane; const bf16* src = (const bf16*)(C.ws + WS_PC) + (size_t)b * CL * 1024 + kc0; bf16* dst = (bf16*)(C.ws + WS_KC) + (size_t)b * CL * 512 + kc0;
    const int c0 = sg * 16;
    u32x2 raw[18];
#pragma unroll
    for (int i = 0; i < 18; ++i) { const int cc = c0 - 1 + i; raw[i] = (cc >= 0 && cc < CL) ? *(const u32x2*)(src + (size_t)cc * 1024) : (u32x2){0u, 0u}; }
    f32x4 w[3];
#pragma unroll
    for (int dx = 0; dx < 3; ++dx) w[dx] = *(const f32x4*)(C.w_conv + (3 + dx) * 1024 + 512 + kc0);
    const float ksc = 0.08838834764831845f;
#pragma unroll
    for (int i = 0; i < 16; ++i) { const f32x4 a = w[0] * unpk4(raw[i]) + w[1] * unpk4(raw[i + 1]) + w[2] * unpk4(raw[i + 2]);
        u32x2 o; o.x = pk2(silu_f(a[0]) * ksc, silu_f(a[1]) * ksc); o.y = pk2(silu_f(a[2]) * ksc, silu_f(a[3]) * ksc);
        *(u32x2*)(dst + (size_t)(c0 + i) * 512) = o; }
}
__device__ __forceinline__ void p2_conv(const Ctx& C, int lane, int wave, int G, int rep2) {
    const int NGW = G * 8;
    for (int it0 = blockIdx.x * 8 + wave; it0 < (NB * 512 + NB * 32) * (1 + rep2); it0 += NGW) { const int it = it0 % (NB * 512 + NB * 32); if (it < NB * 512) conv_item_x(C, it, lane); else conv_item_ctx(C, it - NB * 512, lane); }
}

__device__ __forceinline__ void p3b_combine(const Ctx& C, int tid, int G, int rep2) {
    const u32x4* po = (const u32x4*)(C.ws + WS_PO); const u32x4* hf = (const u32x4*)(C.ws + WS_HF); const u32x4* hb = (const u32x4*)(C.ws + WS_HB); u32x4* hm = (u32x4*)(C.ws + WS_HM);
    const size_t n = (size_t)NTOK * 512 / 8;
    for (size_t i0 = (size_t)blockIdx.x * 512 + tid; i0 < n * (1 + rep2); i0 += (size_t)G * 512) { const size_t i = i0 >= n ? i0 - n : i0; const u32x4 o = po[i], a = hf[i], b = hb[i]; u32x4 r;
        r.x = pk2(bflo(o.x) * (bflo(a.x) + bflo(b.x)), bfhi(o.x) * (bfhi(a.x) + bfhi(b.x))); r.y = pk2(bflo(o.y) * (bflo(a.y) + bflo(b.y)), bfhi(o.y) * (bfhi(a.y) + bfhi(b.y)));
        r.z = pk2(bflo(o.z) * (bflo(a.z) + bflo(b.z)), bfhi(o.z) * (bfhi(a.z) + bfhi(b.z))); r.w = pk2(bflo(o.w) * (bflo(a.w) + bflo(b.w)), bfhi(o.w) * (bfhi(a.w) + bfhi(b.w)));
        hm[i] = r; }
}

__device__ __forceinline__ void p6_norm_router(const Ctx& C, LAS unsigned char* lds, int tid, int lane, int wave, int G, int rep2) {
    LAS float* wl = (LAS float*)lds;
    for (int i = tid; i < 1024 * 16; i += 512) { const int col = i >> 4, gc = i & 15; wl[(((((col >> 8) * 4 + (col & 3)) * 4 + (gc >> 2)) * 64 + ((col >> 2) & 63)) * 4) + (gc & 3)] = C.w_router[i]; }
    __syncthreads();
    const float* mod = (const float*)(C.ws + WS_MOD); bf16* HX2 = (bf16*)(C.ws + WS_HX2); float* aff = (float*)(C.ws + WS_AFF);
    const int NGW = G * 8;
    for (int gw0 = blockIdx.x * 8 + wave; gw0 < 2048 * (1 + rep2); gw0 += NGW) { const int gw = gw0 & 2047;
        f32x4 gsc[4], sh[4]; const int b = gw >> 6; const float* m = mod + (size_t)b * 6144;
#pragma unroll
        for (int j = 0; j < 4; ++j) { const int col = 4 * lane + 256 * j; const f32x4 g = *(const f32x4*)(C.g_norm2 + col), s = *(const f32x4*)(m + 4096 + col); gsc[j] = g * (s + 1.f); sh[j] = *(const f32x4*)(m + 3072 + col); }
        for (int q = 0; q < 8; ++q) { const size_t row0 = (size_t)gw * 32 + q * 4; const float lg = rows4_norm_proj<true>(C.out, row0, gsc, sh, HX2, wl, lane);
            float mx = lg;
#pragma unroll
            for (int o = 1; o < 16; o <<= 1) mx = fmaxf(mx, __shfl_xor(mx, o));
            const float ex = expf(lg - mx); float sm = ex;
#pragma unroll
            for (int o = 1; o < 16; o <<= 1) sm += __shfl_xor(sm, o);
            const size_t t = (row0 + (lane >> 4)) & (SEQ - 1);
            aff[((size_t)b * NE + (lane & 15)) * SEQ + t] = ex / sm; }
    }
}

__device__ __forceinline__ unsigned wave_sum_u(unsigned v) {
#pragma unroll
    for (int o = 1; o < 64; o <<= 1) v += __shfl_xor(v, o);
    return v;
}
__device__ __forceinline__ unsigned wave_excl_scan_u(unsigned v, int lane) { unsigned s = v;
#pragma unroll
    for (int o = 1; o < 64; o <<= 1) { const unsigned t = __shfl_up(s, o); if (lane >= o) s += t; }
    return s - v;
}
__device__ __forceinline__ void topk_item(const Ctx& C, int item, int lane) {
    const int b = item >> 4, e = item & 15; const float* a = (const float*)(C.ws + WS_AFF) + ((size_t)b * NE + e) * SEQ + 32 * lane;
    unsigned key[32];
#pragma unroll
    for (int q = 0; q < 8; ++q) { const u32x4 v = *(const u32x4*)(a + 4 * q); key[4 * q] = v.x; key[4 * q + 1] = v.y; key[4 * q + 2] = v.z; key[4 * q + 3] = v.w; }
    unsigned T = 0u;
    for (int bit = 30; bit >= 0; --bit) { const unsigned cand = T | (1u << bit); unsigned cnt = 0u;
#pragma unroll
        for (int i = 0; i < 32; ++i) cnt += key[i] >= cand ? 1u : 0u;
        if (wave_sum_u(cnt) >= (unsigned)CAP) T = cand; }
    unsigned ngt = 0u, neq = 0u;
#pragma unroll
    for (int i = 0; i < 32; ++i) { ngt += key[i] > T ? 1u : 0u; neq += key[i] == T ? 1u : 0u; }
    const unsigned need = (unsigned)CAP - wave_sum_u(ngt);
    unsigned tie_before = wave_excl_scan_u(neq, lane);
    unsigned nsel = 0u; unsigned selmask = 0u;
#pragma unroll
    for (int i = 0; i < 32; ++i) { bool s = key[i] > T; if (key[i] == T) { s = tie_before < need; ++tie_before; } if (s) { selmask |= 1u << i; ++nsel; } }
    unsigned slot = wave_excl_scan_u(nsel, lane);
    const int pm = e * 32 + b; int* idx = (int*)(C.ws + WS_IDX) + (size_t)pm * CAP; float* val = (float*)(C.ws + WS_VAL) + (size_t)pm * CAP; bf16* sl = (bf16*)(C.ws + WS_SLOT);
#pragma unroll
    for (int i = 0; i < 32; ++i) { const int t = 32 * lane + i; const bool s = (selmask >> i) & 1u;
        if (s) { idx[slot] = b * SEQ + t; val[slot] = __uint_as_float(key[i]); }
        sl[((size_t)b * SEQ + t) * NE + e] = s ? (bf16)slot : (bf16)0xffffu; if (s) ++slot; }
}

__device__ __forceinline__ void p10_final(const Ctx& C, int lane, int wave, int G) {
    const float* mod = (const float*)(C.ws + WS_MOD); const bf16* Y = (const bf16*)(C.ws + WS_Y); const bf16* sl = (const bf16*)(C.ws + WS_SLOT);
    const int NGW = G * 8;
    for (int gw = blockIdx.x * 8 + wave; gw < 2048; gw += NGW) { const int b = gw >> 6; const float* m = mod + (size_t)b * 6144 + 5120;
        f32x4 ga[4], gf[4];
#pragma unroll
        for (int j = 0; j < 4; ++j) { ga[j] = *(const f32x4*)(m + 4 * lane + 256 * j); gf[j] = *(const f32x4*)(C.g_final + 4 * lane + 256 * j); }
        for (int q = 0; q < 32; ++q) { const size_t row = (size_t)gw * 32 + q; f32x4 v[4], a[4];
#pragma unroll
            for (int j = 0; j < 4; ++j) { v[j] = *(const f32x4*)(C.out + row * 1024 + 4 * lane + 256 * j); a[j] = (f32x4){0.f, 0.f, 0.f, 0.f}; }
            const unsigned myslot = lane < NE ? (unsigned)sl[row * NE + lane] : 0xffffu;
            for (int e = 0; e < NE; ++e) { const unsigned s = __builtin_amdgcn_readlane(myslot, e); if (s != 0xffffu) { const bf16* yr = Y + ((size_t)(e * 32 + b) * CAP + s) * 1024 + 4 * lane;
#pragma unroll
                for (int j = 0; j < 4; ++j) { const u32x2 p = *(const u32x2*)(yr + 256 * j); a[j] += (f32x4){bflo(p.x), bfhi(p.x), bflo(p.y), bfhi(p.y)}; } } }
            float ss = 0.f;
#pragma unroll
            for (int j = 0; j < 4; ++j) { v[j] = v[j] + ga[j] * a[j]; ss += v[j][0] * v[j][0] + v[j][1] * v[j][1] + v[j][2] * v[j][2] + v[j][3] * v[j][3]; }
            const float rstd = rsqrtf(wave_sum(ss) * (1.f / 1024.f) + EPS);
#pragma unroll
            for (int j = 0; j < 4; ++j) *(f32x4*)(C.out + row * 1024 + 4 * lane + 256 * j) = v[j] * rstd * gf[j]; }
    }
}
namespace ml {
typedef short v4i16_t __attribute__((ext_vector_type(4)));
constexpr int QS = 0, KS = 16384, VS = 32768, CT = 49152, SS = 81920, SM = 90112;
constexpr int U_ = 0, M_ = 64, DEC_ = 128, EM_ = 192, WA_ = 256, QN_ = 320, RS_ = 384, N_ = 512, SC_ = 640;
__device__ __forceinline__ unsigned off_b(unsigned row, unsigned ch) { return 256u * row + 16u * (ch ^ (((row & 3) << 2) | ((row >> 2) & 3))); }
__device__ __forceinline__ unsigned off_s(unsigned row, unsigned ch) { return 128u * row + 16u * (ch ^ (row & 7)); }
__device__ __forceinline__ bf16x8 rowfrag(const LAS unsigned char* tile, int rb, int ks, int lane) { return *(const LAS bf16x8*)(tile + off_b(16 * rb + (lane & 15), 4 * ks + (lane >> 4))); }
__device__ __forceinline__ bf16x8 trfrag(const LAS unsigned char* tile, int c, int ks, int lane) {
    const unsigned g = lane >> 4, q = (lane & 15) >> 2, p = lane & 3;
    const unsigned a0 = off_b(32 * ks + 8 * g + q, 2 * c + (p >> 1)) + 8 * (p & 1), a1 = off_b(32 * ks + 8 * g + 4 + q, 2 * c + (p >> 1)) + 8 * (p & 1);
    const v4i16_t lo = __builtin_amdgcn_ds_read_tr16_b64_v4i16((LAS v4i16_t*)(tile + a0)), hi = __builtin_amdgcn_ds_read_tr16_b64_v4i16((LAS v4i16_t*)(tile + a1));
    bf16x8 r; r[0] = lo[0]; r[1] = lo[1]; r[2] = lo[2]; r[3] = lo[3]; r[4] = hi[0]; r[5] = hi[1]; r[6] = hi[2]; r[7] = hi[3]; return r;
}
__device__ __forceinline__ float scan_add(float v, int lane, int dir) {
#pragma unroll
    for (int d = 1; d < 64; d <<= 1) { const float t = dir ? __shfl_down(v, d) : __shfl_up(v, d); if (dir ? (lane + d < 64) : (lane >= d)) v += t; }
    return v;
}
__device__ __forceinline__ float scan_max(float v, int lane, int dir) {
#pragma unroll
    for (int d = 1; d < 64; d <<= 1) { const float t = dir ? __shfl_down(v, d) : __shfl_up(v, d); if (dir ? (lane + d < 64) : (lane >= d)) v = fmaxf(v, t); }
    return v;
}
__device__ __forceinline__ void gate_math(float ig, float fg, int lane, int dir, float& m0, LAS float* sm) {
    const float fl = log_sigmoid_f(fg);
    const float cum = scan_add(fl, lane, dir);
    const float u = ig - cum;
    const float pmx = scan_max(u, lane, dir);
    const int endl = dir ? 0 : 63;
    const float tot = __shfl(cum, endl), umax = __shfl(pmx, endl);
    const float M = fmaxf(m0, pmx);
    const float mn = fmaxf(tot + m0, tot + umax);
    sm[U_ + lane] = u; sm[M_ + lane] = M; sm[DEC_ + lane] = expf(m0 - M); sm[EM_ + lane] = expf(-(cum + M)); sm[WA_ + lane] = expf(tot + u - mn);
    if (lane == 0) sm[SC_] = expf(tot + m0 - mn);
    m0 = mn;
}

__device__ __forceinline__ void mlstm_phase(const Ctx& C, LAS unsigned char* lds, int tid, int lane, int wave, int G, int rep2) {
    LAS float* sm = (LAS float*)(lds + SM);
    const bf16* QK = (const bf16*)(C.ws + WS_QK); const bf16* KC = (const bf16*)(C.ws + WS_KC); const bf16* PV = (const bf16*)(C.ws + WS_PV); const bf16* PC = (const bf16*)(C.ws + WS_PC);
    const float* gates = (const float*)(C.ws + WS_GATES);
    for (int item0 = blockIdx.x; item0 < 256 * (1 + rep2); item0 += G) { const int item = item0 & 255;
        const int dir = item & 1, h = (item >> 1) & 3, b = item >> 3;
        bf16* Hout = (bf16*)(C.ws + (dir ? WS_HB : WS_HF));
        const int kI = dir ? 2 : 0, kF = dir ? 3 : 1; const float bI = C.b_gates[kI * 4 + h], bF = C.b_gates[kF * 4 + h];
        for (int i = tid; i < 32768 / 16; i += 512) *(LAS u32x4*)(lds + CT + i * 16) = (u32x4){0u, 0u, 0u, 0u};
        if (tid < 128) sm[N_ + tid] = 0.f;
        f32x4 Cacc[8];
#pragma unroll
        for (int t = 0; t < 8; ++t) Cacc[t] = (f32x4){0.f, 0.f, 0.f, 0.f};
        float m0 = 0.f;
        u32x4 pq[2], pk[2], pv[2]; float pig = 0.f, pfg = 0.f;
#define ML_ISSUE(step_) do { const int _st = (step_); const bool _isx = _st >= 4; const int _cc = _isx ? (dir ? 35 - _st : _st - 4) : (dir ? 3 - _st : _st); \
            _Pragma("unroll") for (int _i = 0; _i < 2; ++_i) { const int _idx = tid + 512 * _i, _row = _idx >> 4, _ch = _idx & 15; \
                if (_isx) { const size_t _tok = (size_t)b * SEQ + _cc * 64 + _row; pq[_i] = *(const u32x4*)(QK + _tok * 1024 + h * 128 + _ch * 8); pk[_i] = *(const u32x4*)(QK + _tok * 1024 + 512 + h * 128 + _ch * 8); pv[_i] = *(const u32x4*)(PV + _tok * 512 + h * 128 + _ch * 8); } \
                else { const size_t _tok = (size_t)b * CL + _cc * 64 + _row; pk[_i] = *(const u32x4*)(KC + _tok * 512 + h * 128 + _ch * 8); pv[_i] = *(const u32x4*)(PC + _tok * 1024 + 512 + h * 128 + _ch * 8); pq[_i] = pk[_i]; } } \
            if (wave == 0) { const size_t _tok = _isx ? (size_t)b * SEQ + _cc * 64 + lane : (size_t)NTOK + (size_t)b * CL + _cc * 64 + lane; pig = gates[_tok * 16 + kI * 4 + h] + bI; pfg = gates[_tok * 16 + kF * 4 + h] + bF; } } while (0)
#define ML_COMMIT() do { \
            _Pragma("unroll") for (int _i = 0; _i < 2; ++_i) { const int _idx = tid + 512 * _i, _row = _idx >> 4, _ch = _idx & 15; const unsigned _o = off_b(_row, _ch); \
                *(LAS u32x4*)(lds + QS + _o) = pq[_i]; *(LAS u32x4*)(lds + KS + _o) = pk[_i]; *(LAS u32x4*)(lds + VS + _o) = pv[_i]; } \
            if (wave == 0) gate_math(pig, pfg, lane, dir, m0, sm); } while (0)
        ML_ISSUE(0);
        __syncthreads();
        ML_COMMIT();
        __syncthreads();
        const int g = lane >> 4, li = lane & 15;
        for (int step = 0; step < 36; ++step) {
            const bool isx = step >= 4; const int cc = isx ? (dir ? 35 - step : step - 4) : 0;
            if (!isx && step + 1 < 36) ML_ISSUE(step + 1);
            if (isx) {
                const int jt = wave >> 1, j = 16 * jt + li;
                {   const int jr = tid >> 3, part = tid & 7; float dsum = 0.f;
#pragma unroll
                    for (int c2 = 0; c2 < 2; ++c2) { const u32x4 qv = *(const LAS u32x4*)(lds + QS + off_b(jr, 2 * part + c2)); const LAS float* np = sm + N_ + 16 * part + 8 * c2; const f32x4 n0 = *(const LAS f32x4*)np, n1 = *(const LAS f32x4*)(np + 4);
                        dsum += bflo(qv.x) * n0[0] + bfhi(qv.x) * n0[1] + bflo(qv.y) * n0[2] + bfhi(qv.y) * n0[3] + bflo(qv.z) * n1[0] + bfhi(qv.z) * n1[1] + bflo(qv.w) * n1[2] + bfhi(qv.w) * n1[3]; }
                    dsum += __shfl_xor(dsum, 1); dsum += __shfl_xor(dsum, 2); dsum += __shfl_xor(dsum, 4);
                    if (part == 0) sm[QN_ + jr] = dsum; }
                bf16x8 qf[4];
#pragma unroll
                for (int ks = 0; ks < 4; ++ks) qf[ks] = rowfrag(lds + QS, jt, ks, lane);
                const float Mj = sm[M_ + j]; float rsum = 0.f;
#pragma unroll
                for (int t = 0; t < 2; ++t) { const int st = 2 * (wave & 1) + t; f32x4 sa = {0.f, 0.f, 0.f, 0.f};
#pragma unroll
                    for (int ks = 0; ks < 4; ++ks) sa = __builtin_amdgcn_mfma_f32_16x16x32_bf16(rowfrag(lds + KS, st, ks, lane), qf[ks], sa, 0, 0, 0);
                    const int s0 = 16 * st + 4 * g; const f32x4 u4 = *(const LAS f32x4*)(sm + U_ + s0); float sp[4];
#pragma unroll
                    for (int r = 0; r < 4; ++r) { const int s = s0 + r; const bool keep = dir ? (s >= j) : (s <= j); const float dv = __expf(fminf(u4[r] - Mj, 0.f)); sp[r] = keep ? sa[r] * dv : 0.f; rsum += sp[r]; }
                    u32x2 w; w.x = pk2(sp[0], sp[1]); w.y = pk2(sp[2], sp[3]);
                    *(LAS u32x2*)(lds + SS + off_s(j, 2 * st + (g >> 1)) + (g & 1) * 8) = w; }
                rsum += __shfl_xor(rsum, 16); rsum += __shfl_xor(rsum, 32);
                if (g == 0) sm[RS_ + 2 * j + (wave & 1)] = rsum;
                __syncthreads();
                if (step + 1 < 36) ML_ISSUE(step + 1);
                f32x4 oa[4];
#pragma unroll
                for (int t = 0; t < 4; ++t) { const int dvt = 4 * (wave & 1) + t; oa[t] = (f32x4){0.f, 0.f, 0.f, 0.f};
#pragma unroll
                    for (int ks = 0; ks < 4; ++ks) oa[t] = __builtin_amdgcn_mfma_f32_16x16x32_bf16(rowfrag(lds + CT, dvt, ks, lane), rowfrag(lds + QS, jt, ks, lane), oa[t], 0, 0, 0); }
                const float dj = sm[DEC_ + j];
                bf16x8 sf[2];
#pragma unroll
                for (int ks = 0; ks < 2; ++ks) sf[ks] = *(const LAS bf16x8*)(lds + SS + off_s(j, 4 * ks + g));
                const float den = (sm[RS_ + 2 * j] + sm[RS_ + 2 * j + 1]) + dj * sm[QN_ + j];
                const float inv = 1.f / fmaxf(fabsf(den), sm[EM_ + j]);
                const size_t tok = (size_t)b * SEQ + cc * 64 + j;
#pragma unroll
                for (int t = 0; t < 4; ++t) { const int dvt = 4 * (wave & 1) + t; f32x4 o = oa[t] * dj;
#pragma unroll
                    for (int ks = 0; ks < 2; ++ks) o = __builtin_amdgcn_mfma_f32_16x16x32_bf16(trfrag(lds + VS, dvt, ks, lane), sf[ks], o, 0, 0, 0);
                    o = o * inv; u32x2 w; w.x = pk2(o[0], o[1]); w.y = pk2(o[2], o[3]);
                    *(u32x2*)(Hout + tok * 512 + h * 128 + 16 * dvt + 4 * g) = w; }
            }
            {   const float dn = sm[SC_];
                bf16x8 kf[2];
#pragma unroll
                for (int ks = 0; ks < 2; ++ks) { const bf16x8 kr = trfrag(lds + KS, wave, ks, lane); const f32x4 w0 = *(const LAS f32x4*)(sm + WA_ + 32 * ks + 8 * g), w1 = *(const LAS f32x4*)(sm + WA_ + 32 * ks + 8 * g + 4);
                    u32x4 pkd; pkd.x = pk2(bf1((bf16)kr[0]) * w0[0], bf1((bf16)kr[1]) * w0[1]); pkd.y = pk2(bf1((bf16)kr[2]) * w0[2], bf1((bf16)kr[3]) * w0[3]);
                    pkd.z = pk2(bf1((bf16)kr[4]) * w1[0], bf1((bf16)kr[5]) * w1[1]); pkd.w = pk2(bf1((bf16)kr[6]) * w1[2], bf1((bf16)kr[7]) * w1[3]);
                    kf[ks] = __builtin_bit_cast(bf16x8, pkd); }
                {   const int dk = tid >> 2, part = tid & 3; float a = 0.f;
#pragma unroll
                    for (int e = 0; e < 16; ++e) { const int s = 16 * part + e; a += sm[WA_ + s] * bf1(*(const LAS bf16*)(lds + KS + off_b(s, dk >> 3) + (dk & 7) * 2)); }
                    a += __shfl_xor(a, 1); a += __shfl_xor(a, 2);
                    if (part == 0) sm[N_ + dk] = dn * sm[N_ + dk] + a; }
#pragma unroll
                for (int dvt = 0; dvt < 8; ++dvt) { f32x4 c = Cacc[dvt] * dn;
#pragma unroll
                    for (int ks = 0; ks < 2; ++ks) c = __builtin_amdgcn_mfma_f32_16x16x32_bf16(kf[ks], trfrag(lds + VS, dvt, ks, lane), c, 0, 0, 0);
                    Cacc[dvt] = c; }
            }
            __syncthreads();
#pragma unroll
            for (int dvt = 0; dvt < 8; ++dvt) { const f32x4 c = Cacc[dvt]; u32x2 w; w.x = pk2(c[0], c[1]); w.y = pk2(c[2], c[3]);
                *(LAS u32x2*)(lds + CT + off_b(16 * dvt + li, 2 * wave + (g >> 1)) + (g & 1) * 8) = w; }
            if (step + 1 < 36) ML_COMMIT();
            __syncthreads();
        }
    }
}
#undef ML_ISSUE
#undef ML_COMMIT
}
constexpr int N_PHASES = 13;
#ifndef PROBE_PH
#define PROBE_PH 0
#endif
struct Args { const float* in[19]; float* out; unsigned char* ws; int ph_lo, ph_hi, probe, pad; };
static_assert(sizeof(Args) == 19 * 8 + 8 + 8 + 16, "Args has no padding");

__global__ void __launch_bounds__(512, 2) mk_fwd(Args a) {
    extern __shared__ __attribute__((aligned(16))) unsigned char lds_raw[];
    LAS unsigned char* lds = (LAS unsigned char*)lds_raw;
    const int tid = threadIdx.x, lane = tid & 63, wave = __builtin_amdgcn_readfirstlane(tid >> 6), G = gridDim.x;
    Ctx C;
    C.x = a.in[0]; C.c = a.in[1]; C.ctx = a.in[2]; C.c_ctx = a.in[3]; C.w_ada = a.in[4]; C.b_ada = a.in[5]; C.g_norm1 = a.in[6]; C.w_in = a.in[7]; C.b_gates = a.in[8]; C.w_conv = a.in[9];
    C.w_fourier = a.in[10]; C.w_mlstm = a.in[11]; C.w_out = a.in[12]; C.g_norm2 = a.in[13]; C.w_router = a.in[14]; C.w_gate_e = a.in[15]; C.w_up_e = a.in[16]; C.w_down_e = a.in[17]; C.g_final = a.in[18];
    C.out = a.out; C.ws = a.ws;
    const int lo = a.ph_lo, hi = a.ph_hi;
#if MK_XCD_BAR
    volatile LAS unsigned* bst = (volatile LAS unsigned*)(lds + LDS_PHASE_BYTES);
    if (tid < 4) bst[tid] = 0u;
    __syncthreads();
    XcdBarrier bar = xcd_barrier_post((unsigned*)(a.ws + WS_CTL) + 4096, bst);
#endif
    int nsync = 0;
#define IN(k) (lo <= (k) && (k) < hi)
#if MK_XCD_BAR
#define GRIDBAR() do { if (nsync == 0) cg::this_grid().sync(); else xcd_barrier(bar); ++nsync; } while (0)
#else
#define GRIDBAR() do { cg::this_grid().sync(); ++nsync; } while (0)
#endif
#define SEAM(k) do { if (IN(k) && IN((k) + 1)) GRIDBAR(); } while (0)
#define PHASE(k, ...) do { if (IN(k)) { __VA_ARGS__ } SEAM(k); } while (0)
    PHASE(0, { for (int _r = 0; _r < 1 + (a.probe & 1); ++_r) { p0_prep(C, lds, tid, lane, wave, G); __syncthreads(); } });
    PHASE(1, { p1a_norm_gates(C, lds, tid, lane, wave, G, (a.probe >> 1) & 1); __syncthreads(); });
    PHASE(2, { SchedP1 S{C.ws, G, (int)blockIdx.x, 1 + ((a.probe >> 2) & 1)}; EpiP1 E{C.ws}; mg::gemm_phase<EpiP1, SchedP1, false>(lds, 1024, S, E); });
    PHASE(3, { SchedF2 S{C.ws, G, (int)blockIdx.x, 1 + ((a.probe >> 3) & 1)}; EpiF2 E{C.ws}; mg::gemm_phase<EpiF2, SchedF2, false>(lds, 4096, S, E); p2_conv(C, lane, wave, G, (a.probe >> 13) & 1); });
    PHASE(4, { ml::mlstm_phase(C, lds, tid, lane, wave, G, (a.probe >> 4) & 1); });
    PHASE(5, { p3b_combine(C, tid, G, (a.probe >> 5) & 1); });
    PHASE(6, { SchedMerge S{C.ws, G, (int)blockIdx.x, 1 + ((a.probe >> 6) & 1)}; EpiMerge E{C.ws}; mg::gemm_phase<EpiMerge, SchedMerge, false>(lds, 512, S, E); });
    PHASE(7, { SchedOut S{C.ws, G, (int)blockIdx.x, 1 + ((a.probe >> 7) & 1)}; EpiOut E{C.x, (const float*)(C.ws + WS_MOD), C.out}; mg::gemm_phase<EpiOut, SchedOut, false>(lds, 1024, S, E); });
    PHASE(8, { p6_norm_router(C, lds, tid, lane, wave, G, (a.probe >> 8) & 1); __syncthreads(); });
    PHASE(9, { const int NGW = G * 8; const int rp9 = 1 + ((a.probe >> 9) & 1); for (int it = blockIdx.x * 8 + wave; it < NB * NE * rp9; it += NGW) topk_item(C, it % (NB * NE), lane); convert_experts(C, lds, lane, wave, G, rp9); for (int i = blockIdx.x * 512 + tid; i < NE * NB * CAP; i += G * 512) ((int*)(C.ws + WS_IDENT))[i] = i; __syncthreads(); });
    PHASE(10, { SchedUp S{C.ws, G, (int)blockIdx.x, 1 + ((a.probe >> 10) & 1)}; EpiSwiglu E{C.ws}; mg::gemm_phase<EpiSwiglu, SchedUp, true, true>(lds, 1024, S, E); });
    PHASE(11, { SchedDown S{C.ws, G, (int)blockIdx.x, 1 + ((a.probe >> 11) & 1)}; EpiDown E{C.ws}; mg::gemm_phase<EpiDown, SchedDown, true, true>(lds, 1024, S, E); });
    if (IN(12)) { p10_final(C, lane, wave, G); }
#undef PHASE
#undef PHASE_L
#undef IN
#undef SEAM
#undef GRIDBAR
}

static void mk_launch(void* const* d_in, void* d_out, void* d_ws, hipStream_t stream, int lo, int hi, bool coop) {
    static int grid = 0;
    if (grid == 0) {
        int dev = 0, cus = 0, per_cu = 0;
        (void)hipGetDevice(&dev); (void)hipDeviceGetAttribute(&cus, hipDeviceAttributeMultiprocessorCount, dev);
        (void)hipFuncSetAttribute((const void*)mk_fwd, hipFuncAttributeMaxDynamicSharedMemorySize, LDS_BYTES);
        (void)hipOccupancyMaxActiveBlocksPerMultiprocessor(&per_cu, (const void*)mk_fwd, 512, LDS_BYTES);
        if (per_cu < 1) fprintf(stderr, "mk_launch: occupancy query says %d blocks/CU\n", per_cu);
        grid = cus > 0 ? cus : 256;
    }
    Args a{};
    for (int i = 0; i < 19; ++i) a.in[i] = (const float*)d_in[i];
    a.out = (float*)d_out; a.ws = (unsigned char*)d_ws; a.ph_lo = lo; a.ph_hi = hi; a.probe = PROBE_PH; a.pad = 0;
    if (coop) { void* args[] = {&a}; hipError_t e = hipLaunchCooperativeKernel((const void*)mk_fwd, dim3(grid), dim3(512), args, LDS_BYTES, stream);
        if (e != hipSuccess) fprintf(stderr, "cooperative launch failed: %s (grid %d)\n", hipGetErrorString(e), grid); }
    else hipLaunchKernelGGL(mk_fwd, dim3(grid), dim3(512), LDS_BYTES, stream, a);
}
extern "C" void kernel_launch(void* const* d_in, const int* in_sizes, int n_in, void* d_out, int out_size, void* d_ws, size_t ws_size, hipStream_t stream) {
    (void)hipMemsetAsync((char*)d_ws + WS_CTL, 0, 65536, stream);
    mk_launch(d_in, d_out, d_ws, stream, 0, N_PHASES, true);
}
```

```cpp
#ifndef MK_XCD_BAR
#define MK_XCD_BAR 1
#endif
#include <hip/hip_runtime.h>
#include <hip/hip_cooperative_groups.h>
#include <cstdio>
#include <cstdint>
namespace cg = cooperative_groups;

#define LAS __attribute__((address_space(3)))
typedef unsigned short bf16;
typedef short bf16x8 __attribute__((ext_vector_type(8)));
typedef short s16x4 __attribute__((ext_vector_type(4)));
typedef float f32x4 __attribute__((ext_vector_type(4)));
typedef float f32x2 __attribute__((ext_vector_type(2)));
typedef unsigned u32x4 __attribute__((ext_vector_type(4)));
typedef unsigned u32x2 __attribute__((ext_vector_type(2)));
typedef __bf16 bf16x2_t __attribute__((ext_vector_type(2)));
typedef int v8i_t __attribute__((ext_vector_type(8)));
typedef int v4i_t __attribute__((ext_vector_type(4)));

__device__ __forceinline__ unsigned pk2(float lo, float hi) { f32x2 v = {lo, hi}; bf16x2_t b = __builtin_convertvector(v, bf16x2_t); return __builtin_bit_cast(unsigned, b); }
__device__ __forceinline__ float bflo(unsigned w) { return __uint_as_float(w << 16); }
__device__ __forceinline__ float bfhi(unsigned w) { return __uint_as_float(w & 0xffff0000u); }
__device__ __forceinline__ float bf1(bf16 b) { return __uint_as_float((unsigned)b << 16); }
__device__ __forceinline__ float silu_f(float v) { return v * __builtin_amdgcn_rcpf(1.f + __expf(-v)); }
__device__ __forceinline__ float sigmoid_f(float v) { return __builtin_amdgcn_rcpf(1.f + __expf(-v)); }
__device__ __forceinline__ float log_sigmoid_f(float v) { return fminf(v, 0.f) - log1pf(expf(-fabsf(v))); }
__device__ __forceinline__ float wave_sum(float v) {
#pragma unroll
    for (int o = 1; o < 64; o <<= 1) v += __shfl_xor(v, o);
    return v;
}

#define XB_TMO      128
#define XB_XCNT(j)  (256  + 64 * (j))
#define XB_XSUB(j)  (1280 + 64 * (j))
#define XB_XGEN(j)  (2304 + 64 * (j))
#define XB_TOP      3328
#define XB_TOPGEN   3392
#define XCD_BAR_WORDS 3456
#define XB_SPIN_CAP (1u << 20)
__device__ __forceinline__ unsigned xb_ld(unsigned* p)              { return __hip_atomic_load(p, __ATOMIC_RELAXED, __HIP_MEMORY_SCOPE_AGENT); }
__device__ __forceinline__ unsigned xb_add(unsigned* p, unsigned v) { return __hip_atomic_fetch_add(p, v, __ATOMIC_RELAXED, __HIP_MEMORY_SCOPE_AGENT); }
__device__ __forceinline__ unsigned xb_xcc_id() { return (unsigned)__builtin_amdgcn_s_getreg((3 << 11) | 20) & 0xFu; }
#define XB_SPIN(cond, bar) do { unsigned _sp = 0; while (cond) { __builtin_amdgcn_s_sleep(1); \
    if ((++_sp & 255u) == 0u) { if (xb_ld(&(bar)[XB_TMO])) break; if (_sp > XB_SPIN_CAP) { atomicAdd(&(bar)[XB_TMO], 1u); break; } } } } while (0)
struct XcdBarrier { unsigned* bar; unsigned x; volatile LAS unsigned* st; };
__device__ __forceinline__ XcdBarrier xcd_barrier_post(unsigned* bar, volatile LAS unsigned* st) {
    XcdBarrier b; b.bar = bar; b.x = xb_xcc_id(); b.st = st;
    if (threadIdx.x == 0) (void)xb_add(&bar[XB_XCNT(b.x)], 1u);
    return b;
}
__device__ __forceinline__ void xcd_barrier_complete(unsigned* bar, unsigned x, unsigned& nloc, unsigned& nx) {
    const unsigned G = gridDim.x * gridDim.y * gridDim.z;
    unsigned sum, cnt, mine, sp = 0u;
    for (;;) {
        sum = 0u; cnt = 0u; mine = 0u;
#pragma unroll
        for (unsigned j = 0; j < 16; ++j) { const unsigned c = xb_ld(&bar[XB_XCNT(j)]); sum += c; cnt += (c > 0u) ? 1u : 0u; mine = (j == x) ? c : mine; }
        if (sum == G) break;
        __builtin_amdgcn_s_sleep(1);
        if ((++sp & 255u) == 0u) { if (xb_ld(&bar[XB_TMO])) break; if (sp > XB_SPIN_CAP) { atomicAdd(&bar[XB_TMO], 1u); break; } }
    }
    nloc = mine > 0u ? mine : 1u; nx = cnt > 0u ? cnt : 1u;
}
__device__ __forceinline__ void xcd_barrier(const XcdBarrier& b) {
    asm volatile("s_waitcnt vmcnt(0)" ::: "memory");
    __syncthreads();
    if (threadIdx.x == 0) {
        unsigned* bar = b.bar;
        __builtin_amdgcn_s_waitcnt(0);
        unsigned nloc = b.st[0], nx = b.st[1];
        if (nloc == 0u) { xcd_barrier_complete(bar, b.x, nloc, nx); b.st[0] = nloc; b.st[1] = nx; }
        const unsigned old = xb_add(&bar[XB_XSUB(b.x)], 1u);
        const unsigned gen = old / nloc;
        if (old + 1u == (gen + 1u) * nloc) {
            __builtin_amdgcn_fence(__ATOMIC_RELEASE, "agent");
            asm volatile("s_waitcnt vmcnt(0)" ::: "memory");
            const unsigned og = xb_add(&bar[XB_TOP], 1u);
            const unsigned tg = og / nx;
            if (og + 1u == (tg + 1u) * nx) xb_add(&bar[XB_TOPGEN], 1u);
            else XB_SPIN(xb_ld(&bar[XB_TOPGEN]) == tg, bar);
            __builtin_amdgcn_fence(__ATOMIC_ACQUIRE, "agent");
            xb_add(&bar[XB_XGEN(b.x)], 1u);
            asm volatile("s_waitcnt vmcnt(0)" ::: "memory");
        } else {
            XB_SPIN(xb_ld(&bar[XB_XGEN(b.x)]) == gen, bar);
            __builtin_amdgcn_fence(__ATOMIC_ACQUIRE, "agent");
            asm volatile("s_waitcnt vmcnt(0)" ::: "memory");
        }
    }
    __syncthreads();
}

namespace mg {
template <bool F8> struct Frag { bf16x8 k[2]; };
template <> struct Frag<true> { v8i_t v; };
constexpr int BM = 256, BK = 64, HALF = 128, HTB = HALF * BK * 2, STAGE_BYTES = 8 * HTB, NXCD = 8, WGM = 8;
__host__ __device__ __forceinline__ int lds_byte(int r, int c) { const int st = (r >> 4) * 2 + (c >> 5), rr = r & 15, cc = c & 31, ob = rr * 64 + cc * 2; return st * 1024 + (ob ^ (((ob >> 9) & 1) << 5)); }
__host__ __device__ __forceinline__ void stage_rc(int b, int& R, int& C) { const int st = b / 1024, sb = b % 1024, swz = sb ^ (((sb >> 9) & 1) << 5); R = (st >> 1) * 16 + swz / 64; C = (st & 1) * 32 + (swz % 64) / 2; }
__host__ __device__ __forceinline__ int perm32(int rho) { const int n = rho >> 4, i = rho & 15; return 8 * (i >> 2) + 4 * n + (i & 3); }

struct Unit { int pm, pn, ty; const char* a; const char* b; const int* gi; };
__device__ __forceinline__ void tile_of(int wgid, int nM, int nN, int& pm, int& pn) {
    const int nwg = nM * nN; { const int q = nwg / NXCD, r = nwg % NXCD, xcd = wgid % NXCD, off = wgid / NXCD; wgid = (xcd < r ? xcd * (q + 1) : r * (q + 1) + (xcd - r) * q) + off; }
    const int nig = WGM * nN, gid = wgid / nig, fm = gid * WGM, gsz = (nM - fm) < WGM ? (nM - fm) : WGM;
    pm = fm + ((wgid % nig) % gsz); pn = (wgid % nig) / gsz;
}

template <class Epi, class Sched, bool GATHER, bool FP8 = false>
__device__ __forceinline__ void gemm_phase(LAS unsigned char* lds, const int K, const Sched& S, const Epi& E) {
    const int tid = threadIdx.x, wid = __builtin_amdgcn_readfirstlane(tid >> 6), lane = tid & 63, wr = wid >> 2, wc = wid & 3, fr = lane & 15, fq = lane >> 4;
    const int KB = FP8 ? K : 2 * K;
    const int nt = KB / (BK * 2);
    unsigned voffB[2], vAc[2][2]; int stR[2], stC[2]; int gnx[2][2];
    const size_t kstep = (size_t)(BK * 2);
    const size_t hstep = (size_t)HALF * KB;
#pragma unroll
    for (int i = 0; i < 2; ++i) { int R, C; stage_rc(tid * 16 + i * 8192, R, C); stR[i] = R; stC[i] = C; const int Rb = Epi::PERM ? ((R & ~31) + perm32(R & 31)) : R;
        voffB[i] = (unsigned)(Rb * KB + 2 * C); }
    const unsigned ldsw = (unsigned)wid * 1024u;
    const int aoff = lds_byte(wr * 64 + fr, fq * (FP8 ? 16 : 8)), boff = lds_byte(wc * 32 + fr, fq * (FP8 ? 16 : 8));
#define MG_SA(b, h) (((b) * 2 + (h)) * HTB)
#define MG_SB(b, h) ((4 + (b) * 2 + (h)) * HTB)
#define MG_STAGE(bufoff, gbase, voff) do { const char* _gb = (const char*)(gbase); asm volatile("" : "+s"(_gb));     \
        _Pragma("unroll") for (int _i = 0; _i < 2; ++_i) { unsigned _vo = (voff)[_i]; asm volatile("" : "+v"(_vo)); \
        __builtin_amdgcn_global_load_lds((const unsigned*)(_gb + _vo), (LAS unsigned*)(lds + (bufoff) + ldsw + _i * 8192), 16, 0, 0); } } while (0)
#define MG_LD16(off_) (*(const LAS v4i_t*)(lds + (off_)))
#define MG_LDA(dst, b, h) do { _Pragma("unroll") for (int m = 0; m < 4; ++m) { const int _o = MG_SA(b, h) + aoff + m * 2048; \
        if constexpr (FP8) dst[m].v = __builtin_shufflevector(MG_LD16(_o), MG_LD16(_o + 16), 0, 1, 2, 3, 4, 5, 6, 7); \
        else { dst[m].k[0] = __builtin_bit_cast(bf16x8, MG_LD16(_o)); dst[m].k[1] = __builtin_bit_cast(bf16x8, MG_LD16(_o + 1024)); } } } while (0)
#define MG_LDB(dst, b, h) do { _Pragma("unroll") for (int n = 0; n < 2; ++n) { const int _o = MG_SB(b, h) + boff + n * 2048; \
        if constexpr (FP8) dst[n].v = __builtin_shufflevector(MG_LD16(_o), MG_LD16(_o + 16), 0, 1, 2, 3, 4, 5, 6, 7); \
        else { dst[n].k[0] = __builtin_bit_cast(bf16x8, MG_LD16(_o)); dst[n].k[1] = __builtin_bit_cast(bf16x8, MG_LD16(_o + 1024)); } } } while (0)
#define MG_MMA(ai, bj, At, Bt) do { __builtin_amdgcn_s_setprio(1); _Pragma("unroll") for (int m = 0; m < 4; ++m) _Pragma("unroll") for (int n = 0; n < 2; ++n) { \
        if constexpr (FP8) acc[ai][bj][m][n] = __builtin_amdgcn_mfma_scale_f32_16x16x128_f8f6f4(Bt[n].v, At[m].v, acc[ai][bj][m][n], 0, 0, 0, 0, 0, 0); \
        else { _Pragma("unroll") for (int k = 0; k < 2; ++k) acc[ai][bj][m][n] = __builtin_amdgcn_mfma_f32_16x16x32_bf16(Bt[n].k[k], At[m].k[k], acc[ai][bj][m][n], 0, 0, 0); } } \
        __builtin_amdgcn_s_setprio(0); } while (0)
#define MG_WAIT_V(n) asm volatile("s_waitcnt vmcnt(" #n ")" ::: "memory")
#define MG_WAIT_L(n) asm volatile("s_waitcnt lgkmcnt(" #n ")" ::: "memory")
#define MG_BAR __builtin_amdgcn_s_barrier()
#define MG_SCHED __builtin_amdgcn_sched_barrier(0)
#define MG_AOFF(dst, u) do { _Pragma("unroll") for (int _h = 0; _h < 2; ++_h) _Pragma("unroll") for (int _i = 0; _i < 2; ++_i) { \
        if constexpr (GATHER) dst[_h][_i] = (unsigned)(u).gi[_h * HALF + stR[_i]] * (unsigned)KB + 2u * (unsigned)stC[_i]; \
        else dst[_h][_i] = (unsigned)((_h * HALF + stR[_i]) * KB + 2 * stC[_i]); } } while (0)
    Unit cur, nxt; int ui = 0;
    if (!S.next(0, cur)) return;
    f32x4 acc[2][2][4][2];
#pragma unroll
    for (int a = 0; a < 2; ++a)
#pragma unroll
        for (int b = 0; b < 2; ++b)
#pragma unroll
            for (int m = 0; m < 4; ++m)
#pragma unroll
                for (int n = 0; n < 2; ++n) acc[a][b][m][n] = (f32x4){0.f, 0.f, 0.f, 0.f};
    Frag<FP8> At[4], B0[2], B1[2];
    const char* cA = cur.a; const char* cB = cur.b;
    MG_AOFF(vAc, cur);
    MG_STAGE(MG_SB(0, 0), cB, voffB); MG_STAGE(MG_SB(0, 1), cB + hstep, voffB); MG_STAGE(MG_SA(0, 0), cA, vAc[0]); MG_STAGE(MG_SA(0, 1), cA, vAc[1]);
    if (wr == 1) MG_BAR;
    MG_WAIT_V(2); MG_BAR;
    MG_STAGE(MG_SB(1, 0), cB + kstep, voffB); MG_STAGE(MG_SA(1, 0), cA + kstep, vAc[0]); MG_STAGE(MG_SB(1, 1), cB + hstep + kstep, voffB);
    MG_WAIT_V(6); MG_BAR;
    for (;;) {
        const bool has_next = S.next(ui + 1, nxt);
        const char* nA = has_next ? nxt.a : cA; const char* nB = has_next ? nxt.b : cB;
        if constexpr (GATHER) { if (has_next) {
#pragma unroll
            for (int h = 0; h < 2; ++h)
#pragma unroll
                for (int i = 0; i < 2; ++i) gnx[h][i] = nxt.gi[h * HALF + stR[i]]; } }
#pragma unroll 1
        for (int t = 0; t < nt; t += 2) {
            const bool last = (t == nt - 2);
            const char* a1 = cA + (size_t)(t + 1) * kstep;
            const char* a2 = last ? nA : cA + (size_t)(t + 2) * kstep; const char* b2 = last ? nB : cB + (size_t)(t + 2) * kstep;
            const char* a3 = a2 + kstep; const char* b3 = b2 + kstep;
            MG_LDB(B0, 0, 0); MG_LDB(B1, 0, 1); MG_SCHED; MG_LDA(At, 0, 0); MG_STAGE(MG_SA(1, 1), a1, vAc[1]);
            if constexpr (GATHER) { if (last && has_next) {
#pragma unroll
                for (int h = 0; h < 2; ++h)
#pragma unroll
                    for (int i = 0; i < 2; ++i) vAc[h][i] = (unsigned)gnx[h][i] * (unsigned)KB + 2u * (unsigned)stC[i]; } }
            MG_WAIT_V(8); MG_WAIT_L(0); MG_BAR; MG_MMA(0, 0, At, B0); MG_MMA(0, 1, At, B1); MG_BAR; MG_SCHED;
            MG_LDA(At, 0, 1); MG_STAGE(MG_SB(0, 0), b2, voffB); MG_STAGE(MG_SB(0, 1), b2 + hstep, voffB); MG_STAGE(MG_SA(0, 0), a2, vAc[0]);
            MG_WAIT_V(8); MG_WAIT_L(0); MG_BAR; MG_MMA(1, 0, At, B0); MG_MMA(1, 1, At, B1); MG_BAR; MG_SCHED;
            MG_LDB(B0, 1, 0); MG_LDB(B1, 1, 1); MG_SCHED; MG_LDA(At, 1, 0); MG_STAGE(MG_SA(0, 1), a2, vAc[1]);
            MG_WAIT_V(8); MG_WAIT_L(0); MG_BAR; MG_MMA(0, 0, At, B0); MG_MMA(0, 1, At, B1); MG_BAR; MG_SCHED;
            MG_LDA(At, 1, 1); MG_STAGE(MG_SB(1, 0), b3, voffB); MG_STAGE(MG_SB(1, 1), b3 + hstep, voffB); MG_STAGE(MG_SA(1, 0), a3, vAc[0]);
            MG_WAIT_V(8); MG_WAIT_L(0); MG_BAR; MG_MMA(1, 0, At, B0); MG_MMA(1, 1, At, B1); MG_BAR; MG_SCHED;
        }
        if (wr == 0) MG_BAR;
        { int fr_ = fr, fq_ = fq; asm volatile("" : "+v"(fr_), "+v"(fq_));
          E(acc, cur, wr, wc, fr_, fq_); }
        if (!has_next) break;
#pragma unroll
        for (int a = 0; a < 2; ++a)
#pragma unroll
            for (int b = 0; b < 2; ++b)
#pragma unroll
                for (int m = 0; m < 4; ++m)
#pragma unroll
                    for (int n = 0; n < 2; ++n) acc[a][b][m][n] = (f32x4){0.f, 0.f, 0.f, 0.f};
        cur = nxt; cA = nA; cB = nB; ++ui;
        if (wr == 1) MG_BAR;
    }
    MG_WAIT_V(0);
    MG_BAR;
#undef MG_SA
#undef MG_SB
#undef MG_STAGE
#undef MG_LDA
#undef MG_LDB
#undef MG_MMA
#undef MG_LD16
#undef MG_WAIT_V
#undef MG_WAIT_L
#undef MG_BAR
#undef MG_SCHED
#undef MG_AOFF
}
}
constexpr int D = 1024, NB = 32, SEQ = 2048, CL = 256, NTOK = NB * SEQ, NCTX = NB * CL, INC = 4624;
constexpr int NE = 16, CAP = 256;
constexpr int OFF_QK = 512, OFF_V = 1536, OFF_O = 2048, OFF_G = 2560, OFF_BR = 2576;
constexpr float EPS = 1e-6f;
constexpr size_t MiB = 1u << 20;
constexpr size_t WS_CTL = 0, CTL_BYTES = 1 * MiB;
constexpr size_t WS_MOD = 1 * MiB;
constexpr size_t WS_GATES = 2 * MiB;
constexpr size_t WS_AFF = 11 * MiB;
constexpr size_t WS_IDX = 15 * MiB;
constexpr size_t WS_VAL = 15 * MiB + 512 * 1024;
constexpr size_t WS_SLOT = 16 * MiB;
constexpr size_t WS_WTF = 18 * MiB;
constexpr size_t WS_WFT = 20 * MiB;
constexpr size_t WS_WMT = 21 * MiB;
constexpr size_t WS_WOT = 22 * MiB;
constexpr size_t WS_WTM = 24 * MiB;
constexpr size_t WS_TT = 32 * MiB;
constexpr size_t WS_PC = 48 * MiB;
constexpr size_t WS_H = 64 * MiB;
constexpr size_t WS_QK = 64 * MiB;
constexpr size_t WS_KC = 192 * MiB;
constexpr size_t WS_MRG = 64 * MiB;
constexpr size_t WS_WGU = 64 * MiB;
constexpr size_t WS_WD = 128 * MiB;
constexpr size_t WS_AB = 208 * MiB;
constexpr size_t WS_HF = 208 * MiB;
constexpr size_t WS_HB = 272 * MiB;
constexpr size_t WS_HX2 = 208 * MiB;
constexpr size_t WS_FU = 336 * MiB;
constexpr size_t WS_PQK = 400 * MiB;
constexpr size_t WS_HM = 400 * MiB;
constexpr size_t WS_PV = 528 * MiB;
constexpr size_t WS_PO = 592 * MiB;
constexpr size_t WS_PBR = 656 * MiB;
constexpr size_t WS_HID = 400 * MiB;
constexpr size_t WS_Y = 656 * MiB;
constexpr size_t WS_IDENT = 912 * MiB;
constexpr size_t WS_W64 = 913 * MiB;
constexpr size_t WS_A64T = 913 * MiB + 65536;
constexpr size_t WS_F64 = 914 * MiB;
constexpr size_t WS_END = 916 * MiB;
constexpr int LDS_PHASE_BYTES = 147456, LDS_BYTES = LDS_PHASE_BYTES + 256;

__device__ __forceinline__ unsigned pk4_fp8(float a, float b, float c, float d) { int w = __builtin_amdgcn_cvt_pk_fp8_f32(a, b, 0, false); w = __builtin_amdgcn_cvt_pk_fp8_f32(c, d, w, true); return (unsigned)w; }
constexpr float W8_SCALE = 32.f, W8_INV = 1.f / 32.f;
struct Ctx {
    const float *x, *c, *ctx, *c_ctx, *w_ada, *b_ada, *g_norm1, *w_in, *b_gates, *w_conv, *w_fourier, *w_mlstm, *w_out, *g_norm2, *w_router, *w_gate_e, *w_up_e, *w_down_e, *g_final;
    float* out; unsigned char* ws;
};

__device__ __forceinline__ void store_tile_bf16(const f32x4 (&acc)[2][2][4][2], bf16* base, int ldc, bool sig, int wr, int wc, int fr, int fq) {
    bf16* p0 = base + (size_t)(wr * 64 + fr) * ldc + wc * 32 + 8 * fq;
#pragma unroll
    for (int ai = 0; ai < 2; ++ai)
#pragma unroll
        for (int m = 0; m < 4; ++m) { bf16* rowp = p0 + (size_t)(ai * 128 + m * 16) * ldc;
#pragma unroll
            for (int bj = 0; bj < 2; ++bj) { f32x4 v0 = acc[ai][bj][m][0], v1 = acc[ai][bj][m][1];
                if (sig) {
#pragma unroll
                    for (int j = 0; j < 4; ++j) { v0[j] = sigmoid_f(v0[j]); v1[j] = sigmoid_f(v1[j]); } }
                u32x4 w; w.x = pk2(v0[0], v0[1]); w.y = pk2(v0[2], v0[3]); w.z = pk2(v1[0], v1[1]); w.w = pk2(v1[2], v1[3]);
                *(u32x4*)(rowp + bj * 128) = w; } }
}
struct EpiP1 {
    static constexpr bool PERM = true; unsigned char* ws;
    __device__ __forceinline__ void operator()(const f32x4 (&acc)[2][2][4][2], const mg::Unit& u, int wr, int wc, int fr, int fq) const {
        bf16* base; int ldc; bool sig = false;
        if (u.ty == 0) { const size_t r0 = (size_t)u.pm * 256;
            if (u.pn < 4) { base = (bf16*)(ws + WS_PQK) + r0 * 1024 + u.pn * 256; ldc = 1024; }
            else if (u.pn < 6) { base = (bf16*)(ws + WS_PV) + r0 * 512 + (u.pn - 4) * 256; ldc = 512; }
            else if (u.pn < 8) { base = (bf16*)(ws + WS_PO) + r0 * 512 + (u.pn - 6) * 256; ldc = 512; sig = true; }
            else { base = (bf16*)(ws + WS_PBR) + r0 * 2048 + (u.pn - 8) * 256; ldc = 2048; sig = true; }
        } else if (u.ty == 1) { base = (bf16*)(ws + WS_AB) + ((size_t)(u.pn >> 3) * 512 + (size_t)u.pm * 256) * 2048 + (u.pn & 7) * 256; ldc = 2048; }
        else { base = (bf16*)(ws + WS_PC) + (size_t)u.pm * 256 * 1024 + u.pn * 256; ldc = 1024; }
        store_tile_bf16(acc, base, ldc, sig, wr, wc, fr, fq);
    }
};
struct EpiF2 {
    static constexpr bool PERM = true; unsigned char* ws;
    __device__ __forceinline__ void operator()(const f32x4 (&acc)[2][2][4][2], const mg::Unit& u, int wr, int wc, int fr, int fq) const {
        bf16* fb = (bf16*)(ws + WS_FU) + (size_t)u.pn * 2048 * 512 + wc * 32 + 8 * fq;
#pragma unroll
        for (int ai = 0; ai < 2; ++ai)
#pragma unroll
            for (int m = 0; m < 4; ++m) { const int k = u.pm * 256 + ai * 128 + wr * 64 + m * 16 + fr, km = (2048 - k) & 2047;
#pragma unroll
                for (int bj = 0; bj < 2; ++bj) { const f32x4 v0 = acc[ai][bj][m][0], v1 = acc[ai][bj][m][1];
                    u32x4 w; w.x = pk2(v0[0], v0[1]); w.y = pk2(v0[2], v0[3]); w.z = pk2(v1[0], v1[1]); w.w = pk2(v1[2], v1[3]);
                    *(u32x4*)(fb + (size_t)k * 512 + bj * 128) = w; *(u32x4*)(fb + (size_t)km * 512 + 256 + bj * 128) = w; } }
    }
};
struct EpiMerge {
    static constexpr bool PERM = true; unsigned char* ws; const float* wf;
    __device__ __forceinline__ void operator()(const f32x4 (&acc)[2][2][4][2], const mg::Unit& u, int wr, int wc, int fr, int fq) const {
        const size_t row0 = (size_t)u.pm * 256 + wr * 64 + fr; const int col0 = u.pn * 256 + wc * 32 + 8 * fq;
#pragma unroll
        for (int bj = 0; bj < 2; ++bj) {
            f32x4 w64[4][2];
            if (u.ty == 0) {
#pragma unroll
                for (int g = 0; g < 4; ++g) { w64[g][0] = *(const f32x4*)(wf + (size_t)(g * 128 + 64) * 1024 + col0 + bj * 128); w64[g][1] = *(const f32x4*)(wf + (size_t)(g * 128 + 64) * 1024 + col0 + bj * 128 + 4); } }
#pragma unroll
            for (int ai = 0; ai < 2; ++ai)
#pragma unroll
                for (int m = 0; m < 4; ++m) { const size_t row = row0 + ai * 128 + m * 16;
                    bf16* mp = (bf16*)(ws + WS_MRG) + row * 1024 + col0 + bj * 128; const u32x4 g = *(const u32x4*)((const bf16*)(ws + WS_PBR) + row * 2048 + u.ty * 1024 + col0 + bj * 128);
                    f32x4 v0 = acc[ai][bj][m][0], v1 = acc[ai][bj][m][1];
                    if (u.ty == 0) { const f32x4 f4 = *(const f32x4*)((const float*)(ws + WS_F64) + row * 4);
#pragma unroll
                        for (int gg = 0; gg < 4; ++gg) { v0 += w64[gg][0] * f4[gg]; v1 += w64[gg][1] * f4[gg]; } }
                    float r[8] = {bflo(g.x) * v0[0], bfhi(g.x) * v0[1], bflo(g.y) * v0[2], bfhi(g.y) * v0[3], bflo(g.z) * v1[0], bfhi(g.z) * v1[1], bflo(g.w) * v1[2], bfhi(g.w) * v1[3]};
                    if (u.ty == 1) { const u32x4 t = *(const u32x4*)mp;
                        r[0] += bflo(t.x); r[1] += bfhi(t.x); r[2] += bflo(t.y); r[3] += bfhi(t.y); r[4] += bflo(t.z); r[5] += bfhi(t.z); r[6] += bflo(t.w); r[7] += bfhi(t.w); }
                    u32x4 w; w.x = pk2(r[0], r[1]); w.y = pk2(r[2], r[3]); w.z = pk2(r[4], r[5]); w.w = pk2(r[6], r[7]);
                    *(u32x4*)mp = w; } }
    }
};
struct EpiOut {
    static constexpr bool PERM = false; const float* x; const float* mod; float* out;
    __device__ __forceinline__ void operator()(const f32x4 (&acc)[2][2][4][2], const mg::Unit& u, int wr, int wc, int fr, int fq) const {
        const size_t row0 = (size_t)u.pm * 256 + wr * 64 + fr; const int col0 = u.pn * 256 + wc * 32 + 4 * fq; const int b = u.pm >> 3;
        f32x4 ga[2][2];
#pragma unroll
        for (int bj = 0; bj < 2; ++bj)
#pragma unroll
            for (int n = 0; n < 2; ++n) ga[bj][n] = *(const f32x4*)(mod + (size_t)b * 6144 + 2048 + col0 + bj * 128 + n * 16);
#pragma unroll
        for (int ai = 0; ai < 2; ++ai)
#pragma unroll
            for (int m = 0; m < 4; ++m) { const size_t off = (row0 + ai * 128 + m * 16) * 1024 + col0;
#pragma unroll
                for (int bj = 0; bj < 2; ++bj)
#pragma unroll
                    for (int n = 0; n < 2; ++n) { const f32x4 xv = *(const f32x4*)(x + off + bj * 128 + n * 16); *(f32x4*)(out + off + bj * 128 + n * 16) = xv + ga[bj][n] * acc[ai][bj][m][n]; } }
    }
};
struct EpiSwiglu {
    static constexpr bool PERM = true; unsigned char* ws;
    __device__ __forceinline__ void operator()(const f32x4 (&acc)[2][2][4][2], const mg::Unit& u, int wr, int wc, int fr, int fq) const {
        unsigned char* p0 = ws + WS_HID + ((size_t)u.pm * 256 + wr * 64 + fr) * 1024 + u.pn * 128 + wc * 32 + 8 * fq;
#pragma unroll
        for (int ai = 0; ai < 2; ++ai)
#pragma unroll
            for (int m = 0; m < 4; ++m) { float r[8];
#pragma unroll
                for (int n = 0; n < 2; ++n)
#pragma unroll
                    for (int j = 0; j < 4; ++j) r[n * 4 + j] = silu_f(acc[ai][0][m][n][j] * W8_INV) * (acc[ai][1][m][n][j] * W8_INV);
                u32x2 w; w.x = pk4_fp8(r[0], r[1], r[2], r[3]); w.y = pk4_fp8(r[4], r[5], r[6], r[7]);
                *(u32x2*)(p0 + (size_t)(ai * 128 + m * 16) * 1024) = w; }
    }
};
struct EpiDown {
    static constexpr bool PERM = true; unsigned char* ws;
    __device__ __forceinline__ void operator()(const f32x4 (&acc)[2][2][4][2], const mg::Unit& u, int wr, int wc, int fr, int fq) const {
        const size_t row0 = (size_t)u.pm * 256 + wr * 64 + fr; const float* val = (const float*)(ws + WS_VAL);
        bf16* p0 = (bf16*)(ws + WS_Y) + row0 * 1024 + u.pn * 256 + wc * 32 + 8 * fq;
#pragma unroll
        for (int ai = 0; ai < 2; ++ai)
#pragma unroll
            for (int m = 0; m < 4; ++m) { const float vv = val[row0 + ai * 128 + m * 16] * W8_INV; bf16* rowp = p0 + (size_t)(ai * 128 + m * 16) * 1024;
#pragma unroll
                for (int bj = 0; bj < 2; ++bj) { const f32x4 v0 = acc[ai][bj][m][0] * vv, v1 = acc[ai][bj][m][1] * vv;
                    u32x4 w; w.x = pk2(v0[0], v0[1]); w.y = pk2(v0[2], v0[3]); w.z = pk2(v1[0], v1[1]); w.w = pk2(v1[2], v1[3]);
                    *(u32x4*)(rowp + bj * 128) = w; } }
    }
};

struct SchedP1 {
    unsigned char* ws; int G, c, nrep;
    __device__ __forceinline__ bool next(int i, mg::Unit& u) const {
        int L = i * G + c; if (L >= 4736 * nrep) return false; L %= 4736; const char* H = (const char*)(ws + WS_H); u.gi = nullptr;
        if (L < 4096) { mg::tile_of(L, 256, 16, u.pm, u.pn); u.ty = 0; u.a = H + (size_t)u.pm * 256 * 2048; u.b = (const char*)(ws + WS_WTM) + (size_t)u.pn * 256 * 2048; return true; }
        L -= 4096;
        if (L < 512) { mg::tile_of(L, 2, 256, u.pm, u.pn); u.ty = 1; u.a = (const char*)(ws + WS_WTF) + (size_t)u.pm * 256 * 2048; u.b = H + (size_t)u.pn * 256 * 2048; return true; }
        L -= 512;
        if (L < 128) { mg::tile_of(L, 32, 4, u.pm, u.pn); u.ty = 2; u.a = H + ((size_t)NTOK + (size_t)u.pm * 256) * 2048; u.b = (const char*)(ws + WS_WTM) + ((size_t)512 + (size_t)u.pn * 256) * 2048; return true; }
        return false;
    }
};
struct SchedF2 {
    unsigned char* ws; int G, c, nrep;
    __device__ __forceinline__ bool next(int i, mg::Unit& u) const {
        int L = i * G + c; if (L >= 256 * nrep) return false; L %= 256; mg::tile_of(L, 8, 32, u.pm, u.pn); u.ty = 0; u.gi = nullptr;
        u.a = (const char*)(ws + WS_TT) + (size_t)u.pm * 256 * 8192; u.b = (const char*)(ws + WS_AB) + (size_t)u.pn * 256 * 8192; return true;
    }
};
struct SchedMerge {
    unsigned char* ws; int G, c, nrep;
    __device__ __forceinline__ bool next(int i, mg::Unit& u) const {
        int L = (i >> 1) * G + c; if (L >= 1024 * nrep) return false; L %= 1024; mg::tile_of(L, 256, 4, u.pm, u.pn); u.ty = i & 1; u.gi = nullptr;
        u.a = (const char*)(ws + (u.ty ? WS_HM : WS_FU)) + (size_t)u.pm * 256 * 1024; u.b = (const char*)(ws + (u.ty ? WS_WMT : WS_WFT)) + (size_t)u.pn * 256 * 1024; return true;
    }
};
struct SchedOut {
    unsigned char* ws; int G, c, nrep;
    __device__ __forceinline__ bool next(int i, mg::Unit& u) const {
        int L = i * G + c; if (L >= 1024 * nrep) return false; L %= 1024; mg::tile_of(L, 256, 4, u.pm, u.pn); u.ty = 0; u.gi = nullptr;
        u.a = (const char*)(ws + WS_MRG) + (size_t)u.pm * 256 * 2048; u.b = (const char*)(ws + WS_WOT) + (size_t)u.pn * 256 * 2048; return true;
    }
};
struct SchedUp {
    unsigned char* ws; int G, c, nrep;
    __device__ __forceinline__ bool next(int i, mg::Unit& u) const {
        int L = i * G + c; if (L >= 4096 * nrep) return false; L %= 4096; mg::tile_of(L, 512, 8, u.pm, u.pn); u.ty = 0;
        u.a = (const char*)(ws + WS_HX2); u.gi = (const int*)(ws + WS_IDX) + (size_t)u.pm * 256; u.b = (const char*)(ws + WS_WGU) + ((size_t)(u.pm >> 5) * 8 + u.pn) * 256 * 1024; return true;
    }
};
struct SchedDown {
    unsigned char* ws; int G, c, nrep;
    __device__ __forceinline__ bool next(int i, mg::Unit& u) const {
        int L = i * G + c; if (L >= 2048 * nrep) return false; L %= 2048; mg::tile_of(L, 512, 4, u.pm, u.pn); u.ty = 0;
        u.a = (const char*)(ws + WS_HID); u.gi = (const int*)(ws + WS_IDENT) + (size_t)u.pm * 256; u.b = (const char*)(ws + WS_WD) + ((size_t)(u.pm >> 5) * 4 + u.pn) * 256 * 1024; return true;
    }
};

__device__ __forceinline__ void transpose_item(const float* W, int ldw, int n0, int k0, bf16* dst, int drow0, int Kd, LAS float* scr, int lane) {
#pragma unroll 8
    for (int i = 0; i < 32; ++i) { const int kk = 2 * i + (lane >> 5); scr[kk * 33 + (lane & 31)] = W[(size_t)(k0 + kk) * ldw + n0 + (lane & 31)]; }
    asm volatile("s_waitcnt lgkmcnt(0)" ::: "memory");
    const int c = lane & 7;
#pragma unroll
    for (int j = 0; j < 4; ++j) { const int n = (lane >> 3) + 8 * j; const LAS float* s = scr + (8 * c) * 33 + n;
        u32x4 o; o.x = pk2(s[0 * 33], s[1 * 33]); o.y = pk2(s[2 * 33], s[3 * 33]); o.z = pk2(s[4 * 33], s[5 * 33]); o.w = pk2(s[6 * 33], s[7 * 33]);
        *(u32x4*)(dst + (size_t)(drow0 + n) * Kd + k0 + 8 * c) = o; }
    asm volatile("s_waitcnt lgkmcnt(0)" ::: "memory");
}

__device__ __forceinline__ void transpose_item8(const float* W, int ldw, int n0, int k0, unsigned char* dst, int drow0, int Kd, LAS float* scr, int lane) {
#pragma unroll 8
    for (int i = 0; i < 32; ++i) { const int kk = 2 * i + (lane >> 5); scr[kk * 33 + (lane & 31)] = W[(size_t)(k0 + kk) * ldw + n0 + (lane & 31)] * W8_SCALE; }
    asm volatile("s_waitcnt lgkmcnt(0)" ::: "memory");
    const int c = lane & 7;
#pragma unroll
    for (int j = 0; j < 4; ++j) { const int n = (lane >> 3) + 8 * j; const LAS float* s = scr + (8 * c) * 33 + n;
        u32x2 o; o.x = pk4_fp8(s[0 * 33], s[1 * 33], s[2 * 33], s[3 * 33]); o.y = pk4_fp8(s[4 * 33], s[5 * 33], s[6 * 33], s[7 * 33]);
        *(u32x2*)(dst + (size_t)(drow0 + n) * Kd + k0 + 8 * c) = o; }
    asm volatile("s_waitcnt lgkmcnt(0)" ::: "memory");
}

__device__ __forceinline__ void p0_prep(const Ctx& C, LAS unsigned char* lds, int tid, int lane, int wave, int G) {
    const int blk = blockIdx.x;
    for (int item = blk; item < 192; item += G) {
        LAS float* sT = (LAS float*)lds;
        for (int i = tid; i < 33 * 1024; i += 512) { const int r = i >> 10, k = i & 1023; const float v = r < 32 ? C.c[r * 1024 + k] : C.c_ctx[k]; sT[k * 36 + r] = silu_f(v); }
        for (int i = tid; i < 3 * 1024; i += 512) { const int r = 33 + (i >> 10), k = i & 1023; sT[k * 36 + r] = 0.f; }
        __syncthreads();
        const int col0 = item * 32, kg = tid >> 5, j = tid & 31;
        float acc[36];
#pragma unroll
        for (int r = 0; r < 36; ++r) acc[r] = 0.f;
#pragma unroll 4
        for (int kk = 0; kk < 64; ++kk) { const int k = kg * 64 + kk; const float w = C.w_ada[(size_t)k * 6144 + col0 + j];
#pragma unroll
            for (int q = 0; q < 9; ++q) { const f32x4 s4 = *(const LAS f32x4*)(sT + k * 36 + 4 * q); acc[4 * q] += s4[0] * w; acc[4 * q + 1] += s4[1] * w; acc[4 * q + 2] += s4[2] * w; acc[4 * q + 3] += s4[3] * w; } }
        __syncthreads();
        LAS float* red = (LAS float*)lds;
#pragma unroll
        for (int r = 0; r < 33; ++r) red[(kg * 33 + r) * 32 + j] = acc[r];
        __syncthreads();
        float* mod = (float*)(C.ws + WS_MOD);
        for (int o = tid; o < 33 * 32; o += 512) { const int r = o >> 5, jj = o & 31; float s = 0.f;
#pragma unroll
            for (int g = 0; g < 16; ++g) s += red[(g * 33 + r) * 32 + jj];
            mod[(size_t)r * 6144 + col0 + jj] = s + C.b_ada[col0 + jj]; }
        __syncthreads();
    }
    for (int item = blk; item < 256; item += G) {
        LAS float* wl = (LAS float*)lds; LAS float* cs = wl + 16 * 128; LAS float* sn = cs + 128;
        const int g = item >> 6, d0 = (item & 63) * 16;
        for (int i = tid; i < 16 * 128; i += 512) { const int dd = i >> 7, cc = i & 127; wl[i] = C.w_in[(size_t)(d0 + dd) * INC + g * 128 + cc]; }
        if (tid < 128) { cs[tid] = cospif((float)tid * (1.f / 64.f)); sn[tid] = sinpif((float)tid * (1.f / 64.f)); }
        __syncthreads();
        const int rj = tid & 127, j = rj >> 1, ab = rj & 1, qd = tid >> 7;
        float acc[4] = {0.f, 0.f, 0.f, 0.f};
        const LAS float* tw = ab ? sn : cs;
        for (int cc = 0; cc < 128; ++cc) { const float t = tw[(j * cc) & 127];
#pragma unroll
            for (int i = 0; i < 4; ++i) acc[i] += wl[(qd * 4 + i) * 128 + cc] * t; }
        u32x2 o; o.x = pk2(acc[0], acc[1]); o.y = pk2(acc[2], acc[3]);
        *(u32x2*)((bf16*)(C.ws + WS_WTF) + (size_t)(g * 128 + rj) * 1024 + d0 + qd * 4) = o;
        if (tid < 16) { float sacc = 0.f; for (int cc = 0; cc < 128; ++cc) sacc += (cc & 1) ? -wl[tid * 128 + cc] : wl[tid * 128 + cc]; ((float*)(C.ws + WS_W64))[(d0 + tid) * 4 + g] = sacc; }
        __syncthreads();
    }
    {
        LAS float* tc = (LAS float*)lds; LAS float* ts = tc + 2048;
        for (int i = tid; i < 2048; i += 512) { const float a = (float)i * (1.f / 1024.f); tc[i] = cospif(a) * (1.f / 512.f); ts[i] = -sinpif(a) * (1.f / 512.f); }
        __syncthreads();
        for (int item = blk; item < 256; item += G)
            for (int rr = 0; rr < 8; ++rr) { const int k = item * 8 + rr; const int lp0 = tid * 8; const LAS float* tb = lp0 < 2048 ? tc : ts; const int l0 = lp0 & 2047; float v[8];
#pragma unroll
                for (int e = 0; e < 8; ++e) v[e] = tb[(k * (l0 + e)) & 2047];
                u32x4 o; o.x = pk2(v[0], v[1]); o.y = pk2(v[2], v[3]); o.z = pk2(v[4], v[5]); o.w = pk2(v[6], v[7]);
                *(u32x4*)((bf16*)(C.ws + WS_TT) + (size_t)k * 4096 + lp0) = o; }
        __syncthreads();
    }
    {
        LAS float* scr = (LAS float*)lds + wave * (64 * 33);
        const int gw = blk * 8 + wave, NGW = G * 8;
        constexpr int I_IN = 16 * 128, I_M = 8 * 32, I_O = 16 * 32;
        for (int it = gw; it < I_IN + I_M + I_O; it += NGW) {
            int r = it;
            if (r < I_IN) { const int kb = r >> 7, nb = r & 127; const int n0 = nb < 64 ? 512 + 32 * nb : 2576 + 32 * (nb - 64);
                transpose_item(C.w_in, INC, n0, kb * 64, (bf16*)(C.ws + WS_WTM), 32 * nb, 1024, scr, lane); continue; }
            r -= I_IN;
            if (r < I_M) { const int kb = r >> 5, nb = r & 31; transpose_item(C.w_mlstm, 1024, 32 * nb, kb * 64, (bf16*)(C.ws + WS_WMT), 32 * nb, 512, scr, lane); continue; }
            r -= I_M;
            { const int kb = r >> 5, nb = r & 31; transpose_item(C.w_out, 1024, 32 * nb, kb * 64, (bf16*)(C.ws + WS_WOT), 32 * nb, 1024, scr, lane); }
        }
        for (int idx = blk * 512 + tid; idx < 1024 * 64; idx += G * 512) { const int n = idx >> 6, k0 = (idx & 63) * 8; float v[8];
#pragma unroll
            for (int e = 0; e < 8; ++e) { const int kp = k0 + e, kk = kp & 255, gg = kk >> 6, j = kk & 63; const int src = kp < 256 ? gg * 128 + j : (j ? gg * 128 + 128 - j : -1); v[e] = src >= 0 ? C.w_fourier[(size_t)src * 1024 + n] : 0.f; }
            u32x4 o; o.x = pk2(v[0], v[1]); o.y = pk2(v[2], v[3]); o.z = pk2(v[4], v[5]); o.w = pk2(v[6], v[7]);
            *(u32x4*)((bf16*)(C.ws + WS_WFT) + (size_t)n * 512 + k0) = o; }
    }
}
__device__ __forceinline__ void convert_experts(const Ctx& C, LAS unsigned char* lds, int lane, int wave, int G, int rep) {
    LAS float* scr = (LAS float*)lds + wave * (64 * 33);
    const int gw = blockIdx.x * 8 + wave, NGW = G * 8;
    for (int it0 = gw; it0 < 48 * 512 * rep; it0 += NGW) { const int it = it0 % (48 * 512);
        const int mat = it >> 9, r = it & 511, kb = r >> 5, nb = r & 31, e = mat & 15, which = mat >> 4;
        if (which < 2) { const float* W = (which ? C.w_up_e : C.w_gate_e) + (size_t)e * 1024 * 1024; const int n0 = 32 * nb;
            transpose_item8(W, 1024, n0, kb * 64, C.ws + WS_WGU, e * 2048 + (n0 >> 7) * 256 + which * 128 + (n0 & 127), 1024, scr, lane); }
        else transpose_item8(C.w_down_e + (size_t)e * 1024 * 1024, 1024, 32 * nb, kb * 64, C.ws + WS_WD, e * 1024 + 32 * nb, 1024, scr, lane);
    }
}

__device__ __forceinline__ float butterfly64(float (&v)[64], int lane) {
#pragma unroll
    for (int i = 0; i < 32; ++i) { const bool up = lane & 32; const float send = up ? v[i] : v[i + 32], keep = up ? v[i + 32] : v[i]; v[i] = keep + __shfl_xor(send, 32); }
#pragma unroll
    for (int i = 0; i < 16; ++i) { const bool up = lane & 16; const float send = up ? v[i] : v[i + 16], keep = up ? v[i + 16] : v[i]; v[i] = keep + __shfl_xor(send, 16); }
#pragma unroll
    for (int i = 0; i < 8; ++i) { const bool up = lane & 8; const float send = up ? v[i] : v[i + 8], keep = up ? v[i + 8] : v[i]; v[i] = keep + __shfl_xor(send, 8); }
#pragma unroll
    for (int i = 0; i < 4; ++i) { const bool up = lane & 4; const float send = up ? v[i] : v[i + 4], keep = up ? v[i + 4] : v[i]; v[i] = keep + __shfl_xor(send, 4); }
#pragma unroll
    for (int i = 0; i < 2; ++i) { const bool up = lane & 2; const float send = up ? v[i] : v[i + 2], keep = up ? v[i + 2] : v[i]; v[i] = keep + __shfl_xor(send, 2); }
    { const bool up = lane & 1; const float send = up ? v[0] : v[1], keep = up ? v[1] : v[0]; v[0] = keep + __shfl_xor(send, 1); }
    return v[0];
}

__device__ __forceinline__ float butterfly16(float (&v)[16], int lane) {
#pragma unroll
    for (int i = 0; i < 8; ++i) { const bool up = lane & 32; const float send = up ? v[i] : v[i + 8], keep = up ? v[i + 8] : v[i]; v[i] = keep + __shfl_xor(send, 32); }
#pragma unroll
    for (int i = 0; i < 4; ++i) { const bool up = lane & 16; const float send = up ? v[i] : v[i + 4], keep = up ? v[i + 4] : v[i]; v[i] = keep + __shfl_xor(send, 16); }
#pragma unroll
    for (int i = 0; i < 2; ++i) { const bool up = lane & 8; const float send = up ? v[i] : v[i + 2], keep = up ? v[i + 2] : v[i]; v[i] = keep + __shfl_xor(send, 8); }
    { const bool up = lane & 4; const float send = up ? v[0] : v[1], keep = up ? v[1] : v[0]; v[0] = keep + __shfl_xor(send, 4); }
    v[0] += __shfl_xor(v[0], 2); v[0] += __shfl_xor(v[0], 1);
    return v[0];
}
template <bool OUT8, bool PROJ4> __device__ __forceinline__ float rows4_norm_proj(const float* xin, size_t row0, const f32x4 (&gsc)[4], const f32x4 (&sh)[4], bf16* hout, const LAS float* wl, const LAS float* wl2, float& p4, int lane) {
    f32x4 v[4][4]; float ss[4];
#pragma unroll
    for (int r = 0; r < 4; ++r) { ss[r] = 0.f;
#pragma unroll
        for (int j = 0; j < 4; ++j) { v[r][j] = *(const f32x4*)(xin + (row0 + r) * 1024 + 4 * lane + 256 * j); ss[r] += v[r][j][0] * v[r][j][0] + v[r][j][1] * v[r][j][1] + v[r][j][2] * v[r][j][2] + v[r][j][3] * v[r][j][3]; } }
#pragma unroll
    for (int r = 0; r < 4; ++r) { const float rstd = rsqrtf(wave_sum(ss[r]) * (1.f / 1024.f) + EPS);
#pragma unroll
        for (int j = 0; j < 4; ++j) { v[r][j] = v[r][j] * rstd * gsc[j] + sh[j];
            if constexpr (OUT8) *(unsigned*)((unsigned char*)hout + (row0 + r) * 1024 + 4 * lane + 256 * j) = pk4_fp8(v[r][j][0], v[r][j][1], v[r][j][2], v[r][j][3]);
            else { u32x2 w; w.x = pk2(v[r][j][0], v[r][j][1]); w.y = pk2(v[r][j][2], v[r][j][3]); *(u32x2*)(hout + (row0 + r) * 1024 + 4 * lane + 256 * j) = w; } } }
    float acc[64], acc2[16];
#pragma unroll
    for (int i = 0; i < 64; ++i) acc[i] = 0.f;
#pragma unroll
    for (int i = 0; i < 16; ++i) acc2[i] = 0.f;
#pragma unroll
    for (int j = 0; j < 4; ++j)
#pragma unroll
        for (int e = 0; e < 4; ++e) { const LAS float* wp = wl + ((j * 4 + e) * 4) * 256 + lane * 4;
            if constexpr (PROJ4) { const f32x4 wb = *(const LAS f32x4*)(wl2 + ((j * 4 + e) * 64 + lane) * 4);
#pragma unroll
                for (int r = 0; r < 4; ++r) { const float hv = v[r][j][e]; acc2[r * 4] += hv * wb[0]; acc2[r * 4 + 1] += hv * wb[1]; acc2[r * 4 + 2] += hv * wb[2]; acc2[r * 4 + 3] += hv * wb[3]; } }
#pragma unroll
            for (int q = 0; q < 4; ++q) { const f32x4 w4 = *(const LAS f32x4*)(wp + q * 256);
#pragma unroll
                for (int r = 0; r < 4; ++r) { const float hv = v[r][j][e]; acc[r * 16 + 4 * q] += hv * w4[0]; acc[r * 16 + 4 * q + 1] += hv * w4[1]; acc[r * 16 + 4 * q + 2] += hv * w4[2]; acc[r * 16 + 4 * q + 3] += hv * w4[3]; } }
            asm volatile("" ::: "memory"); }
    if constexpr (PROJ4) p4 = butterfly16(acc2, lane);
    return butterfly64(acc, lane);
}

__device__ __forceinline__ void p1a_norm_gates(const Ctx& C, LAS unsigned char* lds, int tid, int lane, int wave, int G, int rep2) {
    LAS float* wl = (LAS float*)lds;
    for (int i = tid; i < 1024 * 16; i += 512) { const int col = i >> 4, gc = i & 15; wl[(((((col >> 8) * 4 + (col & 3)) * 4 + (gc >> 2)) * 64 + ((col >> 2) & 63)) * 4) + (gc & 3)] = C.w_in[(size_t)col * INC + OFF_G + gc]; }
    LAS float* wl2 = wl + 1024 * 16;
    for (int i = tid; i < 1024 * 4; i += 512) { const int col = i >> 2, gg = i & 3; wl2[((((col >> 8) * 4 + (col & 3)) * 64 + ((col >> 2) & 63)) * 4) + gg] = ((const float*)(C.ws + WS_W64))[i]; }
    __syncthreads();
    const float* mod = (const float*)(C.ws + WS_MOD); bf16* H = (bf16*)(C.ws + WS_H); float* gates = (float*)(C.ws + WS_GATES); bf16* a64t = (bf16*)(C.ws + WS_A64T);
    const int NGW = G * 8;
    for (int gw0 = blockIdx.x * 8 + wave; gw0 < 2048 * (1 + rep2); gw0 += NGW) { const int gw = gw0 & 2047;
        f32x4 gsc[4], sh[4];
        {   const int b = gw >> 6; const float* m = mod + (size_t)b * 6144;
#pragma unroll
            for (int j = 0; j < 4; ++j) { const int col = 4 * lane + 256 * j; const f32x4 g = *(const f32x4*)(C.g_norm1 + col), s = *(const f32x4*)(m + 1024 + col); gsc[j] = g * (s + 1.f); sh[j] = *(const f32x4*)(m + col); }
            for (int q = 0; q < 8; ++q) { const size_t row0 = (size_t)gw * 32 + q * 4; float p4; const float gv = rows4_norm_proj<false, true>(C.x, row0, gsc, sh, H, wl, wl2, p4, lane); gates[(row0 + (lane >> 4)) * 16 + (lane & 15)] = gv;
                if ((lane & 3) == 0) { const int idx = lane >> 2; const size_t row = row0 + (idx >> 2); a64t[((row >> 11) * 4 + (idx & 3)) * 2048 + (row & 2047)] = (bf16)(pk2(p4, 0.f) & 0xffffu); } } }
        {   const float* m = mod + (size_t)32 * 6144;
#pragma unroll
            for (int j = 0; j < 4; ++j) { const int col = 4 * lane + 256 * j; const f32x4 g = *(const f32x4*)(C.g_norm1 + col), s = *(const f32x4*)(m + 1024 + col); gsc[j] = g * (s + 1.f); sh[j] = *(const f32x4*)(m + col); }
            const size_t row0 = (size_t)gw * 4; float p4; const float gv = rows4_norm_proj<false, false>(C.ctx, row0, gsc, sh, H + (size_t)NTOK * 1024, wl, wl2, p4, lane); gates[((size_t)NTOK + row0 + (lane >> 4)) * 16 + (lane & 15)] = gv; }
    }
}

__device__ __forceinline__ f32x4 unpk4(u32x2 p) { return (f32x4){bflo(p.x), bfhi(p.x), bflo(p.y), bfhi(p.y)}; }
__device__ __forceinline__ void conv_item_x(const Ctx& C, int item, int lane) {
    const int qt = item & 3, cb = (item >> 2) & 3, r = (item >> 4) & 31, b = item >> 9;
    const int ch0 = cb * 256 + 4 * lane; const bf16* src = (const bf16*)(C.ws + WS_PQK) + (size_t)b * SEQ * 1024 + ch0; bf16* dst = (bf16*)(C.ws + WS_QK) + (size_t)b * SEQ * 1024 + ch0;
    const int c0 = qt * 16;
    u32x2 raw[3][18];
#pragma unroll
    for (int dy = 0; dy < 3; ++dy) { const int rr = r + dy - 1; const bool rok = rr >= 0 && rr < 32;
#pragma unroll
        for (int i = 0; i < 18; ++i) { const int cc = c0 - 1 + i; raw[dy][i] = (rok && cc >= 0 && cc < 64) ? *(const u32x2*)(src + (size_t)(rr * 64 + cc) * 1024) : (u32x2){0u, 0u}; } }
    f32x4 w[3][3];
#pragma unroll
    for (int dy = 0; dy < 3; ++dy)
#pragma unroll
        for (int dx = 0; dx < 3; ++dx) w[dy][dx] = *(const f32x4*)(C.w_conv + (dy * 3 + dx) * 1024 + ch0);
    const float ksc = cb >= 2 ? 0.08838834764831845f : 1.f;
#pragma unroll
    for (int i = 0; i < 16; ++i) { f32x4 a = {0.f, 0.f, 0.f, 0.f};
#pragma unroll
        for (int dy = 0; dy < 3; ++dy)
#pragma unroll
            for (int dx = 0; dx < 3; ++dx) a += w[dy][dx] * unpk4(raw[dy][i + dx]);
        u32x2 o; o.x = pk2(silu_f(a[0]) * ksc, silu_f(a[1]) * ksc); o.y = pk2(silu_f(a[2]) * ksc, silu_f(a[3]) * ksc);
        *(u32x2*)(dst + (size_t)(r * 64 + c0 + i) * 1024) = o; }
}
__device__ __forceinline__ void conv_item_ctx(const Ctx& C, int item, int lane) {
    const int sg = item & 15, cb = (item >> 4) & 1, b = item >> 5;
    const int kc0 = cb * 256 + 4 * lane; const bf16* src = (const bf16*)(C.ws + WS_PC) + (size_t)b * CL * 1024 + kc0; bf16* dst = (bf16*)(C.ws + WS_KC) + (size_t)b * CL * 512 + kc0;
    const int c0 = sg * 16;
    u32x2 raw[18];
#pragma unroll
    for (int i = 0; i < 18; ++i) { const int cc = c0 - 1 + i; raw[i] = (cc >= 0 && cc < CL) ? *(const u32x2*)(src + (size_t)cc * 1024) : (u32x2){0u, 0u}; }
    f32x4 w[3];
#pragma unroll
    for (int dx = 0; dx < 3; ++dx) w[dx] = *(const f32x4*)(C.w_conv + (3 + dx) * 1024 + 512 + kc0);
    const float ksc = 0.08838834764831845f;
#pragma unroll
    for (int i = 0; i < 16; ++i) { const f32x4 a = w[0] * unpk4(raw[i]) + w[1] * unpk4(raw[i + 1]) + w[2] * unpk4(raw[i + 2]);
        u32x2 o; o.x = pk2(silu_f(a[0]) * ksc, silu_f(a[1]) * ksc); o.y = pk2(silu_f(a[2]) * ksc, silu_f(a[3]) * ksc);
        *(u32x2*)(dst + (size_t)(c0 + i) * 512) = o; }
}
__device__ __forceinline__ void f64_tile(const Ctx& C, int tile, int lane) {
    const int kt = tile >> 3, nt8 = tile & 7, i = lane & 15, g4 = lane >> 4;
    const bf16* ap = (const bf16*)(C.ws + WS_TT) + (size_t)(16 * kt + i) * 4096 + 8 * g4; const bf16* bp = (const bf16*)(C.ws + WS_A64T) + (size_t)(16 * nt8 + i) * 2048 + 8 * g4;
    f32x4 acc = {0.f, 0.f, 0.f, 0.f};
#pragma unroll 8
    for (int ks = 0; ks < 64; ++ks) acc = __builtin_amdgcn_mfma_f32_16x16x32_bf16(*(const bf16x8*)(ap + 32 * ks), *(const bf16x8*)(bp + 32 * ks), acc, 0, 0, 0);
    const int n = 16 * nt8 + i; float* f64 = (float*)(C.ws + WS_F64) + ((size_t)(n >> 2) * 2048 + 16 * kt + 4 * g4) * 4 + (n & 3);
#pragma unroll
    for (int r = 0; r < 4; ++r) f64[r * 4] = acc[r];
}
__device__ __forceinline__ void p2_conv(const Ctx& C, int lane, int wave, int G, int rep2) {
    const int NGW = G * 8;
    for (int it = blockIdx.x * 8 + wave; it < 1024; it += NGW) f64_tile(C, it, lane);
    for (int it0 = blockIdx.x * 8 + wave; it0 < (NB * 512 + NB * 32) * (1 + rep2); it0 += NGW) { const int it = it0 % (NB * 512 + NB * 32); if (it < NB * 512) conv_item_x(C, it, lane); else conv_item_ctx(C, it - NB * 512, lane); }
}

__device__ __forceinline__ void p3b_combine(const Ctx& C, int tid, int G, int rep2) {
    const u32x4* po = (const u32x4*)(C.ws + WS_PO); const u32x4* hf = (const u32x4*)(C.ws + WS_HF); const u32x4* hb = (const u32x4*)(C.ws + WS_HB); u32x4* hm = (u32x4*)(C.ws + WS_HM);
    const size_t n = (size_t)NTOK * 512 / 8;
    for (size_t i0 = (size_t)blockIdx.x * 512 + tid; i0 < n * (1 + rep2); i0 += (size_t)G * 512) { const size_t i = i0 >= n ? i0 - n : i0; const u32x4 o = po[i], a = hf[i], b = hb[i]; u32x4 r;
        r.x = pk2(bflo(o.x) * (bflo(a.x) + bflo(b.x)), bfhi(o.x) * (bfhi(a.x) + bfhi(b.x))); r.y = pk2(bflo(o.y) * (bflo(a.y) + bflo(b.y)), bfhi(o.y) * (bfhi(a.y) + bfhi(b.y)));
        r.z = pk2(bflo(o.z) * (bflo(a.z) + bflo(b.z)), bfhi(o.z) * (bfhi(a.z) + bfhi(b.z))); r.w = pk2(bflo(o.w) * (bflo(a.w) + bflo(b.w)), bfhi(o.w) * (bfhi(a.w) + bfhi(b.w)));
        hm[i] = r; }
}

__device__ __forceinline__ void p6_norm_router(const Ctx& C, LAS unsigned char* lds, int tid, int lane, int wave, int G, int rep2) {
    LAS float* wl = (LAS float*)lds;
    for (int i = tid; i < 1024 * 16; i += 512) { const int col = i >> 4, gc = i & 15; wl[(((((col >> 8) * 4 + (col & 3)) * 4 + (gc >> 2)) * 64 + ((col >> 2) & 63)) * 4) + (gc & 3)] = C.w_router[i]; }
    __syncthreads();
    const float* mod = (const float*)(C.ws + WS_MOD); bf16* HX2 = (bf16*)(C.ws + WS_HX2); float* aff = (float*)(C.ws + WS_AFF);
    const int NGW = G * 8;
    for (int gw0 = blockIdx.x * 8 + wave; gw0 < 2048 * (1 + rep2); gw0 += NGW) { const int gw = gw0 & 2047;
        f32x4 gsc[4], sh[4]; const int b = gw >> 6; const float* m = mod + (size_t)b * 6144;
#pragma unroll
        for (int j = 0; j < 4; ++j) { const int col = 4 * lane + 256 * j; const f32x4 g = *(const f32x4*)(C.g_norm2 + col), s = *(const f32x4*)(m + 4096 + col); gsc[j] = g * (s + 1.f); sh[j] = *(const f32x4*)(m + 3072 + col); }
        for (int q = 0; q < 8; ++q) { const size_t row0 = (size_t)gw * 32 + q * 4; float p4; const float lg = rows4_norm_proj<true, false>(C.out, row0, gsc, sh, HX2, wl, wl, p4, lane);
            float mx = lg;
#pragma unroll
            for (int o = 1; o < 16; o <<= 1) mx = fmaxf(mx, __shfl_xor(mx, o));
            const float ex = expf(lg - mx); float sm = ex;
#pragma unroll
            for (int o = 1; o < 16; o <<= 1) sm += __shfl_xor(sm, o);
            const size_t t = (row0 + (lane >> 4)) & (SEQ - 1);
            aff[((size_t)b * NE + (lane & 15)) * SEQ + t] = ex / sm; }
    }
}

__device__ __forceinline__ unsigned wave_sum_u(unsigned v) {
#pragma unroll
    for (int o = 1; o < 64; o <<= 1) v += __shfl_xor(v, o);
    return v;
}
__device__ __forceinline__ unsigned wave_excl_scan_u(unsigned v, int lane) { unsigned s = v;
#pragma unroll
    for (int o = 1; o < 64; o <<= 1) { const unsigned t = __shfl_up(s, o); if (lane >= o) s += t; }
    return s - v;
}
__device__ __forceinline__ void topk_item(const Ctx& C, int item, int lane) {
    const int b = item >> 4, e = item & 15; const float* a = (const float*)(C.ws + WS_AFF) + ((size_t)b * NE + e) * SEQ + 32 * lane;
    unsigned key[32];
#pragma unroll
    for (int q = 0; q < 8; ++q) { const u32x4 v = *(const u32x4*)(a + 4 * q); key[4 * q] = v.x; key[4 * q + 1] = v.y; key[4 * q + 2] = v.z; key[4 * q + 3] = v.w; }
    unsigned T = 0u;
    for (int bit = 30; bit >= 0; --bit) { const unsigned cand = T | (1u << bit); unsigned cnt = 0u;
#pragma unroll
        for (int i = 0; i < 32; ++i) cnt += key[i] >= cand ? 1u : 0u;
        if (wave_sum_u(cnt) >= (unsigned)CAP) T = cand; }
    unsigned ngt = 0u, neq = 0u;
#pragma unroll
    for (int i = 0; i < 32; ++i) { ngt += key[i] > T ? 1u : 0u; neq += key[i] == T ? 1u : 0u; }
    const unsigned need = (unsigned)CAP - wave_sum_u(ngt);
    unsigned tie_before = wave_excl_scan_u(neq, lane);
    unsigned nsel = 0u; unsigned selmask = 0u;
#pragma unroll
    for (int i = 0; i < 32; ++i) { bool s = key[i] > T; if (key[i] == T) { s = tie_before < need; ++tie_before; } if (s) { selmask |= 1u << i; ++nsel; } }
    unsigned slot = wave_excl_scan_u(nsel, lane);
    const int pm = e * 32 + b; int* idx = (int*)(C.ws + WS_IDX) + (size_t)pm * CAP; float* val = (float*)(C.ws + WS_VAL) + (size_t)pm * CAP; bf16* sl = (bf16*)(C.ws + WS_SLOT);
#pragma unroll
    for (int i = 0; i < 32; ++i) { const int t = 32 * lane + i; const bool s = (selmask >> i) & 1u;
        if (s) { idx[slot] = b * SEQ + t; val[slot] = __uint_as_float(key[i]); }
        sl[((size_t)b * SEQ + t) * NE + e] = s ? (bf16)slot : (bf16)0xffffu; if (s) ++slot; }
}

__device__ __forceinline__ void p10_final(const Ctx& C, int lane, int wave, int G) {
    const float* mod = (const float*)(C.ws + WS_MOD); const bf16* Y = (const bf16*)(C.ws + WS_Y); const bf16* sl = (const bf16*)(C.ws + WS_SLOT);
    const int NGW = G * 8;
    for (int gw = blockIdx.x * 8 + wave; gw < 2048; gw += NGW) { const int b = gw >> 6; const float* m = mod + (size_t)b * 6144 + 5120;
        f32x4 ga[4], gf[4];
#pragma unroll
        for (int j = 0; j < 4; ++j) { ga[j] = *(const f32x4*)(m + 4 * lane + 256 * j); gf[j] = *(const f32x4*)(C.g_final + 4 * lane + 256 * j); }
        for (int q = 0; q < 32; ++q) { const size_t row = (size_t)gw * 32 + q; f32x4 v[4], a[4];
#pragma unroll
            for (int j = 0; j < 4; ++j) { v[j] = *(const f32x4*)(C.out + row * 1024 + 4 * lane + 256 * j); a[j] = (f32x4){0.f, 0.f, 0.f, 0.f}; }
            const unsigned myslot = lane < NE ? (unsigned)sl[row * NE + lane] : 0xffffu;
            for (int e = 0; e < NE; ++e) { const unsigned s = __builtin_amdgcn_readlane(myslot, e); if (s != 0xffffu) { const bf16* yr = Y + ((size_t)(e * 32 + b) * CAP + s) * 1024 + 4 * lane;
#pragma unroll
                for (int j = 0; j < 4; ++j) { const u32x2 p = *(const u32x2*)(yr + 256 * j); a[j] += (f32x4){bflo(p.x), bfhi(p.x), bflo(p.y), bfhi(p.y)}; } } }
            float ss = 0.f;
#pragma unroll
            for (int j = 0; j < 4; ++j) { v[j] = v[j] + ga[j] * a[j]; ss += v[j][0] * v[j][0] + v[j][1] * v[j][1] + v[j][2] * v[j][2] + v[j][3] * v[j][3]; }
            const float rstd = rsqrtf(wave_sum(ss) * (1.f / 1024.f) + EPS);
#pragma unroll
            for (int j = 0; j < 4; ++j) *(f32x4*)(C.out + row * 1024 + 4 * lane + 256 * j) = v[j] * rstd * gf[j]; }
    }
}
namespace ml {
typedef short v4i16_t __attribute__((ext_vector_type(4)));
constexpr int QS = 0, KS = 16384, VS = 32768, CT = 49152, SS = 81920, SM = 90112;
constexpr int U_ = 0, M_ = 64, DEC_ = 128, EM_ = 192, WA_ = 256, QN_ = 320, RS_ = 384, N_ = 512, SC_ = 640;
__device__ __forceinline__ unsigned off_b(unsigned row, unsigned ch) { return 256u * row + 16u * (ch ^ (((row & 3) << 2) | ((row >> 2) & 3))); }
__device__ __forceinline__ unsigned off_s(unsigned row, unsigned ch) { return 128u * row + 16u * (ch ^ (row & 7)); }
__device__ __forceinline__ bf16x8 rowfrag(const LAS unsigned char* tile, int rb, int ks, int lane) { return *(const LAS bf16x8*)(tile + off_b(16 * rb + (lane & 15), 4 * ks + (lane >> 4))); }
__device__ __forceinline__ bf16x8 trfrag(const LAS unsigned char* tile, int c, int ks, int lane) {
    const unsigned g = lane >> 4, q = (lane & 15) >> 2, p = lane & 3;
    const unsigned a0 = off_b(32 * ks + 8 * g + q, 2 * c + (p >> 1)) + 8 * (p & 1), a1 = off_b(32 * ks + 8 * g + 4 + q, 2 * c + (p >> 1)) + 8 * (p & 1);
    const v4i16_t lo = __builtin_amdgcn_ds_read_tr16_b64_v4i16((LAS v4i16_t*)(tile + a0)), hi = __builtin_amdgcn_ds_read_tr16_b64_v4i16((LAS v4i16_t*)(tile + a1));
    bf16x8 r; r[0] = lo[0]; r[1] = lo[1]; r[2] = lo[2]; r[3] = lo[3]; r[4] = hi[0]; r[5] = hi[1]; r[6] = hi[2]; r[7] = hi[3]; return r;
}
__device__ __forceinline__ float scan_add(float v, int lane, int dir) {
#pragma unroll
    for (int d = 1; d < 64; d <<= 1) { const float t = dir ? __shfl_down(v, d) : __shfl_up(v, d); if (dir ? (lane + d < 64) : (lane >= d)) v += t; }
    return v;
}
__device__ __forceinline__ float scan_max(float v, int lane, int dir) {
#pragma unroll
    for (int d = 1; d < 64; d <<= 1) { const float t = dir ? __shfl_down(v, d) : __shfl_up(v, d); if (dir ? (lane + d < 64) : (lane >= d)) v = fmaxf(v, t); }
    return v;
}
__device__ __forceinline__ void gate_math(float ig, float fg, int lane, int dir, float& m0, LAS float* sm) {
    const float fl = log_sigmoid_f(fg);
    const float cum = scan_add(fl, lane, dir);
    const float u = ig - cum;
    const float pmx = scan_max(u, lane, dir);
    const int endl = dir ? 0 : 63;
    const float tot = __shfl(cum, endl), umax = __shfl(pmx, endl);
    const float M = fmaxf(m0, pmx);
    const float mn = fmaxf(tot + m0, tot + umax);
    sm[U_ + lane] = u; sm[M_ + lane] = M; sm[DEC_ + lane] = expf(m0 - M); sm[EM_ + lane] = expf(-(cum + M)); sm[WA_ + lane] = expf(tot + u - mn);
    if (lane == 0) sm[SC_] = expf(tot + m0 - mn);
    m0 = mn;
}

__device__ __forceinline__ void mlstm_phase(const Ctx& C, LAS unsigned char* lds, int tid, int lane, int wave, int G, int rep2) {
    LAS float* sm = (LAS float*)(lds + SM);
    const bf16* QK = (const bf16*)(C.ws + WS_QK); const bf16* KC = (const bf16*)(C.ws + WS_KC); const bf16* PV = (const bf16*)(C.ws + WS_PV); const bf16* PC = (const bf16*)(C.ws + WS_PC);
    const float* gates = (const float*)(C.ws + WS_GATES);
    for (int item0 = blockIdx.x; item0 < 256 * (1 + rep2); item0 += G) { const int item = item0 & 255;
        const int dir = item & 1, h = (item >> 1) & 3, b = item >> 3;
        bf16* Hout = (bf16*)(C.ws + (dir ? WS_HB : WS_HF));
        const int kI = dir ? 2 : 0, kF = dir ? 3 : 1; const float bI = C.b_gates[kI * 4 + h], bF = C.b_gates[kF * 4 + h];
        for (int i = tid; i < 32768 / 16; i += 512) *(LAS u32x4*)(lds + CT + i * 16) = (u32x4){0u, 0u, 0u, 0u};
        if (tid < 128) sm[N_ + tid] = 0.f;
        f32x4 Cacc[8];
#pragma unroll
        for (int t = 0; t < 8; ++t) Cacc[t] = (f32x4){0.f, 0.f, 0.f, 0.f};
        float m0 = 0.f;
        u32x4 pq[2], pk[2], pv[2]; float pig = 0.f, pfg = 0.f;
#define ML_ISSUE(step_) do { const int _st = (step_); const bool _isx = _st >= 4; const int _cc = _isx ? (dir ? 35 - _st : _st - 4) : (dir ? 3 - _st : _st); \
            _Pragma("unroll") for (int _i = 0; _i < 2; ++_i) { const int _idx = tid + 512 * _i, _row = _idx >> 4, _ch = _idx & 15; \
                if (_isx) { const size_t _tok = (size_t)b * SEQ + _cc * 64 + _row; pq[_i] = *(const u32x4*)(QK + _tok * 1024 + h * 128 + _ch * 8); pk[_i] = *(const u32x4*)(QK + _tok * 1024 + 512 + h * 128 + _ch * 8); pv[_i] = *(const u32x4*)(PV + _tok * 512 + h * 128 + _ch * 8); } \
                else { const size_t _tok = (size_t)b * CL + _cc * 64 + _row; pk[_i] = *(const u32x4*)(KC + _tok * 512 + h * 128 + _ch * 8); pv[_i] = *(const u32x4*)(PC + _tok * 1024 + 512 + h * 128 + _ch * 8); pq[_i] = pk[_i]; } } \
            if (wave == 0) { const size_t _tok = _isx ? (size_t)b * SEQ + _cc * 64 + lane : (size_t)NTOK + (size_t)b * CL + _cc * 64 + lane; pig = gates[_tok * 16 + kI * 4 + h] + bI; pfg = gates[_tok * 16 + kF * 4 + h] + bF; } } while (0)
#define ML_COMMIT() do { \
            _Pragma("unroll") for (int _i = 0; _i < 2; ++_i) { const int _idx = tid + 512 * _i, _row = _idx >> 4, _ch = _idx & 15; const unsigned _o = off_b(_row, _ch); \
                *(LAS u32x4*)(lds + QS + _o) = pq[_i]; *(LAS u32x4*)(lds + KS + _o) = pk[_i]; *(LAS u32x4*)(lds + VS + _o) = pv[_i]; } \
            if (wave == 0) gate_math(pig, pfg, lane, dir, m0, sm); } while (0)
        ML_ISSUE(0);
        __syncthreads();
        ML_COMMIT();
        __syncthreads();
        const int g = lane >> 4, li = lane & 15;
        for (int step = 0; step < 36; ++step) {
            const bool isx = step >= 4; const int cc = isx ? (dir ? 35 - step : step - 4) : 0;
            if (!isx && step + 1 < 36) ML_ISSUE(step + 1);
            if (isx) {
                const int jt = wave >> 1, j = 16 * jt + li;
                {   const int jr = tid >> 3, part = tid & 7; float dsum = 0.f;
#pragma unroll
                    for (int c2 = 0; c2 < 2; ++c2) { const u32x4 qv = *(const LAS u32x4*)(lds + QS + off_b(jr, 2 * part + c2)); const LAS float* np = sm + N_ + 16 * part + 8 * c2; const f32x4 n0 = *(const LAS f32x4*)np, n1 = *(const LAS f32x4*)(np + 4);
                        dsum += bflo(qv.x) * n0[0] + bfhi(qv.x) * n0[1] + bflo(qv.y) * n0[2] + bfhi(qv.y) * n0[3] + bflo(qv.z) * n1[0] + bfhi(qv.z) * n1[1] + bflo(qv.w) * n1[2] + bfhi(qv.w) * n1[3]; }
                    dsum += __shfl_xor(dsum, 1); dsum += __shfl_xor(dsum, 2); dsum += __shfl_xor(dsum, 4);
                    if (part == 0) sm[QN_ + jr] = dsum; }
                bf16x8 qf[4];
#pragma unroll
                for (int ks = 0; ks < 4; ++ks) qf[ks] = rowfrag(lds + QS, jt, ks, lane);
                const float Mj = sm[M_ + j]; float rsum = 0.f;
#pragma unroll
                for (int t = 0; t < 2; ++t) { const int st = 2 * (wave & 1) + t; f32x4 sa = {0.f, 0.f, 0.f, 0.f};
#pragma unroll
                    for (int ks = 0; ks < 4; ++ks) sa = __builtin_amdgcn_mfma_f32_16x16x32_bf16(rowfrag(lds + KS, st, ks, lane), qf[ks], sa, 0, 0, 0);
                    const int s0 = 16 * st + 4 * g; const f32x4 u4 = *(const LAS f32x4*)(sm + U_ + s0); float sp[4];
#pragma unroll
                    for (int r = 0; r < 4; ++r) { const int s = s0 + r; const bool keep = dir ? (s >= j) : (s <= j); const float dv = __expf(fminf(u4[r] - Mj, 0.f)); sp[r] = keep ? sa[r] * dv : 0.f; rsum += sp[r]; }
                    u32x2 w; w.x = pk2(sp[0], sp[1]); w.y = pk2(sp[2], sp[3]);
                    *(LAS u32x2*)(lds + SS + off_s(j, 2 * st + (g >> 1)) + (g & 1) * 8) = w; }
                rsum += __shfl_xor(rsum, 16); rsum += __shfl_xor(rsum, 32);
                if (g == 0) sm[RS_ + 2 * j + (wave & 1)] = rsum;
                __syncthreads();
                if (step + 1 < 36) ML_ISSUE(step + 1);
                f32x4 oa[4];
#pragma unroll
                for (int t = 0; t < 4; ++t) { const int dvt = 4 * (wave & 1) + t; oa[t] = (f32x4){0.f, 0.f, 0.f, 0.f};
#pragma unroll
                    for (int ks = 0; ks < 4; ++ks) oa[t] = __builtin_amdgcn_mfma_f32_16x16x32_bf16(rowfrag(lds + CT, dvt, ks, lane), rowfrag(lds + QS, jt, ks, lane), oa[t], 0, 0, 0); }
                const float dj = sm[DEC_ + j];
                bf16x8 sf[2];
#pragma unroll
                for (int ks = 0; ks < 2; ++ks) sf[ks] = *(const LAS bf16x8*)(lds + SS + off_s(j, 4 * ks + g));
                const float den = (sm[RS_ + 2 * j] + sm[RS_ + 2 * j + 1]) + dj * sm[QN_ + j];
                const float inv = 1.f / fmaxf(fabsf(den), sm[EM_ + j]);
                const size_t tok = (size_t)b * SEQ + cc * 64 + j;
#pragma unroll
                for (int t = 0; t < 4; ++t) { const int dvt = 4 * (wave & 1) + t; f32x4 o = oa[t] * dj;
#pragma unroll
                    for (int ks = 0; ks < 2; ++ks) o = __builtin_amdgcn_mfma_f32_16x16x32_bf16(trfrag(lds + VS, dvt, ks, lane), sf[ks], o, 0, 0, 0);
                    o = o * inv; u32x2 w; w.x = pk2(o[0], o[1]); w.y = pk2(o[2], o[3]);
                    *(u32x2*)(Hout + tok * 512 + h * 128 + 16 * dvt + 4 * g) = w; }
            }
            {   const float dn = sm[SC_];
                bf16x8 kf[2];
#pragma unroll
                for (int ks = 0; ks < 2; ++ks) { const bf16x8 kr = trfrag(lds + KS, wave, ks, lane); const f32x4 w0 = *(const LAS f32x4*)(sm + WA_ + 32 * ks + 8 * g), w1 = *(const LAS f32x4*)(sm + WA_ + 32 * ks + 8 * g + 4);
                    u32x4 pkd; pkd.x = pk2(bf1((bf16)kr[0]) * w0[0], bf1((bf16)kr[1]) * w0[1]); pkd.y = pk2(bf1((bf16)kr[2]) * w0[2], bf1((bf16)kr[3]) * w0[3]);
                    pkd.z = pk2(bf1((bf16)kr[4]) * w1[0], bf1((bf16)kr[5]) * w1[1]); pkd.w = pk2(bf1((bf16)kr[6]) * w1[2], bf1((bf16)kr[7]) * w1[3]);
                    kf[ks] = __builtin_bit_cast(bf16x8, pkd); }
                {   const int dk = tid >> 2, part = tid & 3; float a = 0.f;
#pragma unroll
                    for (int e = 0; e < 16; ++e) { const int s = 16 * part + e; a += sm[WA_ + s] * bf1(*(const LAS bf16*)(lds + KS + off_b(s, dk >> 3) + (dk & 7) * 2)); }
                    a += __shfl_xor(a, 1); a += __shfl_xor(a, 2);
                    if (part == 0) sm[N_ + dk] = dn * sm[N_ + dk] + a; }
#pragma unroll
                for (int dvt = 0; dvt < 8; ++dvt) { f32x4 c = Cacc[dvt] * dn;
#pragma unroll
                    for (int ks = 0; ks < 2; ++ks) c = __builtin_amdgcn_mfma_f32_16x16x32_bf16(kf[ks], trfrag(lds + VS, dvt, ks, lane), c, 0, 0, 0);
                    Cacc[dvt] = c; }
            }
            __syncthreads();
#pragma unroll
            for (int dvt = 0; dvt < 8; ++dvt) { const f32x4 c = Cacc[dvt]; u32x2 w; w.x = pk2(c[0], c[1]); w.y = pk2(c[2], c[3]);
                *(LAS u32x2*)(lds + CT + off_b(16 * dvt + li, 2 * wave + (g >> 1)) + (g & 1) * 8) = w; }
            if (step + 1 < 36) ML_COMMIT();
            __syncthreads();
        }
    }
}
#undef ML_ISSUE
#undef ML_COMMIT
}
constexpr int N_PHASES = 13;
#ifndef PROBE_PH
#define PROBE_PH 0
#endif
struct Args { const float* in[19]; float* out; unsigned char* ws; int ph_lo, ph_hi, probe, pad; };
static_assert(sizeof(Args) == 19 * 8 + 8 + 8 + 16, "Args has no padding");

__global__ void __launch_bounds__(512, 2) mk_fwd(Args a) {
    extern __shared__ __attribute__((aligned(16))) unsigned char lds_raw[];
    LAS unsigned char* lds = (LAS unsigned char*)lds_raw;
    const int tid = threadIdx.x, lane = tid & 63, wave = __builtin_amdgcn_readfirstlane(tid >> 6), G = gridDim.x;
    Ctx C;
    C.x = a.in[0]; C.c = a.in[1]; C.ctx = a.in[2]; C.c_ctx = a.in[3]; C.w_ada = a.in[4]; C.b_ada = a.in[5]; C.g_norm1 = a.in[6]; C.w_in = a.in[7]; C.b_gates = a.in[8]; C.w_conv = a.in[9];
    C.w_fourier = a.in[10]; C.w_mlstm = a.in[11]; C.w_out = a.in[12]; C.g_norm2 = a.in[13]; C.w_router = a.in[14]; C.w_gate_e = a.in[15]; C.w_up_e = a.in[16]; C.w_down_e = a.in[17]; C.g_final = a.in[18];
    C.out = a.out; C.ws = a.ws;
    const int lo = a.ph_lo, hi = a.ph_hi;
#if MK_XCD_BAR
    volatile LAS unsigned* bst = (volatile LAS unsigned*)(lds + LDS_PHASE_BYTES);
    if (tid < 4) bst[tid] = 0u;
    __syncthreads();
    XcdBarrier bar = xcd_barrier_post((unsigned*)(a.ws + WS_CTL) + 4096, bst);
#endif
    int nsync = 0;
#define IN(k) (lo <= (k) && (k) < hi)
#if MK_XCD_BAR
#define GRIDBAR() do { if (nsync == 0) cg::this_grid().sync(); else xcd_barrier(bar); ++nsync; } while (0)
#else
#define GRIDBAR() do { cg::this_grid().sync(); ++nsync; } while (0)
#endif
#define SEAM(k) do { if (IN(k) && IN((k) + 1)) GRIDBAR(); } while (0)
#define PHASE(k, ...) do { if (IN(k)) { __VA_ARGS__ } SEAM(k); } while (0)
    PHASE(0, { for (int _r = 0; _r < 1 + (a.probe & 1); ++_r) { p0_prep(C, lds, tid, lane, wave, G); __syncthreads(); } });
    PHASE(1, { p1a_norm_gates(C, lds, tid, lane, wave, G, (a.probe >> 1) & 1); __syncthreads(); });
    PHASE(2, { SchedP1 S{C.ws, G, (int)blockIdx.x, 1 + ((a.probe >> 2) & 1)}; EpiP1 E{C.ws}; mg::gemm_phase<EpiP1, SchedP1, false>(lds, 1024, S, E); });
    PHASE(3, { SchedF2 S{C.ws, G, (int)blockIdx.x, 1 + ((a.probe >> 3) & 1)}; EpiF2 E{C.ws}; mg::gemm_phase<EpiF2, SchedF2, false>(lds, 4096, S, E); p2_conv(C, lane, wave, G, (a.probe >> 13) & 1); });
    PHASE(4, { ml::mlstm_phase(C, lds, tid, lane, wave, G, (a.probe >> 4) & 1); });
    PHASE(5, { p3b_combine(C, tid, G, (a.probe >> 5) & 1); });
    PHASE(6, { SchedMerge S{C.ws, G, (int)blockIdx.x, 1 + ((a.probe >> 6) & 1)}; EpiMerge E{C.ws, C.w_fourier}; mg::gemm_phase<EpiMerge, SchedMerge, false>(lds, 512, S, E); });
    PHASE(7, { SchedOut S{C.ws, G, (int)blockIdx.x, 1 + ((a.probe >> 7) & 1)}; EpiOut E{C.x, (const float*)(C.ws + WS_MOD), C.out}; mg::gemm_phase<EpiOut, SchedOut, false>(lds, 1024, S, E); });
    PHASE(8, { p6_norm_router(C, lds, tid, lane, wave, G, (a.probe >> 8) & 1); __syncthreads(); });
    PHASE(9, { const int NGW = G * 8; const int rp9 = 1 + ((a.probe >> 9) & 1); for (int it = blockIdx.x * 8 + wave; it < NB * NE * rp9; it += NGW) topk_item(C, it % (NB * NE), lane); convert_experts(C, lds, lane, wave, G, rp9); for (int i = blockIdx.x * 512 + tid; i < NE * NB * CAP; i += G * 512) ((int*)(C.ws + WS_IDENT))[i] = i; __syncthreads(); });
    PHASE(10, { SchedUp S{C.ws, G, (int)blockIdx.x, 1 + ((a.probe >> 10) & 1)}; EpiSwiglu E{C.ws}; mg::gemm_phase<EpiSwiglu, SchedUp, true, true>(lds, 1024, S, E); });
    PHASE(11, { SchedDown S{C.ws, G, (int)blockIdx.x, 1 + ((a.probe >> 11) & 1)}; EpiDown E{C.ws}; mg::gemm_phase<EpiDown, SchedDown, true, true>(lds, 1024, S, E); });
    if (IN(12)) { p10_final(C, lane, wave, G); }
#undef PHASE
#undef PHASE_L
#undef IN
#undef SEAM
#undef GRIDBAR
}

static void mk_launch(void* const* d_in, void* d_out, void* d_ws, hipStream_t stream, int lo, int hi, bool coop) {
    static int grid = 0;
    if (grid == 0) {
        int dev = 0, cus = 0, per_cu = 0;
        (void)hipGetDevice(&dev); (void)hipDeviceGetAttribute(&cus, hipDeviceAttributeMultiprocessorCount, dev);
        (void)hipFuncSetAttribute((const void*)mk_fwd, hipFuncAttributeMaxDynamicSharedMemorySize, LDS_BYTES);
        (void)hipOccupancyMaxActiveBlocksPerMultiprocessor(&per_cu, (const void*)mk_fwd, 512, LDS_BYTES);
        if (per_cu < 1) fprintf(stderr, "mk_launch: occupancy query says %d blocks/CU\n", per_cu);
        grid = cus > 0 ? cus : 256;
    }
    Args a{};
    for (int i = 0; i < 19; ++i) a.in[i] = (const float*)d_in[i];
    a.out = (float*)d_out; a.ws = (unsigned char*)d_ws; a.ph_lo = lo; a.ph_hi = hi; a.probe = PROBE_PH; a.pad = 0;
    if (coop) { void* args[] = {&a}; hipError_t e = hipLaunchCooperativeKernel((const void*)mk_fwd, dim3(grid), dim3(512), args, LDS_BYTES, stream);
        if (e != hipSuccess) fprintf(stderr, "cooperative launch failed: %s (grid %d)\n", hipGetErrorString(e), grid); }
    else hipLaunchKernelGGL(mk_fwd, dim3(grid), dim3(512), LDS_BYTES, stream, a);
}
extern "C" void kernel_launch(void* const* d_in, const int* in_sizes, int n_in, void* d_out, int out_size, void* d_ws, size_t ws_size, hipStream_t stream) {
    (void)hipMemsetAsync((char*)d_ws + WS_CTL, 0, 65536, stream);
    mk_launch(d_in, d_out, d_ws, stream, 0, N_PHASES, true);
}
```

```cpp
#ifndef MK_XCD_BAR
#define MK_XCD_BAR 1
#endif
#include <hip/hip_runtime.h>
#include <hip/hip_cooperative_groups.h>
#include <cstdio>
#include <cstdint>
namespace cg = cooperative_groups;

#define LAS __attribute__((address_space(3)))
typedef unsigned short bf16;
typedef short bf16x8 __attribute__((ext_vector_type(8)));
typedef short s16x4 __attribute__((ext_vector_type(4)));
typedef float f32x4 __attribute__((ext_vector_type(4)));
typedef float f32x2 __attribute__((ext_vector_type(2)));
typedef unsigned u32x4 __attribute__((ext_vector_type(4)));
typedef unsigned u32x2 __attribute__((ext_vector_type(2)));
typedef __bf16 bf16x2_t __attribute__((ext_vector_type(2)));
typedef int v8i_t __attribute__((ext_vector_type(8)));
typedef int v4i_t __attribute__((ext_vector_type(4)));

__device__ __forceinline__ unsigned pk2(float lo, float hi) { f32x2 v = {lo, hi}; bf16x2_t b = __builtin_convertvector(v, bf16x2_t); return __builtin_bit_cast(unsigned, b); }
__device__ __forceinline__ float bflo(unsigned w) { return __uint_as_float(w << 16); }
__device__ __forceinline__ float bfhi(unsigned w) { return __uint_as_float(w & 0xffff0000u); }
__device__ __forceinline__ float bf1(bf16 b) { return __uint_as_float((unsigned)b << 16); }
__device__ __forceinline__ float silu_f(float v) { return v * __builtin_amdgcn_rcpf(1.f + __expf(-v)); }
__device__ __forceinline__ float sigmoid_f(float v) { return __builtin_amdgcn_rcpf(1.f + __expf(-v)); }
__device__ __forceinline__ float log_sigmoid_f(float v) { return fminf(v, 0.f) - log1pf(expf(-fabsf(v))); }
__device__ __forceinline__ float wave_sum(float v) {
#define WS_DPP(ctrl, rmask) v += __int_as_float(__builtin_amdgcn_update_dpp(0, __float_as_int(v), ctrl, rmask, 0xf, false));
    WS_DPP(0x111, 0xf) WS_DPP(0x112, 0xf) WS_DPP(0x114, 0xf) WS_DPP(0x118, 0xf) WS_DPP(0x142, 0xa) WS_DPP(0x143, 0xc)
#undef WS_DPP
    return __int_as_float(__builtin_amdgcn_readlane(__float_as_int(v), 63));
}

#define XB_TMO      128
#define XB_XCNT(j)  (256  + 64 * (j))
#define XB_XSUB(j)  (1280 + 64 * (j))
#define XB_XGEN(j)  (2304 + 64 * (j))
#define XB_TOP      3328
#define XB_TOPGEN   3392
#define XCD_BAR_WORDS 3456
#define XB_SPIN_CAP (1u << 20)
__device__ __forceinline__ unsigned xb_ld(unsigned* p)              { return __hip_atomic_load(p, __ATOMIC_RELAXED, __HIP_MEMORY_SCOPE_AGENT); }
__device__ __forceinline__ unsigned xb_add(unsigned* p, unsigned v) { return __hip_atomic_fetch_add(p, v, __ATOMIC_RELAXED, __HIP_MEMORY_SCOPE_AGENT); }
__device__ __forceinline__ unsigned xb_xcc_id() { return (unsigned)__builtin_amdgcn_s_getreg((3 << 11) | 20) & 0xFu; }
#define XB_SPIN(cond, bar) do { unsigned _sp = 0; while (cond) { __builtin_amdgcn_s_sleep(1); \
    if ((++_sp & 255u) == 0u) { if (xb_ld(&(bar)[XB_TMO])) break; if (_sp > XB_SPIN_CAP) { atomicAdd(&(bar)[XB_TMO], 1u); break; } } } } while (0)
struct XcdBarrier { unsigned* bar; unsigned x; volatile LAS unsigned* st; };
__device__ __forceinline__ XcdBarrier xcd_barrier_post(unsigned* bar, volatile LAS unsigned* st) {
    XcdBarrier b; b.bar = bar; b.x = xb_xcc_id(); b.st = st;
    if (threadIdx.x == 0) (void)xb_add(&bar[XB_XCNT(b.x)], 1u);
    return b;
}
__device__ __forceinline__ void xcd_barrier_complete(unsigned* bar, unsigned x, unsigned& nloc, unsigned& nx) {
    const unsigned G = gridDim.x * gridDim.y * gridDim.z;
    unsigned sum, cnt, mine, sp = 0u;
    for (;;) {
        sum = 0u; cnt = 0u; mine = 0u;
#pragma unroll
        for (unsigned j = 0; j < 16; ++j) { const unsigned c = xb_ld(&bar[XB_XCNT(j)]); sum += c; cnt += (c > 0u) ? 1u : 0u; mine = (j == x) ? c : mine; }
        if (sum == G) break;
        __builtin_amdgcn_s_sleep(1);
        if ((++sp & 255u) == 0u) { if (xb_ld(&bar[XB_TMO])) break; if (sp > XB_SPIN_CAP) { atomicAdd(&bar[XB_TMO], 1u); break; } }
    }
    nloc = mine > 0u ? mine : 1u; nx = cnt > 0u ? cnt : 1u;
}
__device__ __forceinline__ void xcd_barrier(const XcdBarrier& b) {
    asm volatile("s_waitcnt vmcnt(0)" ::: "memory");
    __syncthreads();
    if (threadIdx.x == 0) {
        unsigned* bar = b.bar;
        __builtin_amdgcn_s_waitcnt(0);
        unsigned nloc = b.st[0], nx = b.st[1];
        if (nloc == 0u) { xcd_barrier_complete(bar, b.x, nloc, nx); b.st[0] = nloc; b.st[1] = nx; }
        const unsigned old = xb_add(&bar[XB_XSUB(b.x)], 1u);
        const unsigned gen = old / nloc;
        if (old + 1u == (gen + 1u) * nloc) {
            __builtin_amdgcn_fence(__ATOMIC_RELEASE, "agent");
            asm volatile("s_waitcnt vmcnt(0)" ::: "memory");
            const unsigned og = xb_add(&bar[XB_TOP], 1u);
            const unsigned tg = og / nx;
            if (og + 1u == (tg + 1u) * nx) xb_add(&bar[XB_TOPGEN], 1u);
            else XB_SPIN(xb_ld(&bar[XB_TOPGEN]) == tg, bar);
            __builtin_amdgcn_fence(__ATOMIC_ACQUIRE, "agent");
            xb_add(&bar[XB_XGEN(b.x)], 1u);
            asm volatile("s_waitcnt vmcnt(0)" ::: "memory");
        } else {
            XB_SPIN(xb_ld(&bar[XB_XGEN(b.x)]) == gen, bar);
            __builtin_amdgcn_fence(__ATOMIC_ACQUIRE, "agent");
            asm volatile("s_waitcnt vmcnt(0)" ::: "memory");
        }
    }
    __syncthreads();
}

#ifndef MK_TIMING
#define MK_TIMING 0
#endif
namespace mg {
template <bool F8> struct Frag { bf16x8 k[2]; };
template <> struct Frag<true> { v8i_t v; };
constexpr int BM = 256, BK = 64, HALF = 128, HTB = HALF * BK * 2, STAGE_BYTES = 8 * HTB, NXCD = 8, WGM = 8;
__host__ __device__ __forceinline__ int lds_byte(int r, int c) { const int st = (r >> 4) * 2 + (c >> 5), rr = r & 15, cc = c & 31, ob = rr * 64 + cc * 2; return st * 1024 + (ob ^ (((ob >> 9) & 1) << 5)); }
__host__ __device__ __forceinline__ void stage_rc(int b, int& R, int& C) { const int st = b / 1024, sb = b % 1024, swz = sb ^ (((sb >> 9) & 1) << 5); R = (st >> 1) * 16 + swz / 64; C = (st & 1) * 32 + (swz % 64) / 2; }
__host__ __device__ __forceinline__ int perm128x(int R) { return 64 * (R >> 5) + 16 * ((R >> 2) & 3) + 4 * ((R >> 4) & 1) + (R & 3); }
__host__ __device__ __forceinline__ int perm32(int rho) { const int n = rho >> 4, i = rho & 15; return 8 * (i >> 2) + 4 * n + (i & 3); }

struct Unit { int pm, pn, ty; const char* a; const char* b; const int* gi; const char* a2; const char* b2; };
__device__ __forceinline__ void tile_of(int wgid, int nM, int nN, int& pm, int& pn) {
    const int nwg = nM * nN; { const int q = nwg / NXCD, r = nwg % NXCD, xcd = wgid % NXCD, off = wgid / NXCD; wgid = (xcd < r ? xcd * (q + 1) : r * (q + 1) + (xcd - r) * q) + off; }
    const int nig = WGM * nN, gid = wgid / nig, fm = gid * WGM, gsz = (nM - fm) < WGM ? (nM - fm) : WGM;
    pm = fm + ((wgid % nig) % gsz); pn = (wgid % nig) / gsz;
}

template <class Epi, bool P> struct EpiPreOf { struct type {}; };
template <class Epi> struct EpiPreOf<Epi, true> { typedef typename Epi::Pre type; };
template <class Epi, class Sched, bool GATHER, bool FP8 = false, bool SPLITK = false>
__device__ __forceinline__ void gemm_phase(LAS unsigned char* lds, const int K, const Sched& S, const Epi& E) {
    const int tid = threadIdx.x, wid = __builtin_amdgcn_readfirstlane(tid >> 6), lane = tid & 63, wr = wid >> 2, wc = wid & 3, fr = lane & 15, fq = lane >> 4;
    const int KB = FP8 ? K : 2 * K;
    const int nh = KB / (BK * 2), nt = SPLITK ? 2 * nh : nh;
    unsigned voffB[2], vAc[2][2]; int stR[2], stC[2]; int gnx[2][2];
    const size_t kstep = (size_t)(BK * 2);
    const size_t hstep = (size_t)(Epi::PERM2 ? 8 : HALF) * KB;
#pragma unroll
    for (int i = 0; i < 2; ++i) { int R, C; stage_rc(tid * 16 + i * 8192, R, C); stR[i] = R; stC[i] = C; const int Rb = Epi::PERM2 ? perm128x(R) : (Epi::PERM ? ((R & ~31) + perm32(R & 31)) : R);
        voffB[i] = (unsigned)(Rb * KB + 2 * C); }
    const unsigned ldsw = (unsigned)wid * 1024u;
    const int aoff = lds_byte(wr * 64 + fr, fq * (FP8 ? 16 : 8)), boff = lds_byte(wc * 32 + fr, fq * (FP8 ? 16 : 8));
#define MG_SA(b, h) (((b) * 2 + (h)) * HTB)
#define MG_SB(b, h) ((4 + (b) * 2 + (h)) * HTB)
#define MG_STAGE(bufoff, gbase, voff) do { const char* _gb = (const char*)(gbase); asm volatile("" : "+s"(_gb));     \
        _Pragma("unroll") for (int _i = 0; _i < 2; ++_i) { unsigned _vo = (voff)[_i]; asm volatile("" : "+v"(_vo)); \
        __builtin_amdgcn_global_load_lds((const unsigned*)(_gb + _vo), (LAS unsigned*)(lds + (bufoff) + ldsw + _i * 8192), 16, 0, 0); } } while (0)
#define MG_LD16(off_) (*(const LAS v4i_t*)(lds + (off_)))
#define MG_LDA(dst, b, h) do { _Pragma("unroll") for (int m = 0; m < 4; ++m) { const int _o = MG_SA(b, h) + aoff + m * 2048; \
        if constexpr (FP8) dst[m].v = __builtin_shufflevector(MG_LD16(_o), MG_LD16(_o + 16), 0, 1, 2, 3, 4, 5, 6, 7); \
        else { dst[m].k[0] = __builtin_bit_cast(bf16x8, MG_LD16(_o)); dst[m].k[1] = __builtin_bit_cast(bf16x8, MG_LD16(_o + 1024)); } } } while (0)
#define MG_LDB(dst, b, h) do { _Pragma("unroll") for (int n = 0; n < 2; ++n) { const int _o = MG_SB(b, h) + boff + n * 2048; \
        if constexpr (FP8) dst[n].v = __builtin_shufflevector(MG_LD16(_o), MG_LD16(_o + 16), 0, 1, 2, 3, 4, 5, 6, 7); \
        else { dst[n].k[0] = __builtin_bit_cast(bf16x8, MG_LD16(_o)); dst[n].k[1] = __builtin_bit_cast(bf16x8, MG_LD16(_o + 1024)); } } } while (0)
#define MG_MMA(ai, bj, At, Bt) do { __builtin_amdgcn_s_setprio(1); _Pragma("unroll") for (int m = 0; m < 4; ++m) _Pragma("unroll") for (int n = 0; n < 2; ++n) { \
        if constexpr (FP8) acc[ai][bj][m][n] = __builtin_amdgcn_mfma_scale_f32_16x16x128_f8f6f4(Bt[n].v, At[m].v, acc[ai][bj][m][n], 0, 0, 0, 0, 0, 0); \
        else { _Pragma("unroll") for (int k = 0; k < 2; ++k) acc[ai][bj][m][n] = __builtin_amdgcn_mfma_f32_16x16x32_bf16(Bt[n].k[k], At[m].k[k], acc[ai][bj][m][n], 0, 0, 0); } } \
        __builtin_amdgcn_s_setprio(0); } while (0)
#define MG_WAIT_V(n) asm volatile("s_waitcnt vmcnt(" #n ")" ::: "memory")
#define MG_WAIT_L(n) asm volatile("s_waitcnt lgkmcnt(" #n ")" ::: "memory")
#define MG_BAR __builtin_amdgcn_s_barrier()
#define MG_SCHED __builtin_amdgcn_sched_barrier(0)
#define MG_AOFF(dst, u) do { _Pragma("unroll") for (int _h = 0; _h < 2; ++_h) _Pragma("unroll") for (int _i = 0; _i < 2; ++_i) { \
        if constexpr (GATHER) dst[_h][_i] = (unsigned)(u).gi[_h * HALF + stR[_i]] * (unsigned)KB + 2u * (unsigned)stC[_i]; \
        else dst[_h][_i] = (unsigned)((_h * HALF + stR[_i]) * KB + 2 * stC[_i]); } } while (0)
    Unit cur, nxt; int ui = 0;
    if (!S.next(0, cur)) return;
#if MK_TIMING
    unsigned long long tmE = 0, tmR = 0, tmK = 0, tm0 = wall_clock64(), tm1 = 0; const unsigned long long tmS = tm0; int tmU = 0;
#endif
    f32x4 acc[2][2][4][2];
#pragma unroll
    for (int a = 0; a < 2; ++a)
#pragma unroll
        for (int b = 0; b < 2; ++b)
#pragma unroll
            for (int m = 0; m < 4; ++m)
#pragma unroll
                for (int n = 0; n < 2; ++n) acc[a][b][m][n] = (f32x4){0.f, 0.f, 0.f, 0.f};
    Frag<FP8> At[4], B0[2], B1[2];
    struct NoPre {}; typename std::conditional<Epi::PRE, typename EpiPreOf<Epi, Epi::PRE>::type, NoPre>::type pre;
    const char* cA = cur.a; const char* cB = cur.b; const char* cA2 = cur.a2; const char* cB2 = cur.b2;
#define MG_TP(p0, p1, tt) ((SPLITK && (tt) >= nh) ? (p1) + (size_t)((tt) - nh) * kstep : (p0) + (size_t)(tt) * kstep)
    MG_AOFF(vAc, cur);
    MG_STAGE(MG_SB(0, 0), cB, voffB); MG_STAGE(MG_SB(0, 1), cB + hstep, voffB); MG_STAGE(MG_SA(0, 0), cA, vAc[0]); MG_STAGE(MG_SA(0, 1), cA, vAc[1]);
    if (wr == 1) MG_BAR;
    MG_WAIT_V(2); MG_BAR;
    MG_STAGE(MG_SB(1, 0), cB + kstep, voffB); MG_STAGE(MG_SA(1, 0), cA + kstep, vAc[0]); MG_STAGE(MG_SB(1, 1), cB + hstep + kstep, voffB);
    MG_WAIT_V(6); MG_BAR;
    for (;;) {
        const bool has_next = S.next(ui + 1, nxt);
        const char* nA = has_next ? nxt.a : cA; const char* nB = has_next ? nxt.b : cB;
        if constexpr (GATHER) { if (has_next) {
#pragma unroll
            for (int h = 0; h < 2; ++h)
#pragma unroll
                for (int i = 0; i < 2; ++i) asm volatile("global_load_dword %0, %1, off" : "=v"(gnx[h][i]) : "v"(nxt.gi + h * HALF + stR[i]) : "memory"); } }
#pragma unroll 1
        for (int t = 0; t < nt; t += 2) {
            const bool last = (t == nt - 2);
            const char* a1 = MG_TP(cA, cA2, t + 1);
            const char* a2 = last ? nA : MG_TP(cA, cA2, t + 2); const char* b2 = last ? nB : MG_TP(cB, cB2, t + 2);
            if constexpr (SPLITK) { if (t == nh) { int fr_ = fr, fq_ = fq; asm volatile("" : "+v"(fr_), "+v"(fq_)); if constexpr (Epi::PRE) E.mid(acc, cur, wr, wc, fr_, fq_, pre); else E.mid(acc, cur, wr, wc, fr_, fq_); } }
            if constexpr (Epi::PRE) { if (Epi::PRE_MID && SPLITK && t == nh - 2) { int fr_ = fr, fq_ = fq; asm volatile("" : "+v"(fr_), "+v"(fq_)); E.pre_mid(pre, cur, wr, wc, fr_, fq_); }
                if (last) { int fr_ = fr, fq_ = fq; asm volatile("" : "+v"(fr_), "+v"(fq_)); E.pre_fin(pre, cur, wr, wc, fr_, fq_); } }
            const char* a3 = a2 + kstep; const char* b3 = b2 + kstep;
            MG_LDB(B0, 0, 0); MG_LDB(B1, 0, 1); MG_SCHED; MG_LDA(At, 0, 0); MG_STAGE(MG_SA(1, 1), a1, vAc[1]);
            if constexpr (GATHER) { if (last && has_next) {
                asm volatile("" : "+v"(gnx[0][0]), "+v"(gnx[0][1]), "+v"(gnx[1][0]), "+v"(gnx[1][1]));
#pragma unroll
                for (int h = 0; h < 2; ++h)
#pragma unroll
                    for (int i = 0; i < 2; ++i) vAc[h][i] = (unsigned)gnx[h][i] * (unsigned)KB + 2u * (unsigned)stC[i]; } }
            MG_WAIT_V(8); MG_WAIT_L(0); MG_BAR; MG_MMA(0, 0, At, B0); MG_MMA(0, 1, At, B1); MG_BAR; MG_SCHED;
            MG_LDA(At, 0, 1); MG_STAGE(MG_SB(0, 0), b2, voffB); MG_STAGE(MG_SB(0, 1), b2 + hstep, voffB); MG_STAGE(MG_SA(0, 0), a2, vAc[0]);
            MG_WAIT_V(8); MG_WAIT_L(0); MG_BAR; MG_MMA(1, 0, At, B0); MG_MMA(1, 1, At, B1); MG_BAR; MG_SCHED;
            MG_LDB(B0, 1, 0); MG_LDB(B1, 1, 1); MG_SCHED; MG_LDA(At, 1, 0); MG_STAGE(MG_SA(0, 1), a2, vAc[1]);
            MG_WAIT_V(8); MG_WAIT_L(0); MG_BAR; MG_MMA(0, 0, At, B0); MG_MMA(0, 1, At, B1); MG_BAR; MG_SCHED;
            MG_LDA(At, 1, 1); MG_STAGE(MG_SB(1, 0), b3, voffB); MG_STAGE(MG_SB(1, 1), b3 + hstep, voffB); MG_STAGE(MG_SA(1, 0), a3, vAc[0]);
            MG_WAIT_V(8); MG_WAIT_L(0); MG_BAR; MG_MMA(1, 0, At, B0); MG_MMA(1, 1, At, B1); MG_BAR; MG_SCHED;
        }
        if (wr == 0) MG_BAR;
#if MK_TIMING
        tm1 = wall_clock64(); tmK += tm1 - tm0; ++tmU;
#endif
        { int fr_ = fr, fq_ = fq; asm volatile("" : "+v"(fr_), "+v"(fq_));
          if constexpr (Epi::PRE) E(acc, cur, wr, wc, fr_, fq_, pre); else E(acc, cur, wr, wc, fr_, fq_);
#ifdef PROBE_EPI
          if constexpr (Sched::TSLOT == PROBE_EPI) { asm volatile("" : "+v"(fr_), "+v"(fq_)); if constexpr (Epi::PRE) E(acc, cur, wr, wc, fr_, fq_, pre); else E(acc, cur, wr, wc, fr_, fq_); }
#endif
        }
#if MK_TIMING
        tm0 = wall_clock64(); tmE += tm0 - tm1;
#endif
        if (!has_next) break;
#pragma unroll
        for (int a = 0; a < 2; ++a)
#pragma unroll
            for (int b = 0; b < 2; ++b)
#pragma unroll
                for (int m = 0; m < 4; ++m)
#pragma unroll
                    for (int n = 0; n < 2; ++n) acc[a][b][m][n] = (f32x4){0.f, 0.f, 0.f, 0.f};
        cur = nxt; cA = nA; cB = nB; cA2 = cur.a2; cB2 = cur.b2; ++ui;
        if (wr == 1) MG_BAR;
    }
    MG_WAIT_V(0);
    MG_BAR;
#if MK_TIMING
    if (blockIdx.x == 7 && tid == 0) { float* tp = (float*)S.ws + 8192 + 8 * Sched::TSLOT; tp[0] = (float)tmE * 0.01f; tp[1] = (float)tmK * 0.01f; tp[2] = (float)(wall_clock64() - tmS) * 0.01f; tp[3] = (float)tmU; }
#endif
#undef MG_SA
#undef MG_SB
#undef MG_STAGE
#undef MG_LDA
#undef MG_LDB
#undef MG_MMA
#undef MG_LD16
#undef MG_WAIT_V
#undef MG_WAIT_L
#undef MG_BAR
#undef MG_SCHED
#undef MG_AOFF
#undef MG_TP
}
}
constexpr int D = 1024, NB = 32, SEQ = 2048, CL = 256, NTOK = NB * SEQ, NCTX = NB * CL, INC = 4624;
constexpr int NE = 16, CAP = 256;
constexpr int OFF_QK = 512, OFF_V = 1536, OFF_O = 2048, OFF_G = 2560, OFF_BR = 2576;
constexpr float EPS = 1e-6f;
constexpr size_t MiB = 1u << 20;
constexpr size_t WS_CTL = 0, CTL_BYTES = 1 * MiB;
constexpr size_t WS_MOD = 1 * MiB;
constexpr size_t WS_GATES = 2 * MiB;
constexpr size_t WS_AFF = 11 * MiB;
constexpr size_t WS_IDX = 15 * MiB;
constexpr size_t WS_VAL = 15 * MiB + 512 * 1024;
constexpr size_t WS_SLOT = 16 * MiB;
constexpr size_t WS_WTF = 18 * MiB;
constexpr size_t WS_WFT = 20 * MiB;
constexpr size_t WS_WMT = 21 * MiB;
constexpr size_t WS_WOT = 22 * MiB;
constexpr size_t WS_WTM = 24 * MiB;
constexpr size_t WS_TT = 32 * MiB;
constexpr size_t WS_PC = 48 * MiB;
constexpr size_t WS_H = 64 * MiB;
constexpr size_t WS_QK = 64 * MiB;
constexpr size_t WS_KC = 192 * MiB;
constexpr size_t WS_MRG = 64 * MiB;
constexpr size_t WS_WGU = 784 * MiB;
constexpr size_t WS_WD = 816 * MiB;
constexpr size_t WS_AB = 208 * MiB;
constexpr size_t WS_HF = 208 * MiB;
constexpr size_t WS_HB = 272 * MiB;
constexpr size_t WS_HX2 = 208 * MiB;
constexpr size_t WS_X1 = 272 * MiB;
constexpr size_t WS_FU = 336 * MiB;
constexpr size_t WS_PQK = 400 * MiB;
constexpr size_t WS_HM = 400 * MiB;
constexpr size_t WS_PV = 528 * MiB;
constexpr size_t WS_PO = 592 * MiB;
constexpr size_t WS_PBR = 656 * MiB;
constexpr size_t WS_HID = 400 * MiB;
constexpr size_t WS_Y = 656 * MiB;
#ifndef VAL_IN_FINAL
#define VAL_IN_FINAL 0
#endif
constexpr size_t WS_VALT = 832 * MiB;
constexpr size_t WS_IDENT = 912 * MiB;
constexpr size_t WS_W64 = 913 * MiB;
constexpr size_t WS_A64T = 913 * MiB + 65536;
constexpr size_t WS_F64 = 914 * MiB;
constexpr size_t WS_END = 916 * MiB;
constexpr int LDS_PHASE_BYTES = 147456, LDS_BYTES = LDS_PHASE_BYTES + 256;

__device__ __forceinline__ unsigned pk4_fp8(float a, float b, float c, float d) { int w = __builtin_amdgcn_cvt_pk_fp8_f32(a, b, 0, false); w = __builtin_amdgcn_cvt_pk_fp8_f32(c, d, w, true); return (unsigned)w; }
constexpr float W8_SCALE = 32.f, W8_INV = 1.f / 32.f;
__device__ __forceinline__ unsigned pk4_u8(float a, float b, float c, float d) { return (unsigned)(a * 255.f + 0.5f) | ((unsigned)(b * 255.f + 0.5f) << 8) | ((unsigned)(c * 255.f + 0.5f) << 16) | ((unsigned)(d * 255.f + 0.5f) << 24); }
__device__ __forceinline__ float u8f0(unsigned w) { return (float)(w & 0xffu) * (1.f / 255.f); }
__device__ __forceinline__ float u8f1(unsigned w) { return (float)((w >> 8) & 0xffu) * (1.f / 255.f); }
__device__ __forceinline__ float u8f2(unsigned w) { return (float)((w >> 16) & 0xffu) * (1.f / 255.f); }
__device__ __forceinline__ float u8f3(unsigned w) { return (float)(w >> 24) * (1.f / 255.f); }
struct Ctx {
    const float *x, *c, *ctx, *c_ctx, *w_ada, *b_ada, *g_norm1, *w_in, *b_gates, *w_conv, *w_fourier, *w_mlstm, *w_out, *g_norm2, *w_router, *w_gate_e, *w_up_e, *w_down_e, *g_final;
    float* out; unsigned char* ws;
};

__device__ __forceinline__ void store_tile_bf16(const f32x4 (&acc)[2][2][4][2], bf16* base, int ldc, bool sig, int wr, int wc, int fr, int fq, bool nost = false, size_t bjs = 128) {
    bf16* p0 = base + (size_t)(wr * 64 + fr) * ldc + wc * 32 + 8 * fq;
#pragma unroll
    for (int ai = 0; ai < 2; ++ai)
#pragma unroll
        for (int m = 0; m < 4; ++m) { bf16* rowp = p0 + (size_t)(ai * 128 + m * 16) * ldc;
#pragma unroll
            for (int bj = 0; bj < 2; ++bj) { f32x4 v0 = acc[ai][bj][m][0], v1 = acc[ai][bj][m][1];
                if (sig) {
#pragma unroll
                    for (int j = 0; j < 4; ++j) { v0[j] = sigmoid_f(v0[j]); v1[j] = sigmoid_f(v1[j]); } }
                u32x4 w; w.x = pk2(v0[0], v0[1]); w.y = pk2(v0[2], v0[3]); w.z = pk2(v1[0], v1[1]); w.w = pk2(v1[2], v1[3]);
                if (nost) asm volatile("" :: "v"(w.x), "v"(w.y), "v"(w.z), "v"(w.w)); else *(u32x4*)(rowp + bj * bjs) = w; } }
}
__device__ __forceinline__ f32x2 sig2_q(f32x2 v) { const f32x2 x = v * (f32x2){-1.4426950408889634f, -1.4426950408889634f}; const f32x2 e = {__builtin_amdgcn_exp2f(x.x), __builtin_amdgcn_exp2f(x.y)};
    const f32x2 d = e + (f32x2){1.f, 1.f}; const f32x2 r = {__builtin_amdgcn_rcpf(d.x), __builtin_amdgcn_rcpf(d.y)}; return __builtin_elementwise_fma(r, (f32x2){255.f, 255.f}, (f32x2){0.5f, 0.5f}); }
__device__ __forceinline__ unsigned sig4_u8(f32x4 v) { const f32x2 a = sig2_q((f32x2){v[0], v[1]}), b = sig2_q((f32x2){v[2], v[3]}); return (unsigned)a.x | ((unsigned)a.y << 8) | ((unsigned)b.x << 16) | ((unsigned)b.y << 24); }
__device__ __forceinline__ void store_tile_sig_u8(const f32x4 (&acc)[2][2][4][2], unsigned char* base, int ldc, int wr, int wc, int fr, int fq, bool nost = false) {
    unsigned char* p0 = base + (size_t)(wr * 64 + fr) * ldc + wc * 32 + 8 * fq;
#pragma unroll
    for (int ai = 0; ai < 2; ++ai)
#pragma unroll
        for (int m = 0; m < 4; ++m) { unsigned char* rowp = p0 + (size_t)(ai * 128 + m * 16) * ldc;
#pragma unroll
            for (int bj = 0; bj < 2; ++bj) { const f32x4 v0 = acc[ai][bj][m][0], v1 = acc[ai][bj][m][1];
                u32x2 w; w.x = sig4_u8(v0); w.y = sig4_u8(v1);
                if (nost) asm volatile("" :: "v"(w.x), "v"(w.y)); else *(u32x2*)(rowp + bj * 128) = w; }
            asm volatile("" ::: "memory"); }
}
struct EpiP1 {
    static constexpr bool PERM = true, PRE = false, PERM2 = false; unsigned char* ws;
    __device__ __forceinline__ void operator()(const f32x4 (&acc)[2][2][4][2], const mg::Unit& u, int wr, int wc, int fr, int fq) const {
        bf16* base; int ldc; bool sig = false;
#ifdef PROBE_SKIP_EPI
        if (u.ty >= 8) return;
#endif
#ifdef PROBE_SKIP_ST
        const bool nost = u.ty >= 8;
#else
        const bool nost = false;
#endif
        const int ty = u.ty & 7;
        if (ty == 0) { const size_t r0 = (size_t)u.pm * 256;
            if (u.pn < 4) { base = (bf16*)(ws + WS_PQK) + r0 * 1024 + u.pn * 256; ldc = 1024; }
            else if (u.pn < 6) { store_tile_bf16(acc, (bf16*)(ws + WS_PV) + ((size_t)((u.pm >> 3) * 4 + (u.pn - 4) * 2) * SEQ + (size_t)(u.pm & 7) * 256) * 128, 128, false, wr, wc, fr, fq, nost, (size_t)SEQ * 128); return; }
            else if (u.pn < 8) { store_tile_sig_u8(acc, ws + WS_PO + r0 * 512 + (u.pn - 6) * 256, 512, wr, wc, fr, fq, nost); return; }
            else { store_tile_sig_u8(acc, ws + WS_PBR + r0 * 2048 + (u.pn - 8) * 256, 2048, wr, wc, fr, fq, nost); return; }
        } else if (ty == 1) { base = (bf16*)(ws + WS_AB) + ((size_t)(u.pn >> 3) * 512 + (size_t)u.pm * 256) * 2048 + (u.pn & 7) * 256; ldc = 2048; }
        else { base = (bf16*)(ws + WS_PC) + (size_t)u.pm * 256 * 1024 + u.pn * 256; ldc = 1024; }
        store_tile_bf16(acc, base, ldc, sig, wr, wc, fr, fq, nost);
    }
};
struct EpiF2 {
    static constexpr bool PERM = true, PRE = false, PERM2 = false; unsigned char* ws;
    __device__ __forceinline__ void operator()(const f32x4 (&acc)[2][2][4][2], const mg::Unit& u, int wr, int wc, int fr, int fq) const {
        bf16* fb = (bf16*)(ws + WS_FU) + (size_t)u.pn * 2048 * 512 + wc * 32 + 8 * fq;
        const bool j0 = ((wc * 32 + 8 * fq) & 63) == 0;
#pragma unroll
        for (int ai = 0; ai < 2; ++ai)
#pragma unroll
            for (int m = 0; m < 4; ++m) { const int k = u.pm * 256 + ai * 128 + wr * 64 + m * 16 + fr, km = (2048 - k) & 2047;
#pragma unroll
                for (int bj = 0; bj < 2; ++bj) { const f32x4 v0 = acc[ai][bj][m][0], v1 = acc[ai][bj][m][1];
                    u32x4 w; w.x = pk2(v0[0], v0[1]); w.y = pk2(v0[2], v0[3]); w.z = pk2(v1[0], v1[1]); w.w = pk2(v1[2], v1[3]);
                    *(u32x4*)(fb + (size_t)k * 512 + bj * 128) = w;
                    bf16* mp = fb + (size_t)km * 512 + 256 + bj * 128;
                    if (j0) { mp[1] = (bf16)(w.x >> 16); *(unsigned*)(mp + 2) = w.y; *(u32x2*)(mp + 4) = (u32x2){w.z, w.w}; } else *(u32x4*)mp = w; } }
    }
};
struct EpiMerge {
    static constexpr bool PERM = true, PRE = false, PERM2 = true; unsigned char* ws;
#define MRG_R(wa, wb, sh) ((float)(((wa) >> (sh)) & 0xffu) * __builtin_amdgcn_rcpf(fmaxf((float)(((wb) >> (sh)) & 0xffu), 0.5f)))
#define MRG_SCALE1(ai, m, bj, n, wa, wb) do { f32x4 v = acc[ai][bj][m][n]; \
            v = (f32x4){v[0] * MRG_R(wa, wb, 0), v[1] * MRG_R(wa, wb, 8), v[2] * MRG_R(wa, wb, 16), v[3] * MRG_R(wa, wb, 24)}; acc[ai][bj][m][n] = v; } while (0)
    __device__ __forceinline__ void mid(f32x4 (&acc)[2][2][4][2], const mg::Unit& u, int wr, int wc, int fr, int fq) const {
        const size_t row0 = (size_t)u.pm * 256 + wr * 64 + fr; const int col0 = u.pn * 256 + wc * 64 + 16 * fq;
        u32x4 g1[2][2], g2[2][2];
#define MRG_LOADQ(buf, q_) do { _Pragma("unroll") for (int mm = 0; mm < 2; ++mm) { const unsigned char* gp = ws + WS_PBR + (row0 + ((q_) >> 1) * 128 + (((q_) & 1) * 2 + mm) * 16) * 2048 + col0; \
            g1[buf][mm] = *(const u32x4*)gp; g2[buf][mm] = *(const u32x4*)(gp + 1024); } } while (0)
#define MRG_DOQ(buf, ai, mh) do { _Pragma("unroll") for (int mm = 0; mm < 2; ++mm) { const u32x4 a = g1[buf][mm], b = g2[buf][mm]; \
            MRG_SCALE1(ai, (mh) * 2 + mm, 0, 0, a.x, b.x); MRG_SCALE1(ai, (mh) * 2 + mm, 0, 1, a.y, b.y); MRG_SCALE1(ai, (mh) * 2 + mm, 1, 0, a.z, b.z); MRG_SCALE1(ai, (mh) * 2 + mm, 1, 1, a.w, b.w); } } while (0)
        MRG_LOADQ(0, 0); MRG_LOADQ(1, 1);
        MRG_DOQ(0, 0, 0); asm volatile("" ::: "memory"); MRG_LOADQ(0, 2);
        MRG_DOQ(1, 0, 1); asm volatile("" ::: "memory"); MRG_LOADQ(1, 3);
        MRG_DOQ(0, 1, 0); asm volatile("" ::: "memory");
        MRG_DOQ(1, 1, 1); asm volatile("" ::: "memory");
#undef MRG_LOADQ
#undef MRG_DOQ
    }
#undef MRG_SCALE1
#undef MRG_R
    __device__ __forceinline__ void operator()(const f32x4 (&acc)[2][2][4][2], const mg::Unit& u, int wr, int wc, int fr, int fq) const {
        const size_t row0 = (size_t)u.pm * 256 + wr * 64 + fr; const int col0 = u.pn * 256 + wc * 64 + 16 * fq;
        u32x4 g2a[2][4];
#pragma unroll
        for (int ai = 0; ai < 2; ++ai)
#pragma unroll
            for (int m = 0; m < 4; ++m) g2a[ai][m] = *(const u32x4*)(ws + WS_PBR + (row0 + ai * 128 + m * 16) * 2048 + 1024 + col0);
#pragma unroll
        for (int ai = 0; ai < 2; ++ai) {
#pragma unroll
            for (int m = 0; m < 4; ++m) { const u32x4 b = g2a[ai][m]; bf16* op = (bf16*)(ws + WS_MRG) + (row0 + ai * 128 + m * 16) * 1024 + col0;
#define MRG_G(wb, sh) (fmaxf((float)(((wb) >> (sh)) & 0xffu), 0.5f) * (1.f / 255.f))
#define MRG_OUT(bj, bw0, bw1, dst) do { const f32x4 v0 = acc[ai][bj][m][0], v1 = acc[ai][bj][m][1]; u32x4 w; \
                    w.x = pk2(v0[0] * MRG_G(bw0, 0), v0[1] * MRG_G(bw0, 8)); w.y = pk2(v0[2] * MRG_G(bw0, 16), v0[3] * MRG_G(bw0, 24)); \
                    w.z = pk2(v1[0] * MRG_G(bw1, 0), v1[1] * MRG_G(bw1, 8)); w.w = pk2(v1[2] * MRG_G(bw1, 16), v1[3] * MRG_G(bw1, 24)); *(u32x4*)(dst) = w; } while (0)
                MRG_OUT(0, b.x, b.y, op); MRG_OUT(1, b.z, b.w, op + 8);
#undef MRG_OUT
#undef MRG_G
            }
            asm volatile("" ::: "memory"); }
    }
};
struct EpiOut {
    static constexpr bool PERM = true, PRE = false, PERM2 = false; const float* x; const float* mod; unsigned char* ws;
    __device__ __forceinline__ void operator()(const f32x4 (&acc)[2][2][4][2], const mg::Unit& u, int wr, int wc, int fr, int fq) const {
        const size_t row0 = (size_t)u.pm * 256 + wr * 64 + fr; const int col0 = u.pn * 256 + wc * 32 + 8 * fq; const int b = u.pm >> 3;
        f32x4 ga[2][2];
#pragma unroll
        for (int bj = 0; bj < 2; ++bj)
#pragma unroll
            for (int n = 0; n < 2; ++n) ga[bj][n] = *(const f32x4*)(mod + (size_t)b * 6144 + 2048 + col0 + bj * 128 + n * 4);
        f32x4 xv[2][2][2][2];
#define OUT_LOADQ(buf, q_) do { _Pragma("unroll") for (int mm = 0; mm < 2; ++mm) { const size_t off = (row0 + ((q_) >> 1) * 128 + (((q_) & 1) * 2 + mm) * 16) * 1024 + col0; \
            _Pragma("unroll") for (int bj = 0; bj < 2; ++bj) { xv[buf][mm][bj][0] = *(const f32x4*)(x + off + bj * 128); xv[buf][mm][bj][1] = *(const f32x4*)(x + off + bj * 128 + 4); } } } while (0)
#define OUT_DOQ(buf, ai, mh) do { _Pragma("unroll") for (int mm = 0; mm < 2; ++mm) { const int m = (mh) * 2 + mm; const size_t off = (row0 + (ai) * 128 + m * 16) * 1024 + col0; \
            _Pragma("unroll") for (int bj = 0; bj < 2; ++bj) { const f32x4 v0 = xv[buf][mm][bj][0] + ga[bj][0] * acc[ai][bj][m][0], v1 = xv[buf][mm][bj][1] + ga[bj][1] * acc[ai][bj][m][1]; \
                u32x4 w; w.x = pk2(v0[0], v0[1]); w.y = pk2(v0[2], v0[3]); w.z = pk2(v1[0], v1[1]); w.w = pk2(v1[2], v1[3]); \
                *(u32x4*)((bf16*)(ws + WS_X1) + off + bj * 128) = w; } } } while (0)
        OUT_LOADQ(0, 0); OUT_LOADQ(1, 1);
        OUT_DOQ(0, 0, 0); asm volatile("" ::: "memory"); OUT_LOADQ(0, 2);
        OUT_DOQ(1, 0, 1); asm volatile("" ::: "memory"); OUT_LOADQ(1, 3);
        OUT_DOQ(0, 1, 0); asm volatile("" ::: "memory");
        OUT_DOQ(1, 1, 1); asm volatile("" ::: "memory");
#undef OUT_LOADQ
#undef OUT_DOQ
    }
};
struct EpiSwiglu {
    static constexpr bool PERM = true, PRE = false, PERM2 = false; unsigned char* ws;
    __device__ __forceinline__ void operator()(const f32x4 (&acc)[2][2][4][2], const mg::Unit& u, int wr, int wc, int fr, int fq) const {
        unsigned char* p0 = ws + WS_HID + ((size_t)u.pm * 256 + wr * 64 + fr) * 1024 + u.pn * 128 + wc * 32 + 8 * fq;
#pragma unroll
        for (int ai = 0; ai < 2; ++ai)
#pragma unroll
            for (int m = 0; m < 4; ++m) { float r[8];
#pragma unroll
                for (int n = 0; n < 2; ++n)
#pragma unroll
                    for (int j = 0; j < 4; j += 2) {
                        const f32x2 g = {acc[ai][0][m][n][j], acc[ai][0][m][n][j + 1]}, uu = {acc[ai][1][m][n][j], acc[ai][1][m][n][j + 1]};
                        const f32x2 x = g * (f32x2){-1.4426950408889634f * W8_INV, -1.4426950408889634f * W8_INV};
                        const f32x2 e = {__builtin_amdgcn_exp2f(x.x), __builtin_amdgcn_exp2f(x.y)};
                        const f32x2 d = __builtin_elementwise_fma(e, (f32x2){1024.f, 1024.f}, (f32x2){1024.f, 1024.f});
                        const f32x2 rr = {__builtin_amdgcn_rcpf(d.x), __builtin_amdgcn_rcpf(d.y)};
                        const f32x2 o = (g * uu) * rr; r[n * 4 + j] = o.x; r[n * 4 + j + 1] = o.y; }
                u32x2 w; w.x = pk4_fp8(r[0], r[1], r[2], r[3]); w.y = pk4_fp8(r[4], r[5], r[6], r[7]);
                *(u32x2*)(p0 + (size_t)(ai * 128 + m * 16) * 1024) = w; }
    }
};
constexpr float Y8_SCALE = 8.f, Y8_INV = 1.f / 8.f;
struct EpiDown {
    static constexpr bool PERM = true, PRE = true, PRE_MID = false, PERM2 = true; unsigned char* ws;
    struct Pre { float v[8]; };
    __device__ __forceinline__ void pre_mid(Pre&, const mg::Unit&, int, int, int, int) const {}
    __device__ __forceinline__ void pre_fin(Pre& P, const mg::Unit& u, int wr, int wc, int fr, int fq) const {
        const float* val = (const float*)(ws + WS_VAL) + (size_t)u.pm * 256 + wr * 64 + fr;
#pragma unroll
        for (int ai = 0; ai < 2; ++ai)
#pragma unroll
            for (int m = 0; m < 4; ++m) asm volatile("global_load_dword %0, %1, off" : "=v"(P.v[ai * 4 + m]) : "v"(val + ai * 128 + m * 16) : "memory");
    }
    __device__ __forceinline__ void operator()(const f32x4 (&acc)[2][2][4][2], const mg::Unit& u, int wr, int wc, int fr, int fq, Pre& P) const {
        const size_t row0 = (size_t)u.pm * 256 + wr * 64 + fr;
        unsigned char* p0 = ws + WS_Y + row0 * 1024 + u.pn * 256 + wc * 64 + 16 * fq;
        asm volatile("s_waitcnt vmcnt(16)" : "+v"(P.v[0]), "+v"(P.v[1]), "+v"(P.v[2]), "+v"(P.v[3]), "+v"(P.v[4]), "+v"(P.v[5]), "+v"(P.v[6]), "+v"(P.v[7]) :: "memory");
#pragma unroll
        for (int ai = 0; ai < 2; ++ai)
#pragma unroll
            for (int m = 0; m < 4; ++m) { const float vv = P.v[ai * 4 + m] * (W8_INV * Y8_SCALE); unsigned char* rowp = p0 + (size_t)(ai * 128 + m * 16) * 1024;
                const f32x4 v0 = acc[ai][0][m][0] * vv, v1 = acc[ai][0][m][1] * vv, v2 = acc[ai][1][m][0] * vv, v3 = acc[ai][1][m][1] * vv;
                u32x4 w; w.x = pk4_fp8(v0[0], v0[1], v0[2], v0[3]); w.y = pk4_fp8(v1[0], v1[1], v1[2], v1[3]); w.z = pk4_fp8(v2[0], v2[1], v2[2], v2[3]); w.w = pk4_fp8(v3[0], v3[1], v3[2], v3[3]);
                *(u32x4*)rowp = w; }
    }
};

struct SchedP1 {
    static constexpr int TSLOT = 0; unsigned char* ws; int G, c, nrep; int erep = 1;
    __device__ __forceinline__ bool next(int i, mg::Unit& u) const {
        int L = i * G + c; if (L >= 4736 * nrep) return false; const int dup = L >= 4736 ? 8 : 0; L %= 4736; const char* H = (const char*)(ws + WS_H); u.gi = nullptr;
        if (L < 4096) { mg::tile_of(L, 256, 16, u.pm, u.pn); u.ty = 0 + dup; u.a = H + (size_t)u.pm * 256 * 2048; u.b = (const char*)(ws + WS_WTM) + (size_t)u.pn * 256 * 2048; return true; }
        L -= 4096;
        if (L < 512) { mg::tile_of(L, 2, 256, u.pm, u.pn); u.ty = 1 + dup; u.a = (const char*)(ws + WS_WTF) + (size_t)u.pm * 256 * 2048; u.b = H + (size_t)u.pn * 256 * 2048; return true; }
        L -= 512;
        if (L < 128) { mg::tile_of(L, 32, 4, u.pm, u.pn); u.ty = 2 + dup; u.a = H + ((size_t)NTOK + (size_t)u.pm * 256) * 2048; u.b = (const char*)(ws + WS_WTM) + ((size_t)512 + (size_t)u.pn * 256) * 2048; return true; }
        return false;
    }
};
struct SchedF2 {
    static constexpr int TSLOT = 1; unsigned char* ws; int G, c, nrep; int erep = 1;
    __device__ __forceinline__ bool next(int i, mg::Unit& u) const {
        int L = i * G + c; if (L >= 256 * nrep) return false; L %= 256; mg::tile_of(L, 8, 32, u.pm, u.pn); u.ty = 0; u.gi = nullptr;
        u.a = (const char*)(ws + WS_TT) + (size_t)u.pm * 256 * 8192; u.b = (const char*)(ws + WS_AB) + (size_t)u.pn * 256 * 8192; return true;
    }
};
struct SchedMerge {
    static constexpr int TSLOT = 2; unsigned char* ws; int G, c, nrep; int erep = 1;
    __device__ __forceinline__ bool next(int i, mg::Unit& u) const {
        int L = i * G + c; if (L >= 1024 * nrep) return false; L %= 1024; mg::tile_of(L, 256, 4, u.pm, u.pn); u.ty = 0; u.gi = nullptr;
        u.a = (const char*)(ws + WS_FU) + (size_t)u.pm * 256 * 1024; u.b = (const char*)(ws + WS_WFT) + (size_t)u.pn * 256 * 1024;
        u.a2 = (const char*)(ws + WS_HM) + (size_t)u.pm * 256 * 1024; u.b2 = (const char*)(ws + WS_WMT) + (size_t)u.pn * 256 * 1024; return true;
    }
};
struct SchedOut {
    static constexpr int TSLOT = 3; unsigned char* ws; int G, c, nrep; int erep = 1;
    __device__ __forceinline__ bool next(int i, mg::Unit& u) const {
        int L = i * G + c; if (L >= 1024 * nrep) return false; L %= 1024; mg::tile_of(L, 256, 4, u.pm, u.pn); u.ty = 0; u.gi = nullptr;
        u.a = (const char*)(ws + WS_MRG) + (size_t)u.pm * 256 * 2048; u.b = (const char*)(ws + WS_WOT) + (size_t)u.pn * 256 * 2048; return true;
    }
};
struct SchedUp {
    static constexpr int TSLOT = 4; unsigned char* ws; int G, c, nrep; int erep = 1;
    __device__ __forceinline__ bool next(int i, mg::Unit& u) const {
        int L = i * G + c; if (L >= 4096 * nrep) return false; L %= 4096; mg::tile_of(L, 512, 8, u.pm, u.pn); u.ty = 0;
        u.a = (const char*)(ws + WS_HX2); u.gi = (const int*)(ws + WS_IDX) + (size_t)u.pm * 256; u.b = (const char*)(ws + WS_WGU) + ((size_t)(u.pm >> 5) * 8 + u.pn) * 256 * 1024; return true;
    }
};
struct SchedDown {
    static constexpr int TSLOT = 5; unsigned char* ws; int G, c, nrep; int erep = 1;
    __device__ __forceinline__ bool next(int i, mg::Unit& u) const {
        int L = i * G + c; if (L >= 2048 * nrep) return false; L %= 2048; mg::tile_of(L, 512, 4, u.pm, u.pn); u.ty = 0;
        u.a = (const char*)(ws + WS_HID); u.gi = (const int*)(ws + WS_IDENT) + (size_t)u.pm * 256; u.b = (const char*)(ws + WS_WD) + ((size_t)(u.pm >> 5) * 4 + u.pn) * 256 * 1024; return true;
    }
};

__device__ __forceinline__ void transpose_item(const float* W, int ldw, int n0, int k0, bf16* dst, int drow0, int Kd, LAS float* scr, int lane) {
#pragma unroll 8
    for (int i = 0; i < 32; ++i) { const int kk = 2 * i + (lane >> 5); scr[kk * 33 + (lane & 31)] = W[(size_t)(k0 + kk) * ldw + n0 + (lane & 31)]; }
    asm volatile("s_waitcnt lgkmcnt(0)" ::: "memory");
    const int c = lane & 7;
#pragma unroll
    for (int j = 0; j < 4; ++j) { const int n = (lane >> 3) + 8 * j; const LAS float* s = scr + (8 * c) * 33 + n;
        u32x4 o; o.x = pk2(s[0 * 33], s[1 * 33]); o.y = pk2(s[2 * 33], s[3 * 33]); o.z = pk2(s[4 * 33], s[5 * 33]); o.w = pk2(s[6 * 33], s[7 * 33]);
        *(u32x4*)(dst + (size_t)(drow0 + n) * Kd + k0 + 8 * c) = o; }
    asm volatile("s_waitcnt lgkmcnt(0)" ::: "memory");
}

__device__ __forceinline__ void transpose_item8(const float* W, int ldw, int n0, int k0, unsigned char* dst, int drow0, int Kd, LAS float* scr, int lane) {
#pragma unroll 8
    for (int i = 0; i < 32; ++i) { const int kk = 2 * i + (lane >> 5); scr[kk * 33 + (lane & 31)] = W[(size_t)(k0 + kk) * ldw + n0 + (lane & 31)] * W8_SCALE; }
    asm volatile("s_waitcnt lgkmcnt(0)" ::: "memory");
    const int c = lane & 7;
#pragma unroll
    for (int j = 0; j < 4; ++j) { const int n = (lane >> 3) + 8 * j; const LAS float* s = scr + (8 * c) * 33 + n;
        u32x2 o; o.x = pk4_fp8(s[0 * 33], s[1 * 33], s[2 * 33], s[3 * 33]); o.y = pk4_fp8(s[4 * 33], s[5 * 33], s[6 * 33], s[7 * 33]);
        *(u32x2*)(dst + (size_t)(drow0 + n) * Kd + k0 + 8 * c) = o; }
    asm volatile("s_waitcnt lgkmcnt(0)" ::: "memory");
}

__device__ __forceinline__ void split8(const float (&x)[8], bf16x8& hi, bf16x8& lo) {
    u32x4 h, l;
    h.x = pk2(x[0], x[1]); h.y = pk2(x[2], x[3]); h.z = pk2(x[4], x[5]); h.w = pk2(x[6], x[7]);
    l.x = pk2(x[0] - bflo(h.x), x[1] - bfhi(h.x)); l.y = pk2(x[2] - bflo(h.y), x[3] - bfhi(h.y)); l.z = pk2(x[4] - bflo(h.z), x[5] - bfhi(h.z)); l.w = pk2(x[6] - bflo(h.w), x[7] - bfhi(h.w));
    hi = __builtin_bit_cast(bf16x8, h); lo = __builtin_bit_cast(bf16x8, l);
}
__device__ __forceinline__ void p0_prep(const Ctx& C, LAS unsigned char* lds, int tid, int lane, int wave, int G) {
    const int blk = blockIdx.x;
    for (int item = blk; item < 384; item += 2 * G) {
        const bool two = item + G < 384; const int n0 = item * 16, n1 = (two ? item + G : item) * 16, i = lane & 15, g = lane >> 4;
        f32x4 acc[2][3];
#pragma unroll
        for (int q = 0; q < 2; ++q)
#pragma unroll
            for (int rt = 0; rt < 3; ++rt) acc[q][rt] = (f32x4){0.f, 0.f, 0.f, 0.f};
        float wv[2][4][8]; f32x4 cv[4][3][2];
#pragma unroll
        for (int sx = 0; sx < 4; ++sx) { const int k0 = 32 * (4 * wave + sx) + 8 * g;
#pragma unroll
            for (int e = 0; e < 8; ++e) { wv[0][sx][e] = C.w_ada[(size_t)(k0 + e) * 6144 + n0 + i]; wv[1][sx][e] = C.w_ada[(size_t)(k0 + e) * 6144 + n1 + i]; }
#pragma unroll
            for (int rt = 0; rt < 3; ++rt) { const float* cp = rt < 2 ? C.c + (size_t)(16 * rt + i) * 1024 + k0 : (i == 0 ? C.c_ctx + k0 : C.c + (size_t)i * 1024 + k0);
                cv[sx][rt][0] = *(const f32x4*)cp; cv[sx][rt][1] = *(const f32x4*)(cp + 4); } }
#pragma unroll
        for (int sx = 0; sx < 4; ++sx) { bf16x8 ah[2], al[2]; split8(wv[0][sx], ah[0], al[0]); split8(wv[1][sx], ah[1], al[1]);
#pragma unroll
            for (int rt = 0; rt < 3; ++rt) { float sv[8];
#pragma unroll
                for (int e = 0; e < 4; ++e) { sv[e] = silu_f(cv[sx][rt][0][e]); sv[4 + e] = silu_f(cv[sx][rt][1][e]); }
                bf16x8 bh, bl; split8(sv, bh, bl);
#pragma unroll
                for (int q = 0; q < 2; ++q) {
                    acc[q][rt] = __builtin_amdgcn_mfma_f32_16x16x32_bf16(ah[q], bh, acc[q][rt], 0, 0, 0);
                    acc[q][rt] = __builtin_amdgcn_mfma_f32_16x16x32_bf16(al[q], bh, acc[q][rt], 0, 0, 0);
                    acc[q][rt] = __builtin_amdgcn_mfma_f32_16x16x32_bf16(ah[q], bl, acc[q][rt], 0, 0, 0); } } }
        LAS f32x4* red = (LAS f32x4*)lds;
#pragma unroll
        for (int q = 0; q < 2; ++q)
#pragma unroll
            for (int rt = 0; rt < 3; ++rt) red[((q * 8 + wave) * 3 + rt) * 64 + lane] = acc[q][rt];
        __syncthreads();
        float* mod = (float*)(C.ws + WS_MOD);
        for (int o = tid; o < (two ? 2 : 1) * 33 * 16; o += 512) { const int q = o >= 33 * 16, oo = o - q * 33 * 16, r = oo >> 4, n = oo & 15; float sacc = 0.f;
#pragma unroll
            for (int w = 0; w < 8; ++w) sacc += ((const LAS float*)(red + ((q * 8 + w) * 3 + (r >> 4)) * 64 + ((n >> 2) * 16 + (r & 15))))[n & 3];
            const int nn = (q ? n1 : n0) + n; mod[(size_t)r * 6144 + nn] = sacc + C.b_ada[nn]; }
        __syncthreads();
    }
    {   const int NGW = G * 8;
        for (int d = blk * 8 + wave; d < 1024; d += NGW) { const float sg = (lane & 1) ? -1.f : 1.f;
#pragma unroll
            for (int g = 0; g < 4; ++g) { const float* wp = C.w_in + (size_t)d * INC + g * 128; const float sv = wave_sum(sg * (wp[lane] + wp[lane + 64])); if (lane == 0) ((float*)(C.ws + WS_W64))[d * 4 + g] = sv; } }
    }
}
__device__ __forceinline__ void p0_wtf(const Ctx& C, LAS unsigned char* lds, int tid, int vb, int nvb) {
    LAS float* cs = (LAS float*)lds; LAS float* sn = cs + 128; const int lane = tid & 63, wave = tid >> 6, i = lane & 15, g4 = lane >> 4;
    if (tid < 128) { cs[tid] = cospif((float)tid * (1.f / 64.f)); sn[tid] = sinpif((float)tid * (1.f / 64.f)); }
    __syncthreads();
    for (int item = vb; item < 256; item += nvb) {
        const int g = item >> 6, d0 = (item & 63) * 16; const int rj = 16 * wave + i, jj = rj >> 1; const LAS float* tw = (rj & 1) ? sn : cs;
        const float* ap = C.w_in + (size_t)(d0 + i) * INC + g * 128 + 8 * g4;
        f32x4 av[4][2];
#pragma unroll
        for (int ks = 0; ks < 4; ++ks) { av[ks][0] = *(const f32x4*)(ap + 32 * ks); av[ks][1] = *(const f32x4*)(ap + 32 * ks + 4); }
        f32x4 acc = {0.f, 0.f, 0.f, 0.f};
#pragma unroll
        for (int ks = 0; ks < 4; ++ks) { float a8[8], b8[8];
#pragma unroll
            for (int e = 0; e < 4; ++e) { a8[e] = av[ks][0][e]; a8[4 + e] = av[ks][1][e]; }
#pragma unroll
            for (int e = 0; e < 8; ++e) b8[e] = tw[(jj * (32 * ks + 8 * g4 + e)) & 127];
            bf16x8 ah, al, bh, bl; split8(a8, ah, al); split8(b8, bh, bl);
            acc = __builtin_amdgcn_mfma_f32_16x16x32_bf16(ah, bh, acc, 0, 0, 0);
            acc = __builtin_amdgcn_mfma_f32_16x16x32_bf16(al, bh, acc, 0, 0, 0);
            acc = __builtin_amdgcn_mfma_f32_16x16x32_bf16(ah, bl, acc, 0, 0, 0); }
        u32x2 o; o.x = pk2(acc[0], acc[1]); o.y = pk2(acc[2], acc[3]);
        *(u32x2*)((bf16*)(C.ws + WS_WTF) + (size_t)(g * 128 + rj) * 1024 + d0 + 4 * g4) = o;
    }
    __syncthreads();
}
__device__ __forceinline__ void p0_tt(const Ctx& C, LAS unsigned char* lds, int tid, int vb, int nvb) {
    {
        LAS float* tc = (LAS float*)lds; LAS float* ts = tc + 2048;
        for (int i = tid; i < 2048; i += 512) { const float a = (float)i * (1.f / 1024.f); tc[i] = cospif(a) * (1.f / 512.f); ts[i] = -sinpif(a) * (1.f / 512.f); }
        __syncthreads();
        for (int item = vb; item < 256; item += nvb)
            for (int rr = 0; rr < 8; ++rr) { const int k = item * 8 + rr; const int lp0 = tid * 8; const LAS float* tb = lp0 < 2048 ? tc : ts; const int l0 = lp0 & 2047; float v[8];
#pragma unroll
                for (int e = 0; e < 8; ++e) v[e] = tb[(k * (l0 + e)) & 2047];
                u32x4 o; o.x = pk2(v[0], v[1]); o.y = pk2(v[2], v[3]); o.z = pk2(v[4], v[5]); o.w = pk2(v[6], v[7]);
                *(u32x4*)((bf16*)(C.ws + WS_TT) + (size_t)k * 4096 + lp0) = o; }
        __syncthreads();
    }
}
__device__ __forceinline__ void p0_weights(const Ctx& C, LAS unsigned char* lds, int tid, int lane, int wave, int G) {
    const int blk = blockIdx.x;
    {
        LAS float* scr = (LAS float*)lds + wave * (64 * 33);
        const int gw = blk * 8 + wave, NGW = G * 8;
        constexpr int I_IN = 16 * 128, I_M = 8 * 32, I_O = 16 * 32;
        for (int it = gw; it < I_IN + I_M + I_O; it += NGW) {
            int r = it;
            if (r < I_IN) { const int kb = r >> 7, nb = r & 127; const int n0 = nb < 64 ? 512 + 32 * nb : 2576 + 32 * (nb - 64);
                transpose_item(C.w_in, INC, n0, kb * 64, (bf16*)(C.ws + WS_WTM), 32 * nb, 1024, scr, lane); continue; }
            r -= I_IN;
            if (r < I_M) { const int kb = r >> 5, nb = r & 31; transpose_item(C.w_mlstm, 1024, 32 * nb, kb * 64, (bf16*)(C.ws + WS_WMT), 32 * nb, 512, scr, lane); continue; }
            r -= I_M;
            { const int kb = r >> 5, nb = r & 31; transpose_item(C.w_out, 1024, 32 * nb, kb * 64, (bf16*)(C.ws + WS_WOT), 32 * nb, 1024, scr, lane); }
        }
        for (int idx = blk * 512 + tid; idx < 1024 * 64; idx += G * 512) { const int n = idx >> 6, k0 = (idx & 63) * 8; float v[8];
#pragma unroll
            for (int e = 0; e < 8; ++e) { const int kp = k0 + e, kk = kp & 255, gg = kk >> 6, j = kk & 63; const int src = kp < 256 ? gg * 128 + j : gg * 128 + 128 - j - (j ? 0 : 64); v[e] = C.w_fourier[(size_t)src * 1024 + n]; }
            u32x4 o; o.x = pk2(v[0], v[1]); o.y = pk2(v[2], v[3]); o.z = pk2(v[4], v[5]); o.w = pk2(v[6], v[7]);
            *(u32x4*)((bf16*)(C.ws + WS_WFT) + (size_t)n * 512 + k0) = o; }
    }
}
#ifndef CVT_N1
#define CVT_N1 4
#define CVT_N2 10
#endif
static_assert(512 * CVT_N1 + 1536 * CVT_N2 == 24576 - 7168, "conversion split");
__device__ __forceinline__ void convert_item(const Ctx& C, LAS float* scr, int it, int lane);
__device__ __forceinline__ void convert_experts(const Ctx& C, LAS unsigned char* lds, int lane, int wave, int G, int rep, int part) {
    LAS float* scr = (LAS float*)lds + wave * (64 * 33);
    const int gw = blockIdx.x * 8 + wave, NGW = G * 8;
    if (G == 256) {
        for (int r = 0; r < rep; ++r) {
            if (part == 0) { if ((int)blockIdx.x >= 128) { const int w = gw - 1024; for (int k = 0; k < 7; ++k) convert_item(C, scr, w * 7 + k, lane); } }
            else if (wave < 2) { const int ib = (int)blockIdx.x * 2 + wave; for (int k = 0; k < CVT_N1; ++k) convert_item(C, scr, 7168 + 1536 * CVT_N2 + ib * CVT_N1 + k, lane); }
            else { const int ia = (int)blockIdx.x * 6 + wave - 2; for (int k = 0; k < CVT_N2; ++k) convert_item(C, scr, 7168 + ia * CVT_N2 + k, lane); } }
        return; }
    if (part == 0) return;
    for (int it0 = gw; it0 < 48 * 512 * rep; it0 += NGW) convert_item(C, scr, it0 % (48 * 512), lane);
}
__device__ __forceinline__ void convert_item(const Ctx& C, LAS float* scr, int it, int lane) { {
        const int mat = it >> 9, r = it & 511, kb = r >> 5, nb = r & 31, e = mat & 15, which = mat >> 4;
        if (which < 2) { const float* W = (which ? C.w_up_e : C.w_gate_e) + (size_t)e * 1024 * 1024; const int n0 = 32 * nb;
            transpose_item8(W, 1024, n0, kb * 64, C.ws + WS_WGU, e * 2048 + (n0 >> 7) * 256 + which * 128 + (n0 & 127), 1024, scr, lane); }
        else transpose_item8(C.w_down_e + (size_t)e * 1024 * 1024, 1024, 32 * nb, kb * 64, C.ws + WS_WD, e * 1024 + 32 * nb, 1024, scr, lane);
    }
}

__device__ __forceinline__ float swap_add32(float a, float b) { const u32x2 r = __builtin_amdgcn_permlane32_swap(__float_as_uint(a), __float_as_uint(b), false, false); return __uint_as_float(r.x) + __uint_as_float(r.y); }
__device__ __forceinline__ float swap_add16(float a, float b) { const u32x2 r = __builtin_amdgcn_permlane16_swap(__float_as_uint(a), __float_as_uint(b), false, false); return __uint_as_float(r.x) + __uint_as_float(r.y); }
__device__ __forceinline__ float butterfly64(float (&v)[64], int lane) {
#pragma unroll
    for (int i = 0; i < 32; ++i) v[i] = swap_add32(v[i], v[i + 32]);
#pragma unroll
    for (int i = 0; i < 16; ++i) v[i] = swap_add16(v[i], v[i + 16]);
#pragma unroll
    for (int i = 0; i < 8; ++i) { const bool up = lane & 8; const float send = up ? v[i] : v[i + 8], keep = up ? v[i + 8] : v[i]; v[i] = keep + __shfl_xor(send, 8); }
#pragma unroll
    for (int i = 0; i < 4; ++i) { const bool up = lane & 4; const float send = up ? v[i] : v[i + 4], keep = up ? v[i + 4] : v[i]; v[i] = keep + __shfl_xor(send, 4); }
#pragma unroll
    for (int i = 0; i < 2; ++i) { const bool up = lane & 2; const float send = up ? v[i] : v[i + 2], keep = up ? v[i + 2] : v[i]; v[i] = keep + __shfl_xor(send, 2); }
    { const bool up = lane & 1; const float send = up ? v[0] : v[1], keep = up ? v[1] : v[0]; v[0] = keep + __shfl_xor(send, 1); }
    return v[0];
}

__device__ __forceinline__ float butterfly16(float (&v)[16], int lane) {
#pragma unroll
    for (int i = 0; i < 8; ++i) v[i] = swap_add32(v[i], v[i + 8]);
#pragma unroll
    for (int i = 0; i < 4; ++i) v[i] = swap_add16(v[i], v[i + 4]);
#pragma unroll
    for (int i = 0; i < 2; ++i) { const bool up = lane & 8; const float send = up ? v[i] : v[i + 2], keep = up ? v[i + 2] : v[i]; v[i] = keep + __shfl_xor(send, 8); }
    { const bool up = lane & 4; const float send = up ? v[0] : v[1], keep = up ? v[1] : v[0]; v[0] = keep + __shfl_xor(send, 4); }
    v[0] += __shfl_xor(v[0], 2); v[0] += __shfl_xor(v[0], 1);
    return v[0];
}
template <bool OUT8, bool PROJ4, bool IN16 = false> __device__ __forceinline__ float rows4_norm_proj(const float* xin, size_t row0, const f32x4 (&gsc)[4], const f32x4 (&sh)[4], bf16* hout, const LAS float* wl, const LAS float* wl2, float& p4, int lane, const u32x2 (*raw)[4] = nullptr) {
    f32x4 v[4][4]; float ss[4];
#pragma unroll
    for (int r = 0; r < 4; ++r) { ss[r] = 0.f;
#pragma unroll
        for (int j = 0; j < 4; ++j) { if constexpr (IN16) { const u32x2 pw = raw ? raw[r][j] : *(const u32x2*)((const bf16*)xin + (row0 + r) * 1024 + 4 * lane + 256 * j); v[r][j] = (f32x4){bflo(pw.x), bfhi(pw.x), bflo(pw.y), bfhi(pw.y)}; }
            else v[r][j] = *(const f32x4*)(xin + (row0 + r) * 1024 + 4 * lane + 256 * j);
            ss[r] += v[r][j][0] * v[r][j][0] + v[r][j][1] * v[r][j][1] + v[r][j][2] * v[r][j][2] + v[r][j][3] * v[r][j][3]; } }
#pragma unroll
    for (int r = 0; r < 4; ++r) { const float rstd = rsqrtf(wave_sum(ss[r]) * (1.f / 1024.f) + EPS);
#pragma unroll
        for (int j = 0; j < 4; ++j) { v[r][j] = v[r][j] * rstd * gsc[j] + sh[j];
            if constexpr (OUT8) *(unsigned*)((unsigned char*)hout + (row0 + r) * 1024 + 4 * lane + 256 * j) = pk4_fp8(v[r][j][0], v[r][j][1], v[r][j][2], v[r][j][3]);
            else { u32x2 w; w.x = pk2(v[r][j][0], v[r][j][1]); w.y = pk2(v[r][j][2], v[r][j][3]); *(u32x2*)(hout + (row0 + r) * 1024 + 4 * lane + 256 * j) = w; } } }
    f32x2 accp[32], acc2p[8];
#pragma unroll
    for (int i = 0; i < 32; ++i) accp[i] = (f32x2){0.f, 0.f};
#pragma unroll
    for (int i = 0; i < 8; ++i) acc2p[i] = (f32x2){0.f, 0.f};
#pragma unroll
    for (int j = 0; j < 4; ++j)
#pragma unroll
        for (int e = 0; e < 4; ++e) { const LAS float* wp = wl + ((j * 4 + e) * 4) * 256 + lane * 4;
            if constexpr (PROJ4) { const f32x4 wb = *(const LAS f32x4*)(wl2 + ((j * 4 + e) * 64 + lane) * 4); const f32x2 wb0 = {wb[0], wb[1]}, wb1 = {wb[2], wb[3]};
#pragma unroll
                for (int r = 0; r < 4; ++r) { const f32x2 hv2 = {v[r][j][e], v[r][j][e]}; acc2p[r * 2] = __builtin_elementwise_fma(hv2, wb0, acc2p[r * 2]); acc2p[r * 2 + 1] = __builtin_elementwise_fma(hv2, wb1, acc2p[r * 2 + 1]); } }
#pragma unroll
            for (int q = 0; q < 4; ++q) { const f32x4 w4 = *(const LAS f32x4*)(wp + q * 256); const f32x2 w0 = {w4[0], w4[1]}, w1 = {w4[2], w4[3]};
#pragma unroll
                for (int r = 0; r < 4; ++r) { const f32x2 hv2 = {v[r][j][e], v[r][j][e]}; accp[r * 8 + 2 * q] = __builtin_elementwise_fma(hv2, w0, accp[r * 8 + 2 * q]); accp[r * 8 + 2 * q + 1] = __builtin_elementwise_fma(hv2, w1, accp[r * 8 + 2 * q + 1]); } }
            asm volatile("" ::: "memory"); }
    float acc[64], acc2[16];
#pragma unroll
    for (int i = 0; i < 32; ++i) { acc[2 * i] = accp[i][0]; acc[2 * i + 1] = accp[i][1]; }
#pragma unroll
    for (int i = 0; i < 8; ++i) { acc2[2 * i] = acc2p[i][0]; acc2[2 * i + 1] = acc2p[i][1]; }
    if constexpr (PROJ4) p4 = butterfly16(acc2, lane);
    return butterfly64(acc, lane);
}

__device__ __forceinline__ float gate_xf(float v, int lane) { return ((lane >> 2) & 1) ? fminf(v, 0.f) - log1pf(expf(-fabsf(v))) : v; }
__device__ __forceinline__ void p1a_norm_gates(const Ctx& C, LAS unsigned char* lds, int tid, int lane, int wave, int G, int rep2) {
    LAS float* wl = (LAS float*)lds;
    for (int i = tid; i < 1024 * 16; i += 512) { const int col = i >> 4, gc = i & 15; wl[(((((col >> 8) * 4 + (col & 3)) * 4 + (gc >> 2)) * 64 + ((col >> 2) & 63)) * 4) + (gc & 3)] = C.w_in[(size_t)col * INC + OFF_G + gc]; }
    LAS float* wl2 = wl + 1024 * 16;
    for (int i = tid; i < 1024 * 4; i += 512) { const int col = i >> 2, gg = i & 3; wl2[((((col >> 8) * 4 + (col & 3)) * 64 + ((col >> 2) & 63)) * 4) + gg] = ((const float*)(C.ws + WS_W64))[i]; }
    __syncthreads();
    const float* mod = (const float*)(C.ws + WS_MOD); bf16* H = (bf16*)(C.ws + WS_H); float* gates = (float*)(C.ws + WS_GATES); bf16* a64t = (bf16*)(C.ws + WS_A64T);
    const float gbias = C.b_gates[lane & 15];
    const int NGW = G * 8;
    for (int gw0 = blockIdx.x * 8 + wave; gw0 < 2048 * (1 + rep2); gw0 += NGW) { const int gw = gw0 & 2047;
        f32x4 gsc[4], sh[4];
        {   const int b = gw >> 6; const float* m = mod + (size_t)b * 6144;
#pragma unroll
            for (int j = 0; j < 4; ++j) { const int col = 4 * lane + 256 * j; const f32x4 g = *(const f32x4*)(C.g_norm1 + col), s = *(const f32x4*)(m + 1024 + col); gsc[j] = g * (s + 1.f); sh[j] = *(const f32x4*)(m + col); }
            for (int q = 0; q < 8; ++q) { const size_t row0 = (size_t)gw * 32 + q * 4; float p4; const float gv = rows4_norm_proj<false, true>(C.x, row0, gsc, sh, H, wl, wl2, p4, lane); gates[(row0 + (lane >> 4)) * 16 + (lane & 15)] = gate_xf(gv + gbias, lane);
                if ((lane & 3) == 0) { const int idx = lane >> 2; const size_t row = row0 + (idx >> 2); a64t[((row >> 11) * 4 + (idx & 3)) * 2048 + (row & 2047)] = (bf16)(pk2(p4, 0.f) & 0xffffu); } } }
        {   const float* m = mod + (size_t)32 * 6144;
#pragma unroll
            for (int j = 0; j < 4; ++j) { const int col = 4 * lane + 256 * j; const f32x4 g = *(const f32x4*)(C.g_norm1 + col), s = *(const f32x4*)(m + 1024 + col); gsc[j] = g * (s + 1.f); sh[j] = *(const f32x4*)(m + col); }
            const size_t row0 = (size_t)gw * 4; float p4; const float gv = rows4_norm_proj<false, false>(C.ctx, row0, gsc, sh, H + (size_t)NTOK * 1024, wl, wl2, p4, lane); gates[((size_t)NTOK + row0 + (lane >> 4)) * 16 + (lane & 15)] = gate_xf(gv + gbias, lane); }
    }
}

__device__ __forceinline__ f32x4 unpk4(u32x2 p) { return (f32x4){bflo(p.x), bfhi(p.x), bflo(p.y), bfhi(p.y)}; }
__device__ __forceinline__ void conv_load_x(const Ctx& C, int item, int lane, u32x2 (&raw)[3][10]) {
    const int sg = item & 7, cb = (item >> 3) & 3, r = (item >> 5) & 31, b = item >> 10;
    const bf16* ub = (const bf16*)(C.ws + WS_PQK) + (size_t)b * SEQ * 1024 + cb * 256; const int c0 = sg * 8; unsigned lo = 4u * (unsigned)lane;
    asm volatile("" : "+s"(ub), "+v"(lo));
#pragma unroll
    for (int dy = 0; dy < 3; ++dy) { const int rr = r + dy - 1; const bool rok = rr >= 0 && rr < 32;
#pragma unroll
        for (int i = 0; i < 10; ++i) { const int cc = c0 - 1 + i; const bool ok = rok && cc >= 0 && cc < 64; const int rc = min(max(rr, 0), 31), ccl = min(max(cc, 0), 63);
            const u32x2 t = *(const u32x2*)(ub + (size_t)(rc * 64 + ccl) * 1024 + lo); raw[dy][i] = ok ? t : (u32x2){0u, 0u}; } }
}
__device__ __forceinline__ f32x2 silu2_scaled(f32x2 a, float ik) { const f32x2 x = a * (f32x2){-1.4426950408889634f, -1.4426950408889634f}; const f32x2 e = {__builtin_amdgcn_exp2f(x.x), __builtin_amdgcn_exp2f(x.y)};
    const f32x2 d = __builtin_elementwise_fma(e, (f32x2){ik, ik}, (f32x2){ik, ik}); const f32x2 r = {__builtin_amdgcn_rcpf(d.x), __builtin_amdgcn_rcpf(d.y)}; return a * r; }
__device__ __forceinline__ void conv_compute_x(const Ctx& C, int item, int lane, const u32x2 (&raw)[3][10], const f32x4 (&w)[3][3]) {
    const int sg = item & 7, cb = (item >> 3) & 3, r = (item >> 5) & 31, b = item >> 10;
    const int cq = (cb & 1) * 256 + 4 * lane;
    bf16* dst = (bf16*)(C.ws + WS_QK) + ((size_t)(b * 4 + (cq >> 7)) * SEQ) * 256 + (cb >> 1) * 128 + (cq & 127); const int c0 = sg * 8;
    const float iksc = cb >= 2 ? 11.313708498984761f : 1.f;
#pragma unroll
    for (int i = 0; i < 8; ++i) { f32x4 a = {0.f, 0.f, 0.f, 0.f};
#pragma unroll
        for (int dy = 0; dy < 3; ++dy)
#pragma unroll
            for (int dx = 0; dx < 3; ++dx) a += w[dy][dx] * unpk4(raw[dy][i + dx]);
        const f32x2 s0 = silu2_scaled((f32x2){a[0], a[1]}, iksc), s1 = silu2_scaled((f32x2){a[2], a[3]}, iksc);
        u32x2 o; o.x = pk2(s0.x, s0.y); o.y = pk2(s1.x, s1.y);
        *(u32x2*)(dst + (size_t)(r * 64 + c0 + i) * 256) = o; }
}
__device__ __forceinline__ void conv_item_ctx(const Ctx& C, int item, int lane) {
    const int sg = item & 15, cb = (item >> 4) & 1, b = item >> 5;
    const int kc0 = cb * 256 + 4 * lane; const bf16* src = (const bf16*)(C.ws + WS_PC) + (size_t)b * CL * 1024 + kc0; bf16* dst = (bf16*)(C.ws + WS_KC) + (size_t)b * CL * 512 + kc0;
    const int c0 = sg * 16;
    u32x2 raw[18];
#pragma unroll
    for (int i = 0; i < 18; ++i) { const int cc = c0 - 1 + i; raw[i] = (cc >= 0 && cc < CL) ? *(const u32x2*)(src + (size_t)cc * 1024) : (u32x2){0u, 0u}; }
    f32x4 w[3];
#pragma unroll
    for (int dx = 0; dx < 3; ++dx) w[dx] = *(const f32x4*)(C.w_conv + (3 + dx) * 1024 + 512 + kc0);
    const float ksc = 0.08838834764831845f;
#pragma unroll
    for (int i = 0; i < 16; ++i) { const f32x4 a = w[0] * unpk4(raw[i]) + w[1] * unpk4(raw[i + 1]) + w[2] * unpk4(raw[i + 2]);
        u32x2 o; o.x = pk2(silu_f(a[0]) * ksc, silu_f(a[1]) * ksc); o.y = pk2(silu_f(a[2]) * ksc, silu_f(a[3]) * ksc);
        *(u32x2*)(dst + (size_t)(c0 + i) * 512) = o; }
}
__device__ __forceinline__ void f64_tile(const Ctx& C, int tile, int lane) {
    const int kt = tile >> 3, nt8 = tile & 7, i = lane & 15, g4 = lane >> 4;
    const bf16* ap = (const bf16*)(C.ws + WS_TT) + (size_t)(16 * kt + i) * 4096 + 8 * g4; const bf16* bp = (const bf16*)(C.ws + WS_A64T) + (size_t)(16 * nt8 + i) * 2048 + 8 * g4;
    f32x4 acc = {0.f, 0.f, 0.f, 0.f};
    for (int kb = 0; kb < 64; kb += 16) {
        bf16x8 fa[16], fb[16];
#pragma unroll
        for (int q = 0; q < 16; ++q) { fa[q] = *(const bf16x8*)(ap + 32 * (kb + q)); fb[q] = *(const bf16x8*)(bp + 32 * (kb + q)); }
        __builtin_amdgcn_sched_barrier(0);
#pragma unroll
        for (int q = 0; q < 16; ++q) acc = __builtin_amdgcn_mfma_f32_16x16x32_bf16(fa[q], fb[q], acc, 0, 0, 0);
        __builtin_amdgcn_sched_barrier(0); }
    const int n = 16 * nt8 + i; bf16* fo = (bf16*)(C.ws + WS_FU) + ((size_t)(n >> 2) * 2048 + 16 * kt + 4 * g4) * 512 + 256 + (n & 3) * 64;
#pragma unroll
    for (int r = 0; r < 4; ++r) fo[(size_t)r * 512] = (bf16)(pk2(acc[r], 0.f) & 0xffffu);
}
__device__ __forceinline__ void conv_load_row(const bf16* ub, unsigned lo, int rr, int c0, u32x2 (&row)[10]) {
    const bool rok = rr >= 0 && rr < 32; const int rc = min(max(rr, 0), 31);
#pragma unroll
    for (int i = 0; i < 10; ++i) { const int cc = c0 - 1 + i; const bool ok = rok && cc >= 0 && cc < 64; const int ccl = min(max(cc, 0), 63);
        const u32x2 t = *(const u32x2*)(ub + (size_t)(rc * 64 + ccl) * 1024 + lo); row[i] = ok ? t : (u32x2){0u, 0u}; }
}
__device__ __forceinline__ void conv_out_row(bf16* dst, const u32x2 (&ra)[10], const u32x2 (&rb)[10], const u32x2 (&rc)[10], const f32x4 (&w)[3][3], float iksc) {
#pragma unroll
    for (int i = 0; i < 8; ++i) { f32x4 a = {0.f, 0.f, 0.f, 0.f};
#pragma unroll
        for (int dx = 0; dx < 3; ++dx) { a += w[0][dx] * unpk4(ra[i + dx]); a += w[1][dx] * unpk4(rb[i + dx]); a += w[2][dx] * unpk4(rc[i + dx]); }
        const f32x2 s0 = silu2_scaled((f32x2){a[0], a[1]}, iksc), s1 = silu2_scaled((f32x2){a[2], a[3]}, iksc);
        u32x2 o; o.x = pk2(s0.x, s0.y); o.y = pk2(s1.x, s1.y);
        *(u32x2*)(dst + (size_t)i * 256) = o; }
}
__device__ __forceinline__ void conv_strip(const Ctx& C, int strip, int lane) {
    const int half = strip & 1, sg = (strip >> 1) & 7, cb = (strip >> 4) & 3, b = strip >> 6, rbase = 16 * half, c0 = sg * 8;
    f32x4 w[3][3];
#pragma unroll
    for (int dy = 0; dy < 3; ++dy)
#pragma unroll
        for (int dx = 0; dx < 3; ++dx) w[dy][dx] = *(const f32x4*)(C.w_conv + (dy * 3 + dx) * 1024 + cb * 256 + 4 * lane);
    const bf16* ub = (const bf16*)(C.ws + WS_PQK) + (size_t)b * SEQ * 1024 + cb * 256; unsigned lo = 4u * (unsigned)lane;
    asm volatile("" : "+s"(ub), "+v"(lo));
    const int cq = (cb & 1) * 256 + 4 * lane;
    bf16* dst = (bf16*)(C.ws + WS_QK) + ((size_t)(b * 4 + (cq >> 7)) * SEQ) * 256 + (cb >> 1) * 128 + (cq & 127) + (size_t)c0 * 256;
    const float iksc = cb >= 2 ? 11.313708498984761f : 1.f;
    u32x2 R0[10], R1[10], R2[10], R3[10];
    conv_load_row(ub, lo, rbase - 1, c0, R0); conv_load_row(ub, lo, rbase, c0, R1); conv_load_row(ub, lo, rbase + 1, c0, R2);
#pragma unroll 1
    for (int q = 0; q < 16; q += 4) { const int r = rbase + q; bf16* d = dst + (size_t)r * 64 * 256;
        conv_load_row(ub, lo, r + 2, c0, R3); conv_out_row(d, R0, R1, R2, w, iksc);
        conv_load_row(ub, lo, r + 3, c0, R0); conv_out_row(d + (size_t)64 * 256, R1, R2, R3, w, iksc);
        conv_load_row(ub, lo, r + 4, c0, R1); conv_out_row(d + (size_t)128 * 256, R2, R3, R0, w, iksc);
        conv_load_row(ub, lo, r + 5, c0, R2); conv_out_row(d + (size_t)192 * 256, R3, R0, R1, w, iksc); }
}
__device__ __forceinline__ void p2_conv(const Ctx& C, int lane, int wave, int G, int rep2) {
    const int NGW = G * 8;
    for (int it = wave * G + (int)blockIdx.x; it < 1024; it += NGW) f64_tile(C, it, lane);
    const int vblk = (int)blockIdx.x;
    for (int rep = 0; rep <= rep2; ++rep) {
        for (int st = vblk * 8 + wave; st < NB * 64; st += NGW) conv_strip(C, st, lane);
        for (int itc = ((wave + 4) & 7) * G + vblk; itc < NB * 32; itc += NGW) conv_item_ctx(C, itc, lane);
    }
}

__device__ __forceinline__ void p3b_combine(const Ctx& C, int tid, int G, int rep2) {
    const u32x2* po = (const u32x2*)(C.ws + WS_PO); const u32x4* hf = (const u32x4*)(C.ws + WS_HF); const u32x4* hb = (const u32x4*)(C.ws + WS_HB); u32x4* hm = (u32x4*)(C.ws + WS_HM);
    const size_t n = (size_t)NTOK * 512 / 8;
    for (size_t i0 = (size_t)blockIdx.x * 512 + tid; i0 < n * (1 + rep2); i0 += (size_t)G * 512) { const size_t i = i0 >= n ? i0 - n : i0; const u32x2 o = po[i]; const u32x4 a = hf[i], b = hb[i]; u32x4 r;
        r.x = pk2(u8f0(o.x) * (bflo(a.x) + bflo(b.x)), u8f1(o.x) * (bfhi(a.x) + bfhi(b.x))); r.y = pk2(u8f2(o.x) * (bflo(a.y) + bflo(b.y)), u8f3(o.x) * (bfhi(a.y) + bfhi(b.y)));
        r.z = pk2(u8f0(o.y) * (bflo(a.z) + bflo(b.z)), u8f1(o.y) * (bfhi(a.z) + bfhi(b.z))); r.w = pk2(u8f2(o.y) * (bflo(a.w) + bflo(b.w)), u8f3(o.y) * (bfhi(a.w) + bfhi(b.w)));
        hm[i] = r; }
}

__device__ __forceinline__ void p6_norm_router(const Ctx& C, LAS unsigned char* lds, int tid, int lane, int wave, int G, int rep2) {
    LAS float* wl = (LAS float*)lds;
    for (int i = tid; i < 1024 * 16; i += 512) { const int col = i >> 4, gc = i & 15; wl[(((((col >> 8) * 4 + (col & 3)) * 4 + (gc >> 2)) * 64 + ((col >> 2) & 63)) * 4) + (gc & 3)] = C.w_router[i]; }
    __syncthreads();
    const float* mod = (const float*)(C.ws + WS_MOD); bf16* HX2 = (bf16*)(C.ws + WS_HX2); float* aff = (float*)(C.ws + WS_AFF);
    const int NGW = G * 8;
    for (int gw0 = blockIdx.x * 8 + wave; gw0 < 2048 * (1 + rep2); gw0 += NGW) { const int gw = gw0 & 2047;
        f32x4 gsc[4], sh[4]; const int b = gw >> 6; const float* m = mod + (size_t)b * 6144;
#pragma unroll
        for (int j = 0; j < 4; ++j) { const int col = 4 * lane + 256 * j; const f32x4 g = *(const f32x4*)(C.g_norm2 + col), s = *(const f32x4*)(m + 4096 + col); gsc[j] = g * (s + 1.f); sh[j] = *(const f32x4*)(m + 3072 + col); }
        u32x2 rawc[4][4], rawn[4][4];
#pragma unroll
        for (int r = 0; r < 4; ++r)
#pragma unroll
            for (int j = 0; j < 4; ++j) rawc[r][j] = *(const u32x2*)((const bf16*)(C.ws + WS_X1) + ((size_t)gw * 32 + r) * 1024 + 4 * lane + 256 * j);
        for (int q = 0; q < 8; ++q) { const size_t row0 = (size_t)gw * 32 + q * 4;
            if (q < 7) {
#pragma unroll
                for (int r = 0; r < 4; ++r)
#pragma unroll
                    for (int j = 0; j < 4; ++j) rawn[r][j] = *(const u32x2*)((const bf16*)(C.ws + WS_X1) + (row0 + 4 + r) * 1024 + 4 * lane + 256 * j); }
            float p4; const float lg = rows4_norm_proj<true, false, true>((const float*)(C.ws + WS_X1), row0, gsc, sh, HX2, wl, wl, p4, lane, rawc);
#pragma unroll
            for (int r = 0; r < 4; ++r)
#pragma unroll
                for (int j = 0; j < 4; ++j) rawc[r][j] = rawn[r][j];
            float mx = lg;
#pragma unroll
            for (int o = 1; o < 16; o <<= 1) mx = fmaxf(mx, __shfl_xor(mx, o));
            const float ex = expf(lg - mx); float sm = ex;
#pragma unroll
            for (int o = 1; o < 16; o <<= 1) sm += __shfl_xor(sm, o);
            const size_t t = (row0 + (lane >> 4)) & (SEQ - 1);
            aff[((size_t)b * NE + (lane & 15)) * SEQ + t] = ex / sm; }
    }
}

__device__ __forceinline__ unsigned wave_excl_scan_u(unsigned v, int lane) { unsigned s = v; (void)lane;
#define TK_DPP(ctrl, rmask) s += (unsigned)__builtin_amdgcn_update_dpp(0, (int)s, ctrl, rmask, 0xf, false);
    TK_DPP(0x111, 0xf) TK_DPP(0x112, 0xf) TK_DPP(0x114, 0xf) TK_DPP(0x118, 0xf) TK_DPP(0x142, 0xa) TK_DPP(0x143, 0xc)
#undef TK_DPP
    return s - v;
}
__device__ __forceinline__ void topk_item(const Ctx& C, int item, int lane) {
    const int b = item >> 4, e = item & 15; const float* a = (const float*)(C.ws + WS_AFF) + ((size_t)b * NE + e) * SEQ + 32 * lane;
    unsigned key[32];
#pragma unroll
    for (int q = 0; q < 8; ++q) { const u32x4 v = *(const u32x4*)(a + 4 * q); key[4 * q] = v.x; key[4 * q + 1] = v.y; key[4 * q + 2] = v.z; key[4 * q + 3] = v.w; }
    unsigned T = 0u;
    for (int bit = 30; bit >= 0; --bit) { const unsigned cand = T | (1u << bit); unsigned cnt = 0u;
#pragma unroll
        for (int i = 0; i < 32; ++i) cnt += (unsigned)__builtin_popcountll(__ballot(key[i] >= cand));
        if (cnt >= (unsigned)CAP) T = cand; }
    unsigned ngt = 0u, neq = 0u;
#pragma unroll
    for (int i = 0; i < 32; ++i) { ngt += (unsigned)__builtin_popcountll(__ballot(key[i] > T)); neq += key[i] == T ? 1u : 0u; }
    const unsigned need = (unsigned)CAP - ngt;
    unsigned tie_before = wave_excl_scan_u(neq, lane);
    unsigned nsel = 0u; unsigned selmask = 0u;
#pragma unroll
    for (int i = 0; i < 32; ++i) { bool s = key[i] > T; if (key[i] == T) { s = tie_before < need; ++tie_before; } if (s) { selmask |= 1u << i; ++nsel; } }
    unsigned slot = wave_excl_scan_u(nsel, lane);
    const int pm = e * 32 + b; int* idx = (int*)(C.ws + WS_IDX) + (size_t)pm * CAP; float* val = (float*)(C.ws + WS_VAL) + (size_t)pm * CAP; bf16* sl = (bf16*)(C.ws + WS_SLOT); float* vt = (float*)(C.ws + WS_VALT);
    unsigned sw[16];
#pragma unroll
    for (int i = 0; i < 32; ++i) { const int t = 32 * lane + i; const bool s = (selmask >> i) & 1u;
        if (s) { idx[slot] = b * SEQ + t; val[slot] = __uint_as_float(key[i]); }
        const unsigned h = s ? (slot & 0xffffu) : 0xffffu; if (i & 1) sw[i >> 1] |= h << 16; else sw[i >> 1] = h;
        if (VAL_IN_FINAL) vt[((size_t)b * SEQ + t) * NE + e] = s ? __uint_as_float(key[i]) : 0.f; if (s) ++slot; }
    u32x4* so = (u32x4*)(sl + ((size_t)(b * NE + e) * SEQ + 32 * lane));
#pragma unroll
    for (int q = 0; q < 4; ++q) so[q] = (u32x4){sw[4 * q], sw[4 * q + 1], sw[4 * q + 2], sw[4 * q + 3]};
}

__device__ __forceinline__ f32x4 fp8x4_to_f32(unsigned w) { const f32x2 lo = __builtin_amdgcn_cvt_pk_f32_fp8(w, false), hi = __builtin_amdgcn_cvt_pk_f32_fp8(w, true); return (f32x4){lo[0], lo[1], hi[0], hi[1]}; }
__device__ __forceinline__ void p10_final(const Ctx& C, int lane, int wave, int G) {
    const float* mod = (const float*)(C.ws + WS_MOD); const unsigned char* Y = C.ws + WS_Y; const bf16* sl = (const bf16*)(C.ws + WS_SLOT);
    const int NGW = G * 8;
    for (int gw = blockIdx.x * 8 + wave; gw < 2048; gw += NGW) { const int b = gw >> 6; const float* m = mod + (size_t)b * 6144 + 5120;
        f32x4 ga[4], gf[4];
#pragma unroll
        for (int j = 0; j < 4; ++j) { ga[j] = *(const f32x4*)(m + 4 * lane + 256 * j) * Y8_INV; gf[j] = *(const f32x4*)(C.g_final + 4 * lane + 256 * j); }
        u32x2 xr[4][4]; unsigned t[4][2][4]; bool tv[4][2]; unsigned em[4];
        const u32x4 SW = *(const u32x4*)(sl + ((size_t)(b * NE + (lane & 15)) * SEQ + (gw & 63) * 32 + 8 * (lane >> 4)));
#define FIN_W(q_, r) (((q_) & 1) ? ((r) >> 1 ? SW.w : SW.z) : ((r) >> 1 ? SW.y : SW.x))
#define FIN_SLOT(q_, r, e_) ((__builtin_amdgcn_readlane(FIN_W(q_, r), (e_) + 16 * ((q_) >> 1)) >> (16 * ((r) & 1))) & 0xffffu)
#define FIN_ROUND(q_) do { _Pragma("unroll") for (int r = 0; r < 4; ++r) _Pragma("unroll") for (int c = 0; c < 2; ++c) { tv[r][c] = em[r] != 0u; \
            if (tv[r][c]) { const int e = __builtin_ctz(em[r]); em[r] &= em[r] - 1u; const unsigned sv = FIN_SLOT(q_, r, e); \
                const unsigned char* yr = Y + ((size_t)(e * 32 + b) * CAP + sv) * 1024 + 4 * lane; _Pragma("unroll") for (int j = 0; j < 4; ++j) t[r][c][j] = *(const unsigned*)(yr + 256 * j); } } } while (0)
#define FIN_ISSUE(q_) do { const size_t _r0 = (size_t)gw * 32 + (q_) * 4; \
            _Pragma("unroll") for (int r = 0; r < 4; ++r) _Pragma("unroll") for (int j = 0; j < 4; ++j) xr[r][j] = *(const u32x2*)((const bf16*)(C.ws + WS_X1) + (_r0 + r) * 1024 + 4 * lane + 256 * j); \
            _Pragma("unroll") for (int r = 0; r < 4; ++r) { const unsigned long long _bal = __ballot(((FIN_W(q_, r) >> (16 * (r & 1))) & 0xffffu) != 0xffffu); em[r] = (unsigned)((_bal >> (16 * ((q_) >> 1))) & 0xffffu); } \
            FIN_ROUND(q_); } while (0)
#define FIN_ACC() do { _Pragma("unroll") for (int r = 0; r < 4; ++r) _Pragma("unroll") for (int c = 0; c < 2; ++c) if (tv[r][c]) { _Pragma("unroll") for (int j = 0; j < 4; ++j) a[r][j] += fp8x4_to_f32(t[r][c][j]); } } while (0)
        FIN_ISSUE(0);
        for (int q = 0; q < 8; ++q) { const size_t row0 = (size_t)gw * 32 + q * 4; f32x4 v[4][4], a[4][4];
#pragma unroll
            for (int r = 0; r < 4; ++r)
#pragma unroll
                for (int j = 0; j < 4; ++j) { const u32x2 pw = xr[r][j]; v[r][j] = (f32x4){bflo(pw.x), bfhi(pw.x), bflo(pw.y), bfhi(pw.y)}; a[r][j] = (f32x4){0.f, 0.f, 0.f, 0.f}; }
            FIN_ACC();
            while (em[0] | em[1] | em[2] | em[3]) { FIN_ROUND(q); FIN_ACC(); }
            if (q < 7) FIN_ISSUE(q + 1);
#pragma unroll
            for (int r = 0; r < 4; ++r) { float ss = 0.f;
#pragma unroll
                for (int j = 0; j < 4; ++j) { v[r][j] = v[r][j] + ga[j] * a[r][j]; ss += v[r][j][0] * v[r][j][0] + v[r][j][1] * v[r][j][1] + v[r][j][2] * v[r][j][2] + v[r][j][3] * v[r][j][3]; }
                const float rstd = rsqrtf(wave_sum(ss) * (1.f / 1024.f) + EPS);
#pragma unroll
                for (int j = 0; j < 4; ++j) *(f32x4*)(C.out + (row0 + r) * 1024 + 4 * lane + 256 * j) = v[r][j] * rstd * gf[j]; } }
#undef FIN_ROUND
#undef FIN_W
#undef FIN_SLOT
#undef FIN_ISSUE
#undef FIN_ACC
    }
}
#ifndef ML_CVT_ON
#define ML_CVT_ON 0
#endif
namespace ml {
typedef short v4i16_t __attribute__((ext_vector_type(4)));
constexpr int TB = 49152, QO = 0, KO = 16384, VO = 32768;
constexpr int CT = 98304;
constexpr int SS = 135168;
constexpr int SM = 143360;
constexpr int GA = 384, U_ = 0, M_ = 64, DEC_ = 128, EM_ = 192, WA_ = 256, SC_ = 320;
constexpr int GST = SM + 2 * GA * 4;
static_assert(GST + 2 * 512 <= LDS_PHASE_BYTES, "mLSTM LDS map");
__device__ __forceinline__ unsigned off_b(unsigned row, unsigned ch) { return 256u * row + 16u * (ch ^ (((row & 3) << 2) | ((row >> 2) & 3))); }
__device__ __forceinline__ unsigned off_s(unsigned row, unsigned ch) { return 128u * row + 16u * (ch ^ (row & 7)); }
__device__ __forceinline__ bf16x8 rowfrag(const LAS unsigned char* tile, int rb, int ks, int lane) { return *(const LAS bf16x8*)(tile + off_b(16 * rb + (lane & 15), 4 * ks + (lane >> 4))); }
__device__ __forceinline__ bf16x8 trfrag(const LAS unsigned char* tile, int c, int ks, int lane) {
    const unsigned g = lane >> 4, q = (lane & 15) >> 2, p = lane & 3;
    const unsigned a0 = off_b(32 * ks + 8 * g + q, 2 * c + (p >> 1)) + 8 * (p & 1), a1 = off_b(32 * ks + 8 * g + 4 + q, 2 * c + (p >> 1)) + 8 * (p & 1);
    const v4i16_t lo = __builtin_amdgcn_ds_read_tr16_b64_v4i16((LAS v4i16_t*)(tile + a0)), hi = __builtin_amdgcn_ds_read_tr16_b64_v4i16((LAS v4i16_t*)(tile + a1));
    bf16x8 r; r[0] = lo[0]; r[1] = lo[1]; r[2] = lo[2]; r[3] = lo[3]; r[4] = hi[0]; r[5] = hi[1]; r[6] = hi[2]; r[7] = hi[3]; return r;
}
template <int KS> __device__ __forceinline__ bf16x8 trfrag_a(unsigned tile, int c, int lane) {
    const unsigned g = lane >> 4, q = (lane & 15) >> 2, p = lane & 3;
    const unsigned a0 = tile + off_b(8 * g + q, 2 * c + (p >> 1)) + 8 * (p & 1), a1 = tile + off_b(8 * g + 4 + q, 2 * c + (p >> 1)) + 8 * (p & 1);
    u32x2 lo, hi;
    asm volatile("ds_read_b64_tr_b16 %0, %1 offset:%2" : "=v"(lo) : "v"(a0), "n"(KS * 8192) : "memory");
    asm volatile("ds_read_b64_tr_b16 %0, %1 offset:%2" : "=v"(hi) : "v"(a1), "n"(KS * 8192) : "memory");
    const u32x4 r = {lo.x, lo.y, hi.x, hi.y}; return __builtin_bit_cast(bf16x8, r);
}
__device__ __forceinline__ void dma_b128(const void* g, unsigned ldsaddr) { asm volatile("s_mov_b32 m0, %1\n\ts_nop 0\n\tglobal_load_lds_dwordx4 %0, off" :: "v"(g), "s"(ldsaddr) : "memory", "m0"); }
__device__ __forceinline__ void dma_b32(const void* g, unsigned ldsaddr) { asm volatile("s_mov_b32 m0, %1\n\ts_nop 0\n\tglobal_load_lds_dword %0, off" :: "v"(g), "s"(ldsaddr) : "memory", "m0"); }
template <int OFF> __device__ __forceinline__ void st_b64(void* p, u32x2 v) { asm volatile("global_store_dwordx2 %0, %1, off offset:%2" :: "v"(p), "v"(v), "n"(OFF) : "memory"); }
__device__ __forceinline__ void st_b128(void* p, u32x4 v) { asm volatile("global_store_dwordx4 %0, %1, off" :: "v"(p), "v"(v) : "memory"); }
__device__ __forceinline__ unsigned rf_lane(int ks, int lane) { const unsigned i = lane & 15, g4 = lane >> 4; return 256u * i + 16u * ((4u * ks + g4) ^ (((i & 3) << 2) | ((i >> 2) & 3))); }
template <int OFF> __device__ __forceinline__ bf16x8 ldsr128(unsigned a) { u32x4 r; asm volatile("ds_read_b128 %0, %1 offset:%2" : "=v"(r) : "v"(a), "n"(OFF) : "memory"); return __builtin_bit_cast(bf16x8, r); }
#define ML_LGKM0_5(a, b, c, d, e) asm volatile("s_waitcnt lgkmcnt(0)" : "+v"(a), "+v"(b), "+v"(c), "+v"(d), "+v"(e) :: "memory")
#define ML_LGKM0_4(a, b, c, d) asm volatile("s_waitcnt lgkmcnt(0)" : "+v"(a), "+v"(b), "+v"(c), "+v"(d) :: "memory")
#define ML_LGKM0_8(a, b, c, d, e, f, g_, h) asm volatile("s_waitcnt lgkmcnt(0)" : "+v"(a), "+v"(b), "+v"(c), "+v"(d), "+v"(e), "+v"(f), "+v"(g_), "+v"(h) :: "memory")
#define ML_LGKM0_2(a, b) asm volatile("s_waitcnt lgkmcnt(0)" : "+v"(a), "+v"(b) :: "memory")
template <bool MAX> __device__ __forceinline__ float wave_scan(float v) {
    const int id = MAX ? (int)0xff800000u : 0;
#define ML_DPP(ctrl, rmask) { const float t = __int_as_float(__builtin_amdgcn_update_dpp(id, __float_as_int(v), ctrl, rmask, 0xf, false)); v = MAX ? fmaxf(v, t) : v + t; }
    ML_DPP(0x111, 0xf) ML_DPP(0x112, 0xf) ML_DPP(0x114, 0xf) ML_DPP(0x118, 0xf) ML_DPP(0x142, 0xa) ML_DPP(0x143, 0xc)
#undef ML_DPP
    return v;
}
__device__ __forceinline__ void gate_math(float ig, float fg, int pos, float& m0, LAS float* ga) {
    const float fl = fg;
    const float cum = wave_scan<false>(fl);
    const float u = ig - cum;
    const float pmx = wave_scan<true>(u);
    const float tot = __int_as_float(__builtin_amdgcn_readlane(__float_as_int(cum), 63)), umax = __int_as_float(__builtin_amdgcn_readlane(__float_as_int(pmx), 63));
    const float M = fmaxf(m0, pmx);
    const float mn = fmaxf(tot + m0, tot + umax);
    ga[U_ + pos] = u; ga[M_ + pos] = M; ga[DEC_ + pos] = __expf(m0 - M); ga[EM_ + pos] = __expf(-(cum + M)); ga[WA_ + pos] = __expf(tot + u - mn);
    if (pos == 0) ga[SC_] = __expf(tot + m0 - mn);
    m0 = mn;
}

#define ML_VM0() do { asm volatile("" ::: "memory"); __builtin_amdgcn_s_waitcnt(0x0f70); asm volatile("" ::: "memory"); } while (0)
#define ML_BAR() do { asm volatile("s_waitcnt lgkmcnt(0)" ::: "memory"); __builtin_amdgcn_s_barrier(); asm volatile("" ::: "memory"); } while (0)
__device__ __forceinline__ void mlstm_phase(const Ctx& C, LAS unsigned char* lds, int tid, int lane, int wave, int G, int rep2) {
    LAS float* sm = (LAS float*)(lds + SM); const unsigned ldsu = __builtin_amdgcn_readfirstlane((unsigned)(size_t)lds);
    const bf16* QK = (const bf16*)(C.ws + WS_QK); const bf16* KC = (const bf16*)(C.ws + WS_KC); const bf16* PV = (const bf16*)(C.ws + WS_PV); const bf16* PC = (const bf16*)(C.ws + WS_PC);
    const float* gates = (const float*)(C.ws + WS_GATES);
    const int g = lane >> 4, li = lane & 15;
    bf16x8 onesf;
#pragma unroll
    for (int e = 0; e < 8; ++e) onesf[e] = li == 0 ? (short)0x3f80 : (short)0;
    const float* cvt_wg = C.w_gate_e; const float* cvt_wu = C.w_up_e; const float* cvt_wd = C.w_down_e; asm volatile("" : "+s"(cvt_wg), "+s"(cvt_wu), "+s"(cvt_wd));
    const int cvt_gw = blockIdx.x * 8 + wave, cvt_ngw = G * 8, cvt_np = ML_CVT_ON ? (cvt_gw < 6144 ? 8 * ((6144 - cvt_gw + cvt_ngw - 1) / cvt_ngw) : 0) : 0; int cvt_tp = 0;
    float cw[16];
    for (int item0 = blockIdx.x; item0 < 256 * (1 + rep2); item0 += G) { const int item = item0 & 255;
        const int dir = item & 1, h = (item >> 1) & 3, b = item >> 3;
        bf16* Hout = (bf16*)(C.ws + (dir ? WS_HB : WS_HF));
        const int kI = dir ? 2 : 0, kF = dir ? 3 : 1; const float bI = C.b_gates[kI * 4 + h], bF = C.b_gates[kF * 4 + h];
        const int pos = dir ? 63 - lane : lane;
#define ML_CC(s_) ((s_) >= 4 ? (dir ? 35 - (s_) : (s_) - 4) : (dir ? 3 - (s_) : (s_)))
#define ML_GDMA(s_) do { const int _s = (s_); const size_t _tok = _s >= 4 ? (size_t)b * SEQ + ML_CC(_s) * 64 + pos : (size_t)NTOK + (size_t)b * CL + ML_CC(_s) * 64 + pos; \
            dma_b32(gates + _tok * 16 + kI * 4 + h, ldsu + GST + (_s & 1) * 512); dma_b32(gates + _tok * 16 + kF * 4 + h, ldsu + GST + (_s & 1) * 512 + 256); } while (0)
#define ML_GATE(s_, ga_) do { const LAS float* _g = (const LAS float*)(lds + GST + ((s_) & 1) * 512); gate_math(_g[lane], _g[64 + lane], pos, m0, ga_); } while (0)
#define ML_DMA(s_, bf_) do { const int _s = (s_); const bool _x = _s >= 4; const int _cc = ML_CC(_s); \
            _Pragma("unroll") for (int _k = 0; _k < 6; ++_k) { const int _T = _k >> 1, _sub = wave + 8 * (_k & 1); if (!_x && _T == 0) continue; \
                const int _row = 4 * _sub + (lane >> 4), _ch = (lane & 15) ^ (((_row & 3) << 2) | ((_row >> 2) & 3)); const bf16* _src; \
                if (_x) { const size_t _tok = (size_t)(b * 4 + h) * SEQ + _cc * 64 + _row; _src = _T == 2 ? PV + _tok * 128 + _ch * 8 : QK + _tok * 256 + (_T ? 128 : 0) + _ch * 8; } \
                else { const size_t _tok = (size_t)b * CL + _cc * 64 + _row; _src = _T == 2 ? PC + _tok * 1024 + 512 + h * 128 + _ch * 8 : KC + _tok * 512 + h * 128 + _ch * 8; } \
                dma_b128(_src, ldsu + (bf_) * TB + _T * 16384 + _sub * 1024); } } while (0)
#define ML_CVT_ADDR(tp_, src_, dst_) do { const int _u = cvt_gw + cvt_ngw * ((tp_) >> 3), _ks = _u & 7, _nb = (_u >> 3) & 15, _mat = _u >> 7, _e = _mat & 15, _wh = _mat >> 4; \
            const int _k0 = 128 * _ks + 16 * ((tp_) & 7), _n = 64 * _nb + lane; \
            const float* _b = cvt_wg; if (_wh == 1) _b = cvt_wu; if (_wh == 2) _b = cvt_wd; \
            src_ = _b + (size_t)_e * 1048576 + (size_t)_k0 * 1024 + _n; \
            const size_t _row = _wh < 2 ? (size_t)(_e * 2048 + (_n >> 7) * 256 + _wh * 128 + (_n & 127)) : (size_t)(WS_WD - WS_WGU) / 1024 + (size_t)(_e * 1024 + _n); \
            dst_ = C.ws + WS_WGU + _row * 1024 + _k0; } while (0)
#define ML_CVT_LOAD(src_) do { const __attribute__((address_space(1))) float* _g = (const __attribute__((address_space(1))) float*)(src_);     \
            _Pragma("unroll") for (int _r = 0; _r < 16; ++_r) cw[_r] = _g[(size_t)_r * 1024]; } while (0)
#define ML_CVT_PACK(_o) do { _o.x = pk4_fp8(cw[0] * W8_SCALE, cw[1] * W8_SCALE, cw[2] * W8_SCALE, cw[3] * W8_SCALE); _o.y = pk4_fp8(cw[4] * W8_SCALE, cw[5] * W8_SCALE, cw[6] * W8_SCALE, cw[7] * W8_SCALE); \
            _o.z = pk4_fp8(cw[8] * W8_SCALE, cw[9] * W8_SCALE, cw[10] * W8_SCALE, cw[11] * W8_SCALE); _o.w = pk4_fp8(cw[12] * W8_SCALE, cw[13] * W8_SCALE, cw[14] * W8_SCALE, cw[15] * W8_SCALE); } while (0)
#define ML_CVT_STEP() do { if (cvt_np > 0) { u32x4 _o; ML_CVT_PACK(_o); const bool _st = cvt_tp < cvt_np; const float* _s; unsigned char* _d; ML_CVT_ADDR(_st ? cvt_tp : 0, _s, _d); (void)_s; \
            asm volatile("" : "+v"(_o) :: "memory");        \
            if (ML_CVT_ON == 2) _d = C.ws + 840 * MiB + ((size_t)(cvt_gw * 24 + (cvt_tp % 24)) * 64 + lane) * 16;        \
            ++cvt_tp; ML_CVT_ISSUE(cvt_tp); if (_st) st_b128(_d, _o); } } while (0)
#define ML_CVT_ISSUE(tp_) do { const int _t = (tp_) < cvt_np ? (tp_) : cvt_np - 1; const float* _s; unsigned char* _d; ML_CVT_ADDR(_t, _s, _d); (void)_d; ML_CVT_LOAD(_s); } while (0)
        for (int i = tid; i < 36864 / 16; i += 512) *(LAS u32x4*)(lds + CT + i * 16) = (u32x4){0u, 0u, 0u, 0u};
        f32x4 Cown[4], Coth[4], Cext;
#pragma unroll
        for (int t = 0; t < 4; ++t) { Cown[t] = (f32x4){0.f, 0.f, 0.f, 0.f}; Coth[t] = (f32x4){0.f, 0.f, 0.f, 0.f}; }
        Cext = (f32x4){0.f, 0.f, 0.f, 0.f};
        float m0 = 0.f;
        ML_DMA(0, 0); ML_DMA(1, 1);
        if (wave == 0) { ML_GDMA(0); ML_GDMA(1); ML_VM0(); ML_GATE(0, sm); asm volatile("s_waitcnt lgkmcnt(0)" ::: "memory"); ML_GDMA(2); }
        ML_VM0();
        __syncthreads();
        const int jt = wave >> 1, half = wave & 1, j = 16 * jt + li;
        if (cvt_np > 0) ML_CVT_ISSUE(cvt_tp);
        for (int step = 0; step < 36; ++step) {
            const int p = step & 1; const bool isx = step >= 4; const int cc = ML_CC(step);
            const LAS unsigned char* Qt = lds + p * TB + QO; const LAS unsigned char* Kt = lds + p * TB + KO; const LAS unsigned char* Vt = lds + p * TB + VO;
            const LAS float* ga = sm + p * GA;
            if (wave == 0) { if (step + 1 < 36) ML_GATE(step + 1, sm + (p ^ 1) * GA); }
            else if (isx && wave <= 6) {
                const int jtf = wave <= 2 ? 3 : (wave <= 4 ? 2 : (wave == 5 ? 1 : 0)), s0f = (wave == 2 || wave == 4) ? 2 : 0;
                const int jts = dir ? 3 - jtf : jtf, js = 16 * jts + li;
                bf16x8 qf[4], kfr[2][4];
                {   const unsigned qb = (unsigned)(size_t)Qt + 4096u * jts, kb0 = (unsigned)(size_t)Kt + 4096u * (dir ? 3 - s0f : s0f), kb1 = (unsigned)(size_t)Kt + 4096u * (dir ? 3 - (s0f + 1) : s0f + 1);
#pragma unroll
                    for (int ks = 0; ks < 4; ++ks) { const unsigned l_ = rf_lane(ks, lane); qf[ks] = ldsr128<0>(qb + l_); kfr[0][ks] = ldsr128<0>(kb0 + l_); kfr[1][ks] = ldsr128<0>(kb1 + l_); }
                    ML_LGKM0_4(qf[0], qf[1], qf[2], qf[3]); ML_LGKM0_8(kfr[0][0], kfr[0][1], kfr[0][2], kfr[0][3], kfr[1][0], kfr[1][1], kfr[1][2], kfr[1][3]); }
                const float Mj = ga[M_ + js];
#pragma unroll
                for (int t = 0; t < 2; ++t) { const int stf = s0f + t, st = dir ? 3 - stf : stf; u32x2 w = {0u, 0u};
                    if (stf <= jtf) { f32x4 sa = {0.f, 0.f, 0.f, 0.f};
#pragma unroll
                        for (int ks = 0; ks < 4; ++ks) sa = __builtin_amdgcn_mfma_f32_16x16x32_bf16(kfr[t][ks], qf[ks], sa, 0, 0, 0);
                        const int s0 = 16 * st + 4 * g; const f32x4 u4 = *(const LAS f32x4*)(ga + U_ + s0); float sp[4];
#pragma unroll
                        for (int r = 0; r < 4; ++r) { const int s = s0 + r; const bool keep = dir ? (s >= js) : (s <= js); sp[r] = keep ? sa[r] * __expf(fminf(u4[r] - Mj, 0.f)) : 0.f; }
                        w.x = pk2(sp[0], sp[1]); w.y = pk2(sp[2], sp[3]); }
                    *(LAS u32x2*)(lds + SS + off_s(js, 2 * st + (g >> 1)) + (g & 1) * 8) = w; }
            }
            const unsigned Vu = (unsigned)(size_t)Vt, Ku = (unsigned)(size_t)Kt;
            bf16x8 vf[4][2], kr_[2]; u32x2 ow[4] = {}; bf16* optr = nullptr;
            if (isx) {
                ML_BAR();
                const float dj = ga[DEC_ + j];
                f32x4 oa[4], oe = {0.f, 0.f, 0.f, 0.f};
#pragma unroll
                for (int t = 0; t < 4; ++t) oa[t] = (f32x4){0.f, 0.f, 0.f, 0.f};
                {
                    const unsigned qb = (unsigned)(size_t)Qt + 4096u * jt, cb = ldsu + CT + 16384u * half, nb = ldsu + CT + 32768u;
                    bf16x8 qf[4], cA[5], cB[5];
#define ML_LOADC(dst, ks_) do { const unsigned _l = rf_lane(ks_, lane); dst[0] = ldsr128<0>(cb + _l); dst[1] = ldsr128<4096>(cb + _l); dst[2] = ldsr128<8192>(cb + _l); dst[3] = ldsr128<12288>(cb + _l); dst[4] = ldsr128<0>(nb + _l); } while (0)
#define ML_MMAC(src, q_) do { _Pragma("unroll") for (int t = 0; t < 4; ++t) oa[t] = __builtin_amdgcn_mfma_f32_16x16x32_bf16(src[t], q_, oa[t], 0, 0, 0); oe = __builtin_amdgcn_mfma_f32_16x16x32_bf16(src[4], q_, oe, 0, 0, 0); } while (0)
#pragma unroll
                    for (int ks = 0; ks < 4; ++ks) qf[ks] = ldsr128<0>(qb + rf_lane(ks, lane));
                    ML_LOADC(cA, 0);
                    ML_LGKM0_4(qf[0], qf[1], qf[2], qf[3]); ML_LGKM0_5(cA[0], cA[1], cA[2], cA[3], cA[4]);
                    ML_LOADC(cB, 1); ML_MMAC(cA, qf[0]);
                    ML_LGKM0_5(cB[0], cB[1], cB[2], cB[3], cB[4]); ML_LOADC(cA, 2); ML_MMAC(cB, qf[1]);
                    ML_LGKM0_5(cA[0], cA[1], cA[2], cA[3], cA[4]); ML_LOADC(cB, 3); ML_MMAC(cA, qf[2]);
                    ML_LGKM0_5(cB[0], cB[1], cB[2], cB[3], cB[4]); ML_MMAC(cB, qf[3]);
#undef ML_LOADC
#undef ML_MMAC
                }
#pragma unroll
                for (int t = 0; t < 4; ++t) oa[t] = oa[t] * dj;
                oe = oe * dj;
#pragma unroll
                for (int t = 0; t < 4; ++t) { vf[t][0] = trfrag_a<0>(Vu, 4 * half + t, lane); vf[t][1] = trfrag_a<1>(Vu, 4 * half + t, lane); }
                ML_LGKM0_8(vf[0][0], vf[1][0], vf[2][0], vf[3][0], vf[0][1], vf[1][1], vf[2][1], vf[3][1]);
#pragma unroll
                for (int ks = 0; ks < 2; ++ks) {
                    if (dir ? (2 * ks + 1 >= jt) : (2 * ks <= jt)) { const bf16x8 sf = *(const LAS bf16x8*)(lds + SS + off_s(j, 4 * ks + g));
#pragma unroll
                        for (int t = 0; t < 4; ++t) oa[t] = __builtin_amdgcn_mfma_f32_16x16x32_bf16(vf[t][ks], sf, oa[t], 0, 0, 0);
                        oe = __builtin_amdgcn_mfma_f32_16x16x32_bf16(onesf, sf, oe, 0, 0, 0); } }
                kr_[0] = trfrag_a<0>(Ku, wave, lane); kr_[1] = trfrag_a<1>(Ku, wave, lane);
                const float den = __shfl(oe[0], li);
                const float inv = __builtin_amdgcn_rcpf(fmaxf(fabsf(den), ga[EM_ + j]));
                const size_t tok = (size_t)b * SEQ + cc * 64 + j;
                ML_VM0();
#pragma unroll
                for (int t = 0; t < 4; ++t) { const f32x4 o = oa[t] * inv; ow[t].x = pk2(o[0], o[1]); ow[t].y = pk2(o[2], o[3]); }
                optr = Hout + tok * 512 + h * 128 + 64 * half + 4 * g;
            } else {
#pragma unroll
                for (int t = 0; t < 4; ++t) { vf[t][0] = trfrag_a<0>(Vu, 4 * half + t, lane); vf[t][1] = trfrag_a<1>(Vu, 4 * half + t, lane); }
                kr_[0] = trfrag_a<0>(Ku, wave, lane); kr_[1] = trfrag_a<1>(Ku, wave, lane);
                ML_LGKM0_8(vf[0][0], vf[1][0], vf[2][0], vf[3][0], vf[0][1], vf[1][1], vf[2][1], vf[3][1]);
                ML_VM0();
            }
            ML_CVT_STEP();
            if (isx) { st_b64<0>(optr, ow[0]); st_b64<32>(optr, ow[1]); st_b64<64>(optr, ow[2]); st_b64<96>(optr, ow[3]); }
            {   const float dn = ga[SC_];
                ML_LGKM0_2(kr_[0], kr_[1]);
                bf16x8 kf[2];
#pragma unroll
                for (int ks = 0; ks < 2; ++ks) { const bf16x8 kr = kr_[ks]; const f32x4 w0 = *(const LAS f32x4*)(ga + WA_ + 32 * ks + 8 * g), w1 = *(const LAS f32x4*)(ga + WA_ + 32 * ks + 8 * g + 4);
                    u32x4 pkd; pkd.x = pk2(bf1((bf16)kr[0]) * w0[0], bf1((bf16)kr[1]) * w0[1]); pkd.y = pk2(bf1((bf16)kr[2]) * w0[2], bf1((bf16)kr[3]) * w0[3]);
                    pkd.z = pk2(bf1((bf16)kr[4]) * w1[0], bf1((bf16)kr[5]) * w1[1]); pkd.w = pk2(bf1((bf16)kr[6]) * w1[2], bf1((bf16)kr[7]) * w1[3]);
                    kf[ks] = __builtin_bit_cast(bf16x8, pkd); }
#pragma unroll
                for (int t = 0; t < 4; ++t) { f32x4 c = Cown[t] * dn;
#pragma unroll
                    for (int ks = 0; ks < 2; ++ks) c = __builtin_amdgcn_mfma_f32_16x16x32_bf16(kf[ks], vf[t][ks], c, 0, 0, 0);
                    Cown[t] = c; }
                bf16x8 vo[4][2];
#pragma unroll
                for (int t = 0; t < 4; ++t) { vo[t][0] = trfrag_a<0>(Vu, 4 * (half ^ 1) + t, lane); vo[t][1] = trfrag_a<1>(Vu, 4 * (half ^ 1) + t, lane); }
                ML_LGKM0_8(vo[0][0], vo[1][0], vo[2][0], vo[3][0], vo[0][1], vo[1][1], vo[2][1], vo[3][1]);
#pragma unroll
                for (int t = 0; t < 4; ++t) { f32x4 c = Coth[t] * dn;
#pragma unroll
                    for (int ks = 0; ks < 2; ++ks) c = __builtin_amdgcn_mfma_f32_16x16x32_bf16(kf[ks], vo[t][ks], c, 0, 0, 0);
                    Coth[t] = c; }
                {   f32x4 c = Cext * dn;
#pragma unroll
                    for (int ks = 0; ks < 2; ++ks) c = __builtin_amdgcn_mfma_f32_16x16x32_bf16(kf[ks], onesf, c, 0, 0, 0);
                    Cext = c; }
            }
            ML_BAR();
#pragma unroll
            for (int t = 0; t < 4; ++t) { { const f32x4 c = Cown[t]; u32x2 w; w.x = pk2(c[0], c[1]); w.y = pk2(c[2], c[3]); *(LAS u32x2*)(lds + CT + off_b(16 * (4 * half + t) + li, 2 * wave + (g >> 1)) + (g & 1) * 8) = w; }
                { const f32x4 c = Coth[t]; u32x2 w; w.x = pk2(c[0], c[1]); w.y = pk2(c[2], c[3]); *(LAS u32x2*)(lds + CT + off_b(16 * (4 * (half ^ 1) + t) + li, 2 * wave + (g >> 1)) + (g & 1) * 8) = w; } }
            { const f32x4 c = Cext; u32x2 w; w.x = pk2(c[0], c[1]); w.y = pk2(c[2], c[3]); *(LAS u32x2*)(lds + CT + off_b(128 + li, 2 * wave + (g >> 1)) + (g & 1) * 8) = w; }
            if (step + 2 < 36) ML_DMA(step + 2, p);
            if (wave == 0 && step + 3 < 36) ML_GDMA(step + 3);
        }
        ML_VM0();
        if (cvt_tp < cvt_np) { u32x4 _o; ML_CVT_PACK(_o); const float* _s; unsigned char* _d; ML_CVT_ADDR(cvt_tp, _s, _d); (void)_s; st_b128(_d, _o); }
        ++cvt_tp;
        __syncthreads();
    }
    if (cvt_tp > cvt_np) cvt_tp = cvt_np;
    for (; cvt_tp < cvt_np; ++cvt_tp) { const float* _s; unsigned char* _d; ML_CVT_ADDR(cvt_tp, _s, _d); ML_CVT_LOAD(_s); u32x4 _o; ML_CVT_PACK(_o); *(u32x4*)_d = _o; }
#undef ML_CVT_ADDR
#undef ML_CVT_LOAD
#undef ML_CVT_PACK
#undef ML_CVT_STEP
#undef ML_CVT_ISSUE
#undef ML_CC
#undef ML_GDMA
#undef ML_GATE
#undef ML_DMA
}
}
constexpr int N_PHASES = 13;
#ifndef PROBE_PH
#define PROBE_PH 0
#endif
struct Args { const float* in[19]; float* out; unsigned char* ws; int ph_lo, ph_hi, probe, pad; };
static_assert(sizeof(Args) == 19 * 8 + 8 + 8 + 16, "Args has no padding");

__global__ void __launch_bounds__(512, 2) mk_fwd(Args a) {
    extern __shared__ __attribute__((aligned(16))) unsigned char lds_raw[];
    LAS unsigned char* lds = (LAS unsigned char*)lds_raw;
    const int tid = threadIdx.x, lane = tid & 63, wave = __builtin_amdgcn_readfirstlane(tid >> 6), G = gridDim.x;
    Ctx C;
    C.x = a.in[0]; C.c = a.in[1]; C.ctx = a.in[2]; C.c_ctx = a.in[3]; C.w_ada = a.in[4]; C.b_ada = a.in[5]; C.g_norm1 = a.in[6]; C.w_in = a.in[7]; C.b_gates = a.in[8]; C.w_conv = a.in[9];
    C.w_fourier = a.in[10]; C.w_mlstm = a.in[11]; C.w_out = a.in[12]; C.g_norm2 = a.in[13]; C.w_router = a.in[14]; C.w_gate_e = a.in[15]; C.w_up_e = a.in[16]; C.w_down_e = a.in[17]; C.g_final = a.in[18];
    C.out = a.out; C.ws = a.ws;
    const int lo = a.ph_lo, hi = a.ph_hi;
#if MK_XCD_BAR
    volatile LAS unsigned* bst = (volatile LAS unsigned*)(lds + LDS_PHASE_BYTES);
    if (tid < 4) bst[tid] = 0u;
    __syncthreads();
    XcdBarrier bar = xcd_barrier_post((unsigned*)(a.ws + WS_CTL) + 4096, bst);
#endif
    int nsync = 0;
    if (a.pad == 0x7fffffff) cg::this_grid().sync();
#define IN(k) (lo <= (k) && (k) < hi)
#if MK_XCD_BAR
#ifdef PROBE_BAR2
#define GRIDBAR() do { xcd_barrier(bar); xcd_barrier(bar); ++nsync; } while (0)
#else
#define GRIDBAR() do { xcd_barrier(bar); ++nsync; } while (0)
#endif
#else
#define GRIDBAR() do { cg::this_grid().sync(); ++nsync; } while (0)
#endif
#define SEAM(k) do { if (IN(k) && IN((k) + 1)) GRIDBAR(); } while (0)
#define PHASE(k, ...) do { if (IN(k)) { __VA_ARGS__ } SEAM(k); } while (0)
    PHASE(0, { for (int _r = 0; _r < 1 + (a.probe & 1); ++_r) { p0_prep(C, lds, tid, lane, wave, G); __syncthreads();
            p0_wtf(C, lds, tid, (int)blockIdx.x, G);
            __syncthreads(); p0_tt(C, lds, tid, (int)blockIdx.x, G); __syncthreads(); } });
    PHASE(1, { p0_weights(C, lds, tid, lane, wave, G); __syncthreads(); p1a_norm_gates(C, lds, tid, lane, wave, G, (a.probe >> 1) & 1); __syncthreads(); });
#ifndef MK_STAGGER
#define MK_STAGGER 0
#endif
#define STAGGER(ticks) do { if (MK_STAGGER) { const unsigned long long _t0 = wall_clock64(); const unsigned long long _w = (unsigned long long)((blockIdx.x >> 3) & 7) * (ticks); while (wall_clock64() - _t0 < _w) __builtin_amdgcn_s_sleep(32); } } while (0)
    PHASE(2, { STAGGER(400); SchedP1 S{C.ws, G, (int)blockIdx.x, 1 + ((a.probe >> 2) & 1), 1 + ((a.probe >> 16) & 1)}; EpiP1 E{C.ws}; mg::gemm_phase<EpiP1, SchedP1, false>(lds, 1024, S, E);
            convert_experts(C, lds, lane, wave, G, 1, 0); __syncthreads(); });
    PHASE(3, { SchedF2 S{C.ws, G, (int)blockIdx.x, 1 + ((a.probe >> 3) & 1)}; EpiF2 E{C.ws}; mg::gemm_phase<EpiF2, SchedF2, false>(lds, 4096, S, E); p2_conv(C, lane, wave, G, (a.probe >> 13) & 1); });
    PHASE(4, { ml::mlstm_phase(C, lds, tid, lane, wave, G, (a.probe >> 4) & 1); });
    PHASE(5, { p3b_combine(C, tid, G, (a.probe >> 5) & 1); });
    PHASE(6, { SchedMerge S{C.ws, G, (int)blockIdx.x, 1 + ((a.probe >> 6) & 1)}; EpiMerge E{C.ws}; mg::gemm_phase<EpiMerge, SchedMerge, false, false, true>(lds, 512, S, E); });
    PHASE(7, { SchedOut S{C.ws, G, (int)blockIdx.x, 1 + ((a.probe >> 7) & 1), 1 + ((a.probe >> 17) & 1)}; EpiOut E{C.x, (const float*)(C.ws + WS_MOD), C.ws}; mg::gemm_phase<EpiOut, SchedOut, false>(lds, 1024, S, E); });
    PHASE(8, { p6_norm_router(C, lds, tid, lane, wave, G, (a.probe >> 8) & 1); __syncthreads(); });
    PHASE(9, { const int NGW = G * 8; const int rp9 = 1 + ((a.probe >> 9) & 1); for (int it = wave * G + blockIdx.x; it < NB * NE * rp9; it += NGW) topk_item(C, it % (NB * NE), lane);        if (ML_CVT_ON != 1) convert_experts(C, lds, lane, wave, G, rp9 + ((a.probe >> 18) & 1), 1); for (int i = blockIdx.x * 512 + tid; i < NE * NB * CAP; i += G * 512) ((int*)(C.ws + WS_IDENT))[i] = i; __syncthreads(); });
    PHASE(10, { SchedUp S{C.ws, G, (int)blockIdx.x, 1 + ((a.probe >> 10) & 1), 1 + ((a.probe >> 14) & 1)}; EpiSwiglu E{C.ws}; mg::gemm_phase<EpiSwiglu, SchedUp, true, true>(lds, 1024, S, E); });
    PHASE(11, { SchedDown S{C.ws, G, (int)blockIdx.x, 1 + ((a.probe >> 11) & 1), 1 + ((a.probe >> 15) & 1)}; EpiDown E{C.ws}; mg::gemm_phase<EpiDown, SchedDown, true, true>(lds, 1024, S, E); });
    if (IN(12)) {
#pragma unroll 1
        for (int r12 = 0; r12 <= ((a.probe >> 12) & 1); ++r12) p10_final(C, lane, wave, G); }

#undef PHASE
#undef PHASE_L
#undef IN
#undef SEAM
#undef GRIDBAR
}

static void mk_launch(void* const* d_in, void* d_out, void* d_ws, hipStream_t stream, int lo, int hi, bool coop) {
    static int grid = 0;
    if (grid == 0) {
        int dev = 0, cus = 0, per_cu = 0;
        (void)hipGetDevice(&dev); (void)hipDeviceGetAttribute(&cus, hipDeviceAttributeMultiprocessorCount, dev);
        (void)hipFuncSetAttribute((const void*)mk_fwd, hipFuncAttributeMaxDynamicSharedMemorySize, LDS_BYTES);
        (void)hipOccupancyMaxActiveBlocksPerMultiprocessor(&per_cu, (const void*)mk_fwd, 512, LDS_BYTES);
        if (per_cu < 1) fprintf(stderr, "mk_launch: occupancy query says %d blocks/CU\n", per_cu);
        grid = cus > 0 ? cus : 256;
    }
    Args a{};
    for (int i = 0; i < 19; ++i) a.in[i] = (const float*)d_in[i];
    a.out = (float*)d_out; a.ws = (unsigned char*)d_ws; a.ph_lo = lo; a.ph_hi = hi; a.probe = PROBE_PH; a.pad = 0;
    if (coop) { void* args[] = {&a}; hipError_t e = hipLaunchCooperativeKernel((const void*)mk_fwd, dim3(grid), dim3(512), args, LDS_BYTES, stream);
        if (e != hipSuccess) fprintf(stderr, "cooperative launch failed: %s (grid %d)\n", hipGetErrorString(e), grid); }
    else hipLaunchKernelGGL(mk_fwd, dim3(grid), dim3(512), LDS_BYTES, stream, a);
}
extern "C" void kernel_launch(void* const* d_in, const int* in_sizes, int n_in, void* d_out, int out_size, void* d_ws, size_t ws_size, hipStream_t stream) {
    (void)hipMemsetAsync((char*)d_ws + WS_CTL, 0, 65536, stream);
    mk_launch(d_in, d_out, d_ws, stream, 0, N_PHASES, true);
}
```

```cpp
#ifndef MK_XCD_BAR
#define MK_XCD_BAR 1
#endif
#include <hip/hip_runtime.h>
#include <hip/hip_cooperative_groups.h>
#include <cstdio>
#include <cstdint>
namespace cg = cooperative_groups;

#define LAS __attribute__((address_space(3)))
typedef unsigned short bf16;
typedef short bf16x8 __attribute__((ext_vector_type(8)));
typedef short s16x4 __attribute__((ext_vector_type(4)));
typedef float f32x4 __attribute__((ext_vector_type(4)));
typedef float f32x2 __attribute__((ext_vector_type(2)));
typedef unsigned u32x4 __attribute__((ext_vector_type(4)));
typedef unsigned u32x2 __attribute__((ext_vector_type(2)));
typedef __bf16 bf16x2_t __attribute__((ext_vector_type(2)));
typedef int v8i_t __attribute__((ext_vector_type(8)));
typedef int v4i_t __attribute__((ext_vector_type(4)));

__device__ __forceinline__ unsigned pk2(float lo, float hi) { f32x2 v = {lo, hi}; bf16x2_t b = __builtin_convertvector(v, bf16x2_t); return __builtin_bit_cast(unsigned, b); }
__device__ __forceinline__ float bflo(unsigned w) { return __uint_as_float(w << 16); }
__device__ __forceinline__ float bfhi(unsigned w) { return __uint_as_float(w & 0xffff0000u); }
__device__ __forceinline__ float bf1(bf16 b) { return __uint_as_float((unsigned)b << 16); }
__device__ __forceinline__ float silu_f(float v) { return v * __builtin_amdgcn_rcpf(1.f + __expf(-v)); }
__device__ __forceinline__ float sigmoid_f(float v) { return __builtin_amdgcn_rcpf(1.f + __expf(-v)); }
__device__ __forceinline__ float log_sigmoid_f(float v) { return fminf(v, 0.f) - log1pf(expf(-fabsf(v))); }
__device__ __forceinline__ float wave_sum(float v) {
#define WS_DPP(ctrl, rmask) v += __int_as_float(__builtin_amdgcn_update_dpp(0, __float_as_int(v), ctrl, rmask, 0xf, false));
    WS_DPP(0x111, 0xf) WS_DPP(0x112, 0xf) WS_DPP(0x114, 0xf) WS_DPP(0x118, 0xf) WS_DPP(0x142, 0xa) WS_DPP(0x143, 0xc)
#undef WS_DPP
    return __int_as_float(__builtin_amdgcn_readlane(__float_as_int(v), 63));
}

#define XB_TMO      128
#define XB_XCNT(j)  (256  + 64 * (j))
#define XB_XSUB(j)  (1280 + 64 * (j))
#define XB_XGEN(j)  (2304 + 64 * (j))
#define XB_TOP      3328
#define XB_TOPGEN   3392
#define XCD_BAR_WORDS 3456
#define XB_SPIN_CAP (1u << 20)
__device__ __forceinline__ unsigned xb_ld(unsigned* p)              { return __hip_atomic_load(p, __ATOMIC_RELAXED, __HIP_MEMORY_SCOPE_AGENT); }
__device__ __forceinline__ unsigned xb_add(unsigned* p, unsigned v) { return __hip_atomic_fetch_add(p, v, __ATOMIC_RELAXED, __HIP_MEMORY_SCOPE_AGENT); }
__device__ __forceinline__ unsigned xb_xcc_id() { return (unsigned)__builtin_amdgcn_s_getreg((3 << 11) | 20) & 0xFu; }
#define XB_SPIN(cond, bar) do { unsigned _sp = 0; while (cond) { __builtin_amdgcn_s_sleep(1); \
    if ((++_sp & 255u) == 0u) { if (xb_ld(&(bar)[XB_TMO])) break; if (_sp > XB_SPIN_CAP) { atomicAdd(&(bar)[XB_TMO], 1u); break; } } } } while (0)
struct XcdBarrier { unsigned* bar; unsigned x; volatile LAS unsigned* st; };
__device__ __forceinline__ XcdBarrier xcd_barrier_post(unsigned* bar, volatile LAS unsigned* st) {
    XcdBarrier b; b.bar = bar; b.x = xb_xcc_id(); b.st = st;
    if (threadIdx.x == 0) (void)xb_add(&bar[XB_XCNT(b.x)], 1u);
    return b;
}
__device__ __forceinline__ void xcd_barrier_complete(unsigned* bar, unsigned x, unsigned& nloc, unsigned& nx) {
    const unsigned G = gridDim.x * gridDim.y * gridDim.z;
    unsigned sum, cnt, mine, sp = 0u;
    for (;;) {
        sum = 0u; cnt = 0u; mine = 0u;
#pragma unroll
        for (unsigned j = 0; j < 16; ++j) { const unsigned c = xb_ld(&bar[XB_XCNT(j)]); sum += c; cnt += (c > 0u) ? 1u : 0u; mine = (j == x) ? c : mine; }
        if (sum == G) break;
        __builtin_amdgcn_s_sleep(1);
        if ((++sp & 255u) == 0u) { if (xb_ld(&bar[XB_TMO])) break; if (sp > XB_SPIN_CAP) { atomicAdd(&bar[XB_TMO], 1u); break; } }
    }
    nloc = mine > 0u ? mine : 1u; nx = cnt > 0u ? cnt : 1u;
}
__device__ __forceinline__ void xcd_barrier(const XcdBarrier& b) {
    asm volatile("s_waitcnt vmcnt(0)" ::: "memory");
    __syncthreads();
    if (threadIdx.x == 0) {
        unsigned* bar = b.bar;
        __builtin_amdgcn_s_waitcnt(0);
        unsigned nloc = b.st[0], nx = b.st[1];
        if (nloc == 0u) { xcd_barrier_complete(bar, b.x, nloc, nx); b.st[0] = nloc; b.st[1] = nx; }
        const unsigned old = xb_add(&bar[XB_XSUB(b.x)], 1u);
        const unsigned gen = old / nloc;
        if (old + 1u == (gen + 1u) * nloc) {
            __builtin_amdgcn_fence(__ATOMIC_RELEASE, "agent");
            asm volatile("s_waitcnt vmcnt(0)" ::: "memory");
            const unsigned og = xb_add(&bar[XB_TOP], 1u);
            const unsigned tg = og / nx;
            if (og + 1u == (tg + 1u) * nx) xb_add(&bar[XB_TOPGEN], 1u);
            else XB_SPIN(xb_ld(&bar[XB_TOPGEN]) == tg, bar);
            __builtin_amdgcn_fence(__ATOMIC_ACQUIRE, "agent");
            xb_add(&bar[XB_XGEN(b.x)], 1u);
            asm volatile("s_waitcnt vmcnt(0)" ::: "memory");
        } else {
            XB_SPIN(xb_ld(&bar[XB_XGEN(b.x)]) == gen, bar);
            __builtin_amdgcn_fence(__ATOMIC_ACQUIRE, "agent");
            asm volatile("s_waitcnt vmcnt(0)" ::: "memory");
        }
    }
    __syncthreads();
}

#ifndef MK_TIMING
#define MK_TIMING 0
#endif
namespace mg {
template <bool F8> struct Frag { bf16x8 k[2]; };
template <> struct Frag<true> { v8i_t v; };
constexpr int BM = 256, BK = 64, HALF = 128, HTB = HALF * BK * 2, STAGE_BYTES = 8 * HTB, NXCD = 8, WGM = 8;
__host__ __device__ __forceinline__ int lds_byte(int r, int c) { const int st = (r >> 4) * 2 + (c >> 5), rr = r & 15, cc = c & 31, ob = rr * 64 + cc * 2; return st * 1024 + (ob ^ (((ob >> 9) & 1) << 5)); }
__host__ __device__ __forceinline__ void stage_rc(int b, int& R, int& C) { const int st = b / 1024, sb = b % 1024, swz = sb ^ (((sb >> 9) & 1) << 5); R = (st >> 1) * 16 + swz / 64; C = (st & 1) * 32 + (swz % 64) / 2; }
__host__ __device__ __forceinline__ int perm128x(int R) { return 64 * (R >> 5) + 16 * ((R >> 2) & 3) + 4 * ((R >> 4) & 1) + (R & 3); }
__host__ __device__ __forceinline__ int perm32(int rho) { const int n = rho >> 4, i = rho & 15; return 8 * (i >> 2) + 4 * n + (i & 3); }

struct Unit { int pm, pn, ty; const char* a; const char* b; const int* gi; const char* a2; const char* b2; };
__device__ __forceinline__ void tile_of(int wgid, int nM, int nN, int& pm, int& pn) {
    const int nwg = nM * nN; { const int q = nwg / NXCD, r = nwg % NXCD, xcd = wgid % NXCD, off = wgid / NXCD; wgid = (xcd < r ? xcd * (q + 1) : r * (q + 1) + (xcd - r) * q) + off; }
    const int nig = WGM * nN, gid = wgid / nig, fm = gid * WGM, gsz = (nM - fm) < WGM ? (nM - fm) : WGM;
    pm = fm + ((wgid % nig) % gsz); pn = (wgid % nig) / gsz;
}

template <class Epi, bool P> struct EpiPreOf { struct type {}; };
template <class Epi> struct EpiPreOf<Epi, true> { typedef typename Epi::Pre type; };
template <class Epi, class Sched, bool GATHER, bool FP8 = false, bool SPLITK = false>
__device__ __forceinline__ void gemm_phase(LAS unsigned char* lds, const int K, const Sched& S, const Epi& E) {
    const int tid = threadIdx.x, wid = __builtin_amdgcn_readfirstlane(tid >> 6), lane = tid & 63, wr = wid >> 2, wc = wid & 3, fr = lane & 15, fq = lane >> 4;
    const int KB = FP8 ? K : 2 * K;
    const int nh = KB / (BK * 2), nt = SPLITK ? 2 * nh : nh;
    unsigned voffB[2], vAc[2][2]; int stR[2], stC[2]; int gnx[2][2];
    const size_t kstep = (size_t)(BK * 2);
    const size_t hstep = (size_t)(Epi::PERM2 ? 8 : HALF) * KB;
#pragma unroll
    for (int i = 0; i < 2; ++i) { int R, C; stage_rc(tid * 16 + i * 8192, R, C); stR[i] = R; stC[i] = C; const int Rb = Epi::PERM2 ? perm128x(R) : (Epi::PERM ? ((R & ~31) + perm32(R & 31)) : R);
        voffB[i] = (unsigned)(Rb * KB + 2 * C); }
    const unsigned ldsw = (unsigned)wid * 1024u;
    const int aoff = lds_byte(wr * 64 + fr, fq * (FP8 ? 16 : 8)), boff = lds_byte(wc * 32 + fr, fq * (FP8 ? 16 : 8));
#define MG_SA(b, h) (((b) * 2 + (h)) * HTB)
#define MG_SB(b, h) ((4 + (b) * 2 + (h)) * HTB)
#define MG_STAGE(bufoff, gbase, voff) do { const char* _gb = (const char*)(gbase); asm volatile("" : "+s"(_gb));     \
        _Pragma("unroll") for (int _i = 0; _i < 2; ++_i) { unsigned _vo = (voff)[_i]; asm volatile("" : "+v"(_vo)); \
        __builtin_amdgcn_global_load_lds((const unsigned*)(_gb + _vo), (LAS unsigned*)(lds + (bufoff) + ldsw + _i * 8192), 16, 0, 0); } } while (0)
#define MG_LD16(off_) (*(const LAS v4i_t*)(lds + (off_)))
#define MG_LDA(dst, b, h) do { _Pragma("unroll") for (int m = 0; m < 4; ++m) { const int _o = MG_SA(b, h) + aoff + m * 2048; \
        if constexpr (FP8) dst[m].v = __builtin_shufflevector(MG_LD16(_o), MG_LD16(_o + 16), 0, 1, 2, 3, 4, 5, 6, 7); \
        else { dst[m].k[0] = __builtin_bit_cast(bf16x8, MG_LD16(_o)); dst[m].k[1] = __builtin_bit_cast(bf16x8, MG_LD16(_o + 1024)); } } } while (0)
#define MG_LDB(dst, b, h) do { _Pragma("unroll") for (int n = 0; n < 2; ++n) { const int _o = MG_SB(b, h) + boff + n * 2048; \
        if constexpr (FP8) dst[n].v = __builtin_shufflevector(MG_LD16(_o), MG_LD16(_o + 16), 0, 1, 2, 3, 4, 5, 6, 7); \
        else { dst[n].k[0] = __builtin_bit_cast(bf16x8, MG_LD16(_o)); dst[n].k[1] = __builtin_bit_cast(bf16x8, MG_LD16(_o + 1024)); } } } while (0)
#define MG_MMA(ai, bj, At, Bt) do { __builtin_amdgcn_s_setprio(1); _Pragma("unroll") for (int m = 0; m < 4; ++m) _Pragma("unroll") for (int n = 0; n < 2; ++n) { \
        if constexpr (FP8) acc[ai][bj][m][n] = __builtin_amdgcn_mfma_scale_f32_16x16x128_f8f6f4(Bt[n].v, At[m].v, acc[ai][bj][m][n], 0, 0, 0, 0, 0, 0); \
        else { _Pragma("unroll") for (int k = 0; k < 2; ++k) acc[ai][bj][m][n] = __builtin_amdgcn_mfma_f32_16x16x32_bf16(Bt[n].k[k], At[m].k[k], acc[ai][bj][m][n], 0, 0, 0); } } \
        __builtin_amdgcn_s_setprio(0); } while (0)
#define MG_WAIT_V(n) asm volatile("s_waitcnt vmcnt(" #n ")" ::: "memory")
#define MG_WAIT_L(n) asm volatile("s_waitcnt lgkmcnt(" #n ")" ::: "memory")
#define MG_BAR __builtin_amdgcn_s_barrier()
#define MG_SCHED __builtin_amdgcn_sched_barrier(0)
#define MG_AOFF(dst, u) do { _Pragma("unroll") for (int _h = 0; _h < 2; ++_h) _Pragma("unroll") for (int _i = 0; _i < 2; ++_i) { \
        if constexpr (GATHER) dst[_h][_i] = (unsigned)(u).gi[_h * HALF + stR[_i]] * (unsigned)KB + 2u * (unsigned)stC[_i]; \
        else dst[_h][_i] = (unsigned)((_h * HALF + stR[_i]) * KB + 2 * stC[_i]); } } while (0)
    Unit cur, nxt; int ui = 0;
    if (!S.next(0, cur)) return;
#if MK_TIMING
    unsigned long long tmE = 0, tmR = 0, tmK = 0, tm0 = wall_clock64(), tm1 = 0; const unsigned long long tmS = tm0; int tmU = 0;
#endif
    f32x4 acc[2][2][4][2];
#pragma unroll
    for (int a = 0; a < 2; ++a)
#pragma unroll
        for (int b = 0; b < 2; ++b)
#pragma unroll
            for (int m = 0; m < 4; ++m)
#pragma unroll
                for (int n = 0; n < 2; ++n) acc[a][b][m][n] = (f32x4){0.f, 0.f, 0.f, 0.f};
    Frag<FP8> At[4], B0[2], B1[2];
    struct NoPre {}; typename std::conditional<Epi::PRE, typename EpiPreOf<Epi, Epi::PRE>::type, NoPre>::type pre;
    const char* cA = cur.a; const char* cB = cur.b; const char* cA2 = cur.a2; const char* cB2 = cur.b2;
#define MG_TP(p0, p1, tt) ((SPLITK && (tt) >= nh) ? (p1) + (size_t)((tt) - nh) * kstep : (p0) + (size_t)(tt) * kstep)
    MG_AOFF(vAc, cur);
    MG_STAGE(MG_SB(0, 0), cB, voffB); MG_STAGE(MG_SB(0, 1), cB + hstep, voffB); MG_STAGE(MG_SA(0, 0), cA, vAc[0]); MG_STAGE(MG_SA(0, 1), cA, vAc[1]);
    if (wr == 1) MG_BAR;
    MG_WAIT_V(2); MG_BAR;
    MG_STAGE(MG_SB(1, 0), cB + kstep, voffB); MG_STAGE(MG_SA(1, 0), cA + kstep, vAc[0]); MG_STAGE(MG_SB(1, 1), cB + hstep + kstep, voffB);
    MG_WAIT_V(6); MG_BAR;
    for (;;) {
        const bool has_next = S.next(ui + 1, nxt);
        const char* nA = has_next ? nxt.a : cA; const char* nB = has_next ? nxt.b : cB;
        if constexpr (GATHER) { if (has_next) {
#pragma unroll
            for (int h = 0; h < 2; ++h)
#pragma unroll
                for (int i = 0; i < 2; ++i) asm volatile("global_load_dword %0, %1, off" : "=v"(gnx[h][i]) : "v"(nxt.gi + h * HALF + stR[i]) : "memory"); } }
#pragma unroll 1
        for (int t = 0; t < nt; t += 2) {
            const bool last = (t == nt - 2);
            const char* a1 = MG_TP(cA, cA2, t + 1);
            const char* a2 = last ? nA : MG_TP(cA, cA2, t + 2); const char* b2 = last ? nB : MG_TP(cB, cB2, t + 2);
            if constexpr (SPLITK) { if (t == nh) { int fr_ = fr, fq_ = fq; asm volatile("" : "+v"(fr_), "+v"(fq_)); if constexpr (Epi::PRE) E.mid(acc, cur, wr, wc, fr_, fq_, pre); else E.mid(acc, cur, wr, wc, fr_, fq_); } }
            if constexpr (Epi::PRE) { if (Epi::PRE_MID && SPLITK && t == nh - 2) { int fr_ = fr, fq_ = fq; asm volatile("" : "+v"(fr_), "+v"(fq_)); E.pre_mid(pre, cur, wr, wc, fr_, fq_); }
                if (last) { int fr_ = fr, fq_ = fq; asm volatile("" : "+v"(fr_), "+v"(fq_)); E.pre_fin(pre, cur, wr, wc, fr_, fq_); } }
            const char* a3 = a2 + kstep; const char* b3 = b2 + kstep;
            MG_LDB(B0, 0, 0); MG_LDB(B1, 0, 1); MG_SCHED; MG_LDA(At, 0, 0); MG_STAGE(MG_SA(1, 1), a1, vAc[1]);
            if constexpr (GATHER) { if (last && has_next) {
                asm volatile("" : "+v"(gnx[0][0]), "+v"(gnx[0][1]), "+v"(gnx[1][0]), "+v"(gnx[1][1]));
#pragma unroll
                for (int h = 0; h < 2; ++h)
#pragma unroll
                    for (int i = 0; i < 2; ++i) vAc[h][i] = (unsigned)gnx[h][i] * (unsigned)KB + 2u * (unsigned)stC[i]; } }
            MG_WAIT_V(8); MG_WAIT_L(0); MG_BAR; MG_MMA(0, 0, At, B0); MG_MMA(0, 1, At, B1); MG_BAR; MG_SCHED;
            MG_LDA(At, 0, 1); MG_STAGE(MG_SB(0, 0), b2, voffB); MG_STAGE(MG_SB(0, 1), b2 + hstep, voffB); MG_STAGE(MG_SA(0, 0), a2, vAc[0]);
            MG_WAIT_V(8); MG_WAIT_L(0); MG_BAR; MG_MMA(1, 0, At, B0); MG_MMA(1, 1, At, B1); MG_BAR; MG_SCHED;
            MG_LDB(B0, 1, 0); MG_LDB(B1, 1, 1); MG_SCHED; MG_LDA(At, 1, 0); MG_STAGE(MG_SA(0, 1), a2, vAc[1]);
            MG_WAIT_V(8); MG_WAIT_L(0); MG_BAR; MG_MMA(0, 0, At, B0); MG_MMA(0, 1, At, B1); MG_BAR; MG_SCHED;
            MG_LDA(At, 1, 1); MG_STAGE(MG_SB(1, 0), b3, voffB); MG_STAGE(MG_SB(1, 1), b3 + hstep, voffB); MG_STAGE(MG_SA(1, 0), a3, vAc[0]);
            MG_WAIT_V(8); MG_WAIT_L(0); MG_BAR; MG_MMA(1, 0, At, B0); MG_MMA(1, 1, At, B1); MG_BAR; MG_SCHED;
        }
        if (wr == 0) MG_BAR;
#if MK_TIMING
        tm1 = wall_clock64(); tmK += tm1 - tm0; ++tmU;
#endif
        { int fr_ = fr, fq_ = fq; asm volatile("" : "+v"(fr_), "+v"(fq_));
          if constexpr (Epi::PRE) E(acc, cur, wr, wc, fr_, fq_, pre); else E(acc, cur, wr, wc, fr_, fq_);
#ifdef PROBE_EPI
          if constexpr (Sched::TSLOT == PROBE_EPI) { asm volatile("" : "+v"(fr_), "+v"(fq_)); if constexpr (Epi::PRE) E(acc, cur, wr, wc, fr_, fq_, pre); else E(acc, cur, wr, wc, fr_, fq_); }
#endif
        }
#if MK_TIMING
        tm0 = wall_clock64(); tmE += tm0 - tm1;
#endif
        if (!has_next) break;
#pragma unroll
        for (int a = 0; a < 2; ++a)
#pragma unroll
            for (int b = 0; b < 2; ++b)
#pragma unroll
                for (int m = 0; m < 4; ++m)
#pragma unroll
                    for (int n = 0; n < 2; ++n) acc[a][b][m][n] = (f32x4){0.f, 0.f, 0.f, 0.f};
        cur = nxt; cA = nA; cB = nB; cA2 = cur.a2; cB2 = cur.b2; ++ui;
        if (wr == 1) MG_BAR;
    }
    MG_WAIT_V(0);
    MG_BAR;
#if MK_TIMING
    if (blockIdx.x == 7 && tid == 0) { float* tp = (float*)S.ws + 8192 + 8 * Sched::TSLOT; tp[0] = (float)tmE * 0.01f; tp[1] = (float)tmK * 0.01f; tp[2] = (float)(wall_clock64() - tmS) * 0.01f; tp[3] = (float)tmU; }
#endif
#undef MG_SA
#undef MG_SB
#undef MG_STAGE
#undef MG_LDA
#undef MG_LDB
#undef MG_MMA
#undef MG_LD16
#undef MG_WAIT_V
#undef MG_WAIT_L
#undef MG_BAR
#undef MG_SCHED
#undef MG_AOFF
#undef MG_TP
}
}
constexpr int D = 1024, NB = 32, SEQ = 2048, CL = 256, NTOK = NB * SEQ, NCTX = NB * CL, INC = 4624;
constexpr int NE = 16, CAP = 256;
constexpr int OFF_QK = 512, OFF_V = 1536, OFF_O = 2048, OFF_G = 2560, OFF_BR = 2576;
constexpr float EPS = 1e-6f;
constexpr size_t MiB = 1u << 20;
constexpr size_t WS_CTL = 0, CTL_BYTES = 1 * MiB;
constexpr size_t WS_MOD = 1 * MiB;
constexpr size_t WS_GATES = 2 * MiB;
constexpr size_t WS_AFF = 11 * MiB;
constexpr size_t WS_IDX = 15 * MiB;
constexpr size_t WS_VAL = 15 * MiB + 512 * 1024;
constexpr size_t WS_SLOT = 16 * MiB;
constexpr size_t WS_WTF = 18 * MiB;
constexpr size_t WS_WFT = 20 * MiB;
constexpr size_t WS_WMT = 21 * MiB;
constexpr size_t WS_WOT = 22 * MiB;
constexpr size_t WS_WTM = 24 * MiB;
constexpr size_t WS_TT = 32 * MiB;
constexpr size_t WS_PC = 48 * MiB;
constexpr size_t WS_H = 64 * MiB;
constexpr size_t WS_QK = 64 * MiB;
constexpr size_t WS_KC = 192 * MiB;
constexpr size_t WS_MRG = 64 * MiB;
constexpr size_t WS_WGU = 784 * MiB;
constexpr size_t WS_WD = 816 * MiB;
constexpr size_t WS_AB = 208 * MiB;
constexpr size_t WS_HF = 208 * MiB;
constexpr size_t WS_HB = 272 * MiB;
constexpr size_t WS_HX2 = 208 * MiB;
constexpr size_t WS_X1 = 272 * MiB;
constexpr size_t WS_FU = 336 * MiB;
constexpr size_t WS_PQK = 400 * MiB;
constexpr size_t WS_HM = 400 * MiB;
constexpr size_t WS_PV = 528 * MiB;
constexpr size_t WS_PO = 592 * MiB;
constexpr size_t WS_PBR = 656 * MiB;
constexpr size_t WS_HID = 400 * MiB;
constexpr size_t WS_Y = 656 * MiB;
#ifndef VAL_IN_FINAL
#define VAL_IN_FINAL 0
#endif
constexpr size_t WS_VALT = 832 * MiB;
constexpr size_t WS_IDENT = 912 * MiB;
constexpr size_t WS_W64 = 913 * MiB;
constexpr size_t WS_A64T = 913 * MiB + 65536;
constexpr size_t WS_F64 = 914 * MiB;
constexpr size_t WS_END = 916 * MiB;
constexpr int LDS_PHASE_BYTES = 147456, LDS_BYTES = LDS_PHASE_BYTES + 256;

__device__ __forceinline__ unsigned pk4_fp8(float a, float b, float c, float d) { int w = __builtin_amdgcn_cvt_pk_fp8_f32(a, b, 0, false); w = __builtin_amdgcn_cvt_pk_fp8_f32(c, d, w, true); return (unsigned)w; }
constexpr float W8_SCALE = 32.f, W8_INV = 1.f / 32.f;
__device__ __forceinline__ unsigned pk4_u8(float a, float b, float c, float d) { return (unsigned)(a * 255.f + 0.5f) | ((unsigned)(b * 255.f + 0.5f) << 8) | ((unsigned)(c * 255.f + 0.5f) << 16) | ((unsigned)(d * 255.f + 0.5f) << 24); }
__device__ __forceinline__ float u8f0(unsigned w) { return (float)(w & 0xffu) * (1.f / 255.f); }
__device__ __forceinline__ float u8f1(unsigned w) { return (float)((w >> 8) & 0xffu) * (1.f / 255.f); }
__device__ __forceinline__ float u8f2(unsigned w) { return (float)((w >> 16) & 0xffu) * (1.f / 255.f); }
__device__ __forceinline__ float u8f3(unsigned w) { return (float)(w >> 24) * (1.f / 255.f); }
struct Ctx {
    const float *x, *c, *ctx, *c_ctx, *w_ada, *b_ada, *g_norm1, *w_in, *b_gates, *w_conv, *w_fourier, *w_mlstm, *w_out, *g_norm2, *w_router, *w_gate_e, *w_up_e, *w_down_e, *g_final;
    float* out; unsigned char* ws;
};

__device__ __forceinline__ void store_tile_bf16(const f32x4 (&acc)[2][2][4][2], bf16* base, int ldc, bool sig, int wr, int wc, int fr, int fq, bool nost = false, size_t bjs = 128) {
    bf16* p0 = base + (size_t)(wr * 64 + fr) * ldc + wc * 32 + 8 * fq;
#pragma unroll
    for (int ai = 0; ai < 2; ++ai)
#pragma unroll
        for (int m = 0; m < 4; ++m) { bf16* rowp = p0 + (size_t)(ai * 128 + m * 16) * ldc;
#pragma unroll
            for (int bj = 0; bj < 2; ++bj) { f32x4 v0 = acc[ai][bj][m][0], v1 = acc[ai][bj][m][1];
                if (sig) {
#pragma unroll
                    for (int j = 0; j < 4; ++j) { v0[j] = sigmoid_f(v0[j]); v1[j] = sigmoid_f(v1[j]); } }
                u32x4 w; w.x = pk2(v0[0], v0[1]); w.y = pk2(v0[2], v0[3]); w.z = pk2(v1[0], v1[1]); w.w = pk2(v1[2], v1[3]);
                if (nost) asm volatile("" :: "v"(w.x), "v"(w.y), "v"(w.z), "v"(w.w)); else *(u32x4*)(rowp + bj * bjs) = w; } }
}
__device__ __forceinline__ f32x2 sig2_q(f32x2 v) { const f32x2 x = v * (f32x2){-1.4426950408889634f, -1.4426950408889634f}; const f32x2 e = {__builtin_amdgcn_exp2f(x.x), __builtin_amdgcn_exp2f(x.y)};
    const f32x2 d = e + (f32x2){1.f, 1.f}; const f32x2 r = {__builtin_amdgcn_rcpf(d.x), __builtin_amdgcn_rcpf(d.y)}; return __builtin_elementwise_fma(r, (f32x2){255.f, 255.f}, (f32x2){0.5f, 0.5f}); }
__device__ __forceinline__ unsigned sig4_u8(f32x4 v) { const f32x2 a = sig2_q((f32x2){v[0], v[1]}), b = sig2_q((f32x2){v[2], v[3]}); return (unsigned)a.x | ((unsigned)a.y << 8) | ((unsigned)b.x << 16) | ((unsigned)b.y << 24); }
__device__ __forceinline__ void store_tile_sig_u8(const f32x4 (&acc)[2][2][4][2], unsigned char* base, int ldc, int wr, int wc, int fr, int fq, bool nost = false) {
    unsigned char* p0 = base + (size_t)(wr * 64 + fr) * ldc + wc * 32 + 8 * fq;
#pragma unroll
    for (int ai = 0; ai < 2; ++ai)
#pragma unroll
        for (int m = 0; m < 4; ++m) { unsigned char* rowp = p0 + (size_t)(ai * 128 + m * 16) * ldc;
#pragma unroll
            for (int bj = 0; bj < 2; ++bj) { const f32x4 v0 = acc[ai][bj][m][0], v1 = acc[ai][bj][m][1];
                u32x2 w; w.x = sig4_u8(v0); w.y = sig4_u8(v1);
                if (nost) asm volatile("" :: "v"(w.x), "v"(w.y)); else *(u32x2*)(rowp + bj * 128) = w; }
            asm volatile("" ::: "memory"); }
}
struct EpiP1 {
    static constexpr bool PERM = true, PRE = false, PERM2 = false; unsigned char* ws;
    __device__ __forceinline__ void operator()(const f32x4 (&acc)[2][2][4][2], const mg::Unit& u, int wr, int wc, int fr, int fq) const {
        bf16* base; int ldc; bool sig = false;
#ifdef PROBE_SKIP_EPI
        if (u.ty >= 8) return;
#endif
#ifdef PROBE_SKIP_ST
        const bool nost = u.ty >= 8;
#else
        const bool nost = false;
#endif
        const int ty = u.ty & 7;
        if (ty == 0) { const size_t r0 = (size_t)u.pm * 256;
            if (u.pn < 4) { base = (bf16*)(ws + WS_PQK) + r0 * 1024 + u.pn * 256; ldc = 1024; }
            else if (u.pn < 6) { store_tile_bf16(acc, (bf16*)(ws + WS_PV) + ((size_t)((u.pm >> 3) * 4 + (u.pn - 4) * 2) * SEQ + (size_t)(u.pm & 7) * 256) * 128, 128, false, wr, wc, fr, fq, nost, (size_t)SEQ * 128); return; }
            else if (u.pn < 8) { store_tile_sig_u8(acc, ws + WS_PO + r0 * 512 + (u.pn - 6) * 256, 512, wr, wc, fr, fq, nost); return; }
            else { store_tile_sig_u8(acc, ws + WS_PBR + r0 * 2048 + (u.pn - 8) * 256, 2048, wr, wc, fr, fq, nost); return; }
        } else if (ty == 1) { base = (bf16*)(ws + WS_AB) + ((size_t)(u.pn >> 3) * 512 + (size_t)u.pm * 256) * 2048 + (u.pn & 7) * 256; ldc = 2048; }
        else { base = (bf16*)(ws + WS_PC) + (size_t)u.pm * 256 * 1024 + u.pn * 256; ldc = 1024; }
        store_tile_bf16(acc, base, ldc, sig, wr, wc, fr, fq, nost);
    }
};
struct EpiF2 {
    static constexpr bool PERM = true, PRE = false, PERM2 = false; unsigned char* ws;
    __device__ __forceinline__ void operator()(const f32x4 (&acc)[2][2][4][2], const mg::Unit& u, int wr, int wc, int fr, int fq) const {
        bf16* fb = (bf16*)(ws + WS_FU) + (size_t)u.pn * 2048 * 512 + wc * 32 + 8 * fq;
        const bool j0 = ((wc * 32 + 8 * fq) & 63) == 0;
#pragma unroll
        for (int ai = 0; ai < 2; ++ai)
#pragma unroll
            for (int m = 0; m < 4; ++m) { const int k = u.pm * 256 + ai * 128 + wr * 64 + m * 16 + fr, km = (2048 - k) & 2047;
#pragma unroll
                for (int bj = 0; bj < 2; ++bj) { const f32x4 v0 = acc[ai][bj][m][0], v1 = acc[ai][bj][m][1];
                    u32x4 w; w.x = pk2(v0[0], v0[1]); w.y = pk2(v0[2], v0[3]); w.z = pk2(v1[0], v1[1]); w.w = pk2(v1[2], v1[3]);
                    *(u32x4*)(fb + (size_t)k * 512 + bj * 128) = w;
                    bf16* mp = fb + (size_t)km * 512 + 256 + bj * 128;
                    if (j0) { mp[1] = (bf16)(w.x >> 16); *(unsigned*)(mp + 2) = w.y; *(u32x2*)(mp + 4) = (u32x2){w.z, w.w}; } else *(u32x4*)mp = w; } }
    }
};
struct EpiMerge {
    static constexpr bool PERM = true, PRE = true, PRE_MID = false, PERM2 = true; unsigned char* ws;
    struct Pre { u32x4 p[4]; };
    static __device__ __forceinline__ void ld_b128(u32x4& d, const void* p) { asm volatile("global_load_dwordx4 %0, %1, off" : "=v"(d) : "v"(p) : "memory"); }
#define MRG_PRE_FENCE(P) asm volatile("" : "+v"(P.p[0]), "+v"(P.p[1]), "+v"(P.p[2]), "+v"(P.p[3]) :: "memory")
    __device__ __forceinline__ void pre_mid(Pre& P, const mg::Unit& u, int wr, int wc, int fr, int fq) const {
        const size_t row0 = (size_t)u.pm * 256 + wr * 64 + fr; const int col0 = u.pn * 256 + wc * 64 + 16 * fq;
#pragma unroll
        for (int mm = 0; mm < 2; ++mm) { const unsigned char* gp = ws + WS_PBR + (row0 + mm * 16) * 2048 + col0; ld_b128(P.p[mm * 2], gp); ld_b128(P.p[mm * 2 + 1], gp + 1024); }
    }
    __device__ __forceinline__ void pre_fin(Pre& P, const mg::Unit& u, int wr, int wc, int fr, int fq) const {
        const size_t row0 = (size_t)u.pm * 256 + wr * 64 + fr; const int col0 = u.pn * 256 + wc * 64 + 16 * fq;
#pragma unroll
        for (int m = 0; m < 4; ++m) ld_b128(P.p[m], ws + WS_PBR + (row0 + m * 16) * 2048 + 1024 + col0);
    }
#define MRG_R(wa, wb, sh) ((float)(((wa) >> (sh)) & 0xffu) * __builtin_amdgcn_rcpf(fmaxf((float)(((wb) >> (sh)) & 0xffu), 0.5f)))
#define MRG_SCALE1(ai, m, bj, n, wa, wb) do { f32x4 v = acc[ai][bj][m][n]; \
            v = (f32x4){v[0] * MRG_R(wa, wb, 0), v[1] * MRG_R(wa, wb, 8), v[2] * MRG_R(wa, wb, 16), v[3] * MRG_R(wa, wb, 24)}; acc[ai][bj][m][n] = v; } while (0)
    __device__ __forceinline__ void mid(f32x4 (&acc)[2][2][4][2], const mg::Unit& u, int wr, int wc, int fr, int fq, Pre& P) const {
        const size_t row0 = (size_t)u.pm * 256 + wr * 64 + fr; const int col0 = u.pn * 256 + wc * 64 + 16 * fq;
        u32x4 g1[2][2], g2[2][2];
#define MRG_LOADQ(buf, q_) do { _Pragma("unroll") for (int mm = 0; mm < 2; ++mm) { const unsigned char* gp = ws + WS_PBR + (row0 + ((q_) >> 1) * 128 + (((q_) & 1) * 2 + mm) * 16) * 2048 + col0; \
            g1[buf][mm] = *(const u32x4*)gp; g2[buf][mm] = *(const u32x4*)(gp + 1024); } } while (0)
#define MRG_DOQ(buf, ai, mh) do { _Pragma("unroll") for (int mm = 0; mm < 2; ++mm) { const u32x4 a = g1[buf][mm], b = g2[buf][mm]; \
            MRG_SCALE1(ai, (mh) * 2 + mm, 0, 0, a.x, b.x); MRG_SCALE1(ai, (mh) * 2 + mm, 0, 1, a.y, b.y); MRG_SCALE1(ai, (mh) * 2 + mm, 1, 0, a.z, b.z); MRG_SCALE1(ai, (mh) * 2 + mm, 1, 1, a.w, b.w); } } while (0)
        if (PRE_MID) { MRG_PRE_FENCE(P);
            g1[0][0] = P.p[0]; g2[0][0] = P.p[1]; g1[0][1] = P.p[2]; g2[0][1] = P.p[3]; } else MRG_LOADQ(0, 0);
        MRG_LOADQ(1, 1);
        MRG_DOQ(0, 0, 0); asm volatile("" ::: "memory"); MRG_LOADQ(0, 2);
        MRG_DOQ(1, 0, 1); asm volatile("" ::: "memory"); MRG_LOADQ(1, 3);
        MRG_DOQ(0, 1, 0); asm volatile("" ::: "memory");
        MRG_DOQ(1, 1, 1); asm volatile("" ::: "memory");
#undef MRG_LOADQ
#undef MRG_DOQ
    }
#undef MRG_SCALE1
#undef MRG_R
    __device__ __forceinline__ void operator()(const f32x4 (&acc)[2][2][4][2], const mg::Unit& u, int wr, int wc, int fr, int fq, Pre& P) const {
        const size_t row0 = (size_t)u.pm * 256 + wr * 64 + fr; const int col0 = u.pn * 256 + wc * 64 + 16 * fq;
        asm volatile("s_waitcnt vmcnt(16)" ::: "memory"); MRG_PRE_FENCE(P);
        u32x4 g2a[2][4];
#pragma unroll
        for (int m = 0; m < 4; ++m) { g2a[0][m] = P.p[m]; g2a[1][m] = *(const u32x4*)(ws + WS_PBR + (row0 + 128 + m * 16) * 2048 + 1024 + col0); }
#pragma unroll
        for (int ai = 0; ai < 2; ++ai) {
#pragma unroll
            for (int m = 0; m < 4; ++m) { const u32x4 b = g2a[ai][m]; bf16* op = (bf16*)(ws + WS_MRG) + (row0 + ai * 128 + m * 16) * 1024 + col0;
#define MRG_G(wb, sh) (fmaxf((float)(((wb) >> (sh)) & 0xffu), 0.5f) * (1.f / 255.f))
#define MRG_OUT(bj, bw0, bw1, dst) do { const f32x4 v0 = acc[ai][bj][m][0], v1 = acc[ai][bj][m][1]; u32x4 w; \
                    w.x = pk2(v0[0] * MRG_G(bw0, 0), v0[1] * MRG_G(bw0, 8)); w.y = pk2(v0[2] * MRG_G(bw0, 16), v0[3] * MRG_G(bw0, 24)); \
                    w.z = pk2(v1[0] * MRG_G(bw1, 0), v1[1] * MRG_G(bw1, 8)); w.w = pk2(v1[2] * MRG_G(bw1, 16), v1[3] * MRG_G(bw1, 24)); *(u32x4*)(dst) = w; } while (0)
                MRG_OUT(0, b.x, b.y, op); MRG_OUT(1, b.z, b.w, op + 8);
#undef MRG_OUT
#undef MRG_G
            }
            asm volatile("" ::: "memory"); }
    }
#undef MRG_PRE_FENCE
};
struct EpiOut {
    static constexpr bool PERM = true, PRE = false, PERM2 = false; const float* x; const float* mod; unsigned char* ws;
    __device__ __forceinline__ void operator()(const f32x4 (&acc)[2][2][4][2], const mg::Unit& u, int wr, int wc, int fr, int fq) const {
        const size_t row0 = (size_t)u.pm * 256 + wr * 64 + fr; const int col0 = u.pn * 256 + wc * 32 + 8 * fq; const int b = u.pm >> 3;
        f32x4 ga[2][2];
#pragma unroll
        for (int bj = 0; bj < 2; ++bj)
#pragma unroll
            for (int n = 0; n < 2; ++n) ga[bj][n] = *(const f32x4*)(mod + (size_t)b * 6144 + 2048 + col0 + bj * 128 + n * 4);
#pragma unroll
        for (int ai = 0; ai < 2; ++ai) {
            f32x4 xv[4][2][2];
#pragma unroll
            for (int m = 0; m < 4; ++m) { const size_t off = (row0 + ai * 128 + m * 16) * 1024 + col0;
#pragma unroll
                for (int bj = 0; bj < 2; ++bj) { xv[m][bj][0] = *(const f32x4*)(x + off + bj * 128); xv[m][bj][1] = *(const f32x4*)(x + off + bj * 128 + 4); } }
#pragma unroll
            for (int m = 0; m < 4; ++m) { const size_t off = (row0 + ai * 128 + m * 16) * 1024 + col0;
#pragma unroll
                for (int bj = 0; bj < 2; ++bj) { const f32x4 v0 = xv[m][bj][0] + ga[bj][0] * acc[ai][bj][m][0], v1 = xv[m][bj][1] + ga[bj][1] * acc[ai][bj][m][1];
                    u32x4 w; w.x = pk2(v0[0], v0[1]); w.y = pk2(v0[2], v0[3]); w.z = pk2(v1[0], v1[1]); w.w = pk2(v1[2], v1[3]);
                    *(u32x4*)((bf16*)(ws + WS_X1) + off + bj * 128) = w; } }
            asm volatile("" ::: "memory"); }
    }
};
struct EpiSwiglu {
    static constexpr bool PERM = true, PRE = false, PERM2 = false; unsigned char* ws;
    __device__ __forceinline__ void operator()(const f32x4 (&acc)[2][2][4][2], const mg::Unit& u, int wr, int wc, int fr, int fq) const {
        unsigned char* p0 = ws + WS_HID + ((size_t)u.pm * 256 + wr * 64 + fr) * 1024 + u.pn * 128 + wc * 32 + 8 * fq;
#pragma unroll
        for (int ai = 0; ai < 2; ++ai)
#pragma unroll
            for (int m = 0; m < 4; ++m) { float r[8];
#pragma unroll
                for (int n = 0; n < 2; ++n)
#pragma unroll
                    for (int j = 0; j < 4; j += 2) {
                        const f32x2 g = {acc[ai][0][m][n][j], acc[ai][0][m][n][j + 1]}, uu = {acc[ai][1][m][n][j], acc[ai][1][m][n][j + 1]};
                        const f32x2 x = g * (f32x2){-1.4426950408889634f * W8_INV, -1.4426950408889634f * W8_INV};
                        const f32x2 e = {__builtin_amdgcn_exp2f(x.x), __builtin_amdgcn_exp2f(x.y)};
                        const f32x2 d = __builtin_elementwise_fma(e, (f32x2){1024.f, 1024.f}, (f32x2){1024.f, 1024.f});
                        const f32x2 rr = {__builtin_amdgcn_rcpf(d.x), __builtin_amdgcn_rcpf(d.y)};
                        const f32x2 o = (g * uu) * rr; r[n * 4 + j] = o.x; r[n * 4 + j + 1] = o.y; }
                u32x2 w; w.x = pk4_fp8(r[0], r[1], r[2], r[3]); w.y = pk4_fp8(r[4], r[5], r[6], r[7]);
                *(u32x2*)(p0 + (size_t)(ai * 128 + m * 16) * 1024) = w; }
    }
};
constexpr float Y8_SCALE = 8.f, Y8_INV = 1.f / 8.f;
struct EpiDown {
    static constexpr bool PERM = true, PRE = true, PRE_MID = false, PERM2 = true; unsigned char* ws;
    struct Pre { float v[8]; };
    __device__ __forceinline__ void pre_mid(Pre&, const mg::Unit&, int, int, int, int) const {}
    __device__ __forceinline__ void pre_fin(Pre& P, const mg::Unit& u, int wr, int wc, int fr, int fq) const {
        const float* val = (const float*)(ws + WS_VAL) + (size_t)u.pm * 256 + wr * 64 + fr;
#pragma unroll
        for (int ai = 0; ai < 2; ++ai)
#pragma unroll
            for (int m = 0; m < 4; ++m) asm volatile("global_load_dword %0, %1, off" : "=v"(P.v[ai * 4 + m]) : "v"(val + ai * 128 + m * 16) : "memory");
    }
    __device__ __forceinline__ void operator()(const f32x4 (&acc)[2][2][4][2], const mg::Unit& u, int wr, int wc, int fr, int fq, Pre& P) const {
        const size_t row0 = (size_t)u.pm * 256 + wr * 64 + fr;
        unsigned char* p0 = ws + WS_Y + row0 * 1024 + u.pn * 256 + wc * 64 + 16 * fq;
        asm volatile("s_waitcnt vmcnt(16)" : "+v"(P.v[0]), "+v"(P.v[1]), "+v"(P.v[2]), "+v"(P.v[3]), "+v"(P.v[4]), "+v"(P.v[5]), "+v"(P.v[6]), "+v"(P.v[7]) :: "memory");
#pragma unroll
        for (int ai = 0; ai < 2; ++ai)
#pragma unroll
            for (int m = 0; m < 4; ++m) { const float vv = P.v[ai * 4 + m] * (W8_INV * Y8_SCALE); unsigned char* rowp = p0 + (size_t)(ai * 128 + m * 16) * 1024;
                const f32x4 v0 = acc[ai][0][m][0] * vv, v1 = acc[ai][0][m][1] * vv, v2 = acc[ai][1][m][0] * vv, v3 = acc[ai][1][m][1] * vv;
                u32x4 w; w.x = pk4_fp8(v0[0], v0[1], v0[2], v0[3]); w.y = pk4_fp8(v1[0], v1[1], v1[2], v1[3]); w.z = pk4_fp8(v2[0], v2[1], v2[2], v2[3]); w.w = pk4_fp8(v3[0], v3[1], v3[2], v3[3]);
                *(u32x4*)rowp = w; }
    }
};

struct SchedP1 {
    static constexpr int TSLOT = 0; unsigned char* ws; int G, c, nrep; int erep = 1;
    __device__ __forceinline__ bool next(int i, mg::Unit& u) const {
        int L = i * G + c; if (L >= 4736 * nrep) return false; const int dup = L >= 4736 ? 8 : 0; L %= 4736; const char* H = (const char*)(ws + WS_H); u.gi = nullptr;
        if (L < 4096) { mg::tile_of(L, 256, 16, u.pm, u.pn); u.ty = 0 + dup; u.a = H + (size_t)u.pm * 256 * 2048; u.b = (const char*)(ws + WS_WTM) + (size_t)u.pn * 256 * 2048; return true; }
        L -= 4096;
        if (L < 512) { mg::tile_of(L, 2, 256, u.pm, u.pn); u.ty = 1 + dup; u.a = (const char*)(ws + WS_WTF) + (size_t)u.pm * 256 * 2048; u.b = H + (size_t)u.pn * 256 * 2048; return true; }
        L -= 512;
        if (L < 128) { mg::tile_of(L, 32, 4, u.pm, u.pn); u.ty = 2 + dup; u.a = H + ((size_t)NTOK + (size_t)u.pm * 256) * 2048; u.b = (const char*)(ws + WS_WTM) + ((size_t)512 + (size_t)u.pn * 256) * 2048; return true; }
        return false;
    }
};
struct SchedF2 {
    static constexpr int TSLOT = 1; unsigned char* ws; int G, c, nrep; int erep = 1;
    __device__ __forceinline__ bool next(int i, mg::Unit& u) const {
        int L = i * G + c; if (L >= 256 * nrep) return false; L %= 256; mg::tile_of(L, 8, 32, u.pm, u.pn); u.ty = 0; u.gi = nullptr;
        u.a = (const char*)(ws + WS_TT) + (size_t)u.pm * 256 * 8192; u.b = (const char*)(ws + WS_AB) + (size_t)u.pn * 256 * 8192; return true;
    }
};
struct SchedMerge {
    static constexpr int TSLOT = 2; unsigned char* ws; int G, c, nrep; int erep = 1;
    __device__ __forceinline__ bool next(int i, mg::Unit& u) const {
        int L = i * G + c; if (L >= 1024 * nrep) return false; L %= 1024; mg::tile_of(L, 256, 4, u.pm, u.pn); u.ty = 0; u.gi = nullptr;
        u.a = (const char*)(ws + WS_FU) + (size_t)u.pm * 256 * 1024; u.b = (const char*)(ws + WS_WFT) + (size_t)u.pn * 256 * 1024;
        u.a2 = (const char*)(ws + WS_HM) + (size_t)u.pm * 256 * 1024; u.b2 = (const char*)(ws + WS_WMT) + (size_t)u.pn * 256 * 1024; return true;
    }
};
struct SchedOut {
    static constexpr int TSLOT = 3; unsigned char* ws; int G, c, nrep; int erep = 1;
    __device__ __forceinline__ bool next(int i, mg::Unit& u) const {
        int L = i * G + c; if (L >= 1024 * nrep) return false; L %= 1024; mg::tile_of(L, 256, 4, u.pm, u.pn); u.ty = 0; u.gi = nullptr;
        u.a = (const char*)(ws + WS_MRG) + (size_t)u.pm * 256 * 2048; u.b = (const char*)(ws + WS_WOT) + (size_t)u.pn * 256 * 2048; return true;
    }
};
struct SchedUp {
    static constexpr int TSLOT = 4; unsigned char* ws; int G, c, nrep; int erep = 1;
    __device__ __forceinline__ bool next(int i, mg::Unit& u) const {
        int L = i * G + c; if (L >= 4096 * nrep) return false; L %= 4096; mg::tile_of(L, 512, 8, u.pm, u.pn); u.ty = 0;
        u.a = (const char*)(ws + WS_HX2); u.gi = (const int*)(ws + WS_IDX) + (size_t)u.pm * 256; u.b = (const char*)(ws + WS_WGU) + ((size_t)(u.pm >> 5) * 8 + u.pn) * 256 * 1024; return true;
    }
};
struct SchedDown {
    static constexpr int TSLOT = 5; unsigned char* ws; int G, c, nrep; int erep = 1;
    __device__ __forceinline__ bool next(int i, mg::Unit& u) const {
        int L = i * G + c; if (L >= 2048 * nrep) return false; L %= 2048; mg::tile_of(L, 512, 4, u.pm, u.pn); u.ty = 0;
        u.a = (const char*)(ws + WS_HID); u.gi = (const int*)(ws + WS_IDENT) + (size_t)u.pm * 256; u.b = (const char*)(ws + WS_WD) + ((size_t)(u.pm >> 5) * 4 + u.pn) * 256 * 1024; return true;
    }
};

__device__ __forceinline__ void transpose_item(const float* W, int ldw, int n0, int k0, bf16* dst, int drow0, int Kd, LAS float* scr, int lane) {
#pragma unroll 8
    for (int i = 0; i < 32; ++i) { const int kk = 2 * i + (lane >> 5); scr[kk * 33 + (lane & 31)] = W[(size_t)(k0 + kk) * ldw + n0 + (lane & 31)]; }
    asm volatile("s_waitcnt lgkmcnt(0)" ::: "memory");
    const int c = lane & 7;
#pragma unroll
    for (int j = 0; j < 4; ++j) { const int n = (lane >> 3) + 8 * j; const LAS float* s = scr + (8 * c) * 33 + n;
        u32x4 o; o.x = pk2(s[0 * 33], s[1 * 33]); o.y = pk2(s[2 * 33], s[3 * 33]); o.z = pk2(s[4 * 33], s[5 * 33]); o.w = pk2(s[6 * 33], s[7 * 33]);
        *(u32x4*)(dst + (size_t)(drow0 + n) * Kd + k0 + 8 * c) = o; }
    asm volatile("s_waitcnt lgkmcnt(0)" ::: "memory");
}

__device__ __forceinline__ void transpose_item8(const float* W, int ldw, int n0, int k0, unsigned char* dst, int drow0, int Kd, LAS float* scr, int lane) {
#pragma unroll 8
    for (int i = 0; i < 32; ++i) { const int kk = 2 * i + (lane >> 5); scr[kk * 33 + (lane & 31)] = W[(size_t)(k0 + kk) * ldw + n0 + (lane & 31)] * W8_SCALE; }
    asm volatile("s_waitcnt lgkmcnt(0)" ::: "memory");
    const int c = lane & 7;
#pragma unroll
    for (int j = 0; j < 4; ++j) { const int n = (lane >> 3) + 8 * j; const LAS float* s = scr + (8 * c) * 33 + n;
        u32x2 o; o.x = pk4_fp8(s[0 * 33], s[1 * 33], s[2 * 33], s[3 * 33]); o.y = pk4_fp8(s[4 * 33], s[5 * 33], s[6 * 33], s[7 * 33]);
        *(u32x2*)(dst + (size_t)(drow0 + n) * Kd + k0 + 8 * c) = o; }
    asm volatile("s_waitcnt lgkmcnt(0)" ::: "memory");
}

__device__ __forceinline__ void split8(const float (&x)[8], bf16x8& hi, bf16x8& lo) {
    u32x4 h, l;
    h.x = pk2(x[0], x[1]); h.y = pk2(x[2], x[3]); h.z = pk2(x[4], x[5]); h.w = pk2(x[6], x[7]);
    l.x = pk2(x[0] - bflo(h.x), x[1] - bfhi(h.x)); l.y = pk2(x[2] - bflo(h.y), x[3] - bfhi(h.y)); l.z = pk2(x[4] - bflo(h.z), x[5] - bfhi(h.z)); l.w = pk2(x[6] - bflo(h.w), x[7] - bfhi(h.w));
    hi = __builtin_bit_cast(bf16x8, h); lo = __builtin_bit_cast(bf16x8, l);
}
__device__ __forceinline__ void p0_prep(const Ctx& C, LAS unsigned char* lds, int tid, int lane, int wave, int G) {
    const int blk = blockIdx.x;
    for (int item = blk; item < 384; item += 2 * G) {
        const bool two = item + G < 384; const int n0 = item * 16, n1 = (two ? item + G : item) * 16, i = lane & 15, g = lane >> 4;
        f32x4 acc[2][3];
#pragma unroll
        for (int q = 0; q < 2; ++q)
#pragma unroll
            for (int rt = 0; rt < 3; ++rt) acc[q][rt] = (f32x4){0.f, 0.f, 0.f, 0.f};
        float wv[2][4][8]; f32x4 cv[4][3][2];
#pragma unroll
        for (int sx = 0; sx < 4; ++sx) { const int k0 = 32 * (4 * wave + sx) + 8 * g;
#pragma unroll
            for (int e = 0; e < 8; ++e) { wv[0][sx][e] = C.w_ada[(size_t)(k0 + e) * 6144 + n0 + i]; wv[1][sx][e] = C.w_ada[(size_t)(k0 + e) * 6144 + n1 + i]; }
#pragma unroll
            for (int rt = 0; rt < 3; ++rt) { const float* cp = rt < 2 ? C.c + (size_t)(16 * rt + i) * 1024 + k0 : (i == 0 ? C.c_ctx + k0 : C.c + (size_t)i * 1024 + k0);
                cv[sx][rt][0] = *(const f32x4*)cp; cv[sx][rt][1] = *(const f32x4*)(cp + 4); } }
#pragma unroll
        for (int sx = 0; sx < 4; ++sx) { bf16x8 ah[2], al[2]; split8(wv[0][sx], ah[0], al[0]); split8(wv[1][sx], ah[1], al[1]);
#pragma unroll
            for (int rt = 0; rt < 3; ++rt) { float sv[8];
#pragma unroll
                for (int e = 0; e < 4; ++e) { sv[e] = silu_f(cv[sx][rt][0][e]); sv[4 + e] = silu_f(cv[sx][rt][1][e]); }
                bf16x8 bh, bl; split8(sv, bh, bl);
#pragma unroll
                for (int q = 0; q < 2; ++q) {
                    acc[q][rt] = __builtin_amdgcn_mfma_f32_16x16x32_bf16(ah[q], bh, acc[q][rt], 0, 0, 0);
                    acc[q][rt] = __builtin_amdgcn_mfma_f32_16x16x32_bf16(al[q], bh, acc[q][rt], 0, 0, 0);
                    acc[q][rt] = __builtin_amdgcn_mfma_f32_16x16x32_bf16(ah[q], bl, acc[q][rt], 0, 0, 0); } } }
        LAS f32x4* red = (LAS f32x4*)lds;
#pragma unroll
        for (int q = 0; q < 2; ++q)
#pragma unroll
            for (int rt = 0; rt < 3; ++rt) red[((q * 8 + wave) * 3 + rt) * 64 + lane] = acc[q][rt];
        __syncthreads();
        float* mod = (float*)(C.ws + WS_MOD);
        for (int o = tid; o < (two ? 2 : 1) * 33 * 16; o += 512) { const int q = o >= 33 * 16, oo = o - q * 33 * 16, r = oo >> 4, n = oo & 15; float sacc = 0.f;
#pragma unroll
            for (int w = 0; w < 8; ++w) sacc += ((const LAS float*)(red + ((q * 8 + w) * 3 + (r >> 4)) * 64 + ((n >> 2) * 16 + (r & 15))))[n & 3];
            const int nn = (q ? n1 : n0) + n; mod[(size_t)r * 6144 + nn] = sacc + C.b_ada[nn]; }
        __syncthreads();
    }
    {   const int NGW = G * 8;
        for (int d = blk * 8 + wave; d < 1024; d += NGW) { const float sg = (lane & 1) ? -1.f : 1.f;
#pragma unroll
            for (int g = 0; g < 4; ++g) { const float* wp = C.w_in + (size_t)d * INC + g * 128; const float sv = wave_sum(sg * (wp[lane] + wp[lane + 64])); if (lane == 0) ((float*)(C.ws + WS_W64))[d * 4 + g] = sv; } }
    }
}
__device__ __forceinline__ void p0_wtf(const Ctx& C, LAS unsigned char* lds, int tid, int vb, int nvb) {
    LAS float* cs = (LAS float*)lds; LAS float* sn = cs + 128; const int lane = tid & 63, wave = tid >> 6, i = lane & 15, g4 = lane >> 4;
    if (tid < 128) { cs[tid] = cospif((float)tid * (1.f / 64.f)); sn[tid] = sinpif((float)tid * (1.f / 64.f)); }
    __syncthreads();
    for (int item = vb; item < 256; item += nvb) {
        const int g = item >> 6, d0 = (item & 63) * 16; const int rj = 16 * wave + i, jj = rj >> 1; const LAS float* tw = (rj & 1) ? sn : cs;
        const float* ap = C.w_in + (size_t)(d0 + i) * INC + g * 128 + 8 * g4;
        f32x4 av[4][2];
#pragma unroll
        for (int ks = 0; ks < 4; ++ks) { av[ks][0] = *(const f32x4*)(ap + 32 * ks); av[ks][1] = *(const f32x4*)(ap + 32 * ks + 4); }
        f32x4 acc = {0.f, 0.f, 0.f, 0.f};
#pragma unroll
        for (int ks = 0; ks < 4; ++ks) { float a8[8], b8[8];
#pragma unroll
            for (int e = 0; e < 4; ++e) { a8[e] = av[ks][0][e]; a8[4 + e] = av[ks][1][e]; }
#pragma unroll
            for (int e = 0; e < 8; ++e) b8[e] = tw[(jj * (32 * ks + 8 * g4 + e)) & 127];
            bf16x8 ah, al, bh, bl; split8(a8, ah, al); split8(b8, bh, bl);
            acc = __builtin_amdgcn_mfma_f32_16x16x32_bf16(ah, bh, acc, 0, 0, 0);
            acc = __builtin_amdgcn_mfma_f32_16x16x32_bf16(al, bh, acc, 0, 0, 0);
            acc = __builtin_amdgcn_mfma_f32_16x16x32_bf16(ah, bl, acc, 0, 0, 0); }
        u32x2 o; o.x = pk2(acc[0], acc[1]); o.y = pk2(acc[2], acc[3]);
        *(u32x2*)((bf16*)(C.ws + WS_WTF) + (size_t)(g * 128 + rj) * 1024 + d0 + 4 * g4) = o;
    }
    __syncthreads();
}
__device__ __forceinline__ void p0_tt(const Ctx& C, LAS unsigned char* lds, int tid, int vb, int nvb) {
    {
        LAS float* tc = (LAS float*)lds; LAS float* ts = tc + 2048;
        for (int i = tid; i < 2048; i += 512) { const float a = (float)i * (1.f / 1024.f); tc[i] = cospif(a) * (1.f / 512.f); ts[i] = -sinpif(a) * (1.f / 512.f); }
        __syncthreads();
        for (int item = vb; item < 256; item += nvb)
            for (int rr = 0; rr < 8; ++rr) { const int k = item * 8 + rr; const int lp0 = tid * 8; const LAS float* tb = lp0 < 2048 ? tc : ts; const int l0 = lp0 & 2047; float v[8];
#pragma unroll
                for (int e = 0; e < 8; ++e) v[e] = tb[(k * (l0 + e)) & 2047];
                u32x4 o; o.x = pk2(v[0], v[1]); o.y = pk2(v[2], v[3]); o.z = pk2(v[4], v[5]); o.w = pk2(v[6], v[7]);
                *(u32x4*)((bf16*)(C.ws + WS_TT) + (size_t)k * 4096 + lp0) = o; }
        __syncthreads();
    }
}
__device__ __forceinline__ void p0_weights(const Ctx& C, LAS unsigned char* lds, int tid, int lane, int wave, int G) {
    const int blk = blockIdx.x;
    {
        LAS float* scr = (LAS float*)lds + wave * (64 * 33);
        const int gw = blk * 8 + wave, NGW = G * 8;
        constexpr int I_IN = 16 * 128, I_M = 8 * 32, I_O = 16 * 32;
        for (int it = gw; it < I_IN + I_M + I_O; it += NGW) {
            int r = it;
            if (r < I_IN) { const int kb = r >> 7, nb = r & 127; const int n0 = nb < 64 ? 512 + 32 * nb : 2576 + 32 * (nb - 64);
                transpose_item(C.w_in, INC, n0, kb * 64, (bf16*)(C.ws + WS_WTM), 32 * nb, 1024, scr, lane); continue; }
            r -= I_IN;
            if (r < I_M) { const int kb = r >> 5, nb = r & 31; transpose_item(C.w_mlstm, 1024, 32 * nb, kb * 64, (bf16*)(C.ws + WS_WMT), 32 * nb, 512, scr, lane); continue; }
            r -= I_M;
            { const int kb = r >> 5, nb = r & 31; transpose_item(C.w_out, 1024, 32 * nb, kb * 64, (bf16*)(C.ws + WS_WOT), 32 * nb, 1024, scr, lane); }
        }
        for (int idx = blk * 512 + tid; idx < 1024 * 64; idx += G * 512) { const int n = idx >> 6, k0 = (idx & 63) * 8; float v[8];
#pragma unroll
            for (int e = 0; e < 8; ++e) { const int kp = k0 + e, kk = kp & 255, gg = kk >> 6, j = kk & 63; const int src = kp < 256 ? gg * 128 + j : gg * 128 + 128 - j - (j ? 0 : 64); v[e] = C.w_fourier[(size_t)src * 1024 + n]; }
            u32x4 o; o.x = pk2(v[0], v[1]); o.y = pk2(v[2], v[3]); o.z = pk2(v[4], v[5]); o.w = pk2(v[6], v[7]);
            *(u32x4*)((bf16*)(C.ws + WS_WFT) + (size_t)n * 512 + k0) = o; }
    }
}
#ifndef CVT_N1
#define CVT_N1 4
#define CVT_N2 10
#endif
static_assert(512 * CVT_N1 + 1536 * CVT_N2 == 24576 - 7168, "conversion split");
__device__ __forceinline__ void convert_item(const Ctx& C, LAS float* scr, int it, int lane);
__device__ __forceinline__ void convert_experts(const Ctx& C, LAS unsigned char* lds, int lane, int wave, int G, int rep, int part) {
    LAS float* scr = (LAS float*)lds + wave * (64 * 33);
    const int gw = blockIdx.x * 8 + wave, NGW = G * 8;
    if (G == 256) {
        for (int r = 0; r < rep; ++r) {
            if (part == 0) { if ((int)blockIdx.x >= 128) { const int w = gw - 1024; for (int k = 0; k < 7; ++k) convert_item(C, scr, w * 7 + k, lane); } }
            else if (wave < 2) { const int ib = (int)blockIdx.x * 2 + wave; for (int k = 0; k < CVT_N1; ++k) convert_item(C, scr, 7168 + 1536 * CVT_N2 + ib * CVT_N1 + k, lane); }
            else { const int ia = (int)blockIdx.x * 6 + wave - 2; for (int k = 0; k < CVT_N2; ++k) convert_item(C, scr, 7168 + ia * CVT_N2 + k, lane); } }
        return; }
    if (part == 0) return;
    for (int it0 = gw; it0 < 48 * 512 * rep; it0 += NGW) convert_item(C, scr, it0 % (48 * 512), lane);
}
__device__ __forceinline__ void convert_item(const Ctx& C, LAS float* scr, int it, int lane) { {
        const int mat = it >> 9, r = it & 511, kb = r >> 5, nb = r & 31, e = mat & 15, which = mat >> 4;
        if (which < 2) { const float* W = (which ? C.w_up_e : C.w_gate_e) + (size_t)e * 1024 * 1024; const int n0 = 32 * nb;
            transpose_item8(W, 1024, n0, kb * 64, C.ws + WS_WGU, e * 2048 + (n0 >> 7) * 256 + which * 128 + (n0 & 127), 1024, scr, lane); }
        else transpose_item8(C.w_down_e + (size_t)e * 1024 * 1024, 1024, 32 * nb, kb * 64, C.ws + WS_WD, e * 1024 + 32 * nb, 1024, scr, lane);
    }
}

__device__ __forceinline__ float swap_add32(float a, float b) { const u32x2 r = __builtin_amdgcn_permlane32_swap(__float_as_uint(a), __float_as_uint(b), false, false); return __uint_as_float(r.x) + __uint_as_float(r.y); }
__device__ __forceinline__ float swap_add16(float a, float b) { const u32x2 r = __builtin_amdgcn_permlane16_swap(__float_as_uint(a), __float_as_uint(b), false, false); return __uint_as_float(r.x) + __uint_as_float(r.y); }
__device__ __forceinline__ float butterfly64(float (&v)[64], int lane) {
#pragma unroll
    for (int i = 0; i < 32; ++i) v[i] = swap_add32(v[i], v[i + 32]);
#pragma unroll
    for (int i = 0; i < 16; ++i) v[i] = swap_add16(v[i], v[i + 16]);
#pragma unroll
    for (int i = 0; i < 8; ++i) { const bool up = lane & 8; const float send = up ? v[i] : v[i + 8], keep = up ? v[i + 8] : v[i]; v[i] = keep + __shfl_xor(send, 8); }
#pragma unroll
    for (int i = 0; i < 4; ++i) { const bool up = lane & 4; const float send = up ? v[i] : v[i + 4], keep = up ? v[i + 4] : v[i]; v[i] = keep + __shfl_xor(send, 4); }
#pragma unroll
    for (int i = 0; i < 2; ++i) { const bool up = lane & 2; const float send = up ? v[i] : v[i + 2], keep = up ? v[i + 2] : v[i]; v[i] = keep + __shfl_xor(send, 2); }
    { const bool up = lane & 1; const float send = up ? v[0] : v[1], keep = up ? v[1] : v[0]; v[0] = keep + __shfl_xor(send, 1); }
    return v[0];
}

__device__ __forceinline__ float butterfly16(float (&v)[16], int lane) {
#pragma unroll
    for (int i = 0; i < 8; ++i) v[i] = swap_add32(v[i], v[i + 8]);
#pragma unroll
    for (int i = 0; i < 4; ++i) v[i] = swap_add16(v[i], v[i + 4]);
#pragma unroll
    for (int i = 0; i < 2; ++i) { const bool up = lane & 8; const float send = up ? v[i] : v[i + 2], keep = up ? v[i + 2] : v[i]; v[i] = keep + __shfl_xor(send, 8); }
    { const bool up = lane & 4; const float send = up ? v[0] : v[1], keep = up ? v[1] : v[0]; v[0] = keep + __shfl_xor(send, 4); }
    v[0] += __shfl_xor(v[0], 2); v[0] += __shfl_xor(v[0], 1);
    return v[0];
}
template <bool OUT8, bool PROJ4, bool IN16 = false> __device__ __forceinline__ float rows4_norm_proj(const float* xin, size_t row0, const f32x4 (&gsc)[4], const f32x4 (&sh)[4], bf16* hout, const LAS float* wl, const LAS float* wl2, float& p4, int lane, const u32x2 (*raw)[4] = nullptr) {
    f32x4 v[4][4]; float ss[4];
#pragma unroll
    for (int r = 0; r < 4; ++r) { ss[r] = 0.f;
#pragma unroll
        for (int j = 0; j < 4; ++j) { if constexpr (IN16) { const u32x2 pw = raw ? raw[r][j] : *(const u32x2*)((const bf16*)xin + (row0 + r) * 1024 + 4 * lane + 256 * j); v[r][j] = (f32x4){bflo(pw.x), bfhi(pw.x), bflo(pw.y), bfhi(pw.y)}; }
            else v[r][j] = *(const f32x4*)(xin + (row0 + r) * 1024 + 4 * lane + 256 * j);
            ss[r] += v[r][j][0] * v[r][j][0] + v[r][j][1] * v[r][j][1] + v[r][j][2] * v[r][j][2] + v[r][j][3] * v[r][j][3]; } }
#pragma unroll
    for (int r = 0; r < 4; ++r) { const float rstd = rsqrtf(wave_sum(ss[r]) * (1.f / 1024.f) + EPS);
#pragma unroll
        for (int j = 0; j < 4; ++j) { v[r][j] = v[r][j] * rstd * gsc[j] + sh[j];
            if constexpr (OUT8) *(unsigned*)((unsigned char*)hout + (row0 + r) * 1024 + 4 * lane + 256 * j) = pk4_fp8(v[r][j][0], v[r][j][1], v[r][j][2], v[r][j][3]);
            else { u32x2 w; w.x = pk2(v[r][j][0], v[r][j][1]); w.y = pk2(v[r][j][2], v[r][j][3]); *(u32x2*)(hout + (row0 + r) * 1024 + 4 * lane + 256 * j) = w; } } }
    f32x2 accp[32], acc2p[8];
#pragma unroll
    for (int i = 0; i < 32; ++i) accp[i] = (f32x2){0.f, 0.f};
#pragma unroll
    for (int i = 0; i < 8; ++i) acc2p[i] = (f32x2){0.f, 0.f};
#pragma unroll
    for (int j = 0; j < 4; ++j)
#pragma unroll
        for (int e = 0; e < 4; ++e) { const LAS float* wp = wl + ((j * 4 + e) * 4) * 256 + lane * 4;
            if constexpr (PROJ4) { const f32x4 wb = *(const LAS f32x4*)(wl2 + ((j * 4 + e) * 64 + lane) * 4); const f32x2 wb0 = {wb[0], wb[1]}, wb1 = {wb[2], wb[3]};
#pragma unroll
                for (int r = 0; r < 4; ++r) { const f32x2 hv2 = {v[r][j][e], v[r][j][e]}; acc2p[r * 2] = __builtin_elementwise_fma(hv2, wb0, acc2p[r * 2]); acc2p[r * 2 + 1] = __builtin_elementwise_fma(hv2, wb1, acc2p[r * 2 + 1]); } }
#pragma unroll
            for (int q = 0; q < 4; ++q) { const f32x4 w4 = *(const LAS f32x4*)(wp + q * 256); const f32x2 w0 = {w4[0], w4[1]}, w1 = {w4[2], w4[3]};
#pragma unroll
                for (int r = 0; r < 4; ++r) { const f32x2 hv2 = {v[r][j][e], v[r][j][e]}; accp[r * 8 + 2 * q] = __builtin_elementwise_fma(hv2, w0, accp[r * 8 + 2 * q]); accp[r * 8 + 2 * q + 1] = __builtin_elementwise_fma(hv2, w1, accp[r * 8 + 2 * q + 1]); } }
            asm volatile("" ::: "memory"); }
    float acc[64], acc2[16];
#pragma unroll
    for (int i = 0; i < 32; ++i) { acc[2 * i] = accp[i][0]; acc[2 * i + 1] = accp[i][1]; }
#pragma unroll
    for (int i = 0; i < 8; ++i) { acc2[2 * i] = acc2p[i][0]; acc2[2 * i + 1] = acc2p[i][1]; }
    if constexpr (PROJ4) p4 = butterfly16(acc2, lane);
    return butterfly64(acc, lane);
}

__device__ __forceinline__ float gate_xf(float v, int lane) { return ((lane >> 2) & 1) ? fminf(v, 0.f) - log1pf(expf(-fabsf(v))) : v; }
__device__ __forceinline__ void p1a_norm_gates(const Ctx& C, LAS unsigned char* lds, int tid, int lane, int wave, int G, int rep2) {
    LAS float* wl = (LAS float*)lds;
    for (int i = tid; i < 1024 * 16; i += 512) { const int col = i >> 4, gc = i & 15; wl[(((((col >> 8) * 4 + (col & 3)) * 4 + (gc >> 2)) * 64 + ((col >> 2) & 63)) * 4) + (gc & 3)] = C.w_in[(size_t)col * INC + OFF_G + gc]; }
    LAS float* wl2 = wl + 1024 * 16;
    for (int i = tid; i < 1024 * 4; i += 512) { const int col = i >> 2, gg = i & 3; wl2[((((col >> 8) * 4 + (col & 3)) * 64 + ((col >> 2) & 63)) * 4) + gg] = ((const float*)(C.ws + WS_W64))[i]; }
    __syncthreads();
    const float* mod = (const float*)(C.ws + WS_MOD); bf16* H = (bf16*)(C.ws + WS_H); float* gates = (float*)(C.ws + WS_GATES); bf16* a64t = (bf16*)(C.ws + WS_A64T);
    const float gbias = C.b_gates[lane & 15];
    const int NGW = G * 8;
    for (int gw0 = blockIdx.x * 8 + wave; gw0 < 2048 * (1 + rep2); gw0 += NGW) { const int gw = gw0 & 2047;
        f32x4 gsc[4], sh[4];
        {   const int b = gw >> 6; const float* m = mod + (size_t)b * 6144;
#pragma unroll
            for (int j = 0; j < 4; ++j) { const int col = 4 * lane + 256 * j; const f32x4 g = *(const f32x4*)(C.g_norm1 + col), s = *(const f32x4*)(m + 1024 + col); gsc[j] = g * (s + 1.f); sh[j] = *(const f32x4*)(m + col); }
            for (int q = 0; q < 8; ++q) { const size_t row0 = (size_t)gw * 32 + q * 4; float p4; const float gv = rows4_norm_proj<false, true>(C.x, row0, gsc, sh, H, wl, wl2, p4, lane); gates[(row0 + (lane >> 4)) * 16 + (lane & 15)] = gate_xf(gv + gbias, lane);
                if ((lane & 3) == 0) { const int idx = lane >> 2; const size_t row = row0 + (idx >> 2); a64t[((row >> 11) * 4 + (idx & 3)) * 2048 + (row & 2047)] = (bf16)(pk2(p4, 0.f) & 0xffffu); } } }
        {   const float* m = mod + (size_t)32 * 6144;
#pragma unroll
            for (int j = 0; j < 4; ++j) { const int col = 4 * lane + 256 * j; const f32x4 g = *(const f32x4*)(C.g_norm1 + col), s = *(const f32x4*)(m + 1024 + col); gsc[j] = g * (s + 1.f); sh[j] = *(const f32x4*)(m + col); }
            const size_t row0 = (size_t)gw * 4; float p4; const float gv = rows4_norm_proj<false, false>(C.ctx, row0, gsc, sh, H + (size_t)NTOK * 1024, wl, wl2, p4, lane); gates[((size_t)NTOK + row0 + (lane >> 4)) * 16 + (lane & 15)] = gate_xf(gv + gbias, lane); }
    }
}

__device__ __forceinline__ f32x4 unpk4(u32x2 p) { return (f32x4){bflo(p.x), bfhi(p.x), bflo(p.y), bfhi(p.y)}; }
__device__ __forceinline__ void conv_load_x(const Ctx& C, int item, int lane, u32x2 (&raw)[3][10]) {
    const int sg = item & 7, cb = (item >> 3) & 3, r = (item >> 5) & 31, b = item >> 10;
    const bf16* ub = (const bf16*)(C.ws + WS_PQK) + (size_t)b * SEQ * 1024 + cb * 256; const int c0 = sg * 8; unsigned lo = 4u * (unsigned)lane;
    asm volatile("" : "+s"(ub), "+v"(lo));
#pragma unroll
    for (int dy = 0; dy < 3; ++dy) { const int rr = r + dy - 1; const bool rok = rr >= 0 && rr < 32;
#pragma unroll
        for (int i = 0; i < 10; ++i) { const int cc = c0 - 1 + i; const bool ok = rok && cc >= 0 && cc < 64; const int rc = min(max(rr, 0), 31), ccl = min(max(cc, 0), 63);
            const u32x2 t = *(const u32x2*)(ub + (size_t)(rc * 64 + ccl) * 1024 + lo); raw[dy][i] = ok ? t : (u32x2){0u, 0u}; } }
}
__device__ __forceinline__ f32x2 silu2_scaled(f32x2 a, float ik) { const f32x2 x = a * (f32x2){-1.4426950408889634f, -1.4426950408889634f}; const f32x2 e = {__builtin_amdgcn_exp2f(x.x), __builtin_amdgcn_exp2f(x.y)};
    const f32x2 d = __builtin_elementwise_fma(e, (f32x2){ik, ik}, (f32x2){ik, ik}); const f32x2 r = {__builtin_amdgcn_rcpf(d.x), __builtin_amdgcn_rcpf(d.y)}; return a * r; }
__device__ __forceinline__ void conv_compute_x(const Ctx& C, int item, int lane, const u32x2 (&raw)[3][10], const f32x4 (&w)[3][3]) {
    const int sg = item & 7, cb = (item >> 3) & 3, r = (item >> 5) & 31, b = item >> 10;
    const int cq = (cb & 1) * 256 + 4 * lane;
    bf16* dst = (bf16*)(C.ws + WS_QK) + ((size_t)(b * 4 + (cq >> 7)) * SEQ) * 256 + (cb >> 1) * 128 + (cq & 127); const int c0 = sg * 8;
    const float iksc = cb >= 2 ? 11.313708498984761f : 1.f;
#pragma unroll
    for (int i = 0; i < 8; ++i) { f32x4 a = {0.f, 0.f, 0.f, 0.f};
#pragma unroll
        for (int dy = 0; dy < 3; ++dy)
#pragma unroll
            for (int dx = 0; dx < 3; ++dx) a += w[dy][dx] * unpk4(raw[dy][i + dx]);
        const f32x2 s0 = silu2_scaled((f32x2){a[0], a[1]}, iksc), s1 = silu2_scaled((f32x2){a[2], a[3]}, iksc);
        u32x2 o; o.x = pk2(s0.x, s0.y); o.y = pk2(s1.x, s1.y);
        *(u32x2*)(dst + (size_t)(r * 64 + c0 + i) * 256) = o; }
}
__device__ __forceinline__ void conv_item_ctx(const Ctx& C, int item, int lane) {
    const int sg = item & 15, cb = (item >> 4) & 1, b = item >> 5;
    const int kc0 = cb * 256 + 4 * lane; const bf16* src = (const bf16*)(C.ws + WS_PC) + (size_t)b * CL * 1024 + kc0; bf16* dst = (bf16*)(C.ws + WS_KC) + (size_t)b * CL * 512 + kc0;
    const int c0 = sg * 16;
    u32x2 raw[18];
#pragma unroll
    for (int i = 0; i < 18; ++i) { const int cc = c0 - 1 + i; raw[i] = (cc >= 0 && cc < CL) ? *(const u32x2*)(src + (size_t)cc * 1024) : (u32x2){0u, 0u}; }
    f32x4 w[3];
#pragma unroll
    for (int dx = 0; dx < 3; ++dx) w[dx] = *(const f32x4*)(C.w_conv + (3 + dx) * 1024 + 512 + kc0);
    const float ksc = 0.08838834764831845f;
#pragma unroll
    for (int i = 0; i < 16; ++i) { const f32x4 a = w[0] * unpk4(raw[i]) + w[1] * unpk4(raw[i + 1]) + w[2] * unpk4(raw[i + 2]);
        u32x2 o; o.x = pk2(silu_f(a[0]) * ksc, silu_f(a[1]) * ksc); o.y = pk2(silu_f(a[2]) * ksc, silu_f(a[3]) * ksc);
        *(u32x2*)(dst + (size_t)(c0 + i) * 512) = o; }
}
__device__ __forceinline__ void f64_tile(const Ctx& C, int tile, int lane) {
    const int kt = tile >> 3, nt8 = tile & 7, i = lane & 15, g4 = lane >> 4;
    const bf16* ap = (const bf16*)(C.ws + WS_TT) + (size_t)(16 * kt + i) * 4096 + 8 * g4; const bf16* bp = (const bf16*)(C.ws + WS_A64T) + (size_t)(16 * nt8 + i) * 2048 + 8 * g4;
    f32x4 acc = {0.f, 0.f, 0.f, 0.f};
    for (int kb = 0; kb < 64; kb += 16) {
        bf16x8 fa[16], fb[16];
#pragma unroll
        for (int q = 0; q < 16; ++q) { fa[q] = *(const bf16x8*)(ap + 32 * (kb + q)); fb[q] = *(const bf16x8*)(bp + 32 * (kb + q)); }
        __builtin_amdgcn_sched_barrier(0);
#pragma unroll
        for (int q = 0; q < 16; ++q) acc = __builtin_amdgcn_mfma_f32_16x16x32_bf16(fa[q], fb[q], acc, 0, 0, 0);
        __builtin_amdgcn_sched_barrier(0); }
    const int n = 16 * nt8 + i; bf16* fo = (bf16*)(C.ws + WS_FU) + ((size_t)(n >> 2) * 2048 + 16 * kt + 4 * g4) * 512 + 256 + (n & 3) * 64;
#pragma unroll
    for (int r = 0; r < 4; ++r) fo[(size_t)r * 512] = (bf16)(pk2(acc[r], 0.f) & 0xffffu);
}
__device__ __forceinline__ void conv_load_row(const bf16* ub, unsigned lo, int rr, int c0, u32x2 (&row)[10]) {
    const bool rok = rr >= 0 && rr < 32; const int rc = min(max(rr, 0), 31);
#pragma unroll
    for (int i = 0; i < 10; ++i) { const int cc = c0 - 1 + i; const bool ok = rok && cc >= 0 && cc < 64; const int ccl = min(max(cc, 0), 63);
        const u32x2 t = *(const u32x2*)(ub + (size_t)(rc * 64 + ccl) * 1024 + lo); row[i] = ok ? t : (u32x2){0u, 0u}; }
}
__device__ __forceinline__ void conv_out_row(bf16* dst, const u32x2 (&ra)[10], const u32x2 (&rb)[10], const u32x2 (&rc)[10], const f32x4 (&w)[3][3], float iksc) {
#pragma unroll
    for (int i = 0; i < 8; ++i) { f32x4 a = {0.f, 0.f, 0.f, 0.f};
#pragma unroll
        for (int dx = 0; dx < 3; ++dx) { a += w[0][dx] * unpk4(ra[i + dx]); a += w[1][dx] * unpk4(rb[i + dx]); a += w[2][dx] * unpk4(rc[i + dx]); }
        const f32x2 s0 = silu2_scaled((f32x2){a[0], a[1]}, iksc), s1 = silu2_scaled((f32x2){a[2], a[3]}, iksc);
        u32x2 o; o.x = pk2(s0.x, s0.y); o.y = pk2(s1.x, s1.y);
        *(u32x2*)(dst + (size_t)i * 256) = o; }
}
__device__ __forceinline__ void conv_strip(const Ctx& C, int strip, int lane) {
    const int half = strip & 1, sg = (strip >> 1) & 7, cb = (strip >> 4) & 3, b = strip >> 6, rbase = 16 * half, c0 = sg * 8;
    f32x4 w[3][3];
#pragma unroll
    for (int dy = 0; dy < 3; ++dy)
#pragma unroll
        for (int dx = 0; dx < 3; ++dx) w[dy][dx] = *(const f32x4*)(C.w_conv + (dy * 3 + dx) * 1024 + cb * 256 + 4 * lane);
    const bf16* ub = (const bf16*)(C.ws + WS_PQK) + (size_t)b * SEQ * 1024 + cb * 256; unsigned lo = 4u * (unsigned)lane;
    asm volatile("" : "+s"(ub), "+v"(lo));
    const int cq = (cb & 1) * 256 + 4 * lane;
    bf16* dst = (bf16*)(C.ws + WS_QK) + ((size_t)(b * 4 + (cq >> 7)) * SEQ) * 256 + (cb >> 1) * 128 + (cq & 127) + (size_t)c0 * 256;
    const float iksc = cb >= 2 ? 11.313708498984761f : 1.f;
    u32x2 R0[10], R1[10], R2[10], R3[10];
    conv_load_row(ub, lo, rbase - 1, c0, R0); conv_load_row(ub, lo, rbase, c0, R1); conv_load_row(ub, lo, rbase + 1, c0, R2);
#pragma unroll 1
    for (int q = 0; q < 16; q += 4) { const int r = rbase + q; bf16* d = dst + (size_t)r * 64 * 256;
        conv_load_row(ub, lo, r + 2, c0, R3); conv_out_row(d, R0, R1, R2, w, iksc);
        conv_load_row(ub, lo, r + 3, c0, R0); conv_out_row(d + (size_t)64 * 256, R1, R2, R3, w, iksc);
        conv_load_row(ub, lo, r + 4, c0, R1); conv_out_row(d + (size_t)128 * 256, R2, R3, R0, w, iksc);
        conv_load_row(ub, lo, r + 5, c0, R2); conv_out_row(d + (size_t)192 * 256, R3, R0, R1, w, iksc); }
}
__device__ __forceinline__ void p2_conv(const Ctx& C, int lane, int wave, int G, int rep2) {
    const int NGW = G * 8;
    for (int it = wave * G + (int)blockIdx.x; it < 1024; it += NGW) f64_tile(C, it, lane);
    const int vblk = (int)blockIdx.x;
    for (int rep = 0; rep <= rep2; ++rep) {
        for (int st = vblk * 8 + wave; st < NB * 64; st += NGW) conv_strip(C, st, lane);
        for (int itc = ((wave + 4) & 7) * G + vblk; itc < NB * 32; itc += NGW) conv_item_ctx(C, itc, lane);
    }
}

__device__ __forceinline__ void p3b_combine(const Ctx& C, int tid, int G, int rep2) {
    const u32x2* po = (const u32x2*)(C.ws + WS_PO); const u32x4* hf = (const u32x4*)(C.ws + WS_HF); const u32x4* hb = (const u32x4*)(C.ws + WS_HB); u32x4* hm = (u32x4*)(C.ws + WS_HM);
    const size_t n = (size_t)NTOK * 512 / 8;
    for (size_t i0 = (size_t)blockIdx.x * 512 + tid; i0 < n * (1 + rep2); i0 += (size_t)G * 512) { const size_t i = i0 >= n ? i0 - n : i0; const u32x2 o = po[i]; const u32x4 a = hf[i], b = hb[i]; u32x4 r;
        r.x = pk2(u8f0(o.x) * (bflo(a.x) + bflo(b.x)), u8f1(o.x) * (bfhi(a.x) + bfhi(b.x))); r.y = pk2(u8f2(o.x) * (bflo(a.y) + bflo(b.y)), u8f3(o.x) * (bfhi(a.y) + bfhi(b.y)));
        r.z = pk2(u8f0(o.y) * (bflo(a.z) + bflo(b.z)), u8f1(o.y) * (bfhi(a.z) + bfhi(b.z))); r.w = pk2(u8f2(o.y) * (bflo(a.w) + bflo(b.w)), u8f3(o.y) * (bfhi(a.w) + bfhi(b.w)));
        hm[i] = r; }
}

__device__ __forceinline__ void p6_norm_router(const Ctx& C, LAS unsigned char* lds, int tid, int lane, int wave, int G, int rep2) {
    LAS float* wl = (LAS float*)lds;
    for (int i = tid; i < 1024 * 16; i += 512) { const int col = i >> 4, gc = i & 15; wl[(((((col >> 8) * 4 + (col & 3)) * 4 + (gc >> 2)) * 64 + ((col >> 2) & 63)) * 4) + (gc & 3)] = C.w_router[i]; }
    __syncthreads();
    const float* mod = (const float*)(C.ws + WS_MOD); bf16* HX2 = (bf16*)(C.ws + WS_HX2); float* aff = (float*)(C.ws + WS_AFF);
    const int NGW = G * 8;
    for (int gw0 = blockIdx.x * 8 + wave; gw0 < 2048 * (1 + rep2); gw0 += NGW) { const int gw = gw0 & 2047;
        f32x4 gsc[4], sh[4]; const int b = gw >> 6; const float* m = mod + (size_t)b * 6144;
#pragma unroll
        for (int j = 0; j < 4; ++j) { const int col = 4 * lane + 256 * j; const f32x4 g = *(const f32x4*)(C.g_norm2 + col), s = *(const f32x4*)(m + 4096 + col); gsc[j] = g * (s + 1.f); sh[j] = *(const f32x4*)(m + 3072 + col); }
        u32x2 rawc[4][4], rawn[4][4];
#pragma unroll
        for (int r = 0; r < 4; ++r)
#pragma unroll
            for (int j = 0; j < 4; ++j) rawc[r][j] = *(const u32x2*)((const bf16*)(C.ws + WS_X1) + ((size_t)gw * 32 + r) * 1024 + 4 * lane + 256 * j);
        for (int q = 0; q < 8; ++q) { const size_t row0 = (size_t)gw * 32 + q * 4;
            if (q < 7) {
#pragma unroll
                for (int r = 0; r < 4; ++r)
#pragma unroll
                    for (int j = 0; j < 4; ++j) rawn[r][j] = *(const u32x2*)((const bf16*)(C.ws + WS_X1) + (row0 + 4 + r) * 1024 + 4 * lane + 256 * j); }
            float p4; const float lg = rows4_norm_proj<true, false, true>((const float*)(C.ws + WS_X1), row0, gsc, sh, HX2, wl, wl, p4, lane, rawc);
#pragma unroll
            for (int r = 0; r < 4; ++r)
#pragma unroll
                for (int j = 0; j < 4; ++j) rawc[r][j] = rawn[r][j];
            float mx = lg;
#pragma unroll
            for (int o = 1; o < 16; o <<= 1) mx = fmaxf(mx, __shfl_xor(mx, o));
            const float ex = expf(lg - mx); float sm = ex;
#pragma unroll
            for (int o = 1; o < 16; o <<= 1) sm += __shfl_xor(sm, o);
            const size_t t = (row0 + (lane >> 4)) & (SEQ - 1);
            aff[((size_t)b * NE + (lane & 15)) * SEQ + t] = ex / sm; }
    }
}

__device__ __forceinline__ unsigned wave_excl_scan_u(unsigned v, int lane) { unsigned s = v; (void)lane;
#define TK_DPP(ctrl, rmask) s += (unsigned)__builtin_amdgcn_update_dpp(0, (int)s, ctrl, rmask, 0xf, false);
    TK_DPP(0x111, 0xf) TK_DPP(0x112, 0xf) TK_DPP(0x114, 0xf) TK_DPP(0x118, 0xf) TK_DPP(0x142, 0xa) TK_DPP(0x143, 0xc)
#undef TK_DPP
    return s - v;
}
__device__ __forceinline__ void topk_item(const Ctx& C, int item, int lane) {
    const int b = item >> 4, e = item & 15; const float* a = (const float*)(C.ws + WS_AFF) + ((size_t)b * NE + e) * SEQ + 32 * lane;
    unsigned key[32];
#pragma unroll
    for (int q = 0; q < 8; ++q) { const u32x4 v = *(const u32x4*)(a + 4 * q); key[4 * q] = v.x; key[4 * q + 1] = v.y; key[4 * q + 2] = v.z; key[4 * q + 3] = v.w; }
    unsigned T = 0u;
    for (int bit = 30; bit >= 0; --bit) { const unsigned cand = T | (1u << bit); unsigned cnt = 0u;
#pragma unroll
        for (int i = 0; i < 32; ++i) cnt += (unsigned)__builtin_popcountll(__ballot(key[i] >= cand));
        if (cnt >= (unsigned)CAP) T = cand; }
    unsigned ngt = 0u, neq = 0u;
#pragma unroll
    for (int i = 0; i < 32; ++i) { ngt += (unsigned)__builtin_popcountll(__ballot(key[i] > T)); neq += key[i] == T ? 1u : 0u; }
    const unsigned need = (unsigned)CAP - ngt;
    unsigned tie_before = wave_excl_scan_u(neq, lane);
    unsigned nsel = 0u; unsigned selmask = 0u;
#pragma unroll
    for (int i = 0; i < 32; ++i) { bool s = key[i] > T; if (key[i] == T) { s = tie_before < need; ++tie_before; } if (s) { selmask |= 1u << i; ++nsel; } }
    unsigned slot = wave_excl_scan_u(nsel, lane);
    const int pm = e * 32 + b; int* idx = (int*)(C.ws + WS_IDX) + (size_t)pm * CAP; float* val = (float*)(C.ws + WS_VAL) + (size_t)pm * CAP; bf16* sl = (bf16*)(C.ws + WS_SLOT); float* vt = (float*)(C.ws + WS_VALT);
    unsigned sw[16];
#pragma unroll
    for (int i = 0; i < 32; ++i) { const int t = 32 * lane + i; const bool s = (selmask >> i) & 1u;
        if (s) { idx[slot] = b * SEQ + t; val[slot] = __uint_as_float(key[i]); }
        const unsigned h = s ? (slot & 0xffffu) : 0xffffu; if (i & 1) sw[i >> 1] |= h << 16; else sw[i >> 1] = h;
        if (VAL_IN_FINAL) vt[((size_t)b * SEQ + t) * NE + e] = s ? __uint_as_float(key[i]) : 0.f; if (s) ++slot; }
    u32x4* so = (u32x4*)(sl + ((size_t)(b * NE + e) * SEQ + 32 * lane));
#pragma unroll
    for (int q = 0; q < 4; ++q) so[q] = (u32x4){sw[4 * q], sw[4 * q + 1], sw[4 * q + 2], sw[4 * q + 3]};
}

__device__ __forceinline__ f32x4 fp8x4_to_f32(unsigned w) { const f32x2 lo = __builtin_amdgcn_cvt_pk_f32_fp8(w, false), hi = __builtin_amdgcn_cvt_pk_f32_fp8(w, true); return (f32x4){lo[0], lo[1], hi[0], hi[1]}; }
__device__ __forceinline__ void p10_final(const Ctx& C, int lane, int wave, int G) {
    const float* mod = (const float*)(C.ws + WS_MOD); const unsigned char* Y = C.ws + WS_Y; const bf16* sl = (const bf16*)(C.ws + WS_SLOT);
    const int NGW = G * 8;
    for (int gw = blockIdx.x * 8 + wave; gw < 2048; gw += NGW) { const int b = gw >> 6; const float* m = mod + (size_t)b * 6144 + 5120;
        f32x4 ga[4], gf[4];
#pragma unroll
        for (int j = 0; j < 4; ++j) { ga[j] = *(const f32x4*)(m + 4 * lane + 256 * j) * Y8_INV; gf[j] = *(const f32x4*)(C.g_final + 4 * lane + 256 * j); }
        u32x2 xr[4][4]; unsigned t[4][2][4]; bool tv[4][2]; unsigned em[4];
        const u32x4 SW = *(const u32x4*)(sl + ((size_t)(b * NE + (lane & 15)) * SEQ + (gw & 63) * 32 + 8 * (lane >> 4)));
#define FIN_W(q_, r) (((q_) & 1) ? ((r) >> 1 ? SW.w : SW.z) : ((r) >> 1 ? SW.y : SW.x))
#define FIN_SLOT(q_, r, e_) ((__builtin_amdgcn_readlane(FIN_W(q_, r), (e_) + 16 * ((q_) >> 1)) >> (16 * ((r) & 1))) & 0xffffu)
#define FIN_ROUND(q_) do { _Pragma("unroll") for (int r = 0; r < 4; ++r) _Pragma("unroll") for (int c = 0; c < 2; ++c) { tv[r][c] = em[r] != 0u; \
            if (tv[r][c]) { const int e = __builtin_ctz(em[r]); em[r] &= em[r] - 1u; const unsigned sv = FIN_SLOT(q_, r, e); \
                const unsigned char* yr = Y + ((size_t)(e * 32 + b) * CAP + sv) * 1024 + 4 * lane; _Pragma("unroll") for (int j = 0; j < 4; ++j) t[r][c][j] = *(const unsigned*)(yr + 256 * j); } } } while (0)
#define FIN_ISSUE(q_) do { const size_t _r0 = (size_t)gw * 32 + (q_) * 4; \
            _Pragma("unroll") for (int r = 0; r < 4; ++r) _Pragma("unroll") for (int j = 0; j < 4; ++j) xr[r][j] = *(const u32x2*)((const bf16*)(C.ws + WS_X1) + (_r0 + r) * 1024 + 4 * lane + 256 * j); \
            _Pragma("unroll") for (int r = 0; r < 4; ++r) { const unsigned long long _bal = __ballot(((FIN_W(q_, r) >> (16 * (r & 1))) & 0xffffu) != 0xffffu); em[r] = (unsigned)((_bal >> (16 * ((q_) >> 1))) & 0xffffu); } \
            FIN_ROUND(q_); } while (0)
#define FIN_ACC() do { _Pragma("unroll") for (int r = 0; r < 4; ++r) _Pragma("unroll") for (int c = 0; c < 2; ++c) if (tv[r][c]) { _Pragma("unroll") for (int j = 0; j < 4; ++j) a[r][j] += fp8x4_to_f32(t[r][c][j]); } } while (0)
        FIN_ISSUE(0);
        for (int q = 0; q < 8; ++q) { const size_t row0 = (size_t)gw * 32 + q * 4; f32x4 v[4][4], a[4][4];
#pragma unroll
            for (int r = 0; r < 4; ++r)
#pragma unroll
                for (int j = 0; j < 4; ++j) { const u32x2 pw = xr[r][j]; v[r][j] = (f32x4){bflo(pw.x), bfhi(pw.x), bflo(pw.y), bfhi(pw.y)}; a[r][j] = (f32x4){0.f, 0.f, 0.f, 0.f}; }
            FIN_ACC();
            while (em[0] | em[1] | em[2] | em[3]) { FIN_ROUND(q); FIN_ACC(); }
            if (q < 7) FIN_ISSUE(q + 1);
#pragma unroll
            for (int r = 0; r < 4; ++r) { float ss = 0.f;
#pragma unroll
                for (int j = 0; j < 4; ++j) { v[r][j] = v[r][j] + ga[j] * a[r][j]; ss += v[r][j][0] * v[r][j][0] + v[r][j][1] * v[r][j][1] + v[r][j][2] * v[r][j][2] + v[r][j][3] * v[r][j][3]; }
                const float rstd = rsqrtf(wave_sum(ss) * (1.f / 1024.f) + EPS);
#pragma unroll
                for (int j = 0; j < 4; ++j) *(f32x4*)(C.out + (row0 + r) * 1024 + 4 * lane + 256 * j) = v[r][j] * rstd * gf[j]; } }
#undef FIN_ROUND
#undef FIN_W
#undef FIN_SLOT
#undef FIN_ISSUE
#undef FIN_ACC
    }
}
#ifndef ML_CVT_ON
#define ML_CVT_ON 0
#endif
namespace ml {
typedef short v4i16_t __attribute__((ext_vector_type(4)));
constexpr int TB = 49152, QO = 0, KO = 16384, VO = 32768;
constexpr int CT = 98304;
constexpr int SS = 135168;
constexpr int SM = 143360;
constexpr int GA = 384, U_ = 0, M_ = 64, DEC_ = 128, EM_ = 192, WA_ = 256, SC_ = 320;
constexpr int GST = SM + 2 * GA * 4;
static_assert(GST + 2 * 512 <= LDS_PHASE_BYTES, "mLSTM LDS map");
__device__ __forceinline__ unsigned off_b(unsigned row, unsigned ch) { return 256u * row + 16u * (ch ^ (((row & 3) << 2) | ((row >> 2) & 3))); }
__device__ __forceinline__ unsigned off_s(unsigned row, unsigned ch) { return 128u * row + 16u * (ch ^ (row & 7)); }
__device__ __forceinline__ bf16x8 rowfrag(const LAS unsigned char* tile, int rb, int ks, int lane) { return *(const LAS bf16x8*)(tile + off_b(16 * rb + (lane & 15), 4 * ks + (lane >> 4))); }
__device__ __forceinline__ bf16x8 trfrag(const LAS unsigned char* tile, int c, int ks, int lane) {
    const unsigned g = lane >> 4, q = (lane & 15) >> 2, p = lane & 3;
    const unsigned a0 = off_b(32 * ks + 8 * g + q, 2 * c + (p >> 1)) + 8 * (p & 1), a1 = off_b(32 * ks + 8 * g + 4 + q, 2 * c + (p >> 1)) + 8 * (p & 1);
    const v4i16_t lo = __builtin_amdgcn_ds_read_tr16_b64_v4i16((LAS v4i16_t*)(tile + a0)), hi = __builtin_amdgcn_ds_read_tr16_b64_v4i16((LAS v4i16_t*)(tile + a1));
    bf16x8 r; r[0] = lo[0]; r[1] = lo[1]; r[2] = lo[2]; r[3] = lo[3]; r[4] = hi[0]; r[5] = hi[1]; r[6] = hi[2]; r[7] = hi[3]; return r;
}
template <int KS> __device__ __forceinline__ bf16x8 trfrag_a(unsigned tile, int c, int lane) {
    const unsigned g = lane >> 4, q = (lane & 15) >> 2, p = lane & 3;
    const unsigned a0 = tile + off_b(8 * g + q, 2 * c + (p >> 1)) + 8 * (p & 1), a1 = tile + off_b(8 * g + 4 + q, 2 * c + (p >> 1)) + 8 * (p & 1);
    u32x2 lo, hi;
    asm volatile("ds_read_b64_tr_b16 %0, %1 offset:%2" : "=v"(lo) : "v"(a0), "n"(KS * 8192) : "memory");
    asm volatile("ds_read_b64_tr_b16 %0, %1 offset:%2" : "=v"(hi) : "v"(a1), "n"(KS * 8192) : "memory");
    const u32x4 r = {lo.x, lo.y, hi.x, hi.y}; return __builtin_bit_cast(bf16x8, r);
}
__device__ __forceinline__ void dma_b128(const void* g, unsigned ldsaddr) { asm volatile("s_mov_b32 m0, %1\n\ts_nop 0\n\tglobal_load_lds_dwordx4 %0, off" :: "v"(g), "s"(ldsaddr) : "memory", "m0"); }
__device__ __forceinline__ void dma_b32(const void* g, unsigned ldsaddr) { asm volatile("s_mov_b32 m0, %1\n\ts_nop 0\n\tglobal_load_lds_dword %0, off" :: "v"(g), "s"(ldsaddr) : "memory", "m0"); }
template <int OFF> __device__ __forceinline__ void st_b64(void* p, u32x2 v) { asm volatile("global_store_dwordx2 %0, %1, off offset:%2" :: "v"(p), "v"(v), "n"(OFF) : "memory"); }
__device__ __forceinline__ void st_b128(void* p, u32x4 v) { asm volatile("global_store_dwordx4 %0, %1, off" :: "v"(p), "v"(v) : "memory"); }
__device__ __forceinline__ unsigned rf_lane(int ks, int lane) { const unsigned i = lane & 15, g4 = lane >> 4; return 256u * i + 16u * ((4u * ks + g4) ^ (((i & 3) << 2) | ((i >> 2) & 3))); }
template <int OFF> __device__ __forceinline__ bf16x8 ldsr128(unsigned a) { u32x4 r; asm volatile("ds_read_b128 %0, %1 offset:%2" : "=v"(r) : "v"(a), "n"(OFF) : "memory"); return __builtin_bit_cast(bf16x8, r); }
#define ML_LGKM0_5(a, b, c, d, e) asm volatile("s_waitcnt lgkmcnt(0)" : "+v"(a), "+v"(b), "+v"(c), "+v"(d), "+v"(e) :: "memory")
#define ML_LGKM0_4(a, b, c, d) asm volatile("s_waitcnt lgkmcnt(0)" : "+v"(a), "+v"(b), "+v"(c), "+v"(d) :: "memory")
#define ML_LGKM0_8(a, b, c, d, e, f, g_, h) asm volatile("s_waitcnt lgkmcnt(0)" : "+v"(a), "+v"(b), "+v"(c), "+v"(d), "+v"(e), "+v"(f), "+v"(g_), "+v"(h) :: "memory")
#define ML_LGKM0_2(a, b) asm volatile("s_waitcnt lgkmcnt(0)" : "+v"(a), "+v"(b) :: "memory")
template <bool MAX> __device__ __forceinline__ float wave_scan(float v) {
    const int id = MAX ? (int)0xff800000u : 0;
#define ML_DPP(ctrl, rmask) { const float t = __int_as_float(__builtin_amdgcn_update_dpp(id, __float_as_int(v), ctrl, rmask, 0xf, false)); v = MAX ? fmaxf(v, t) : v + t; }
    ML_DPP(0x111, 0xf) ML_DPP(0x112, 0xf) ML_DPP(0x114, 0xf) ML_DPP(0x118, 0xf) ML_DPP(0x142, 0xa) ML_DPP(0x143, 0xc)
#undef ML_DPP
    return v;
}
__device__ __forceinline__ void gate_math(float ig, float fg, int pos, float& m0, LAS float* ga) {
    const float fl = fg;
    const float cum = wave_scan<false>(fl);
    const float u = ig - cum;
    const float pmx = wave_scan<true>(u);
    const float tot = __int_as_float(__builtin_amdgcn_readlane(__float_as_int(cum), 63)), umax = __int_as_float(__builtin_amdgcn_readlane(__float_as_int(pmx), 63));
    const float M = fmaxf(m0, pmx);
    const float mn = fmaxf(tot + m0, tot + umax);
    ga[U_ + pos] = u; ga[M_ + pos] = M; ga[DEC_ + pos] = __expf(m0 - M); ga[EM_ + pos] = __expf(-(cum + M)); ga[WA_ + pos] = __expf(tot + u - mn);
    if (pos == 0) ga[SC_] = __expf(tot + m0 - mn);
    m0 = mn;
}

#define ML_VM0() do { asm volatile("" ::: "memory"); __builtin_amdgcn_s_waitcnt(0x0f70); asm volatile("" ::: "memory"); } while (0)
#define ML_BAR() do { asm volatile("s_waitcnt lgkmcnt(0)" ::: "memory"); __builtin_amdgcn_s_barrier(); asm volatile("" ::: "memory"); } while (0)
__device__ __forceinline__ void mlstm_phase(const Ctx& C, LAS unsigned char* lds, int tid, int lane, int wave, int G, int rep2) {
    LAS float* sm = (LAS float*)(lds + SM); const unsigned ldsu = __builtin_amdgcn_readfirstlane((unsigned)(size_t)lds);
    const bf16* QK = (const bf16*)(C.ws + WS_QK); const bf16* KC = (const bf16*)(C.ws + WS_KC); const bf16* PV = (const bf16*)(C.ws + WS_PV); const bf16* PC = (const bf16*)(C.ws + WS_PC);
    const float* gates = (const float*)(C.ws + WS_GATES);
    const int g = lane >> 4, li = lane & 15;
    bf16x8 onesf;
#pragma unroll
    for (int e = 0; e < 8; ++e) onesf[e] = li == 0 ? (short)0x3f80 : (short)0;
    const float* cvt_wg = C.w_gate_e; const float* cvt_wu = C.w_up_e; const float* cvt_wd = C.w_down_e; asm volatile("" : "+s"(cvt_wg), "+s"(cvt_wu), "+s"(cvt_wd));
    const int cvt_gw = blockIdx.x * 8 + wave, cvt_ngw = G * 8, cvt_np = ML_CVT_ON ? (cvt_gw < 6144 ? 8 * ((6144 - cvt_gw + cvt_ngw - 1) / cvt_ngw) : 0) : 0; int cvt_tp = 0;
    float cw[16];
    for (int item0 = blockIdx.x; item0 < 256 * (1 + rep2); item0 += G) { const int item = item0 & 255;
        const int dir = item & 1, h = (item >> 1) & 3, b = item >> 3;
        bf16* Hout = (bf16*)(C.ws + (dir ? WS_HB : WS_HF));
        const int kI = dir ? 2 : 0, kF = dir ? 3 : 1; const float bI = C.b_gates[kI * 4 + h], bF = C.b_gates[kF * 4 + h];
        const int pos = dir ? 63 - lane : lane;
#define ML_CC(s_) ((s_) >= 4 ? (dir ? 35 - (s_) : (s_) - 4) : (dir ? 3 - (s_) : (s_)))
#define ML_GDMA(s_) do { const int _s = (s_); const size_t _tok = _s >= 4 ? (size_t)b * SEQ + ML_CC(_s) * 64 + pos : (size_t)NTOK + (size_t)b * CL + ML_CC(_s) * 64 + pos; \
            dma_b32(gates + _tok * 16 + kI * 4 + h, ldsu + GST + (_s & 1) * 512); dma_b32(gates + _tok * 16 + kF * 4 + h, ldsu + GST + (_s & 1) * 512 + 256); } while (0)
#define ML_GATE(s_, ga_) do { const LAS float* _g = (const LAS float*)(lds + GST + ((s_) & 1) * 512); gate_math(_g[lane], _g[64 + lane], pos, m0, ga_); } while (0)
#define ML_DMA(s_, bf_) do { const int _s = (s_); const bool _x = _s >= 4; const int _cc = ML_CC(_s); \
            _Pragma("unroll") for (int _k = 0; _k < 6; ++_k) { const int _T = _k >> 1, _sub = wave + 8 * (_k & 1); if (!_x && _T == 0) continue; \
                const int _row = 4 * _sub + (lane >> 4), _ch = (lane & 15) ^ (((_row & 3) << 2) | ((_row >> 2) & 3)); const bf16* _src; \
                if (_x) { const size_t _tok = (size_t)(b * 4 + h) * SEQ + _cc * 64 + _row; _src = _T == 2 ? PV + _tok * 128 + _ch * 8 : QK + _tok * 256 + (_T ? 128 : 0) + _ch * 8; } \
                else { const size_t _tok = (size_t)b * CL + _cc * 64 + _row; _src = _T == 2 ? PC + _tok * 1024 + 512 + h * 128 + _ch * 8 : KC + _tok * 512 + h * 128 + _ch * 8; } \
                dma_b128(_src, ldsu + (bf_) * TB + _T * 16384 + _sub * 1024); } } while (0)
#define ML_CVT_ADDR(tp_, src_, dst_) do { const int _u = cvt_gw + cvt_ngw * ((tp_) >> 3), _ks = _u & 7, _nb = (_u >> 3) & 15, _mat = _u >> 7, _e = _mat & 15, _wh = _mat >> 4; \
            const int _k0 = 128 * _ks + 16 * ((tp_) & 7), _n = 64 * _nb + lane; \
            const float* _b = cvt_wg; if (_wh == 1) _b = cvt_wu; if (_wh == 2) _b = cvt_wd; \
            src_ = _b + (size_t)_e * 1048576 + (size_t)_k0 * 1024 + _n; \
            const size_t _row = _wh < 2 ? (size_t)(_e * 2048 + (_n >> 7) * 256 + _wh * 128 + (_n & 127)) : (size_t)(WS_WD - WS_WGU) / 1024 + (size_t)(_e * 1024 + _n); \
            dst_ = C.ws + WS_WGU + _row * 1024 + _k0; } while (0)
#define ML_CVT_LOAD(src_) do { const __attribute__((address_space(1))) float* _g = (const __attribute__((address_space(1))) float*)(src_);     \
            _Pragma("unroll") for (int _r = 0; _r < 16; ++_r) cw[_r] = _g[(size_t)_r * 1024]; } while (0)
#define ML_CVT_PACK(_o) do { _o.x = pk4_fp8(cw[0] * W8_SCALE, cw[1] * W8_SCALE, cw[2] * W8_SCALE, cw[3] * W8_SCALE); _o.y = pk4_fp8(cw[4] * W8_SCALE, cw[5] * W8_SCALE, cw[6] * W8_SCALE, cw[7] * W8_SCALE); \
            _o.z = pk4_fp8(cw[8] * W8_SCALE, cw[9] * W8_SCALE, cw[10] * W8_SCALE, cw[11] * W8_SCALE); _o.w = pk4_fp8(cw[12] * W8_SCALE, cw[13] * W8_SCALE, cw[14] * W8_SCALE, cw[15] * W8_SCALE); } while (0)
#define ML_CVT_STEP() do { if (cvt_np > 0) { u32x4 _o; ML_CVT_PACK(_o); const bool _st = cvt_tp < cvt_np; const float* _s; unsigned char* _d; ML_CVT_ADDR(_st ? cvt_tp : 0, _s, _d); (void)_s; \
            asm volatile("" : "+v"(_o) :: "memory");        \
            if (ML_CVT_ON == 2) _d = C.ws + 840 * MiB + ((size_t)(cvt_gw * 24 + (cvt_tp % 24)) * 64 + lane) * 16;        \
            ++cvt_tp; ML_CVT_ISSUE(cvt_tp); if (_st) st_b128(_d, _o); } } while (0)
#define ML_CVT_ISSUE(tp_) do { const int _t = (tp_) < cvt_np ? (tp_) : cvt_np - 1; const float* _s; unsigned char* _d; ML_CVT_ADDR(_t, _s, _d); (void)_d; ML_CVT_LOAD(_s); } while (0)
        for (int i = tid; i < 36864 / 16; i += 512) *(LAS u32x4*)(lds + CT + i * 16) = (u32x4){0u, 0u, 0u, 0u};
        f32x4 Cown[4], Coth[4], Cext;
#pragma unroll
        for (int t = 0; t < 4; ++t) { Cown[t] = (f32x4){0.f, 0.f, 0.f, 0.f}; Coth[t] = (f32x4){0.f, 0.f, 0.f, 0.f}; }
        Cext = (f32x4){0.f, 0.f, 0.f, 0.f};
        float m0 = 0.f;
        ML_DMA(0, 0); ML_DMA(1, 1);
        if (wave == 0) { ML_GDMA(0); ML_GDMA(1); ML_VM0(); ML_GATE(0, sm); asm volatile("s_waitcnt lgkmcnt(0)" ::: "memory"); ML_GDMA(2); }
        ML_VM0();
        __syncthreads();
        const int jt = wave >> 1, half = wave & 1, j = 16 * jt + li;
        if (cvt_np > 0) ML_CVT_ISSUE(cvt_tp);
        for (int step = 0; step < 36; ++step) {
            const int p = step & 1; const bool isx = step >= 4; const int cc = ML_CC(step);
            const LAS unsigned char* Qt = lds + p * TB + QO; const LAS unsigned char* Kt = lds + p * TB + KO; const LAS unsigned char* Vt = lds + p * TB + VO;
            const LAS float* ga = sm + p * GA;
            if (wave == 0) { if (step + 1 < 36) ML_GATE(step + 1, sm + (p ^ 1) * GA); }
            else if (isx && wave <= 6) {
                const int jtf = wave <= 2 ? 3 : (wave <= 4 ? 2 : (wave == 5 ? 1 : 0)), s0f = (wave == 2 || wave == 4) ? 2 : 0;
                const int jts = dir ? 3 - jtf : jtf, js = 16 * jts + li;
                bf16x8 qf[4], kfr[2][4];
                {   const unsigned qb = (unsigned)(size_t)Qt + 4096u * jts, kb0 = (unsigned)(size_t)Kt + 4096u * (dir ? 3 - s0f : s0f), kb1 = (unsigned)(size_t)Kt + 4096u * (dir ? 3 - (s0f + 1) : s0f + 1);
#pragma unroll
                    for (int ks = 0; ks < 4; ++ks) { const unsigned l_ = rf_lane(ks, lane); qf[ks] = ldsr128<0>(qb + l_); kfr[0][ks] = ldsr128<0>(kb0 + l_); kfr[1][ks] = ldsr128<0>(kb1 + l_); }
                    ML_LGKM0_4(qf[0], qf[1], qf[2], qf[3]); ML_LGKM0_8(kfr[0][0], kfr[0][1], kfr[0][2], kfr[0][3], kfr[1][0], kfr[1][1], kfr[1][2], kfr[1][3]); }
                const float Mj = ga[M_ + js];
#pragma unroll
                for (int t = 0; t < 2; ++t) { const int stf = s0f + t, st = dir ? 3 - stf : stf; u32x2 w = {0u, 0u};
                    if (stf <= jtf) { f32x4 sa = {0.f, 0.f, 0.f, 0.f};
#pragma unroll
                        for (int ks = 0; ks < 4; ++ks) sa = __builtin_amdgcn_mfma_f32_16x16x32_bf16(kfr[t][ks], qf[ks], sa, 0, 0, 0);
                        const int s0 = 16 * st + 4 * g; const f32x4 u4 = *(const LAS f32x4*)(ga + U_ + s0); float sp[4];
#pragma unroll
                        for (int r = 0; r < 4; ++r) { const int s = s0 + r; const bool keep = dir ? (s >= js) : (s <= js); sp[r] = keep ? sa[r] * __expf(fminf(u4[r] - Mj, 0.f)) : 0.f; }
                        w.x = pk2(sp[0], sp[1]); w.y = pk2(sp[2], sp[3]); }
                    *(LAS u32x2*)(lds + SS + off_s(js, 2 * st + (g >> 1)) + (g & 1) * 8) = w; }
            }
            const unsigned Vu = (unsigned)(size_t)Vt, Ku = (unsigned)(size_t)Kt;
            bf16x8 vf[4][2], kr_[2]; u32x2 ow[4] = {}; bf16* optr = nullptr;
            if (isx) {
                ML_BAR();
                const float dj = ga[DEC_ + j];
                f32x4 oa[4], oe = {0.f, 0.f, 0.f, 0.f};
#pragma unroll
                for (int t = 0; t < 4; ++t) oa[t] = (f32x4){0.f, 0.f, 0.f, 0.f};
                {
                    const unsigned qb = (unsigned)(size_t)Qt + 4096u * jt, cb = ldsu + CT + 16384u * half, nb = ldsu + CT + 32768u;
                    bf16x8 qf[4], cA[5], cB[5];
#define ML_LOADC(dst, ks_) do { const unsigned _l = rf_lane(ks_, lane); dst[0] = ldsr128<0>(cb + _l); dst[1] = ldsr128<4096>(cb + _l); dst[2] = ldsr128<8192>(cb + _l); dst[3] = ldsr128<12288>(cb + _l); dst[4] = ldsr128<0>(nb + _l); } while (0)
#define ML_MMAC(src, q_) do { _Pragma("unroll") for (int t = 0; t < 4; ++t) oa[t] = __builtin_amdgcn_mfma_f32_16x16x32_bf16(src[t], q_, oa[t], 0, 0, 0); oe = __builtin_amdgcn_mfma_f32_16x16x32_bf16(src[4], q_, oe, 0, 0, 0); } while (0)
#pragma unroll
                    for (int ks = 0; ks < 4; ++ks) qf[ks] = ldsr128<0>(qb + rf_lane(ks, lane));
                    ML_LOADC(cA, 0);
                    ML_LGKM0_4(qf[0], qf[1], qf[2], qf[3]); ML_LGKM0_5(cA[0], cA[1], cA[2], cA[3], cA[4]);
                    ML_LOADC(cB, 1); ML_MMAC(cA, qf[0]);
                    ML_LGKM0_5(cB[0], cB[1], cB[2], cB[3], cB[4]); ML_LOADC(cA, 2); ML_MMAC(cB, qf[1]);
                    ML_LGKM0_5(cA[0], cA[1], cA[2], cA[3], cA[4]); ML_LOADC(cB, 3); ML_MMAC(cA, qf[2]);
                    ML_LGKM0_5(cB[0], cB[1], cB[2], cB[3], cB[4]); ML_MMAC(cB, qf[3]);
#undef ML_LOADC
#undef ML_MMAC
                }
#pragma unroll
                for (int t = 0; t < 4; ++t) oa[t] = oa[t] * dj;
                oe = oe * dj;
#pragma unroll
                for (int t = 0; t < 4; ++t) { vf[t][0] = trfrag_a<0>(Vu, 4 * half + t, lane); vf[t][1] = trfrag_a<1>(Vu, 4 * half + t, lane); }
                ML_LGKM0_8(vf[0][0], vf[1][0], vf[2][0], vf[3][0], vf[0][1], vf[1][1], vf[2][1], vf[3][1]);
#pragma unroll
                for (int ks = 0; ks < 2; ++ks) {
                    if (dir ? (2 * ks + 1 >= jt) : (2 * ks <= jt)) { const bf16x8 sf = *(const LAS bf16x8*)(lds + SS + off_s(j, 4 * ks + g));
#pragma unroll
                        for (int t = 0; t < 4; ++t) oa[t] = __builtin_amdgcn_mfma_f32_16x16x32_bf16(vf[t][ks], sf, oa[t], 0, 0, 0);
                        oe = __builtin_amdgcn_mfma_f32_16x16x32_bf16(onesf, sf, oe, 0, 0, 0); } }
                kr_[0] = trfrag_a<0>(Ku, wave, lane); kr_[1] = trfrag_a<1>(Ku, wave, lane);
                const float den = __shfl(oe[0], li);
                const float inv = __builtin_amdgcn_rcpf(fmaxf(fabsf(den), ga[EM_ + j]));
                const size_t tok = (size_t)b * SEQ + cc * 64 + j;
                ML_VM0();
#pragma unroll
                for (int t = 0; t < 4; ++t) { const f32x4 o = oa[t] * inv; ow[t].x = pk2(o[0], o[1]); ow[t].y = pk2(o[2], o[3]); }
                optr = Hout + tok * 512 + h * 128 + 64 * half + 4 * g;
            } else {
#pragma unroll
                for (int t = 0; t < 4; ++t) { vf[t][0] = trfrag_a<0>(Vu, 4 * half + t, lane); vf[t][1] = trfrag_a<1>(Vu, 4 * half + t, lane); }
                kr_[0] = trfrag_a<0>(Ku, wave, lane); kr_[1] = trfrag_a<1>(Ku, wave, lane);
                ML_LGKM0_8(vf[0][0], vf[1][0], vf[2][0], vf[3][0], vf[0][1], vf[1][1], vf[2][1], vf[3][1]);
                ML_VM0();
            }
            ML_CVT_STEP();
            if (isx) { st_b64<0>(optr, ow[0]); st_b64<32>(optr, ow[1]); st_b64<64>(optr, ow[2]); st_b64<96>(optr, ow[3]); }
            {   const float dn = ga[SC_];
                ML_LGKM0_2(kr_[0], kr_[1]);
                bf16x8 kf[2];
#pragma unroll
                for (int ks = 0; ks < 2; ++ks) { const bf16x8 kr = kr_[ks]; const f32x4 w0 = *(const LAS f32x4*)(ga + WA_ + 32 * ks + 8 * g), w1 = *(const LAS f32x4*)(ga + WA_ + 32 * ks + 8 * g + 4);
                    u32x4 pkd; pkd.x = pk2(bf1((bf16)kr[0]) * w0[0], bf1((bf16)kr[1]) * w0[1]); pkd.y = pk2(bf1((bf16)kr[2]) * w0[2], bf1((bf16)kr[3]) * w0[3]);
                    pkd.z = pk2(bf1((bf16)kr[4]) * w1[0], bf1((bf16)kr[5]) * w1[1]); pkd.w = pk2(bf1((bf16)kr[6]) * w1[2], bf1((bf16)kr[7]) * w1[3]);
                    kf[ks] = __builtin_bit_cast(bf16x8, pkd); }
#pragma unroll
                for (int t = 0; t < 4; ++t) { f32x4 c = Cown[t] * dn;
#pragma unroll
                    for (int ks = 0; ks < 2; ++ks) c = __builtin_amdgcn_mfma_f32_16x16x32_bf16(kf[ks], vf[t][ks], c, 0, 0, 0);
                    Cown[t] = c; }
                bf16x8 vo[4][2];
#pragma unroll
                for (int t = 0; t < 4; ++t) { vo[t][0] = trfrag_a<0>(Vu, 4 * (half ^ 1) + t, lane); vo[t][1] = trfrag_a<1>(Vu, 4 * (half ^ 1) + t, lane); }
                ML_LGKM0_8(vo[0][0], vo[1][0], vo[2][0], vo[3][0], vo[0][1], vo[1][1], vo[2][1], vo[3][1]);
#pragma unroll
                for (int t = 0; t < 4; ++t) { f32x4 c = Coth[t] * dn;
#pragma unroll
                    for (int ks = 0; ks < 2; ++ks) c = __builtin_amdgcn_mfma_f32_16x16x32_bf16(kf[ks], vo[t][ks], c, 0, 0, 0);
                    Coth[t] = c; }
                {   f32x4 c = Cext * dn;
#pragma unroll
                    for (int ks = 0; ks < 2; ++ks) c = __builtin_amdgcn_mfma_f32_16x16x32_bf16(kf[ks], onesf, c, 0, 0, 0);
                    Cext = c; }
            }
            ML_BAR();
#pragma unroll
            for (int t = 0; t < 4; ++t) { { const f32x4 c = Cown[t]; u32x2 w; w.x = pk2(c[0], c[1]); w.y = pk2(c[2], c[3]); *(LAS u32x2*)(lds + CT + off_b(16 * (4 * half + t) + li, 2 * wave + (g >> 1)) + (g & 1) * 8) = w; }
                { const f32x4 c = Coth[t]; u32x2 w; w.x = pk2(c[0], c[1]); w.y = pk2(c[2], c[3]); *(LAS u32x2*)(lds + CT + off_b(16 * (4 * (half ^ 1) + t) + li, 2 * wave + (g >> 1)) + (g & 1) * 8) = w; } }
            { const f32x4 c = Cext; u32x2 w; w.x = pk2(c[0], c[1]); w.y = pk2(c[2], c[3]); *(LAS u32x2*)(lds + CT + off_b(128 + li, 2 * wave + (g >> 1)) + (g & 1) * 8) = w; }
            if (step + 2 < 36) ML_DMA(step + 2, p);
            if (wave == 0 && step + 3 < 36) ML_GDMA(step + 3);
        }
        ML_VM0();
        if (cvt_tp < cvt_np) { u32x4 _o; ML_CVT_PACK(_o); const float* _s; unsigned char* _d; ML_CVT_ADDR(cvt_tp, _s, _d); (void)_s; st_b128(_d, _o); }
        ++cvt_tp;
        __syncthreads();
    }
    if (cvt_tp > cvt_np) cvt_tp = cvt_np;
    for (; cvt_tp < cvt_np; ++cvt_tp) { const float* _s; unsigned char* _d; ML_CVT_ADDR(cvt_tp, _s, _d); ML_CVT_LOAD(_s); u32x4 _o; ML_CVT_PACK(_o); *(u32x4*)_d = _o; }
#undef ML_CVT_ADDR
#undef ML_CVT_LOAD
#undef ML_CVT_PACK
#undef ML_CVT_STEP
#undef ML_CVT_ISSUE
#undef ML_CC
#undef ML_GDMA
#undef ML_GATE
#undef ML_DMA
}
}
constexpr int N_PHASES = 13;
#ifndef PROBE_PH
#define PROBE_PH 0
#endif
struct Args { const float* in[19]; float* out; unsigned char* ws; int ph_lo, ph_hi, probe, pad; };
static_assert(sizeof(Args) == 19 * 8 + 8 + 8 + 16, "Args has no padding");

__global__ void __launch_bounds__(512, 2) mk_fwd(Args a) {
    extern __shared__ __attribute__((aligned(16))) unsigned char lds_raw[];
    LAS unsigned char* lds = (LAS unsigned char*)lds_raw;
    const int tid = threadIdx.x, lane = tid & 63, wave = __builtin_amdgcn_readfirstlane(tid >> 6), G = gridDim.x;
    Ctx C;
    C.x = a.in[0]; C.c = a.in[1]; C.ctx = a.in[2]; C.c_ctx = a.in[3]; C.w_ada = a.in[4]; C.b_ada = a.in[5]; C.g_norm1 = a.in[6]; C.w_in = a.in[7]; C.b_gates = a.in[8]; C.w_conv = a.in[9];
    C.w_fourier = a.in[10]; C.w_mlstm = a.in[11]; C.w_out = a.in[12]; C.g_norm2 = a.in[13]; C.w_router = a.in[14]; C.w_gate_e = a.in[15]; C.w_up_e = a.in[16]; C.w_down_e = a.in[17]; C.g_final = a.in[18];
    C.out = a.out; C.ws = a.ws;
    const int lo = a.ph_lo, hi = a.ph_hi;
#if MK_XCD_BAR
    volatile LAS unsigned* bst = (volatile LAS unsigned*)(lds + LDS_PHASE_BYTES);
    if (tid < 4) bst[tid] = 0u;
    __syncthreads();
    XcdBarrier bar = xcd_barrier_post((unsigned*)(a.ws + WS_CTL) + 4096, bst);
#endif
    int nsync = 0;
    if (a.pad == 0x7fffffff) cg::this_grid().sync();
#define IN(k) (lo <= (k) && (k) < hi)
#if MK_XCD_BAR
#ifdef PROBE_BAR2
#define GRIDBAR() do { xcd_barrier(bar); xcd_barrier(bar); ++nsync; } while (0)
#else
#define GRIDBAR() do { xcd_barrier(bar); ++nsync; } while (0)
#endif
#else
#define GRIDBAR() do { cg::this_grid().sync(); ++nsync; } while (0)
#endif
#define SEAM(k) do { if (IN(k) && IN((k) + 1)) GRIDBAR(); } while (0)
#define PHASE(k, ...) do { if (IN(k)) { __VA_ARGS__ } SEAM(k); } while (0)
    PHASE(0, { for (int _r = 0; _r < 1 + (a.probe & 1); ++_r) { p0_prep(C, lds, tid, lane, wave, G); __syncthreads();
            p0_wtf(C, lds, tid, (int)blockIdx.x, G);
            __syncthreads(); p0_tt(C, lds, tid, (int)blockIdx.x, G); __syncthreads(); } });
    PHASE(1, { p0_weights(C, lds, tid, lane, wave, G); __syncthreads(); p1a_norm_gates(C, lds, tid, lane, wave, G, (a.probe >> 1) & 1); __syncthreads(); });
#ifndef MK_STAGGER
#define MK_STAGGER 0
#endif
#define STAGGER(ticks) do { if (MK_STAGGER) { const unsigned long long _t0 = wall_clock64(); const unsigned long long _w = (unsigned long long)((blockIdx.x >> 3) & 7) * (ticks); while (wall_clock64() - _t0 < _w) __builtin_amdgcn_s_sleep(32); } } while (0)
    PHASE(2, { STAGGER(400); SchedP1 S{C.ws, G, (int)blockIdx.x, 1 + ((a.probe >> 2) & 1), 1 + ((a.probe >> 16) & 1)}; EpiP1 E{C.ws}; mg::gemm_phase<EpiP1, SchedP1, false>(lds, 1024, S, E);
            convert_experts(C, lds, lane, wave, G, 1, 0); __syncthreads(); });
    PHASE(3, { SchedF2 S{C.ws, G, (int)blockIdx.x, 1 + ((a.probe >> 3) & 1)}; EpiF2 E{C.ws}; mg::gemm_phase<EpiF2, SchedF2, false>(lds, 4096, S, E); p2_conv(C, lane, wave, G, (a.probe >> 13) & 1); });
    PHASE(4, { ml::mlstm_phase(C, lds, tid, lane, wave, G, (a.probe >> 4) & 1); });
    PHASE(5, { p3b_combine(C, tid, G, (a.probe >> 5) & 1); });
    PHASE(6, { SchedMerge S{C.ws, G, (int)blockIdx.x, 1 + ((a.probe >> 6) & 1)}; EpiMerge E{C.ws}; mg::gemm_phase<EpiMerge, SchedMerge, false, false, true>(lds, 512, S, E); });
    PHASE(7, { SchedOut S{C.ws, G, (int)blockIdx.x, 1 + ((a.probe >> 7) & 1), 1 + ((a.probe >> 17) & 1)}; EpiOut E{C.x, (const float*)(C.ws + WS_MOD), C.ws}; mg::gemm_phase<EpiOut, SchedOut, false>(lds, 1024, S, E); });
    PHASE(8, { p6_norm_router(C, lds, tid, lane, wave, G, (a.probe >> 8) & 1); __syncthreads(); });
    PHASE(9, { const int NGW = G * 8; const int rp9 = 1 + ((a.probe >> 9) & 1); for (int it = wave * G + blockIdx.x; it < NB * NE * rp9; it += NGW) topk_item(C, it % (NB * NE), lane);        if (ML_CVT_ON != 1) convert_experts(C, lds, lane, wave, G, rp9 + ((a.probe >> 18) & 1), 1); for (int i = blockIdx.x * 512 + tid; i < NE * NB * CAP; i += G * 512) ((int*)(C.ws + WS_IDENT))[i] = i; __syncthreads(); });
    PHASE(10, { SchedUp S{C.ws, G, (int)blockIdx.x, 1 + ((a.probe >> 10) & 1), 1 + ((a.probe >> 14) & 1)}; EpiSwiglu E{C.ws}; mg::gemm_phase<EpiSwiglu, SchedUp, true, true>(lds, 1024, S, E); });
    PHASE(11, { SchedDown S{C.ws, G, (int)blockIdx.x, 1 + ((a.probe >> 11) & 1), 1 + ((a.probe >> 15) & 1)}; EpiDown E{C.ws}; mg::gemm_phase<EpiDown, SchedDown, true, true>(lds, 1024, S, E); });
    if (IN(12)) {
#pragma unroll 1
        for (int r12 = 0; r12 <= ((a.probe >> 12) & 1); ++r12) p10_final(C, lane, wave, G); }

#undef PHASE
#undef PHASE_L
#undef IN
#undef SEAM
#undef GRIDBAR
}

static void mk_launch(void* const* d_in, void* d_out, void* d_ws, hipStream_t stream, int lo, int hi, bool coop) {
    static int grid = 0;
    if (grid == 0) {
        int dev = 0, cus = 0, per_cu = 0;
        (void)hipGetDevice(&dev); (void)hipDeviceGetAttribute(&cus, hipDeviceAttributeMultiprocessorCount, dev);
        (void)hipFuncSetAttribute((const void*)mk_fwd, hipFuncAttributeMaxDynamicSharedMemorySize, LDS_BYTES);
        (void)hipOccupancyMaxActiveBlocksPerMultiprocessor(&per_cu, (const void*)mk_fwd, 512, LDS_BYTES);
        if (per_cu < 1) fprintf(stderr, "mk_launch: occupancy query says %d blocks/CU\n", per_cu);
        grid = cus > 0 ? cus : 256;
    }
    Args a{};
    for (int i = 0; i < 19; ++i) a.in[i] = (const float*)d_in[i];
    a.out = (float*)d_out; a.ws = (unsigned char*)d_ws; a.ph_lo = lo; a.ph_hi = hi; a.probe = PROBE_PH; a.pad = 0;
    if (coop) { void* args[] = {&a}; hipError_t e = hipLaunchCooperativeKernel((const void*)mk_fwd, dim3(grid), dim3(512), args, LDS_BYTES, stream);
        if (e != hipSuccess) fprintf(stderr, "cooperative launch failed: %s (grid %d)\n", hipGetErrorString(e), grid); }
    else hipLaunchKernelGGL(mk_fwd, dim3(grid), dim3(512), LDS_BYTES, stream, a);
}
extern "C" void kernel_launch(void* const* d_in, const int* in_sizes, int n_in, void* d_out, int out_size, void* d_ws, size_t ws_size, hipStream_t stream) {
    (void)hipMemsetAsync((char*)d_ws + WS_CTL, 0, 65536, stream);
    mk_launch(d_in, d_out, d_ws, stream, 0, N_PHASES, true);
}
```

```cpp
#ifndef MK_XCD_BAR
#define MK_XCD_BAR 1
#endif
#include <hip/hip_runtime.h>
#include <hip/hip_cooperative_groups.h>
#include <cstdio>
#include <cstdint>
namespace cg = cooperative_groups;

#define LAS __attribute__((address_space(3)))
typedef unsigned short bf16;
typedef short bf16x8 __attribute__((ext_vector_type(8)));
typedef short s16x4 __attribute__((ext_vector_type(4)));
typedef float f32x4 __attribute__((ext_vector_type(4)));
typedef float f32x2 __attribute__((ext_vector_type(2)));
typedef unsigned u32x4 __attribute__((ext_vector_type(4)));
typedef unsigned u32x2 __attribute__((ext_vector_type(2)));
typedef __bf16 bf16x2_t __attribute__((ext_vector_type(2)));
typedef int v8i_t __attribute__((ext_vector_type(8)));
typedef int v4i_t __attribute__((ext_vector_type(4)));

__device__ __forceinline__ unsigned pk2(float lo, float hi) { f32x2 v = {lo, hi}; bf16x2_t b = __builtin_convertvector(v, bf16x2_t); return __builtin_bit_cast(unsigned, b); }
__device__ __forceinline__ float bflo(unsigned w) { return __uint_as_float(w << 16); }
__device__ __forceinline__ float bfhi(unsigned w) { return __uint_as_float(w & 0xffff0000u); }
__device__ __forceinline__ float bf1(bf16 b) { return __uint_as_float((unsigned)b << 16); }
__device__ __forceinline__ float silu_f(float v) { return v * __builtin_amdgcn_rcpf(1.f + __expf(-v)); }
__device__ __forceinline__ float sigmoid_f(float v) { return __builtin_amdgcn_rcpf(1.f + __expf(-v)); }
__device__ __forceinline__ float log_sigmoid_f(float v) { return fminf(v, 0.f) - log1pf(expf(-fabsf(v))); }
__device__ __forceinline__ float wave_sum(float v) {
#define WS_DPP(ctrl, rmask) v += __int_as_float(__builtin_amdgcn_update_dpp(0, __float_as_int(v), ctrl, rmask, 0xf, false));
    WS_DPP(0x111, 0xf) WS_DPP(0x112, 0xf) WS_DPP(0x114, 0xf) WS_DPP(0x118, 0xf) WS_DPP(0x142, 0xa) WS_DPP(0x143, 0xc)
#undef WS_DPP
    return __int_as_float(__builtin_amdgcn_readlane(__float_as_int(v), 63));
}

#define XB_TMO      128
#define XB_XCNT(j)  (256  + 64 * (j))
#define XB_XSUB(j)  (1280 + 64 * (j))
#define XB_XGEN(j)  (2304 + 64 * (j))
#define XB_TOP      3328
#define XB_TOPGEN   3392
#define XCD_BAR_WORDS 3456
#define XB_SPIN_CAP (1u << 20)
__device__ __forceinline__ unsigned xb_ld(unsigned* p)              { return __hip_atomic_load(p, __ATOMIC_RELAXED, __HIP_MEMORY_SCOPE_AGENT); }
__device__ __forceinline__ unsigned xb_add(unsigned* p, unsigned v) { return __hip_atomic_fetch_add(p, v, __ATOMIC_RELAXED, __HIP_MEMORY_SCOPE_AGENT); }
__device__ __forceinline__ unsigned xb_xcc_id() { return (unsigned)__builtin_amdgcn_s_getreg((3 << 11) | 20) & 0xFu; }
#define XB_SPIN(cond, bar) do { unsigned _sp = 0; while (cond) { __builtin_amdgcn_s_sleep(1); \
    if ((++_sp & 255u) == 0u) { if (xb_ld(&(bar)[XB_TMO])) break; if (_sp > XB_SPIN_CAP) { atomicAdd(&(bar)[XB_TMO], 1u); break; } } } } while (0)
struct XcdBarrier { unsigned* bar; unsigned x; volatile LAS unsigned* st; };
__device__ __forceinline__ XcdBarrier xcd_barrier_post(unsigned* bar, volatile LAS unsigned* st) {
    XcdBarrier b; b.bar = bar; b.x = xb_xcc_id(); b.st = st;
    if (threadIdx.x == 0) (void)xb_add(&bar[XB_XCNT(b.x)], 1u);
    return b;
}
__device__ __forceinline__ void xcd_barrier_complete(unsigned* bar, unsigned x, unsigned& nloc, unsigned& nx) {
    const unsigned G = gridDim.x * gridDim.y * gridDim.z;
    unsigned sum, cnt, mine, sp = 0u;
    for (;;) {
        sum = 0u; cnt = 0u; mine = 0u;
#pragma unroll
        for (unsigned j = 0; j < 16; ++j) { const unsigned c = xb_ld(&bar[XB_XCNT(j)]); sum += c; cnt += (c > 0u) ? 1u : 0u; mine = (j == x) ? c : mine; }
        if (sum == G) break;
        __builtin_amdgcn_s_sleep(1);
        if ((++sp & 255u) == 0u) { if (xb_ld(&bar[XB_TMO])) break; if (sp > XB_SPIN_CAP) { atomicAdd(&bar[XB_TMO], 1u); break; } }
    }
    nloc = mine > 0u ? mine : 1u; nx = cnt > 0u ? cnt : 1u;
}
__device__ __forceinline__ void xcd_barrier(const XcdBarrier& b) {
    asm volatile("s_waitcnt vmcnt(0)" ::: "memory");
    __syncthreads();
    if (threadIdx.x == 0) {
        unsigned* bar = b.bar;
        __builtin_amdgcn_s_waitcnt(0);
        unsigned nloc = b.st[0], nx = b.st[1];
        if (nloc == 0u) { xcd_barrier_complete(bar, b.x, nloc, nx); b.st[0] = nloc; b.st[1] = nx; }
        const unsigned old = xb_add(&bar[XB_XSUB(b.x)], 1u);
        const unsigned gen = old / nloc;
        if (old + 1u == (gen + 1u) * nloc) {
            __builtin_amdgcn_fence(__ATOMIC_RELEASE, "agent");
            asm volatile("s_waitcnt vmcnt(0)" ::: "memory");
            const unsigned og = xb_add(&bar[XB_TOP], 1u);
            const unsigned tg = og / nx;
            if (og + 1u == (tg + 1u) * nx) xb_add(&bar[XB_TOPGEN], 1u);
            else XB_SPIN(xb_ld(&bar[XB_TOPGEN]) == tg, bar);
            __builtin_amdgcn_fence(__ATOMIC_ACQUIRE, "agent");
            xb_add(&bar[XB_XGEN(b.x)], 1u);
            asm volatile("s_waitcnt vmcnt(0)" ::: "memory");
        } else {
            XB_SPIN(xb_ld(&bar[XB_XGEN(b.x)]) == gen, bar);
            __builtin_amdgcn_fence(__ATOMIC_ACQUIRE, "agent");
            asm volatile("s_waitcnt vmcnt(0)" ::: "memory");
        }
    }
    __syncthreads();
}

#ifndef MK_TIMING
#define MK_TIMING 0
#endif
namespace mg {
template <bool F8> struct Frag { bf16x8 k[2]; };
template <> struct Frag<true> { v8i_t v; };
constexpr int BM = 256, BK = 64, HALF = 128, HTB = HALF * BK * 2, STAGE_BYTES = 8 * HTB, NXCD = 8, WGM = 8;
__host__ __device__ __forceinline__ int lds_byte(int r, int c) { const int st = (r >> 4) * 2 + (c >> 5), rr = r & 15, cc = c & 31, ob = rr * 64 + cc * 2; return st * 1024 + (ob ^ (((ob >> 9) & 1) << 5)); }
__host__ __device__ __forceinline__ void stage_rc(int b, int& R, int& C) { const int st = b / 1024, sb = b % 1024, swz = sb ^ (((sb >> 9) & 1) << 5); R = (st >> 1) * 16 + swz / 64; C = (st & 1) * 32 + (swz % 64) / 2; }
__host__ __device__ __forceinline__ int perm128x(int R) { return 64 * (R >> 5) + 16 * ((R >> 2) & 3) + 4 * ((R >> 4) & 1) + (R & 3); }
__host__ __device__ __forceinline__ int perm32(int rho) { const int n = rho >> 4, i = rho & 15; return 8 * (i >> 2) + 4 * n + (i & 3); }

struct Unit { int pm, pn, ty; const char* a; const char* b; const int* gi; const char* a2; const char* b2; };
__device__ __forceinline__ void tile_of(int wgid, int nM, int nN, int& pm, int& pn) {
    const int nwg = nM * nN; { const int q = nwg / NXCD, r = nwg % NXCD, xcd = wgid % NXCD, off = wgid / NXCD; wgid = (xcd < r ? xcd * (q + 1) : r * (q + 1) + (xcd - r) * q) + off; }
    const int nig = WGM * nN, gid = wgid / nig, fm = gid * WGM, gsz = (nM - fm) < WGM ? (nM - fm) : WGM;
    pm = fm + ((wgid % nig) % gsz); pn = (wgid % nig) / gsz;
}

template <class Epi, bool P> struct EpiPreOf { struct type {}; };
template <class Epi> struct EpiPreOf<Epi, true> { typedef typename Epi::Pre type; };
template <class Epi, class Sched, bool GATHER, bool FP8 = false, bool SPLITK = false>
__device__ __forceinline__ void gemm_phase(LAS unsigned char* lds, const int K, const Sched& S, const Epi& E) {
    const int tid = threadIdx.x, wid = __builtin_amdgcn_readfirstlane(tid >> 6), lane = tid & 63, wr = wid >> 2, wc = wid & 3, fr = lane & 15, fq = lane >> 4;
    const int KB = FP8 ? K : 2 * K;
    const int nh = KB / (BK * 2), nt = SPLITK ? 2 * nh : nh;
    unsigned voffB[2], vAc[2][2]; int stR[2], stC[2]; int gnx[2][2];
    const size_t kstep = (size_t)(BK * 2);
    const size_t hstep = (size_t)(Epi::PERM2 ? 8 : HALF) * KB;
#pragma unroll
    for (int i = 0; i < 2; ++i) { int R, C; stage_rc(tid * 16 + i * 8192, R, C); stR[i] = R; stC[i] = C; const int Rb = Epi::PERM2 ? perm128x(R) : (Epi::PERM ? ((R & ~31) + perm32(R & 31)) : R);
        voffB[i] = (unsigned)(Rb * KB + 2 * C); }
    const unsigned ldsw = (unsigned)wid * 1024u;
    const int aoff = lds_byte(wr * 64 + fr, fq * (FP8 ? 16 : 8)), boff = lds_byte(wc * 32 + fr, fq * (FP8 ? 16 : 8));
#define MG_SA(b, h) (((b) * 2 + (h)) * HTB)
#define MG_SB(b, h) ((4 + (b) * 2 + (h)) * HTB)
#define MG_STAGE(bufoff, gbase, voff) do { const char* _gb = (const char*)(gbase); asm volatile("" : "+s"(_gb));     \
        _Pragma("unroll") for (int _i = 0; _i < 2; ++_i) { unsigned _vo = (voff)[_i]; asm volatile("" : "+v"(_vo)); \
        __builtin_amdgcn_global_load_lds((const unsigned*)(_gb + _vo), (LAS unsigned*)(lds + (bufoff) + ldsw + _i * 8192), 16, 0, 0); } } while (0)
#define MG_LD16(off_) (*(const LAS v4i_t*)(lds + (off_)))
#define MG_LDA(dst, b, h) do { _Pragma("unroll") for (int m = 0; m < 4; ++m) { const int _o = MG_SA(b, h) + aoff + m * 2048; \
        if constexpr (FP8) dst[m].v = __builtin_shufflevector(MG_LD16(_o), MG_LD16(_o + 16), 0, 1, 2, 3, 4, 5, 6, 7); \
        else { dst[m].k[0] = __builtin_bit_cast(bf16x8, MG_LD16(_o)); dst[m].k[1] = __builtin_bit_cast(bf16x8, MG_LD16(_o + 1024)); } } } while (0)
#define MG_LDB(dst, b, h) do { _Pragma("unroll") for (int n = 0; n < 2; ++n) { const int _o = MG_SB(b, h) + boff + n * 2048; \
        if constexpr (FP8) dst[n].v = __builtin_shufflevector(MG_LD16(_o), MG_LD16(_o + 16), 0, 1, 2, 3, 4, 5, 6, 7); \
        else { dst[n].k[0] = __builtin_bit_cast(bf16x8, MG_LD16(_o)); dst[n].k[1] = __builtin_bit_cast(bf16x8, MG_LD16(_o + 1024)); } } } while (0)
#define MG_MMA(ai, bj, At, Bt) do { __builtin_amdgcn_s_setprio(1); _Pragma("unroll") for (int m = 0; m < 4; ++m) _Pragma("unroll") for (int n = 0; n < 2; ++n) { \
        if constexpr (FP8) acc[ai][bj][m][n] = __builtin_amdgcn_mfma_scale_f32_16x16x128_f8f6f4(Bt[n].v, At[m].v, acc[ai][bj][m][n], 0, 0, 0, 0, 0, 0); \
        else { _Pragma("unroll") for (int k = 0; k < 2; ++k) acc[ai][bj][m][n] = __builtin_amdgcn_mfma_f32_16x16x32_bf16(Bt[n].k[k], At[m].k[k], acc[ai][bj][m][n], 0, 0, 0); } } \
        __builtin_amdgcn_s_setprio(0); } while (0)
#define MG_WAIT_V(n) asm volatile("s_waitcnt vmcnt(" #n ")" ::: "memory")
#define MG_WAIT_L(n) asm volatile("s_waitcnt lgkmcnt(" #n ")" ::: "memory")
#define MG_BAR __builtin_amdgcn_s_barrier()
#define MG_SCHED __builtin_amdgcn_sched_barrier(0)
#define MG_AOFF(dst, u) do { _Pragma("unroll") for (int _h = 0; _h < 2; ++_h) _Pragma("unroll") for (int _i = 0; _i < 2; ++_i) { \
        if constexpr (GATHER) dst[_h][_i] = (unsigned)(u).gi[_h * HALF + stR[_i]] * (unsigned)KB + 2u * (unsigned)stC[_i]; \
        else dst[_h][_i] = (unsigned)((_h * HALF + stR[_i]) * KB + 2 * stC[_i]); } } while (0)
    Unit cur, nxt; int ui = 0;
    if (!S.next(0, cur)) return;
#if MK_TIMING
    unsigned long long tmE = 0, tmR = 0, tmK = 0, tm0 = wall_clock64(), tm1 = 0; const unsigned long long tmS = tm0; int tmU = 0;
#endif
    f32x4 acc[2][2][4][2];
#pragma unroll
    for (int a = 0; a < 2; ++a)
#pragma unroll
        for (int b = 0; b < 2; ++b)
#pragma unroll
            for (int m = 0; m < 4; ++m)
#pragma unroll
                for (int n = 0; n < 2; ++n) acc[a][b][m][n] = (f32x4){0.f, 0.f, 0.f, 0.f};
    Frag<FP8> At[4], B0[2], B1[2];
    struct NoPre {}; typename std::conditional<Epi::PRE, typename EpiPreOf<Epi, Epi::PRE>::type, NoPre>::type pre;
    const char* cA = cur.a; const char* cB = cur.b; const char* cA2 = cur.a2; const char* cB2 = cur.b2;
#define MG_TP(p0, p1, tt) ((SPLITK && (tt) >= nh) ? (p1) + (size_t)((tt) - nh) * kstep : (p0) + (size_t)(tt) * kstep)
    MG_AOFF(vAc, cur);
    MG_STAGE(MG_SB(0, 0), cB, voffB); MG_STAGE(MG_SB(0, 1), cB + hstep, voffB); MG_STAGE(MG_SA(0, 0), cA, vAc[0]); MG_STAGE(MG_SA(0, 1), cA, vAc[1]);
    if (wr == 1) MG_BAR;
    MG_WAIT_V(2); MG_BAR;
    MG_STAGE(MG_SB(1, 0), cB + kstep, voffB); MG_STAGE(MG_SA(1, 0), cA + kstep, vAc[0]); MG_STAGE(MG_SB(1, 1), cB + hstep + kstep, voffB);
    MG_WAIT_V(6); MG_BAR;
    for (;;) {
        const bool has_next = S.next(ui + 1, nxt);
        const char* nA = has_next ? nxt.a : cA; const char* nB = has_next ? nxt.b : cB;
        if constexpr (GATHER) { if (has_next) {
#pragma unroll
            for (int h = 0; h < 2; ++h)
#pragma unroll
                for (int i = 0; i < 2; ++i) asm volatile("global_load_dword %0, %1, off" : "=v"(gnx[h][i]) : "v"(nxt.gi + h * HALF + stR[i]) : "memory"); } }
#pragma unroll 1
        for (int t = 0; t < nt; t += 2) {
            const bool last = (t == nt - 2);
            const char* a1 = MG_TP(cA, cA2, t + 1);
            const char* a2 = last ? nA : MG_TP(cA, cA2, t + 2); const char* b2 = last ? nB : MG_TP(cB, cB2, t + 2);
            if constexpr (SPLITK) { if (t == nh) { int fr_ = fr, fq_ = fq; asm volatile("" : "+v"(fr_), "+v"(fq_)); if constexpr (Epi::PRE) E.mid(acc, cur, wr, wc, fr_, fq_, pre); else E.mid(acc, cur, wr, wc, fr_, fq_); } }
            if constexpr (Epi::PRE) { if (Epi::PRE_MID && SPLITK && t == nh - 2) { int fr_ = fr, fq_ = fq; asm volatile("" : "+v"(fr_), "+v"(fq_)); E.pre_mid(pre, cur, wr, wc, fr_, fq_); }
                if (last) { int fr_ = fr, fq_ = fq; asm volatile("" : "+v"(fr_), "+v"(fq_)); E.pre_fin(pre, cur, wr, wc, fr_, fq_); } }
            const char* a3 = a2 + kstep; const char* b3 = b2 + kstep;
            MG_LDB(B0, 0, 0); MG_LDB(B1, 0, 1); MG_SCHED; MG_LDA(At, 0, 0); MG_STAGE(MG_SA(1, 1), a1, vAc[1]);
            if constexpr (GATHER) { if (last && has_next) {
                asm volatile("" : "+v"(gnx[0][0]), "+v"(gnx[0][1]), "+v"(gnx[1][0]), "+v"(gnx[1][1]));
#pragma unroll
                for (int h = 0; h < 2; ++h)
#pragma unroll
                    for (int i = 0; i < 2; ++i) vAc[h][i] = (unsigned)gnx[h][i] * (unsigned)KB + 2u * (unsigned)stC[i]; } }
            MG_WAIT_V(8); MG_WAIT_L(0); MG_BAR; MG_MMA(0, 0, At, B0); MG_MMA(0, 1, At, B1); MG_BAR; MG_SCHED;
            MG_LDA(At, 0, 1); MG_STAGE(MG_SB(0, 0), b2, voffB); MG_STAGE(MG_SB(0, 1), b2 + hstep, voffB); MG_STAGE(MG_SA(0, 0), a2, vAc[0]);
            MG_WAIT_V(8); MG_WAIT_L(0); MG_BAR; MG_MMA(1, 0, At, B0); MG_MMA(1, 1, At, B1); MG_BAR; MG_SCHED;
            MG_LDB(B0, 1, 0); MG_LDB(B1, 1, 1); MG_SCHED; MG_LDA(At, 1, 0); MG_STAGE(MG_SA(0, 1), a2, vAc[1]);
            MG_WAIT_V(8); MG_WAIT_L(0); MG_BAR; MG_MMA(0, 0, At, B0); MG_MMA(0, 1, At, B1); MG_BAR; MG_SCHED;
            MG_LDA(At, 1, 1); MG_STAGE(MG_SB(1, 0), b3, voffB); MG_STAGE(MG_SB(1, 1), b3 + hstep, voffB); MG_STAGE(MG_SA(1, 0), a3, vAc[0]);
            MG_WAIT_V(8); MG_WAIT_L(0); MG_BAR; MG_MMA(1, 0, At, B0); MG_MMA(1, 1, At, B1); MG_BAR; MG_SCHED;
        }
        if (wr == 0) MG_BAR;
#if MK_TIMING
        tm1 = wall_clock64(); tmK += tm1 - tm0; ++tmU;
#endif
        { int fr_ = fr, fq_ = fq; asm volatile("" : "+v"(fr_), "+v"(fq_));
          if constexpr (Epi::PRE) E(acc, cur, wr, wc, fr_, fq_, pre); else E(acc, cur, wr, wc, fr_, fq_);
#ifdef PROBE_EPI
          if constexpr (Sched::TSLOT == PROBE_EPI) { asm volatile("" : "+v"(fr_), "+v"(fq_)); if constexpr (Epi::PRE) E(acc, cur, wr, wc, fr_, fq_, pre); else E(acc, cur, wr, wc, fr_, fq_); }
#endif
        }
#if MK_TIMING
        tm0 = wall_clock64(); tmE += tm0 - tm1;
#endif
        if (!has_next) break;
#pragma unroll
        for (int a = 0; a < 2; ++a)
#pragma unroll
            for (int b = 0; b < 2; ++b)
#pragma unroll
                for (int m = 0; m < 4; ++m)
#pragma unroll
                    for (int n = 0; n < 2; ++n) acc[a][b][m][n] = (f32x4){0.f, 0.f, 0.f, 0.f};
        cur = nxt; cA = nA; cB = nB; cA2 = cur.a2; cB2 = cur.b2; ++ui;
        if (wr == 1) MG_BAR;
    }
    MG_WAIT_V(0);
    MG_BAR;
#if MK_TIMING
    if (blockIdx.x == 7 && tid == 0) { float* tp = (float*)S.ws + 8192 + 8 * Sched::TSLOT; tp[0] = (float)tmE * 0.01f; tp[1] = (float)tmK * 0.01f; tp[2] = (float)(wall_clock64() - tmS) * 0.01f; tp[3] = (float)tmU; }
#endif
#undef MG_SA
#undef MG_SB
#undef MG_STAGE
#undef MG_LDA
#undef MG_LDB
#undef MG_MMA
#undef MG_LD16
#undef MG_WAIT_V
#undef MG_WAIT_L
#undef MG_BAR
#undef MG_SCHED
#undef MG_AOFF
#undef MG_TP
}
}
constexpr int D = 1024, NB = 32, SEQ = 2048, CL = 256, NTOK = NB * SEQ, NCTX = NB * CL, INC = 4624;
constexpr int NE = 16, CAP = 256;
constexpr int OFF_QK = 512, OFF_V = 1536, OFF_O = 2048, OFF_G = 2560, OFF_BR = 2576;
constexpr float EPS = 1e-6f;
constexpr size_t MiB = 1u << 20;
constexpr size_t WS_CTL = 0, CTL_BYTES = 1 * MiB;
constexpr size_t WS_MOD = 1 * MiB;
constexpr size_t WS_GATES = 2 * MiB;
constexpr size_t WS_AFF = 11 * MiB;
constexpr size_t WS_IDX = 15 * MiB;
constexpr size_t WS_VAL = 15 * MiB + 512 * 1024;
constexpr size_t WS_SLOT = 16 * MiB;
constexpr size_t WS_WTF = 18 * MiB;
constexpr size_t WS_WFT = 20 * MiB;
constexpr size_t WS_WMT = 21 * MiB;
constexpr size_t WS_WOT = 22 * MiB;
constexpr size_t WS_WTM = 24 * MiB;
constexpr size_t WS_TT = 32 * MiB;
constexpr size_t WS_PC = 48 * MiB;
constexpr size_t WS_H = 64 * MiB;
constexpr size_t WS_QK = 64 * MiB;
constexpr size_t WS_KC = 192 * MiB;
constexpr size_t WS_MRG = 64 * MiB;
constexpr size_t WS_WGU = 784 * MiB;
constexpr size_t WS_WD = 816 * MiB;
constexpr size_t WS_AB = 208 * MiB;
constexpr size_t WS_HF = 208 * MiB;
constexpr size_t WS_HB = 272 * MiB;
constexpr size_t WS_HX2 = 208 * MiB;
constexpr size_t WS_X1 = 272 * MiB;
constexpr size_t WS_FU = 336 * MiB;
constexpr size_t WS_PQK = 400 * MiB;
constexpr size_t WS_HM = 400 * MiB;
constexpr size_t WS_PV = 528 * MiB;
constexpr size_t WS_PO = 592 * MiB;
constexpr size_t WS_PBR = 656 * MiB;
constexpr size_t WS_HID = 400 * MiB;
constexpr size_t WS_Y = 656 * MiB;
#ifndef VAL_IN_FINAL
#define VAL_IN_FINAL 0
#endif
constexpr size_t WS_VALT = 832 * MiB;
constexpr size_t WS_IDENT = 912 * MiB;
constexpr size_t WS_W64 = 913 * MiB;
constexpr size_t WS_A64T = 913 * MiB + 65536;
constexpr size_t WS_F64 = 914 * MiB;
constexpr size_t WS_END = 916 * MiB;
constexpr int LDS_PHASE_BYTES = 147456, LDS_BYTES = LDS_PHASE_BYTES + 256;

__device__ __forceinline__ unsigned pk4_fp8(float a, float b, float c, float d) { int w = __builtin_amdgcn_cvt_pk_fp8_f32(a, b, 0, false); w = __builtin_amdgcn_cvt_pk_fp8_f32(c, d, w, true); return (unsigned)w; }
constexpr float W8_SCALE = 32.f, W8_INV = 1.f / 32.f;
__device__ __forceinline__ unsigned pk4_u8(float a, float b, float c, float d) { return (unsigned)(a * 255.f + 0.5f) | ((unsigned)(b * 255.f + 0.5f) << 8) | ((unsigned)(c * 255.f + 0.5f) << 16) | ((unsigned)(d * 255.f + 0.5f) << 24); }
__device__ __forceinline__ float u8f0(unsigned w) { return (float)(w & 0xffu) * (1.f / 255.f); }
__device__ __forceinline__ float u8f1(unsigned w) { return (float)((w >> 8) & 0xffu) * (1.f / 255.f); }
__device__ __forceinline__ float u8f2(unsigned w) { return (float)((w >> 16) & 0xffu) * (1.f / 255.f); }
__device__ __forceinline__ float u8f3(unsigned w) { return (float)(w >> 24) * (1.f / 255.f); }
struct Ctx {
    const float *x, *c, *ctx, *c_ctx, *w_ada, *b_ada, *g_norm1, *w_in, *b_gates, *w_conv, *w_fourier, *w_mlstm, *w_out, *g_norm2, *w_router, *w_gate_e, *w_up_e, *w_down_e, *g_final;
    float* out; unsigned char* ws;
};

__device__ __forceinline__ void store_tile_bf16(const f32x4 (&acc)[2][2][4][2], bf16* base, int ldc, bool sig, int wr, int wc, int fr, int fq, bool nost = false, size_t bjs = 128) {
    bf16* p0 = base + (size_t)(wr * 64 + fr) * ldc + wc * 32 + 8 * fq;
#pragma unroll
    for (int ai = 0; ai < 2; ++ai)
#pragma unroll
        for (int m = 0; m < 4; ++m) { bf16* rowp = p0 + (size_t)(ai * 128 + m * 16) * ldc;
#pragma unroll
            for (int bj = 0; bj < 2; ++bj) { f32x4 v0 = acc[ai][bj][m][0], v1 = acc[ai][bj][m][1];
                if (sig) {
#pragma unroll
                    for (int j = 0; j < 4; ++j) { v0[j] = sigmoid_f(v0[j]); v1[j] = sigmoid_f(v1[j]); } }
                u32x4 w; w.x = pk2(v0[0], v0[1]); w.y = pk2(v0[2], v0[3]); w.z = pk2(v1[0], v1[1]); w.w = pk2(v1[2], v1[3]);
                if (nost) asm volatile("" :: "v"(w.x), "v"(w.y), "v"(w.z), "v"(w.w)); else *(u32x4*)(rowp + bj * bjs) = w; } }
}
__device__ __forceinline__ f32x2 sig2_q(f32x2 v) { const f32x2 x = v * (f32x2){-1.4426950408889634f, -1.4426950408889634f}; const f32x2 e = {__builtin_amdgcn_exp2f(x.x), __builtin_amdgcn_exp2f(x.y)};
    const f32x2 d = e + (f32x2){1.f, 1.f}; const f32x2 r = {__builtin_amdgcn_rcpf(d.x), __builtin_amdgcn_rcpf(d.y)}; return __builtin_elementwise_fma(r, (f32x2){255.f, 255.f}, (f32x2){0.5f, 0.5f}); }
__device__ __forceinline__ unsigned sig4_u8(f32x4 v) { const f32x2 a = sig2_q((f32x2){v[0], v[1]}), b = sig2_q((f32x2){v[2], v[3]}); return (unsigned)a.x | ((unsigned)a.y << 8) | ((unsigned)b.x << 16) | ((unsigned)b.y << 24); }
__device__ __forceinline__ u32x4 widen_pair(u32x2 a, u32x2 b) {
    const u32x2 r0 = __builtin_amdgcn_permlane16_swap(a.x, b.x, false, false), r1 = __builtin_amdgcn_permlane16_swap(a.y, b.y, false, false);
    return (u32x4){r0.x, r1.x, r0.y, r1.y};
}
__device__ __forceinline__ void store_tile_sig_u8(const f32x4 (&acc)[2][2][4][2], unsigned char* base, int ldc, int wr, int wc, int fr, int fq, bool nost = false) {
    unsigned char* p0 = base + (size_t)(wr * 64 + fr + 16 * (fq & 1)) * ldc + wc * 32 + 8 * (fq & ~1);
#pragma unroll
    for (int ai = 0; ai < 2; ++ai)
#pragma unroll
        for (int mp = 0; mp < 2; ++mp) { unsigned char* rowp = p0 + (size_t)(ai * 128 + mp * 32) * ldc;
#pragma unroll
            for (int bj = 0; bj < 2; ++bj) { u32x2 wa, wb;
                wa.x = sig4_u8(acc[ai][bj][2 * mp][0]); wa.y = sig4_u8(acc[ai][bj][2 * mp][1]); wb.x = sig4_u8(acc[ai][bj][2 * mp + 1][0]); wb.y = sig4_u8(acc[ai][bj][2 * mp + 1][1]);
                const u32x4 w = widen_pair(wa, wb);
                if (nost) asm volatile("" :: "v"(w.x), "v"(w.y), "v"(w.z), "v"(w.w)); else __builtin_nontemporal_store(w, (u32x4*)(rowp + bj * 128)); }
            asm volatile("" ::: "memory"); }
}
struct EpiP1 {
    static constexpr bool PERM = true, PRE = false, PERM2 = false; unsigned char* ws;
    __device__ __forceinline__ void operator()(const f32x4 (&acc)[2][2][4][2], const mg::Unit& u, int wr, int wc, int fr, int fq) const {
        bf16* base; int ldc; bool sig = false;
#ifdef PROBE_SKIP_EPI
        if (u.ty >= 8) return;
#endif
#ifdef PROBE_SKIP_ST
        const bool nost = u.ty >= 8;
#else
        const bool nost = false;
#endif
        const int ty = u.ty & 7;
        if (ty == 0) { const size_t r0 = (size_t)u.pm * 256;
            if (u.pn < 4) { base = (bf16*)(ws + WS_PQK) + r0 * 1024 + u.pn * 256; ldc = 1024; }
            else if (u.pn < 6) { store_tile_bf16(acc, (bf16*)(ws + WS_PV) + ((size_t)((u.pm >> 3) * 4 + (u.pn - 4) * 2) * SEQ + (size_t)(u.pm & 7) * 256) * 128, 128, false, wr, wc, fr, fq, nost, (size_t)SEQ * 128); return; }
            else if (u.pn < 8) { store_tile_sig_u8(acc, ws + WS_PO + r0 * 512 + (u.pn - 6) * 256, 512, wr, wc, fr, fq, nost); return; }
            else { store_tile_sig_u8(acc, ws + WS_PBR + r0 * 2048 + (u.pn - 8) * 256, 2048, wr, wc, fr, fq, nost); return; }
        } else if (ty == 1) { base = (bf16*)(ws + WS_AB) + ((size_t)(u.pn >> 3) * 512 + (size_t)u.pm * 256) * 2048 + (u.pn & 7) * 256; ldc = 2048; }
        else { base = (bf16*)(ws + WS_PC) + (size_t)u.pm * 256 * 1024 + u.pn * 256; ldc = 1024; }
        store_tile_bf16(acc, base, ldc, sig, wr, wc, fr, fq, nost);
    }
};
struct EpiF2 {
    static constexpr bool PERM = true, PRE = false, PERM2 = false; unsigned char* ws;
    __device__ __forceinline__ void operator()(const f32x4 (&acc)[2][2][4][2], const mg::Unit& u, int wr, int wc, int fr, int fq) const {
        bf16* fb = (bf16*)(ws + WS_FU) + (size_t)u.pn * 2048 * 512 + wc * 32 + 8 * fq;
        const bool j0 = ((wc * 32 + 8 * fq) & 63) == 0;
#pragma unroll
        for (int ai = 0; ai < 2; ++ai)
#pragma unroll
            for (int m = 0; m < 4; ++m) { const int k = u.pm * 256 + ai * 128 + wr * 64 + m * 16 + fr, km = (2048 - k) & 2047;
#pragma unroll
                for (int bj = 0; bj < 2; ++bj) { const f32x4 v0 = acc[ai][bj][m][0], v1 = acc[ai][bj][m][1];
                    u32x4 w; w.x = pk2(v0[0], v0[1]); w.y = pk2(v0[2], v0[3]); w.z = pk2(v1[0], v1[1]); w.w = pk2(v1[2], v1[3]);
                    *(u32x4*)(fb + (size_t)k * 512 + bj * 128) = w;
                    bf16* mp = fb + (size_t)km * 512 + 256 + bj * 128;
                    if (j0) { mp[1] = (bf16)(w.x >> 16); *(unsigned*)(mp + 2) = w.y; *(u32x2*)(mp + 4) = (u32x2){w.z, w.w}; } else *(u32x4*)mp = w; } }
    }
};
struct EpiMerge {
    static constexpr bool PERM = true, PRE = false, PERM2 = true; unsigned char* ws;
#define MRG_R(wa, wb, sh) ((float)(((wa) >> (sh)) & 0xffu) * __builtin_amdgcn_rcpf(fmaxf((float)(((wb) >> (sh)) & 0xffu), 0.5f)))
#define MRG_SCALE1(ai, m, bj, n, wa, wb) do { f32x4 v = acc[ai][bj][m][n]; \
            v = (f32x4){v[0] * MRG_R(wa, wb, 0), v[1] * MRG_R(wa, wb, 8), v[2] * MRG_R(wa, wb, 16), v[3] * MRG_R(wa, wb, 24)}; acc[ai][bj][m][n] = v; } while (0)
    __device__ __forceinline__ void mid(f32x4 (&acc)[2][2][4][2], const mg::Unit& u, int wr, int wc, int fr, int fq) const {
        const size_t row0 = (size_t)u.pm * 256 + wr * 64 + fr; const int col0 = u.pn * 256 + wc * 64 + 16 * fq;
        u32x4 g1[3][2], g2[3][2];
#define MRG_LOADQ(buf, q_) do { _Pragma("unroll") for (int mm = 0; mm < 2; ++mm) { const unsigned char* gp = ws + WS_PBR + (row0 + ((q_) >> 1) * 128 + (((q_) & 1) * 2 + mm) * 16) * 2048 + col0; \
            g1[buf][mm] = __builtin_nontemporal_load((const u32x4*)gp); g2[buf][mm] = *(const u32x4*)(gp + 1024); } } while (0)
#define MRG_DOQ(buf, ai, mh) do { _Pragma("unroll") for (int mm = 0; mm < 2; ++mm) { const u32x4 a = g1[buf][mm], b = g2[buf][mm]; \
            MRG_SCALE1(ai, (mh) * 2 + mm, 0, 0, a.x, b.x); MRG_SCALE1(ai, (mh) * 2 + mm, 0, 1, a.y, b.y); MRG_SCALE1(ai, (mh) * 2 + mm, 1, 0, a.z, b.z); MRG_SCALE1(ai, (mh) * 2 + mm, 1, 1, a.w, b.w); } } while (0)
        MRG_LOADQ(0, 0); MRG_LOADQ(1, 1); MRG_LOADQ(2, 2);
        MRG_DOQ(0, 0, 0); asm volatile("" ::: "memory"); MRG_LOADQ(0, 3);
        MRG_DOQ(1, 0, 1); asm volatile("" ::: "memory");
        MRG_DOQ(2, 1, 0); asm volatile("" ::: "memory");
        MRG_DOQ(0, 1, 1); asm volatile("" ::: "memory");
#undef MRG_LOADQ
#undef MRG_DOQ
    }
#undef MRG_SCALE1
#undef MRG_R
    __device__ __forceinline__ void operator()(const f32x4 (&acc)[2][2][4][2], const mg::Unit& u, int wr, int wc, int fr, int fq) const {
        const size_t row0 = (size_t)u.pm * 256 + wr * 64 + fr; const int col0 = u.pn * 256 + wc * 64 + 16 * fq;
        u32x4 g2a[2][4];
#pragma unroll
        for (int ai = 0; ai < 2; ++ai)
#pragma unroll
            for (int m = 0; m < 4; ++m) g2a[ai][m] = *(const u32x4*)(ws + WS_PBR + (row0 + ai * 128 + m * 16) * 2048 + 1024 + col0);
#pragma unroll
        for (int ai = 0; ai < 2; ++ai) {
#pragma unroll
            for (int m = 0; m < 4; ++m) { const u32x4 b = g2a[ai][m]; bf16* op = (bf16*)(ws + WS_MRG) + (row0 + ai * 128 + m * 16) * 1024 + col0;
#define MRG_G(wb, sh) (fmaxf((float)(((wb) >> (sh)) & 0xffu), 0.5f) * (1.f / 255.f))
#define MRG_OUT(bj, bw0, bw1, dst) do { const f32x4 v0 = acc[ai][bj][m][0], v1 = acc[ai][bj][m][1]; u32x4 w; \
                    w.x = pk2(v0[0] * MRG_G(bw0, 0), v0[1] * MRG_G(bw0, 8)); w.y = pk2(v0[2] * MRG_G(bw0, 16), v0[3] * MRG_G(bw0, 24)); \
                    w.z = pk2(v1[0] * MRG_G(bw1, 0), v1[1] * MRG_G(bw1, 8)); w.w = pk2(v1[2] * MRG_G(bw1, 16), v1[3] * MRG_G(bw1, 24)); *(u32x4*)(dst) = w; } while (0)
                MRG_OUT(0, b.x, b.y, op); MRG_OUT(1, b.z, b.w, op + 8);
#undef MRG_OUT
#undef MRG_G
            }
            asm volatile("" ::: "memory"); }
    }
};
struct EpiOut {
    static constexpr bool PERM = true, PRE = false, PERM2 = false; const float* x; const float* mod; unsigned char* ws;
    __device__ __forceinline__ void operator()(const f32x4 (&acc)[2][2][4][2], const mg::Unit& u, int wr, int wc, int fr, int fq) const {
        const size_t row0 = (size_t)u.pm * 256 + wr * 64 + fr; const int col0 = u.pn * 256 + wc * 32 + 8 * fq; const int b = u.pm >> 3;
        f32x4 ga[2][2];
#pragma unroll
        for (int bj = 0; bj < 2; ++bj)
#pragma unroll
            for (int n = 0; n < 2; ++n) ga[bj][n] = *(const f32x4*)(mod + (size_t)b * 6144 + 2048 + col0 + bj * 128 + n * 4);
#pragma unroll
        for (int ai = 0; ai < 2; ++ai) {
            f32x4 xv[4][2][2];
#pragma unroll
            for (int m = 0; m < 4; ++m) { const size_t off = (row0 + ai * 128 + m * 16) * 1024 + col0;
#pragma unroll
                for (int bj = 0; bj < 2; ++bj) { xv[m][bj][0] = __builtin_nontemporal_load((const f32x4*)(x + off + bj * 128)); xv[m][bj][1] = __builtin_nontemporal_load((const f32x4*)(x + off + bj * 128 + 4)); } }
#pragma unroll
            for (int m = 0; m < 4; ++m) { const size_t off = (row0 + ai * 128 + m * 16) * 1024 + col0;
#pragma unroll
                for (int bj = 0; bj < 2; ++bj) { const f32x4 v0 = xv[m][bj][0] + ga[bj][0] * acc[ai][bj][m][0], v1 = xv[m][bj][1] + ga[bj][1] * acc[ai][bj][m][1];
                    u32x4 w; w.x = pk2(v0[0], v0[1]); w.y = pk2(v0[2], v0[3]); w.z = pk2(v1[0], v1[1]); w.w = pk2(v1[2], v1[3]);
                    *(u32x4*)((bf16*)(ws + WS_X1) + off + bj * 128) = w; } }
            asm volatile("" ::: "memory"); }
    }
};
struct EpiSwiglu {
    static constexpr bool PERM = true, PRE = false, PERM2 = false; unsigned char* ws;
    __device__ __forceinline__ void operator()(const f32x4 (&acc)[2][2][4][2], const mg::Unit& u, int wr, int wc, int fr, int fq) const {
        unsigned char* p0 = ws + WS_HID + ((size_t)u.pm * 256 + wr * 64 + fr + 16 * (fq & 1)) * 1024 + u.pn * 128 + wc * 32 + 8 * (fq & ~1);
        u32x2 wprev = {0u, 0u};
#pragma unroll
        for (int ai = 0; ai < 2; ++ai)
#pragma unroll
            for (int m = 0; m < 4; ++m) { float r[8];
#pragma unroll
                for (int n = 0; n < 2; ++n)
#pragma unroll
                    for (int j = 0; j < 4; j += 2) {
                        const f32x2 g = {acc[ai][0][m][n][j], acc[ai][0][m][n][j + 1]}, uu = {acc[ai][1][m][n][j], acc[ai][1][m][n][j + 1]};
                        const f32x2 x = g * (f32x2){-1.4426950408889634f * W8_INV, -1.4426950408889634f * W8_INV};
                        const f32x2 e = {__builtin_amdgcn_exp2f(x.x), __builtin_amdgcn_exp2f(x.y)};
                        const f32x2 d = __builtin_elementwise_fma(e, (f32x2){1024.f, 1024.f}, (f32x2){1024.f, 1024.f});
                        const f32x2 rr = {__builtin_amdgcn_rcpf(d.x), __builtin_amdgcn_rcpf(d.y)};
                        const f32x2 o = (g * uu) * rr; r[n * 4 + j] = o.x; r[n * 4 + j + 1] = o.y; }
                u32x2 w; w.x = pk4_fp8(r[0], r[1], r[2], r[3]); w.y = pk4_fp8(r[4], r[5], r[6], r[7]);
                if (m & 1) *(u32x4*)(p0 + (size_t)(ai * 128 + (m - 1) * 16) * 1024) = widen_pair(wprev, w); else wprev = w; }
    }
};
constexpr float Y8_SCALE = 8.f, Y8_INV = 1.f / 8.f;
struct EpiDown {
    static constexpr bool PERM = true, PRE = true, PRE_MID = false, PERM2 = true; unsigned char* ws;
    struct Pre { float v[8]; };
    __device__ __forceinline__ void pre_mid(Pre&, const mg::Unit&, int, int, int, int) const {}
    __device__ __forceinline__ void pre_fin(Pre& P, const mg::Unit& u, int wr, int wc, int fr, int fq) const {
        const float* val = (const float*)(ws + WS_VAL) + (size_t)u.pm * 256 + wr * 64 + fr;
#pragma unroll
        for (int ai = 0; ai < 2; ++ai)
#pragma unroll
            for (int m = 0; m < 4; ++m) asm volatile("global_load_dword %0, %1, off" : "=v"(P.v[ai * 4 + m]) : "v"(val + ai * 128 + m * 16) : "memory");
    }
    __device__ __forceinline__ void operator()(const f32x4 (&acc)[2][2][4][2], const mg::Unit& u, int wr, int wc, int fr, int fq, Pre& P) const {
        const size_t row0 = (size_t)u.pm * 256 + wr * 64 + fr;
        unsigned char* p0 = ws + WS_Y + row0 * 1024 + u.pn * 256 + wc * 64 + 16 * fq;
        asm volatile("s_waitcnt vmcnt(16)" : "+v"(P.v[0]), "+v"(P.v[1]), "+v"(P.v[2]), "+v"(P.v[3]), "+v"(P.v[4]), "+v"(P.v[5]), "+v"(P.v[6]), "+v"(P.v[7]) :: "memory");
#pragma unroll
        for (int ai = 0; ai < 2; ++ai)
#pragma unroll
            for (int m = 0; m < 4; ++m) { const float vv = P.v[ai * 4 + m] * (W8_INV * Y8_SCALE); unsigned char* rowp = p0 + (size_t)(ai * 128 + m * 16) * 1024;
                const f32x4 v0 = acc[ai][0][m][0] * vv, v1 = acc[ai][0][m][1] * vv, v2 = acc[ai][1][m][0] * vv, v3 = acc[ai][1][m][1] * vv;
                u32x4 w; w.x = pk4_fp8(v0[0], v0[1], v0[2], v0[3]); w.y = pk4_fp8(v1[0], v1[1], v1[2], v1[3]); w.z = pk4_fp8(v2[0], v2[1], v2[2], v2[3]); w.w = pk4_fp8(v3[0], v3[1], v3[2], v3[3]);
                *(u32x4*)rowp = w; }
    }
};

struct SchedP1 {
    static constexpr int TSLOT = 0; unsigned char* ws; int G, c, nrep; int erep = 1;
    __device__ __forceinline__ bool next(int i, mg::Unit& u) const {
        int L = i * G + c; if (L >= 4736 * nrep) return false; const int dup = L >= 4736 ? 8 : 0; L %= 4736; const char* H = (const char*)(ws + WS_H); u.gi = nullptr;
        if (L < 4096) { mg::tile_of(L, 256, 16, u.pm, u.pn); u.ty = 0 + dup; u.a = H + (size_t)u.pm * 256 * 2048; u.b = (const char*)(ws + WS_WTM) + (size_t)u.pn * 256 * 2048; return true; }
        L -= 4096;
        if (L < 512) { mg::tile_of(L, 2, 256, u.pm, u.pn); u.ty = 1 + dup; u.a = (const char*)(ws + WS_WTF) + (size_t)u.pm * 256 * 2048; u.b = H + (size_t)u.pn * 256 * 2048; return true; }
        L -= 512;
        if (L < 128) { mg::tile_of(L, 32, 4, u.pm, u.pn); u.ty = 2 + dup; u.a = H + ((size_t)NTOK + (size_t)u.pm * 256) * 2048; u.b = (const char*)(ws + WS_WTM) + ((size_t)512 + (size_t)u.pn * 256) * 2048; return true; }
        return false;
    }
};
struct SchedF2 {
    static constexpr int TSLOT = 1; unsigned char* ws; int G, c, nrep; int erep = 1;
    __device__ __forceinline__ bool next(int i, mg::Unit& u) const {
        int L = i * G + c; if (L >= 256 * nrep) return false; L %= 256; mg::tile_of(L, 8, 32, u.pm, u.pn); u.ty = 0; u.gi = nullptr;
        u.a = (const char*)(ws + WS_TT) + (size_t)u.pm * 256 * 8192; u.b = (const char*)(ws + WS_AB) + (size_t)u.pn * 256 * 8192; return true;
    }
};
struct SchedMerge {
    static constexpr int TSLOT = 2; unsigned char* ws; int G, c, nrep; int erep = 1;
    __device__ __forceinline__ bool next(int i, mg::Unit& u) const {
        int L = i * G + c; if (L >= 1024 * nrep) return false; L %= 1024; mg::tile_of(L, 256, 4, u.pm, u.pn); u.ty = 0; u.gi = nullptr;
        u.a = (const char*)(ws + WS_FU) + (size_t)u.pm * 256 * 1024; u.b = (const char*)(ws + WS_WFT) + (size_t)u.pn * 256 * 1024;
        u.a2 = (const char*)(ws + WS_HM) + (size_t)u.pm * 256 * 1024; u.b2 = (const char*)(ws + WS_WMT) + (size_t)u.pn * 256 * 1024; return true;
    }
};
struct SchedOut {
    static constexpr int TSLOT = 3; unsigned char* ws; int G, c, nrep; int erep = 1;
    __device__ __forceinline__ bool next(int i, mg::Unit& u) const {
        int L = i * G + c; if (L >= 1024 * nrep) return false; L %= 1024; mg::tile_of(L, 256, 4, u.pm, u.pn); u.ty = 0; u.gi = nullptr;
        u.a = (const char*)(ws + WS_MRG) + (size_t)u.pm * 256 * 2048; u.b = (const char*)(ws + WS_WOT) + (size_t)u.pn * 256 * 2048; return true;
    }
};
struct SchedUp {
    static constexpr int TSLOT = 4; unsigned char* ws; int G, c, nrep; int erep = 1;
    __device__ __forceinline__ bool next(int i, mg::Unit& u) const {
        int L = i * G + c; if (L >= 4096 * nrep) return false; L %= 4096; mg::tile_of(L, 512, 8, u.pm, u.pn); u.ty = 0;
        u.a = (const char*)(ws + WS_HX2); u.gi = (const int*)(ws + WS_IDX) + (size_t)u.pm * 256; u.b = (const char*)(ws + WS_WGU) + ((size_t)(u.pm >> 5) * 8 + u.pn) * 256 * 1024; return true;
    }
};
struct SchedDown {
    static constexpr int TSLOT = 5; unsigned char* ws; int G, c, nrep; int erep = 1;
    __device__ __forceinline__ bool next(int i, mg::Unit& u) const {
        int L = i * G + c; if (L >= 2048 * nrep) return false; L %= 2048; mg::tile_of(L, 512, 4, u.pm, u.pn); u.ty = 0;
        u.a = (const char*)(ws + WS_HID); u.gi = (const int*)(ws + WS_IDENT) + (size_t)u.pm * 256; u.b = (const char*)(ws + WS_WD) + ((size_t)(u.pm >> 5) * 4 + u.pn) * 256 * 1024; return true;
    }
};

__device__ __forceinline__ void transpose_item(const float* W, int ldw, int n0, int k0, bf16* dst, int drow0, int Kd, LAS float* scr, int lane) {
#pragma unroll 8
    for (int i = 0; i < 32; ++i) { const int kk = 2 * i + (lane >> 5); scr[kk * 33 + (lane & 31)] = W[(size_t)(k0 + kk) * ldw + n0 + (lane & 31)]; }
    asm volatile("s_waitcnt lgkmcnt(0)" ::: "memory");
    const int c = lane & 7;
#pragma unroll
    for (int j = 0; j < 4; ++j) { const int n = (lane >> 3) + 8 * j; const LAS float* s = scr + (8 * c) * 33 + n;
        u32x4 o; o.x = pk2(s[0 * 33], s[1 * 33]); o.y = pk2(s[2 * 33], s[3 * 33]); o.z = pk2(s[4 * 33], s[5 * 33]); o.w = pk2(s[6 * 33], s[7 * 33]);
        *(u32x4*)(dst + (size_t)(drow0 + n) * Kd + k0 + 8 * c) = o; }
    asm volatile("s_waitcnt lgkmcnt(0)" ::: "memory");
}

__device__ __forceinline__ void transpose_item8(const float* W, int ldw, int n0, int k0, unsigned char* dst, int drow0, int Kd, LAS float* scr, int lane) {
#pragma unroll 8
    for (int i = 0; i < 32; ++i) { const int kk = 2 * i + (lane >> 5); scr[kk * 33 + (lane & 31)] = __builtin_nontemporal_load(W + (size_t)(k0 + kk) * ldw + n0 + (lane & 31)) * W8_SCALE; }
    asm volatile("s_waitcnt lgkmcnt(0)" ::: "memory");
    const int c = lane & 7;
#pragma unroll
    for (int j = 0; j < 4; ++j) { const int n = (lane >> 3) + 8 * j; const LAS float* s = scr + (8 * c) * 33 + n;
        u32x2 o; o.x = pk4_fp8(s[0 * 33], s[1 * 33], s[2 * 33], s[3 * 33]); o.y = pk4_fp8(s[4 * 33], s[5 * 33], s[6 * 33], s[7 * 33]);
        *(u32x2*)(dst + (size_t)(drow0 + n) * Kd + k0 + 8 * c) = o; }
    asm volatile("s_waitcnt lgkmcnt(0)" ::: "memory");
}

__device__ __forceinline__ void split8(const float (&x)[8], bf16x8& hi, bf16x8& lo) {
    u32x4 h, l;
    h.x = pk2(x[0], x[1]); h.y = pk2(x[2], x[3]); h.z = pk2(x[4], x[5]); h.w = pk2(x[6], x[7]);
    l.x = pk2(x[0] - bflo(h.x), x[1] - bfhi(h.x)); l.y = pk2(x[2] - bflo(h.y), x[3] - bfhi(h.y)); l.z = pk2(x[4] - bflo(h.z), x[5] - bfhi(h.z)); l.w = pk2(x[6] - bflo(h.w), x[7] - bfhi(h.w));
    hi = __builtin_bit_cast(bf16x8, h); lo = __builtin_bit_cast(bf16x8, l);
}
__device__ __forceinline__ void p0_prep(const Ctx& C, LAS unsigned char* lds, int tid, int lane, int wave, int G) {
    const int blk = blockIdx.x;
    for (int item = blk; item < 384; item += 2 * G) {
        const bool two = item + G < 384; const int n0 = item * 16, n1 = (two ? item + G : item) * 16, i = lane & 15, g = lane >> 4;
        f32x4 acc[2][3];
#pragma unroll
        for (int q = 0; q < 2; ++q)
#pragma unroll
            for (int rt = 0; rt < 3; ++rt) acc[q][rt] = (f32x4){0.f, 0.f, 0.f, 0.f};
        float wv[2][4][8]; f32x4 cv[4][3][2];
#pragma unroll
        for (int sx = 0; sx < 4; ++sx) { const int k0 = 32 * (4 * wave + sx) + 8 * g;
#pragma unroll
            for (int e = 0; e < 8; ++e) { wv[0][sx][e] = C.w_ada[(size_t)(k0 + e) * 6144 + n0 + i]; wv[1][sx][e] = C.w_ada[(size_t)(k0 + e) * 6144 + n1 + i]; }
#pragma unroll
            for (int rt = 0; rt < 3; ++rt) { const float* cp = rt < 2 ? C.c + (size_t)(16 * rt + i) * 1024 + k0 : (i == 0 ? C.c_ctx + k0 : C.c + (size_t)i * 1024 + k0);
                cv[sx][rt][0] = *(const f32x4*)cp; cv[sx][rt][1] = *(const f32x4*)(cp + 4); } }
#pragma unroll
        for (int sx = 0; sx < 4; ++sx) { bf16x8 ah[2], al[2]; split8(wv[0][sx], ah[0], al[0]); split8(wv[1][sx], ah[1], al[1]);
#pragma unroll
            for (int rt = 0; rt < 3; ++rt) { float sv[8];
#pragma unroll
                for (int e = 0; e < 4; ++e) { sv[e] = silu_f(cv[sx][rt][0][e]); sv[4 + e] = silu_f(cv[sx][rt][1][e]); }
                bf16x8 bh, bl; split8(sv, bh, bl);
#pragma unroll
                for (int q = 0; q < 2; ++q) {
                    acc[q][rt] = __builtin_amdgcn_mfma_f32_16x16x32_bf16(ah[q], bh, acc[q][rt], 0, 0, 0);
                    acc[q][rt] = __builtin_amdgcn_mfma_f32_16x16x32_bf16(al[q], bh, acc[q][rt], 0, 0, 0);
                    acc[q][rt] = __builtin_amdgcn_mfma_f32_16x16x32_bf16(ah[q], bl, acc[q][rt], 0, 0, 0); } } }
        LAS f32x4* red = (LAS f32x4*)lds;
#pragma unroll
        for (int q = 0; q < 2; ++q)
#pragma unroll
            for (int rt = 0; rt < 3; ++rt) red[((q * 8 + wave) * 3 + rt) * 64 + lane] = acc[q][rt];
        __syncthreads();
        float* mod = (float*)(C.ws + WS_MOD);
        for (int o = tid; o < (two ? 2 : 1) * 33 * 16; o += 512) { const int q = o >= 33 * 16, oo = o - q * 33 * 16, r = oo >> 4, n = oo & 15; float sacc = 0.f;
#pragma unroll
            for (int w = 0; w < 8; ++w) sacc += ((const LAS float*)(red + ((q * 8 + w) * 3 + (r >> 4)) * 64 + ((n >> 2) * 16 + (r & 15))))[n & 3];
            const int nn = (q ? n1 : n0) + n; mod[(size_t)r * 6144 + nn] = sacc + C.b_ada[nn]; }
        __syncthreads();
    }
    {   const int NGW = G * 8;
        for (int d = blk * 8 + wave; d < 1024; d += NGW) { const float sg = (lane & 1) ? -1.f : 1.f;
#pragma unroll
            for (int g = 0; g < 4; ++g) { const float* wp = C.w_in + (size_t)d * INC + g * 128; const float sv = wave_sum(sg * (wp[lane] + wp[lane + 64])); if (lane == 0) ((float*)(C.ws + WS_W64))[d * 4 + g] = sv; } }
    }
}
__device__ __forceinline__ void p0_wtf(const Ctx& C, LAS unsigned char* lds, int tid, int vb, int nvb) {
    LAS float* cs = (LAS float*)lds; LAS float* sn = cs + 128; const int lane = tid & 63, wave = tid >> 6, i = lane & 15, g4 = lane >> 4;
    if (tid < 128) { cs[tid] = cospif((float)tid * (1.f / 64.f)); sn[tid] = sinpif((float)tid * (1.f / 64.f)); }
    __syncthreads();
    for (int item = vb; item < 256; item += nvb) {
        const int g = item >> 6, d0 = (item & 63) * 16; const int rj = 16 * wave + i, jj = rj >> 1; const LAS float* tw = (rj & 1) ? sn : cs;
        const float* ap = C.w_in + (size_t)(d0 + i) * INC + g * 128 + 8 * g4;
        f32x4 av[4][2];
#pragma unroll
        for (int ks = 0; ks < 4; ++ks) { av[ks][0] = *(const f32x4*)(ap + 32 * ks); av[ks][1] = *(const f32x4*)(ap + 32 * ks + 4); }
        f32x4 acc = {0.f, 0.f, 0.f, 0.f};
#pragma unroll
        for (int ks = 0; ks < 4; ++ks) { float a8[8], b8[8];
#pragma unroll
            for (int e = 0; e < 4; ++e) { a8[e] = av[ks][0][e]; a8[4 + e] = av[ks][1][e]; }
#pragma unroll
            for (int e = 0; e < 8; ++e) b8[e] = tw[(jj * (32 * ks + 8 * g4 + e)) & 127];
            bf16x8 ah, al, bh, bl; split8(a8, ah, al); split8(b8, bh, bl);
            acc = __builtin_amdgcn_mfma_f32_16x16x32_bf16(ah, bh, acc, 0, 0, 0);
            acc = __builtin_amdgcn_mfma_f32_16x16x32_bf16(al, bh, acc, 0, 0, 0);
            acc = __builtin_amdgcn_mfma_f32_16x16x32_bf16(ah, bl, acc, 0, 0, 0); }
        u32x2 o; o.x = pk2(acc[0], acc[1]); o.y = pk2(acc[2], acc[3]);
        *(u32x2*)((bf16*)(C.ws + WS_WTF) + (size_t)(g * 128 + rj) * 1024 + d0 + 4 * g4) = o;
    }
    __syncthreads();
}
__device__ __forceinline__ void p0_tt(const Ctx& C, LAS unsigned char* lds, int tid, int vb, int nvb) {
    {
        LAS float* tc = (LAS float*)lds; LAS float* ts = tc + 2048;
        for (int i = tid; i < 2048; i += 512) { const float a = (float)i * (1.f / 1024.f); tc[i] = cospif(a) * (1.f / 512.f); ts[i] = -sinpif(a) * (1.f / 512.f); }
        __syncthreads();
        for (int item = vb; item < 256; item += nvb)
            for (int rr = 0; rr < 8; ++rr) { const int k = item * 8 + rr; const int lp0 = tid * 8; const LAS float* tb = lp0 < 2048 ? tc : ts; const int l0 = lp0 & 2047; float v[8];
#pragma unroll
                for (int e = 0; e < 8; ++e) v[e] = tb[(k * (l0 + e)) & 2047];
                u32x4 o; o.x = pk2(v[0], v[1]); o.y = pk2(v[2], v[3]); o.z = pk2(v[4], v[5]); o.w = pk2(v[6], v[7]);
                *(u32x4*)((bf16*)(C.ws + WS_TT) + (size_t)k * 4096 + lp0) = o; }
        __syncthreads();
    }
}
__device__ __forceinline__ void p0_weights(const Ctx& C, LAS unsigned char* lds, int tid, int lane, int wave, int G) {
    const int blk = blockIdx.x;
    {
        LAS float* scr = (LAS float*)lds + wave * (64 * 33);
        const int gw = blk * 8 + wave, NGW = G * 8;
        constexpr int I_IN = 16 * 128, I_M = 8 * 32, I_O = 16 * 32;
        for (int it = gw; it < I_IN + I_M + I_O; it += NGW) {
            int r = it;
            if (r < I_IN) { const int kb = r >> 7, nb = r & 127; const int n0 = nb < 64 ? 512 + 32 * nb : 2576 + 32 * (nb - 64);
                transpose_item(C.w_in, INC, n0, kb * 64, (bf16*)(C.ws + WS_WTM), 32 * nb, 1024, scr, lane); continue; }
            r -= I_IN;
            if (r < I_M) { const int kb = r >> 5, nb = r & 31; transpose_item(C.w_mlstm, 1024, 32 * nb, kb * 64, (bf16*)(C.ws + WS_WMT), 32 * nb, 512, scr, lane); continue; }
            r -= I_M;
            { const int kb = r >> 5, nb = r & 31; transpose_item(C.w_out, 1024, 32 * nb, kb * 64, (bf16*)(C.ws + WS_WOT), 32 * nb, 1024, scr, lane); }
        }
        for (int idx = blk * 512 + tid; idx < 1024 * 64; idx += G * 512) { const int n = idx >> 6, k0 = (idx & 63) * 8; float v[8];
#pragma unroll
            for (int e = 0; e < 8; ++e) { const int kp = k0 + e, kk = kp & 255, gg = kk >> 6, j = kk & 63; const int src = kp < 256 ? gg * 128 + j : gg * 128 + 128 - j - (j ? 0 : 64); v[e] = C.w_fourier[(size_t)src * 1024 + n]; }
            u32x4 o; o.x = pk2(v[0], v[1]); o.y = pk2(v[2], v[3]); o.z = pk2(v[4], v[5]); o.w = pk2(v[6], v[7]);
            *(u32x4*)((bf16*)(C.ws + WS_WFT) + (size_t)n * 512 + k0) = o; }
    }
}
#ifndef CVT_N1
#define CVT_T 8
#define CVT_N1 2
#define CVT_N2 10
#endif
static_assert(512 * CVT_N1 + 1536 * CVT_N2 == 24576 - 1024 * CVT_T, "conversion split");
__device__ __forceinline__ void convert_item(const Ctx& C, LAS float* scr, int it, int lane);
template <int COUNT> __device__ __forceinline__ void convert_range(const Ctx& C, LAS float* scr, int first, int lane);
__device__ __forceinline__ void convert_experts(const Ctx& C, LAS unsigned char* lds, int lane, int wave, int G, int rep, int part) {
    LAS float* scr = (LAS float*)lds + wave * (64 * 33);
    const int gw = blockIdx.x * 8 + wave, NGW = G * 8;
    if (G == 256) {
        for (int r = 0; r < rep; ++r) {
            if (part == 0) { if ((int)blockIdx.x >= 128) { const int w = gw - 1024; convert_range<CVT_T>(C, scr, w * CVT_T, lane); } }
            else if (wave < 2) { const int ib = (int)blockIdx.x * 2 + wave; convert_range<CVT_N1>(C, scr, 1024 * CVT_T + 1536 * CVT_N2 + ib * CVT_N1, lane); }
            else { const int ia = (int)blockIdx.x * 6 + wave - 2; convert_range<CVT_N2>(C, scr, 1024 * CVT_T + ia * CVT_N2, lane); } }
        return; }
    if (part == 0) return;
    for (int it0 = gw; it0 < 48 * 512 * rep; it0 += NGW) convert_item(C, scr, it0 % (48 * 512), lane);
}
__device__ __forceinline__ void convert_item(const Ctx& C, LAS float* scr, int it, int lane) { {
        const int mat = it >> 9, r = it & 511, kb = r >> 5, nb = r & 31, e = mat & 15, which = mat >> 4;
        if (which < 2) { const float* W = (which ? C.w_up_e : C.w_gate_e) + (size_t)e * 1024 * 1024; const int n0 = 32 * nb;
            transpose_item8(W, 1024, n0, kb * 64, C.ws + WS_WGU, e * 2048 + (n0 >> 7) * 256 + which * 128 + (n0 & 127), 1024, scr, lane); }
        else transpose_item8(C.w_down_e + (size_t)e * 1024 * 1024, 1024, 32 * nb, kb * 64, C.ws + WS_WD, e * 1024 + 32 * nb, 1024, scr, lane);
    }
}
__device__ __forceinline__ void cvt_desc(const float* wg, const float* wu, const float* wd, unsigned char* wsb, int it, int lane, const float*& src, unsigned char*& dst) {
    const int mat = it >> 9, r = it & 511, kb = r >> 5, nb = r & 31, e = mat & 15, which = mat >> 4, k0 = kb * 64, n0 = 32 * nb;
    const float* w = wg; if (which == 1) w = wu; if (which == 2) w = wd;
    src = w + (size_t)e * 1024 * 1024 + (size_t)(k0 + (lane >> 5)) * 1024 + n0 + (lane & 31);
    const size_t row = which < 2 ? (size_t)(e * 2048 + (n0 >> 7) * 256 + which * 128 + (n0 & 127)) : (size_t)(WS_WD - WS_WGU) / 1024 + (size_t)(e * 1024 + n0);
    dst = wsb + WS_WGU + row * 1024 + k0;
}
__device__ __forceinline__ void cvt_load(const float* src, float (&v)[32]) {
#pragma unroll
    for (int i = 0; i < 32; ++i) v[i] = __builtin_nontemporal_load(src + (size_t)i * 2048);
}
__device__ __forceinline__ void cvt_finish(LAS float* scr, const float (&v)[32], unsigned char* dst, int lane) {
#pragma unroll
    for (int i = 0; i < 32; ++i) scr[(2 * i + (lane >> 5)) * 33 + (lane & 31)] = v[i] * W8_SCALE;
    asm volatile("s_waitcnt lgkmcnt(0)" ::: "memory");
    const int c = lane & 7;
#pragma unroll
    for (int j = 0; j < 4; ++j) { const int n = (lane >> 3) + 8 * j; const LAS float* sp = scr + (8 * c) * 33 + n;
        u32x2 o; o.x = pk4_fp8(sp[0 * 33], sp[1 * 33], sp[2 * 33], sp[3 * 33]); o.y = pk4_fp8(sp[4 * 33], sp[5 * 33], sp[6 * 33], sp[7 * 33]);
        *(u32x2*)(dst + (size_t)n * 1024 + 8 * c) = o; }
    asm volatile("s_waitcnt lgkmcnt(0)" ::: "memory");
}
template <int COUNT> __device__ __forceinline__ void convert_range(const Ctx& C_, LAS float* scr, int first, int lane) {
    static_assert(COUNT % 2 == 0, "pairs");
    const float* wg = C_.w_gate_e; const float* wu = C_.w_up_e; const float* wd = C_.w_down_e; unsigned char* wsb = C_.ws; asm volatile("" : "+s"(wg), "+s"(wu), "+s"(wd));
    float va[32], vb[32]; const float* sa; const float* sb; unsigned char* da; unsigned char* db;
    cvt_desc(wg, wu, wd, wsb, first, lane, sa, da); cvt_load(sa, va);
#pragma unroll 1
    for (int k = 0; k < COUNT; k += 2) {
        cvt_desc(wg, wu, wd, wsb, first + k + 1, lane, sb, db); cvt_load(sb, vb);
        cvt_finish(scr, va, da, lane);
        if (k + 2 < COUNT) { cvt_desc(wg, wu, wd, wsb, first + k + 2, lane, sa, da); cvt_load(sa, va); }
        cvt_finish(scr, vb, db, lane); }
}

__device__ __forceinline__ float swap_add32(float a, float b) { const u32x2 r = __builtin_amdgcn_permlane32_swap(__float_as_uint(a), __float_as_uint(b), false, false); return __uint_as_float(r.x) + __uint_as_float(r.y); }
__device__ __forceinline__ float swap_add16(float a, float b) { const u32x2 r = __builtin_amdgcn_permlane16_swap(__float_as_uint(a), __float_as_uint(b), false, false); return __uint_as_float(r.x) + __uint_as_float(r.y); }
__device__ __forceinline__ float butterfly64(float (&v)[64], int lane) {
#pragma unroll
    for (int i = 0; i < 32; ++i) v[i] = swap_add32(v[i], v[i + 32]);
#pragma unroll
    for (int i = 0; i < 16; ++i) v[i] = swap_add16(v[i], v[i + 16]);
#pragma unroll
    for (int i = 0; i < 8; ++i) { const bool up = lane & 8; const float send = up ? v[i] : v[i + 8], keep = up ? v[i + 8] : v[i]; v[i] = keep + __shfl_xor(send, 8); }
#pragma unroll
    for (int i = 0; i < 4; ++i) { const bool up = lane & 4; const float send = up ? v[i] : v[i + 4], keep = up ? v[i + 4] : v[i]; v[i] = keep + __shfl_xor(send, 4); }
#pragma unroll
    for (int i = 0; i < 2; ++i) { const bool up = lane & 2; const float send = up ? v[i] : v[i + 2], keep = up ? v[i + 2] : v[i]; v[i] = keep + __shfl_xor(send, 2); }
    { const bool up = lane & 1; const float send = up ? v[0] : v[1], keep = up ? v[1] : v[0]; v[0] = keep + __shfl_xor(send, 1); }
    return v[0];
}

__device__ __forceinline__ float butterfly16(float (&v)[16], int lane) {
#pragma unroll
    for (int i = 0; i < 8; ++i) v[i] = swap_add32(v[i], v[i + 8]);
#pragma unroll
    for (int i = 0; i < 4; ++i) v[i] = swap_add16(v[i], v[i + 4]);
#pragma unroll
    for (int i = 0; i < 2; ++i) { const bool up = lane & 8; const float send = up ? v[i] : v[i + 2], keep = up ? v[i + 2] : v[i]; v[i] = keep + __shfl_xor(send, 8); }
    { const bool up = lane & 4; const float send = up ? v[0] : v[1], keep = up ? v[1] : v[0]; v[0] = keep + __shfl_xor(send, 4); }
    v[0] += __shfl_xor(v[0], 2); v[0] += __shfl_xor(v[0], 1);
    return v[0];
}
template <bool OUT8, bool PROJ4, bool IN16 = false> __device__ __forceinline__ float rows4_norm_proj(const float* xin, size_t row0, const f32x4 (&gsc)[4], const f32x4 (&sh)[4], bf16* hout, const LAS float* wl, const LAS float* wl2, float& p4, int lane, const u32x2 (*raw)[4] = nullptr) {
    f32x4 v[4][4]; float ss[4];
#pragma unroll
    for (int r = 0; r < 4; ++r) { ss[r] = 0.f;
#pragma unroll
        for (int j = 0; j < 4; ++j) { if constexpr (IN16) { const u32x2 pw = raw ? raw[r][j] : *(const u32x2*)((const bf16*)xin + (row0 + r) * 1024 + 4 * lane + 256 * j); v[r][j] = (f32x4){bflo(pw.x), bfhi(pw.x), bflo(pw.y), bfhi(pw.y)}; }
            else v[r][j] = __builtin_nontemporal_load((const f32x4*)(xin + (row0 + r) * 1024 + 4 * lane + 256 * j));
            ss[r] += v[r][j][0] * v[r][j][0] + v[r][j][1] * v[r][j][1] + v[r][j][2] * v[r][j][2] + v[r][j][3] * v[r][j][3]; } }
#pragma unroll
    for (int r = 0; r < 4; ++r) { const float rstd = rsqrtf(wave_sum(ss[r]) * (1.f / 1024.f) + EPS);
#pragma unroll
        for (int j = 0; j < 4; ++j) { v[r][j] = v[r][j] * rstd * gsc[j] + sh[j];
            if constexpr (OUT8) *(unsigned*)((unsigned char*)hout + (row0 + r) * 1024 + 4 * lane + 256 * j) = pk4_fp8(v[r][j][0], v[r][j][1], v[r][j][2], v[r][j][3]);
            else { u32x2 w; w.x = pk2(v[r][j][0], v[r][j][1]); w.y = pk2(v[r][j][2], v[r][j][3]); *(u32x2*)(hout + (row0 + r) * 1024 + 4 * lane + 256 * j) = w; } } }
    f32x2 accp[32], acc2p[8];
#pragma unroll
    for (int i = 0; i < 32; ++i) accp[i] = (f32x2){0.f, 0.f};
#pragma unroll
    for (int i = 0; i < 8; ++i) acc2p[i] = (f32x2){0.f, 0.f};
#pragma unroll
    for (int j = 0; j < 4; ++j)
#pragma unroll
        for (int e = 0; e < 4; ++e) { const LAS float* wp = wl + ((j * 4 + e) * 4) * 256 + lane * 4;
            if constexpr (PROJ4) { const f32x4 wb = *(const LAS f32x4*)(wl2 + ((j * 4 + e) * 64 + lane) * 4); const f32x2 wb0 = {wb[0], wb[1]}, wb1 = {wb[2], wb[3]};
#pragma unroll
                for (int r = 0; r < 4; ++r) { const f32x2 hv2 = {v[r][j][e], v[r][j][e]}; acc2p[r * 2] = __builtin_elementwise_fma(hv2, wb0, acc2p[r * 2]); acc2p[r * 2 + 1] = __builtin_elementwise_fma(hv2, wb1, acc2p[r * 2 + 1]); } }
#pragma unroll
            for (int q = 0; q < 4; ++q) { const f32x4 w4 = *(const LAS f32x4*)(wp + q * 256); const f32x2 w0 = {w4[0], w4[1]}, w1 = {w4[2], w4[3]};
#pragma unroll
                for (int r = 0; r < 4; ++r) { const f32x2 hv2 = {v[r][j][e], v[r][j][e]}; accp[r * 8 + 2 * q] = __builtin_elementwise_fma(hv2, w0, accp[r * 8 + 2 * q]); accp[r * 8 + 2 * q + 1] = __builtin_elementwise_fma(hv2, w1, accp[r * 8 + 2 * q + 1]); } }
            asm volatile("" ::: "memory"); }
    float acc[64], acc2[16];
#pragma unroll
    for (int i = 0; i < 32; ++i) { acc[2 * i] = accp[i][0]; acc[2 * i + 1] = accp[i][1]; }
#pragma unroll
    for (int i = 0; i < 8; ++i) { acc2[2 * i] = acc2p[i][0]; acc2[2 * i + 1] = acc2p[i][1]; }
    if constexpr (PROJ4) p4 = butterfly16(acc2, lane);
    return butterfly64(acc, lane);
}

__device__ __forceinline__ float gate_xf(float v, int lane) { return ((lane >> 2) & 1) ? fminf(v, 0.f) - log1pf(expf(-fabsf(v))) : v; }
__device__ __forceinline__ void p1a_norm_gates(const Ctx& C, LAS unsigned char* lds, int tid, int lane, int wave, int G, int rep2) {
    LAS float* wl = (LAS float*)lds;
    for (int i = tid; i < 1024 * 16; i += 512) { const int col = i >> 4, gc = i & 15; wl[(((((col >> 8) * 4 + (col & 3)) * 4 + (gc >> 2)) * 64 + ((col >> 2) & 63)) * 4) + (gc & 3)] = C.w_in[(size_t)col * INC + OFF_G + gc]; }
    LAS float* wl2 = wl + 1024 * 16;
    for (int i = tid; i < 1024 * 4; i += 512) { const int col = i >> 2, gg = i & 3; wl2[((((col >> 8) * 4 + (col & 3)) * 64 + ((col >> 2) & 63)) * 4) + gg] = ((const float*)(C.ws + WS_W64))[i]; }
    __syncthreads();
    const float* mod = (const float*)(C.ws + WS_MOD); bf16* H = (bf16*)(C.ws + WS_H); float* gates = (float*)(C.ws + WS_GATES); bf16* a64t = (bf16*)(C.ws + WS_A64T);
    const float gbias = C.b_gates[lane & 15];
    const int NGW = G * 8;
    for (int gw0 = blockIdx.x * 8 + wave; gw0 < 2048 * (1 + rep2); gw0 += NGW) { const int gw = gw0 & 2047;
        f32x4 gsc[4], sh[4];
        {   const int b = gw >> 6; const float* m = mod + (size_t)b * 6144;
#pragma unroll
            for (int j = 0; j < 4; ++j) { const int col = 4 * lane + 256 * j; const f32x4 g = *(const f32x4*)(C.g_norm1 + col), s = *(const f32x4*)(m + 1024 + col); gsc[j] = g * (s + 1.f); sh[j] = *(const f32x4*)(m + col); }
            for (int q = 0; q < 8; ++q) { const size_t row0 = (size_t)gw * 32 + q * 4; float p4; const float gv = rows4_norm_proj<false, true>(C.x, row0, gsc, sh, H, wl, wl2, p4, lane); gates[(row0 + (lane >> 4)) * 16 + (lane & 15)] = gate_xf(gv + gbias, lane);
                if ((lane & 3) == 0) { const int idx = lane >> 2; const size_t row = row0 + (idx >> 2); a64t[((row >> 11) * 4 + (idx & 3)) * 2048 + (row & 2047)] = (bf16)(pk2(p4, 0.f) & 0xffffu); } } }
        {   const float* m = mod + (size_t)32 * 6144;
#pragma unroll
            for (int j = 0; j < 4; ++j) { const int col = 4 * lane + 256 * j; const f32x4 g = *(const f32x4*)(C.g_norm1 + col), s = *(const f32x4*)(m + 1024 + col); gsc[j] = g * (s + 1.f); sh[j] = *(const f32x4*)(m + col); }
            const size_t row0 = (size_t)gw * 4; float p4; const float gv = rows4_norm_proj<false, false>(C.ctx, row0, gsc, sh, H + (size_t)NTOK * 1024, wl, wl2, p4, lane); gates[((size_t)NTOK + row0 + (lane >> 4)) * 16 + (lane & 15)] = gate_xf(gv + gbias, lane); }
    }
}

__device__ __forceinline__ f32x4 unpk4(u32x2 p) { return (f32x4){bflo(p.x), bfhi(p.x), bflo(p.y), bfhi(p.y)}; }
__device__ __forceinline__ void conv_load_x(const Ctx& C, int item, int lane, u32x2 (&raw)[3][10]) {
    const int sg = item & 7, cb = (item >> 3) & 3, r = (item >> 5) & 31, b = item >> 10;
    const bf16* ub = (const bf16*)(C.ws + WS_PQK) + (size_t)b * SEQ * 1024 + cb * 256; const int c0 = sg * 8; unsigned lo = 4u * (unsigned)lane;
    asm volatile("" : "+s"(ub), "+v"(lo));
#pragma unroll
    for (int dy = 0; dy < 3; ++dy) { const int rr = r + dy - 1; const bool rok = rr >= 0 && rr < 32;
#pragma unroll
        for (int i = 0; i < 10; ++i) { const int cc = c0 - 1 + i; const bool ok = rok && cc >= 0 && cc < 64; const int rc = min(max(rr, 0), 31), ccl = min(max(cc, 0), 63);
            const u32x2 t = *(const u32x2*)(ub + (size_t)(rc * 64 + ccl) * 1024 + lo); raw[dy][i] = ok ? t : (u32x2){0u, 0u}; } }
}
__device__ __forceinline__ f32x2 silu2_scaled(f32x2 a, float ik) { const f32x2 x = a * (f32x2){-1.4426950408889634f, -1.4426950408889634f}; const f32x2 e = {__builtin_amdgcn_exp2f(x.x), __builtin_amdgcn_exp2f(x.y)};
    const f32x2 d = __builtin_elementwise_fma(e, (f32x2){ik, ik}, (f32x2){ik, ik}); const f32x2 r = {__builtin_amdgcn_rcpf(d.x), __builtin_amdgcn_rcpf(d.y)}; return a * r; }
__device__ __forceinline__ void conv_compute_x(const Ctx& C, int item, int lane, const u32x2 (&raw)[3][10], const f32x4 (&w)[3][3]) {
    const int sg = item & 7, cb = (item >> 3) & 3, r = (item >> 5) & 31, b = item >> 10;
    const int cq = (cb & 1) * 256 + 4 * lane;
    bf16* dst = (bf16*)(C.ws + WS_QK) + ((size_t)(b * 4 + (cq >> 7)) * SEQ) * 256 + (cb >> 1) * 128 + (cq & 127); const int c0 = sg * 8;
    const float iksc = cb >= 2 ? 11.313708498984761f : 1.f;
#pragma unroll
    for (int i = 0; i < 8; ++i) { f32x4 a = {0.f, 0.f, 0.f, 0.f};
#pragma unroll
        for (int dy = 0; dy < 3; ++dy)
#pragma unroll
            for (int dx = 0; dx < 3; ++dx) a += w[dy][dx] * unpk4(raw[dy][i + dx]);
        const f32x2 s0 = silu2_scaled((f32x2){a[0], a[1]}, iksc), s1 = silu2_scaled((f32x2){a[2], a[3]}, iksc);
        u32x2 o; o.x = pk2(s0.x, s0.y); o.y = pk2(s1.x, s1.y);
        *(u32x2*)(dst + (size_t)(r * 64 + c0 + i) * 256) = o; }
}
__device__ __forceinline__ void conv_item_ctx(const Ctx& C, int item, int lane) {
    const int sg = item & 15, cb = (item >> 4) & 1, b = item >> 5;
    const int kc0 = cb * 256 + 4 * lane; const bf16* src = (const bf16*)(C.ws + WS_PC) + (size_t)b * CL * 1024 + kc0; bf16* dst = (bf16*)(C.ws + WS_KC) + (size_t)b * CL * 512 + kc0;
    const int c0 = sg * 16;
    u32x2 raw[18];
#pragma unroll
    for (int i = 0; i < 18; ++i) { const int cc = c0 - 1 + i; raw[i] = (cc >= 0 && cc < CL) ? *(const u32x2*)(src + (size_t)cc * 1024) : (u32x2){0u, 0u}; }
    f32x4 w[3];
#pragma unroll
    for (int dx = 0; dx < 3; ++dx) w[dx] = *(const f32x4*)(C.w_conv + (3 + dx) * 1024 + 512 + kc0);
    const float ksc = 0.08838834764831845f;
#pragma unroll
    for (int i = 0; i < 16; ++i) { const f32x4 a = w[0] * unpk4(raw[i]) + w[1] * unpk4(raw[i + 1]) + w[2] * unpk4(raw[i + 2]);
        u32x2 o; o.x = pk2(silu_f(a[0]) * ksc, silu_f(a[1]) * ksc); o.y = pk2(silu_f(a[2]) * ksc, silu_f(a[3]) * ksc);
        *(u32x2*)(dst + (size_t)(c0 + i) * 512) = o; }
}
__device__ __forceinline__ void f64_tile(const Ctx& C, int tile, int lane) {
    const int kt = tile >> 3, nt8 = tile & 7, i = lane & 15, g4 = lane >> 4;
    const bf16* ap = (const bf16*)(C.ws + WS_TT) + (size_t)(16 * kt + i) * 4096 + 8 * g4; const bf16* bp = (const bf16*)(C.ws + WS_A64T) + (size_t)(16 * nt8 + i) * 2048 + 8 * g4;
    f32x4 acc = {0.f, 0.f, 0.f, 0.f};
    for (int kb = 0; kb < 64; kb += 16) {
        bf16x8 fa[16], fb[16];
#pragma unroll
        for (int q = 0; q < 16; ++q) { fa[q] = *(const bf16x8*)(ap + 32 * (kb + q)); fb[q] = *(const bf16x8*)(bp + 32 * (kb + q)); }
        __builtin_amdgcn_sched_barrier(0);
#pragma unroll
        for (int q = 0; q < 16; ++q) acc = __builtin_amdgcn_mfma_f32_16x16x32_bf16(fa[q], fb[q], acc, 0, 0, 0);
        __builtin_amdgcn_sched_barrier(0); }
    const int n = 16 * nt8 + i; bf16* fo = (bf16*)(C.ws + WS_FU) + ((size_t)(n >> 2) * 2048 + 16 * kt + 4 * g4) * 512 + 256 + (n & 3) * 64;
#pragma unroll
    for (int r = 0; r < 4; ++r) fo[(size_t)r * 512] = (bf16)(pk2(acc[r], 0.f) & 0xffffu);
}
__device__ __forceinline__ void conv_load_row(const bf16* ub, unsigned lo, int rr, int c0, u32x2 (&row)[10]) {
    const bool rok = rr >= 0 && rr < 32; const int rc = min(max(rr, 0), 31);
#pragma unroll
    for (int i = 0; i < 10; ++i) { const int cc = c0 - 1 + i; const bool ok = rok && cc >= 0 && cc < 64; const int ccl = min(max(cc, 0), 63);
        const u32x2 t = __builtin_nontemporal_load((const u32x2*)(ub + (size_t)(rc * 64 + ccl) * 1024 + lo)); row[i] = ok ? t : (u32x2){0u, 0u}; }
}
__device__ __forceinline__ void conv_out_row(bf16* dst, const u32x2 (&ra)[10], const u32x2 (&rb)[10], const u32x2 (&rc)[10], const f32x4 (&w)[3][3], float iksc) {
#pragma unroll
    for (int i = 0; i < 8; ++i) { f32x4 a = {0.f, 0.f, 0.f, 0.f};
#pragma unroll
        for (int dx = 0; dx < 3; ++dx) { a += w[0][dx] * unpk4(ra[i + dx]); a += w[1][dx] * unpk4(rb[i + dx]); a += w[2][dx] * unpk4(rc[i + dx]); }
        const f32x2 s0 = silu2_scaled((f32x2){a[0], a[1]}, iksc), s1 = silu2_scaled((f32x2){a[2], a[3]}, iksc);
        u32x2 o; o.x = pk2(s0.x, s0.y); o.y = pk2(s1.x, s1.y);
        *(u32x2*)(dst + (size_t)i * 256) = o; }
}
__device__ __forceinline__ void conv_strip(const Ctx& C, int strip, int lane) {
    const int half = strip & 1, sg = (strip >> 1) & 7, cb = (strip >> 4) & 3, b = strip >> 6, rbase = 16 * half, c0 = sg * 8;
    f32x4 w[3][3];
#pragma unroll
    for (int dy = 0; dy < 3; ++dy)
#pragma unroll
        for (int dx = 0; dx < 3; ++dx) w[dy][dx] = *(const f32x4*)(C.w_conv + (dy * 3 + dx) * 1024 + cb * 256 + 4 * lane);
    const bf16* ub = (const bf16*)(C.ws + WS_PQK) + (size_t)b * SEQ * 1024 + cb * 256; unsigned lo = 4u * (unsigned)lane;
    asm volatile("" : "+s"(ub), "+v"(lo));
    const int cq = (cb & 1) * 256 + 4 * lane;
    bf16* dst = (bf16*)(C.ws + WS_QK) + ((size_t)(b * 4 + (cq >> 7)) * SEQ) * 256 + (cb >> 1) * 128 + (cq & 127) + (size_t)c0 * 256;
    const float iksc = cb >= 2 ? 11.313708498984761f : 1.f;
    u32x2 R0[10], R1[10], R2[10], R3[10];
    conv_load_row(ub, lo, rbase - 1, c0, R0); conv_load_row(ub, lo, rbase, c0, R1); conv_load_row(ub, lo, rbase + 1, c0, R2);
#pragma unroll 1
    for (int q = 0; q < 16; q += 4) { const int r = rbase + q; bf16* d = dst + (size_t)r * 64 * 256;
        conv_load_row(ub, lo, r + 2, c0, R3); conv_out_row(d, R0, R1, R2, w, iksc);
        conv_load_row(ub, lo, r + 3, c0, R0); conv_out_row(d + (size_t)64 * 256, R1, R2, R3, w, iksc);
        conv_load_row(ub, lo, r + 4, c0, R1); conv_out_row(d + (size_t)128 * 256, R2, R3, R0, w, iksc);
        conv_load_row(ub, lo, r + 5, c0, R2); conv_out_row(d + (size_t)192 * 256, R3, R0, R1, w, iksc); }
}
__device__ __forceinline__ void p2_conv(const Ctx& C, int lane, int wave, int G, int rep2) {
    const int NGW = G * 8;
    for (int it = wave * G + (int)blockIdx.x; it < 1024; it += NGW) f64_tile(C, it, lane);
    const int vblk = (int)blockIdx.x;
    for (int rep = 0; rep <= rep2; ++rep) {
        for (int st = vblk * 8 + wave; st < NB * 64; st += NGW) conv_strip(C, st, lane);
        for (int itc = ((wave + 4) & 7) * G + vblk; itc < NB * 32; itc += NGW) conv_item_ctx(C, itc, lane);
    }
}

__device__ __forceinline__ void p3b_combine(const Ctx& C, int tid, int G, int rep2) {
    const u32x2* po = (const u32x2*)(C.ws + WS_PO); const u32x4* hf = (const u32x4*)(C.ws + WS_HF); const u32x4* hb = (const u32x4*)(C.ws + WS_HB); u32x4* hm = (u32x4*)(C.ws + WS_HM);
    const size_t n = (size_t)NTOK * 512 / 8;
    for (size_t i0 = (size_t)blockIdx.x * 512 + tid; i0 < n * (1 + rep2); i0 += (size_t)G * 512) { const size_t i = i0 >= n ? i0 - n : i0; const u32x2 o = __builtin_nontemporal_load(po + i); const u32x4 a = __builtin_nontemporal_load(hf + i), b = __builtin_nontemporal_load(hb + i); u32x4 r;
        r.x = pk2(u8f0(o.x) * (bflo(a.x) + bflo(b.x)), u8f1(o.x) * (bfhi(a.x) + bfhi(b.x))); r.y = pk2(u8f2(o.x) * (bflo(a.y) + bflo(b.y)), u8f3(o.x) * (bfhi(a.y) + bfhi(b.y)));
        r.z = pk2(u8f0(o.y) * (bflo(a.z) + bflo(b.z)), u8f1(o.y) * (bfhi(a.z) + bfhi(b.z))); r.w = pk2(u8f2(o.y) * (bflo(a.w) + bflo(b.w)), u8f3(o.y) * (bfhi(a.w) + bfhi(b.w)));
        hm[i] = r; }
}

__device__ __forceinline__ void p6_norm_router(const Ctx& C, LAS unsigned char* lds, int tid, int lane, int wave, int G, int rep2) {
    LAS float* wl = (LAS float*)lds;
    for (int i = tid; i < 1024 * 16; i += 512) { const int col = i >> 4, gc = i & 15; wl[(((((col >> 8) * 4 + (col & 3)) * 4 + (gc >> 2)) * 64 + ((col >> 2) & 63)) * 4) + (gc & 3)] = C.w_router[i]; }
    __syncthreads();
    const float* mod = (const float*)(C.ws + WS_MOD); bf16* HX2 = (bf16*)(C.ws + WS_HX2); float* aff = (float*)(C.ws + WS_AFF);
    const int NGW = G * 8;
    for (int gw0 = blockIdx.x * 8 + wave; gw0 < 2048 * (1 + rep2); gw0 += NGW) { const int gw = gw0 & 2047;
        f32x4 gsc[4], sh[4]; const int b = gw >> 6; const float* m = mod + (size_t)b * 6144;
#pragma unroll
        for (int j = 0; j < 4; ++j) { const int col = 4 * lane + 256 * j; const f32x4 g = *(const f32x4*)(C.g_norm2 + col), s = *(const f32x4*)(m + 4096 + col); gsc[j] = g * (s + 1.f); sh[j] = *(const f32x4*)(m + 3072 + col); }
        u32x2 rawc[4][4], rawn[4][4];
#pragma unroll
        for (int r = 0; r < 4; ++r)
#pragma unroll
            for (int j = 0; j < 4; ++j) rawc[r][j] = *(const u32x2*)((const bf16*)(C.ws + WS_X1) + ((size_t)gw * 32 + r) * 1024 + 4 * lane + 256 * j);
        for (int q = 0; q < 8; ++q) { const size_t row0 = (size_t)gw * 32 + q * 4;
            if (q < 7) {
#pragma unroll
                for (int r = 0; r < 4; ++r)
#pragma unroll
                    for (int j = 0; j < 4; ++j) rawn[r][j] = *(const u32x2*)((const bf16*)(C.ws + WS_X1) + (row0 + 4 + r) * 1024 + 4 * lane + 256 * j); }
            float p4; const float lg = rows4_norm_proj<true, false, true>((const float*)(C.ws + WS_X1), row0, gsc, sh, HX2, wl, wl, p4, lane, rawc);
#pragma unroll
            for (int r = 0; r < 4; ++r)
#pragma unroll
                for (int j = 0; j < 4; ++j) rawc[r][j] = rawn[r][j];
            float mx = lg;
#pragma unroll
            for (int o = 1; o < 16; o <<= 1) mx = fmaxf(mx, __shfl_xor(mx, o));
            const float ex = expf(lg - mx); float sm = ex;
#pragma unroll
            for (int o = 1; o < 16; o <<= 1) sm += __shfl_xor(sm, o);
            const size_t t = (row0 + (lane >> 4)) & (SEQ - 1);
            aff[((size_t)b * NE + (lane & 15)) * SEQ + t] = ex / sm; }
    }
}

__device__ __forceinline__ unsigned wave_excl_scan_u(unsigned v, int lane) { unsigned s = v; (void)lane;
#define TK_DPP(ctrl, rmask) s += (unsigned)__builtin_amdgcn_update_dpp(0, (int)s, ctrl, rmask, 0xf, false);
    TK_DPP(0x111, 0xf) TK_DPP(0x112, 0xf) TK_DPP(0x114, 0xf) TK_DPP(0x118, 0xf) TK_DPP(0x142, 0xa) TK_DPP(0x143, 0xc)
#undef TK_DPP
    return s - v;
}
__device__ __forceinline__ void topk_item(const Ctx& C, int item, int lane) {
    const int b = item >> 4, e = item & 15; const float* a = (const float*)(C.ws + WS_AFF) + ((size_t)b * NE + e) * SEQ + 32 * lane;
    unsigned key[32];
#pragma unroll
    for (int q = 0; q < 8; ++q) { const u32x4 v = __builtin_nontemporal_load((const u32x4*)(a + 4 * q)); key[4 * q] = v.x; key[4 * q + 1] = v.y; key[4 * q + 2] = v.z; key[4 * q + 3] = v.w; }
    unsigned T = 0u;
    for (int bit = 30; bit >= 0; --bit) { const unsigned cand = T | (1u << bit); unsigned cnt = 0u;
#pragma unroll
        for (int i = 0; i < 32; ++i) cnt += (unsigned)__builtin_popcountll(__ballot(key[i] >= cand));
        if (cnt >= (unsigned)CAP) T = cand; }
    unsigned ngt = 0u, neq = 0u;
#pragma unroll
    for (int i = 0; i < 32; ++i) { ngt += (unsigned)__builtin_popcountll(__ballot(key[i] > T)); neq += key[i] == T ? 1u : 0u; }
    const unsigned need = (unsigned)CAP - ngt;
    unsigned tie_before = wave_excl_scan_u(neq, lane);
    unsigned nsel = 0u; unsigned selmask = 0u;
#pragma unroll
    for (int i = 0; i < 32; ++i) { bool s = key[i] > T; if (key[i] == T) { s = tie_before < need; ++tie_before; } if (s) { selmask |= 1u << i; ++nsel; } }
    unsigned slot = wave_excl_scan_u(nsel, lane);
    const int pm = e * 32 + b; int* idx = (int*)(C.ws + WS_IDX) + (size_t)pm * CAP; float* val = (float*)(C.ws + WS_VAL) + (size_t)pm * CAP; bf16* sl = (bf16*)(C.ws + WS_SLOT); float* vt = (float*)(C.ws + WS_VALT);
    unsigned sw[16];
#pragma unroll
    for (int i = 0; i < 32; ++i) { const int t = 32 * lane + i; const bool s = (selmask >> i) & 1u;
        if (s) { idx[slot] = b * SEQ + t; val[slot] = __uint_as_float(key[i]); }
        const unsigned h = s ? (slot & 0xffffu) : 0xffffu; if (i & 1) sw[i >> 1] |= h << 16; else sw[i >> 1] = h;
        if (VAL_IN_FINAL) vt[((size_t)b * SEQ + t) * NE + e] = s ? __uint_as_float(key[i]) : 0.f; if (s) ++slot; }
    u32x4* so = (u32x4*)(sl + ((size_t)(b * NE + e) * SEQ + 32 * lane));
#pragma unroll
    for (int q = 0; q < 4; ++q) so[q] = (u32x4){sw[4 * q], sw[4 * q + 1], sw[4 * q + 2], sw[4 * q + 3]};
}

__device__ __forceinline__ f32x4 fp8x4_to_f32(unsigned w) { const f32x2 lo = __builtin_amdgcn_cvt_pk_f32_fp8(w, false), hi = __builtin_amdgcn_cvt_pk_f32_fp8(w, true); return (f32x4){lo[0], lo[1], hi[0], hi[1]}; }
__device__ __forceinline__ void p10_final(const Ctx& C, int lane, int wave, int G) {
    const float* mod = (const float*)(C.ws + WS_MOD); const unsigned char* Y = C.ws + WS_Y; const bf16* sl = (const bf16*)(C.ws + WS_SLOT);
    const int NGW = G * 8;
    for (int gw = blockIdx.x * 8 + wave; gw < 2048; gw += NGW) { const int b = gw >> 6; const float* m = mod + (size_t)b * 6144 + 5120;
        f32x4 ga[4], gf[4];
#pragma unroll
        for (int j = 0; j < 4; ++j) { ga[j] = *(const f32x4*)(m + 4 * lane + 256 * j) * Y8_INV; gf[j] = *(const f32x4*)(C.g_final + 4 * lane + 256 * j); }
        u32x2 xr[4][4]; unsigned t[4][2][4]; bool tv[4][2]; unsigned em[4];
        const u32x4 SW = *(const u32x4*)(sl + ((size_t)(b * NE + (lane & 15)) * SEQ + (gw & 63) * 32 + 8 * (lane >> 4)));
#define FIN_W(q_, r) (((q_) & 1) ? ((r) >> 1 ? SW.w : SW.z) : ((r) >> 1 ? SW.y : SW.x))
#define FIN_SLOT(q_, r, e_) ((__builtin_amdgcn_readlane(FIN_W(q_, r), (e_) + 16 * ((q_) >> 1)) >> (16 * ((r) & 1))) & 0xffffu)
#define FIN_ROUND(q_) do { _Pragma("unroll") for (int r = 0; r < 4; ++r) _Pragma("unroll") for (int c = 0; c < 2; ++c) { tv[r][c] = em[r] != 0u; \
            if (tv[r][c]) { const int e = __builtin_ctz(em[r]); em[r] &= em[r] - 1u; const unsigned sv = FIN_SLOT(q_, r, e); \
                const unsigned char* yr = Y + ((size_t)(e * 32 + b) * CAP + sv) * 1024 + 4 * lane; _Pragma("unroll") for (int j = 0; j < 4; ++j) t[r][c][j] = __builtin_nontemporal_load((const unsigned*)(yr + 256 * j)); } } } while (0)
#define FIN_ISSUE(q_) do { const size_t _r0 = (size_t)gw * 32 + (q_) * 4; \
            _Pragma("unroll") for (int r = 0; r < 4; ++r) _Pragma("unroll") for (int j = 0; j < 4; ++j) xr[r][j] = __builtin_nontemporal_load((const u32x2*)((const bf16*)(C.ws + WS_X1) + (_r0 + r) * 1024 + 4 * lane + 256 * j)); \
            _Pragma("unroll") for (int r = 0; r < 4; ++r) { const unsigned long long _bal = __ballot(((FIN_W(q_, r) >> (16 * (r & 1))) & 0xffffu) != 0xffffu); em[r] = (unsigned)((_bal >> (16 * ((q_) >> 1))) & 0xffffu); } \
            FIN_ROUND(q_); } while (0)
#define FIN_ACC() do { _Pragma("unroll") for (int r = 0; r < 4; ++r) _Pragma("unroll") for (int c = 0; c < 2; ++c) if (tv[r][c]) { _Pragma("unroll") for (int j = 0; j < 4; ++j) a[r][j] += fp8x4_to_f32(t[r][c][j]); } } while (0)
        FIN_ISSUE(0);
        for (int q = 0; q < 8; ++q) { const size_t row0 = (size_t)gw * 32 + q * 4; f32x4 v[4][4], a[4][4];
#pragma unroll
            for (int r = 0; r < 4; ++r)
#pragma unroll
                for (int j = 0; j < 4; ++j) { const u32x2 pw = xr[r][j]; v[r][j] = (f32x4){bflo(pw.x), bfhi(pw.x), bflo(pw.y), bfhi(pw.y)}; a[r][j] = (f32x4){0.f, 0.f, 0.f, 0.f}; }
            FIN_ACC();
            while (em[0] | em[1] | em[2] | em[3]) { FIN_ROUND(q); FIN_ACC(); }
            if (q < 7) FIN_ISSUE(q + 1);
#pragma unroll
            for (int r = 0; r < 4; ++r) { float ss = 0.f;
#pragma unroll
                for (int j = 0; j < 4; ++j) { v[r][j] = v[r][j] + ga[j] * a[r][j]; ss += v[r][j][0] * v[r][j][0] + v[r][j][1] * v[r][j][1] + v[r][j][2] * v[r][j][2] + v[r][j][3] * v[r][j][3]; }
                const float rstd = rsqrtf(wave_sum(ss) * (1.f / 1024.f) + EPS);
#pragma unroll
                for (int j = 0; j < 4; ++j) *(f32x4*)(C.out + (row0 + r) * 1024 + 4 * lane + 256 * j) = v[r][j] * rstd * gf[j]; } }
#undef FIN_ROUND
#undef FIN_W
#undef FIN_SLOT
#undef FIN_ISSUE
#undef FIN_ACC
    }
}
#ifndef ML_CVT_ON
#define ML_CVT_ON 0
#endif
namespace ml {
typedef short v4i16_t __attribute__((ext_vector_type(4)));
constexpr int TB = 49152, QO = 0, KO = 16384, VO = 32768;
constexpr int CT = 98304;
constexpr int SS = 135168;
constexpr int SM = 143360;
constexpr int GA = 384, U_ = 0, M_ = 64, DEC_ = 128, EM_ = 192, WA_ = 256, SC_ = 320;
constexpr int GST = SM + 2 * GA * 4;
static_assert(GST + 2 * 512 <= LDS_PHASE_BYTES, "mLSTM LDS map");
__device__ __forceinline__ unsigned off_b(unsigned row, unsigned ch) { return 256u * row + 16u * (ch ^ (((row & 3) << 2) | ((row >> 2) & 3))); }
__device__ __forceinline__ unsigned off_s(unsigned row, unsigned ch) { return 128u * row + 16u * (ch ^ (row & 7)); }
__device__ __forceinline__ bf16x8 rowfrag(const LAS unsigned char* tile, int rb, int ks, int lane) { return *(const LAS bf16x8*)(tile + off_b(16 * rb + (lane & 15), 4 * ks + (lane >> 4))); }
__device__ __forceinline__ bf16x8 trfrag(const LAS unsigned char* tile, int c, int ks, int lane) {
    const unsigned g = lane >> 4, q = (lane & 15) >> 2, p = lane & 3;
    const unsigned a0 = off_b(32 * ks + 8 * g + q, 2 * c + (p >> 1)) + 8 * (p & 1), a1 = off_b(32 * ks + 8 * g + 4 + q, 2 * c + (p >> 1)) + 8 * (p & 1);
    const v4i16_t lo = __builtin_amdgcn_ds_read_tr16_b64_v4i16((LAS v4i16_t*)(tile + a0)), hi = __builtin_amdgcn_ds_read_tr16_b64_v4i16((LAS v4i16_t*)(tile + a1));
    bf16x8 r; r[0] = lo[0]; r[1] = lo[1]; r[2] = lo[2]; r[3] = lo[3]; r[4] = hi[0]; r[5] = hi[1]; r[6] = hi[2]; r[7] = hi[3]; return r;
}
template <int KS> __device__ __forceinline__ bf16x8 trfrag_a(unsigned tile, int c, int lane) {
    const unsigned g = lane >> 4, q = (lane & 15) >> 2, p = lane & 3;
    const unsigned a0 = tile + off_b(8 * g + q, 2 * c + (p >> 1)) + 8 * (p & 1), a1 = tile + off_b(8 * g + 4 + q, 2 * c + (p >> 1)) + 8 * (p & 1);
    u32x2 lo, hi;
    asm volatile("ds_read_b64_tr_b16 %0, %1 offset:%2" : "=v"(lo) : "v"(a0), "n"(KS * 8192) : "memory");
    asm volatile("ds_read_b64_tr_b16 %0, %1 offset:%2" : "=v"(hi) : "v"(a1), "n"(KS * 8192) : "memory");
    const u32x4 r = {lo.x, lo.y, hi.x, hi.y}; return __builtin_bit_cast(bf16x8, r);
}
__device__ __forceinline__ void dma_b128(const void* g, unsigned ldsaddr) { asm volatile("s_mov_b32 m0, %1\n\ts_nop 0\n\tglobal_load_lds_dwordx4 %0, off" :: "v"(g), "s"(ldsaddr) : "memory", "m0"); }
__device__ __forceinline__ void dma_b32(const void* g, unsigned ldsaddr) { asm volatile("s_mov_b32 m0, %1\n\ts_nop 0\n\tglobal_load_lds_dword %0, off" :: "v"(g), "s"(ldsaddr) : "memory", "m0"); }
template <int OFF> __device__ __forceinline__ void st_b64(void* p, u32x2 v) { asm volatile("global_store_dwordx2 %0, %1, off offset:%2" :: "v"(p), "v"(v), "n"(OFF) : "memory"); }
template <int OFF> __device__ __forceinline__ void st_b128o(void* p, u32x4 v) { asm volatile("global_store_dwordx4 %0, %1, off offset:%2" :: "v"(p), "v"(v), "n"(OFF) : "memory"); }
__device__ __forceinline__ void st_b128(void* p, u32x4 v) { asm volatile("global_store_dwordx4 %0, %1, off" :: "v"(p), "v"(v) : "memory"); }
__device__ __forceinline__ unsigned rf_lane(int ks, int lane) { const unsigned i = lane & 15, g4 = lane >> 4; return 256u * i + 16u * ((4u * ks + g4) ^ (((i & 3) << 2) | ((i >> 2) & 3))); }
template <int OFF> __device__ __forceinline__ bf16x8 ldsr128(unsigned a) { u32x4 r; asm volatile("ds_read_b128 %0, %1 offset:%2" : "=v"(r) : "v"(a), "n"(OFF) : "memory"); return __builtin_bit_cast(bf16x8, r); }
#define ML_LGKM0_5(a, b, c, d, e) asm volatile("s_waitcnt lgkmcnt(0)" : "+v"(a), "+v"(b), "+v"(c), "+v"(d), "+v"(e) :: "memory")
#define ML_LGKM0_4(a, b, c, d) asm volatile("s_waitcnt lgkmcnt(0)" : "+v"(a), "+v"(b), "+v"(c), "+v"(d) :: "memory")
#define ML_LGKM0_8(a, b, c, d, e, f, g_, h) asm volatile("s_waitcnt lgkmcnt(0)" : "+v"(a), "+v"(b), "+v"(c), "+v"(d), "+v"(e), "+v"(f), "+v"(g_), "+v"(h) :: "memory")
#define ML_LGKM0_2(a, b) asm volatile("s_waitcnt lgkmcnt(0)" : "+v"(a), "+v"(b) :: "memory")
template <bool MAX> __device__ __forceinline__ float wave_scan(float v) {
    const int id = MAX ? (int)0xff800000u : 0;
#define ML_DPP(ctrl, rmask) { const float t = __int_as_float(__builtin_amdgcn_update_dpp(id, __float_as_int(v), ctrl, rmask, 0xf, false)); v = MAX ? fmaxf(v, t) : v + t; }
    ML_DPP(0x111, 0xf) ML_DPP(0x112, 0xf) ML_DPP(0x114, 0xf) ML_DPP(0x118, 0xf) ML_DPP(0x142, 0xa) ML_DPP(0x143, 0xc)
#undef ML_DPP
    return v;
}
__device__ __forceinline__ void gate_math(float ig, float fg, int pos, float& m0, LAS float* ga) {
    const float fl = fg;
    const float cum = wave_scan<false>(fl);
    const float u = ig - cum;
    const float pmx = wave_scan<true>(u);
    const float tot = __int_as_float(__builtin_amdgcn_readlane(__float_as_int(cum), 63)), umax = __int_as_float(__builtin_amdgcn_readlane(__float_as_int(pmx), 63));
    const float M = fmaxf(m0, pmx);
    const float mn = fmaxf(tot + m0, tot + umax);
    ga[U_ + pos] = u; ga[M_ + pos] = M; ga[DEC_ + pos] = __expf(m0 - M); ga[EM_ + pos] = __expf(-(cum + M)); ga[WA_ + pos] = __expf(tot + u - mn);
    if (pos == 0) ga[SC_] = __expf(tot + m0 - mn);
    m0 = mn;
}

#define ML_VM0() do { asm volatile("" ::: "memory"); __builtin_amdgcn_s_waitcnt(0x0f70); asm volatile("" ::: "memory"); } while (0)
#define ML_BAR() do { asm volatile("s_waitcnt lgkmcnt(0)" ::: "memory"); __builtin_amdgcn_s_barrier(); asm volatile("" ::: "memory"); } while (0)
__device__ __forceinline__ void mlstm_phase(const Ctx& C, LAS unsigned char* lds, int tid, int lane, int wave, int G, int rep2) {
    LAS float* sm = (LAS float*)(lds + SM); const unsigned ldsu = __builtin_amdgcn_readfirstlane((unsigned)(size_t)lds);
    const bf16* QK = (const bf16*)(C.ws + WS_QK); const bf16* KC = (const bf16*)(C.ws + WS_KC); const bf16* PV = (const bf16*)(C.ws + WS_PV); const bf16* PC = (const bf16*)(C.ws + WS_PC);
    const float* gates = (const float*)(C.ws + WS_GATES);
    const int g = lane >> 4, li = lane & 15;
    bf16x8 onesf;
#pragma unroll
    for (int e = 0; e < 8; ++e) onesf[e] = li == 0 ? (short)0x3f80 : (short)0;
    const float* cvt_wg = C.w_gate_e; const float* cvt_wu = C.w_up_e; const float* cvt_wd = C.w_down_e; asm volatile("" : "+s"(cvt_wg), "+s"(cvt_wu), "+s"(cvt_wd));
    const int cvt_gw = blockIdx.x * 8 + wave, cvt_ngw = G * 8, cvt_np = ML_CVT_ON ? (cvt_gw < 6144 ? 8 * ((6144 - cvt_gw + cvt_ngw - 1) / cvt_ngw) : 0) : 0; int cvt_tp = 0;
    float cw[16];
    for (int item0 = blockIdx.x; item0 < 256 * (1 + rep2); item0 += G) { const int item = item0 & 255;
        const int dir = item & 1, h = (item >> 1) & 3, b = item >> 3;
        bf16* Hout = (bf16*)(C.ws + (dir ? WS_HB : WS_HF));
        const int kI = dir ? 2 : 0, kF = dir ? 3 : 1; const float bI = C.b_gates[kI * 4 + h], bF = C.b_gates[kF * 4 + h];
        const int pos = dir ? 63 - lane : lane;
#define ML_CC(s_) ((s_) >= 4 ? (dir ? 35 - (s_) : (s_) - 4) : (dir ? 3 - (s_) : (s_)))
#define ML_GDMA(s_) do { const int _s = (s_); const size_t _tok = _s >= 4 ? (size_t)b * SEQ + ML_CC(_s) * 64 + pos : (size_t)NTOK + (size_t)b * CL + ML_CC(_s) * 64 + pos; \
            dma_b32(gates + _tok * 16 + kI * 4 + h, ldsu + GST + (_s & 1) * 512); dma_b32(gates + _tok * 16 + kF * 4 + h, ldsu + GST + (_s & 1) * 512 + 256); } while (0)
#define ML_GATE(s_, ga_) do { const LAS float* _g = (const LAS float*)(lds + GST + ((s_) & 1) * 512); gate_math(_g[lane], _g[64 + lane], pos, m0, ga_); } while (0)
#define ML_DMA(s_, bf_) do { const int _s = (s_); const bool _x = _s >= 4; const int _cc = ML_CC(_s); \
            _Pragma("unroll") for (int _k = 0; _k < 6; ++_k) { const int _T = _k >> 1, _sub = wave + 8 * (_k & 1); if (!_x && _T == 0) continue; \
                const int _row = 4 * _sub + (lane >> 4), _ch = (lane & 15) ^ (((_row & 3) << 2) | ((_row >> 2) & 3)); const bf16* _src; \
                if (_x) { const size_t _tok = (size_t)(b * 4 + h) * SEQ + _cc * 64 + _row; _src = _T == 2 ? PV + _tok * 128 + _ch * 8 : QK + _tok * 256 + (_T ? 128 : 0) + _ch * 8; } \
                else { const size_t _tok = (size_t)b * CL + _cc * 64 + _row; _src = _T == 2 ? PC + _tok * 1024 + 512 + h * 128 + _ch * 8 : KC + _tok * 512 + h * 128 + _ch * 8; } \
                dma_b128(_src, ldsu + (bf_) * TB + _T * 16384 + _sub * 1024); } } while (0)
#define ML_CVT_ADDR(tp_, src_, dst_) do { const int _u = cvt_gw + cvt_ngw * ((tp_) >> 3), _ks = _u & 7, _nb = (_u >> 3) & 15, _mat = _u >> 7, _e = _mat & 15, _wh = _mat >> 4; \
            const int _k0 = 128 * _ks + 16 * ((tp_) & 7), _n = 64 * _nb + lane; \
            const float* _b = cvt_wg; if (_wh == 1) _b = cvt_wu; if (_wh == 2) _b = cvt_wd; \
            src_ = _b + (size_t)_e * 1048576 + (size_t)_k0 * 1024 + _n; \
            const size_t _row = _wh < 2 ? (size_t)(_e * 2048 + (_n >> 7) * 256 + _wh * 128 + (_n & 127)) : (size_t)(WS_WD - WS_WGU) / 1024 + (size_t)(_e * 1024 + _n); \
            dst_ = C.ws + WS_WGU + _row * 1024 + _k0; } while (0)
#define ML_CVT_LOAD(src_) do { const __attribute__((address_space(1))) float* _g = (const __attribute__((address_space(1))) float*)(src_);     \
            _Pragma("unroll") for (int _r = 0; _r < 16; ++_r) cw[_r] = _g[(size_t)_r * 1024]; } while (0)
#define ML_CVT_PACK(_o) do { _o.x = pk4_fp8(cw[0] * W8_SCALE, cw[1] * W8_SCALE, cw[2] * W8_SCALE, cw[3] * W8_SCALE); _o.y = pk4_fp8(cw[4] * W8_SCALE, cw[5] * W8_SCALE, cw[6] * W8_SCALE, cw[7] * W8_SCALE); \
            _o.z = pk4_fp8(cw[8] * W8_SCALE, cw[9] * W8_SCALE, cw[10] * W8_SCALE, cw[11] * W8_SCALE); _o.w = pk4_fp8(cw[12] * W8_SCALE, cw[13] * W8_SCALE, cw[14] * W8_SCALE, cw[15] * W8_SCALE); } while (0)
#define ML_CVT_STEP() do { if (cvt_np > 0) { u32x4 _o; ML_CVT_PACK(_o); const bool _st = cvt_tp < cvt_np; const float* _s; unsigned char* _d; ML_CVT_ADDR(_st ? cvt_tp : 0, _s, _d); (void)_s; \
            asm volatile("" : "+v"(_o) :: "memory");        \
            if (ML_CVT_ON == 2) _d = C.ws + 840 * MiB + ((size_t)(cvt_gw * 24 + (cvt_tp % 24)) * 64 + lane) * 16;        \
            ++cvt_tp; ML_CVT_ISSUE(cvt_tp); if (_st) st_b128(_d, _o); } } while (0)
#define ML_CVT_ISSUE(tp_) do { const int _t = (tp_) < cvt_np ? (tp_) : cvt_np - 1; const float* _s; unsigned char* _d; ML_CVT_ADDR(_t, _s, _d); (void)_d; ML_CVT_LOAD(_s); } while (0)
        for (int i = tid; i < 36864 / 16; i += 512) *(LAS u32x4*)(lds + CT + i * 16) = (u32x4){0u, 0u, 0u, 0u};
        f32x4 Cown[4], Coth[4], Cext;
#pragma unroll
        for (int t = 0; t < 4; ++t) { Cown[t] = (f32x4){0.f, 0.f, 0.f, 0.f}; Coth[t] = (f32x4){0.f, 0.f, 0.f, 0.f}; }
        Cext = (f32x4){0.f, 0.f, 0.f, 0.f};
        float m0 = 0.f;
        ML_DMA(0, 0); ML_DMA(1, 1);
        if (wave == 0) { ML_GDMA(0); ML_GDMA(1); ML_VM0(); ML_GATE(0, sm); asm volatile("s_waitcnt lgkmcnt(0)" ::: "memory"); ML_GDMA(2); }
        ML_VM0();
        __syncthreads();
        const int jt = wave >> 1, half = wave & 1, j = 16 * jt + li;
        if (cvt_np > 0) ML_CVT_ISSUE(cvt_tp);
        for (int step = 0; step < 36; ++step) {
            const int p = step & 1; const bool isx = step >= 4; const int cc = ML_CC(step);
            const LAS unsigned char* Qt = lds + p * TB + QO; const LAS unsigned char* Kt = lds + p * TB + KO; const LAS unsigned char* Vt = lds + p * TB + VO;
            const LAS float* ga = sm + p * GA;
            if (wave == 0) { if (step + 1 < 36) ML_GATE(step + 1, sm + (p ^ 1) * GA); }
            else if (isx) {
                const int jtf = wave <= 2 ? 3 : (wave <= 4 ? 2 : (wave == 6 ? 0 : 1)), s0f = (wave == 2 || wave == 4) ? 2 : (wave == 7 ? 1 : 0), ntw = (wave == 5 || wave == 7) ? 1 : 2;
                const int jts = dir ? 3 - jtf : jtf, js = 16 * jts + li;
                bf16x8 qf[4], kfr[2][4];
                {   const unsigned qb = (unsigned)(size_t)Qt + 4096u * jts, kb0 = (unsigned)(size_t)Kt + 4096u * (dir ? 3 - s0f : s0f), kb1 = (unsigned)(size_t)Kt + 4096u * (dir ? 3 - (s0f + 1) : s0f + 1);
#pragma unroll
                    for (int ks = 0; ks < 4; ++ks) { const unsigned l_ = rf_lane(ks, lane); qf[ks] = ldsr128<0>(qb + l_); kfr[0][ks] = ldsr128<0>(kb0 + l_); kfr[1][ks] = ldsr128<0>(kb1 + l_); }
                    ML_LGKM0_4(qf[0], qf[1], qf[2], qf[3]); ML_LGKM0_8(kfr[0][0], kfr[0][1], kfr[0][2], kfr[0][3], kfr[1][0], kfr[1][1], kfr[1][2], kfr[1][3]); }
                const float Mj = ga[M_ + js];
#pragma unroll
                for (int t = 0; t < 2; ++t) { if (t >= ntw) break; const int stf = s0f + t, st = dir ? 3 - stf : stf; u32x2 w = {0u, 0u};
                    if (stf <= jtf) { f32x4 sa = {0.f, 0.f, 0.f, 0.f};
#pragma unroll
                        for (int ks = 0; ks < 4; ++ks) sa = __builtin_amdgcn_mfma_f32_16x16x32_bf16(kfr[t][ks], qf[ks], sa, 0, 0, 0);
                        const int s0 = 16 * st + 4 * g; const f32x4 u4 = *(const LAS f32x4*)(ga + U_ + s0); float sp[4];
#pragma unroll
                        for (int r = 0; r < 4; ++r) { const int s = s0 + r; const bool keep = dir ? (s >= js) : (s <= js); sp[r] = keep ? sa[r] * __expf(fminf(u4[r] - Mj, 0.f)) : 0.f; }
                        w.x = pk2(sp[0], sp[1]); w.y = pk2(sp[2], sp[3]); }
                    *(LAS u32x2*)(lds + SS + off_s(js, 2 * st + (g >> 1)) + (g & 1) * 8) = w; }
            }
            const unsigned Vu = (unsigned)(size_t)Vt, Ku = (unsigned)(size_t)Kt;
            bf16x8 vf[4][2], kr_[2]; u32x2 ow[4] = {}; bf16* optr = nullptr;
            if (isx) {
                ML_BAR();
                const float dj = ga[DEC_ + j];
                f32x4 oa[4], oe = {0.f, 0.f, 0.f, 0.f};
#pragma unroll
                for (int t = 0; t < 4; ++t) oa[t] = (f32x4){0.f, 0.f, 0.f, 0.f};
                {
                    const unsigned qb = (unsigned)(size_t)Qt + 4096u * jt, cb = ldsu + CT + 16384u * half, nb = ldsu + CT + 32768u;
                    bf16x8 qf[4], cA[5], cB[5];
#define ML_LOADC(dst, ks_) do { const unsigned _l = rf_lane(ks_, lane); dst[0] = ldsr128<0>(cb + _l); dst[1] = ldsr128<4096>(cb + _l); dst[2] = ldsr128<8192>(cb + _l); dst[3] = ldsr128<12288>(cb + _l); dst[4] = ldsr128<0>(nb + _l); } while (0)
#define ML_MMAC(src, q_) do { _Pragma("unroll") for (int t = 0; t < 4; ++t) oa[t] = __builtin_amdgcn_mfma_f32_16x16x32_bf16(src[t], q_, oa[t], 0, 0, 0); oe = __builtin_amdgcn_mfma_f32_16x16x32_bf16(src[4], q_, oe, 0, 0, 0); } while (0)
#pragma unroll
                    for (int ks = 0; ks < 4; ++ks) qf[ks] = ldsr128<0>(qb + rf_lane(ks, lane));
                    ML_LOADC(cA, 0);
                    ML_LGKM0_4(qf[0], qf[1], qf[2], qf[3]); ML_LGKM0_5(cA[0], cA[1], cA[2], cA[3], cA[4]);
                    ML_LOADC(cB, 1); ML_MMAC(cA, qf[0]);
                    ML_LGKM0_5(cB[0], cB[1], cB[2], cB[3], cB[4]); ML_LOADC(cA, 2); ML_MMAC(cB, qf[1]);
                    ML_LGKM0_5(cA[0], cA[1], cA[2], cA[3], cA[4]); ML_LOADC(cB, 3); ML_MMAC(cA, qf[2]);
                    ML_LGKM0_5(cB[0], cB[1], cB[2], cB[3], cB[4]); ML_MMAC(cB, qf[3]);
#undef ML_LOADC
#undef ML_MMAC
                }
#pragma unroll
                for (int t = 0; t < 4; ++t) oa[t] = oa[t] * dj;
                oe = oe * dj;
#pragma unroll
                for (int t = 0; t < 4; ++t) { vf[t][0] = trfrag_a<0>(Vu, 4 * half + t, lane); vf[t][1] = trfrag_a<1>(Vu, 4 * half + t, lane); }
                ML_LGKM0_8(vf[0][0], vf[1][0], vf[2][0], vf[3][0], vf[0][1], vf[1][1], vf[2][1], vf[3][1]);
#pragma unroll
                for (int ks = 0; ks < 2; ++ks) {
                    if (dir ? (2 * ks + 1 >= jt) : (2 * ks <= jt)) { const bf16x8 sf = *(const LAS bf16x8*)(lds + SS + off_s(j, 4 * ks + g));
#pragma unroll
                        for (int t = 0; t < 4; ++t) oa[t] = __builtin_amdgcn_mfma_f32_16x16x32_bf16(vf[t][ks], sf, oa[t], 0, 0, 0);
                        oe = __builtin_amdgcn_mfma_f32_16x16x32_bf16(onesf, sf, oe, 0, 0, 0); } }
                kr_[0] = trfrag_a<0>(Ku, wave, lane); kr_[1] = trfrag_a<1>(Ku, wave, lane);
                const float den = __shfl(oe[0], li);
                const float inv = __builtin_amdgcn_rcpf(fmaxf(fabsf(den), ga[EM_ + j]));
                const size_t tok = (size_t)b * SEQ + cc * 64 + j;
                ML_VM0();
#pragma unroll
                for (int t = 0; t < 4; ++t) { const f32x4 o = oa[t] * inv; ow[t].x = pk2(o[0], o[1]); ow[t].y = pk2(o[2], o[3]); }
                optr = Hout + tok * 512 + h * 128 + 64 * half + 16 * (g & 1) + 4 * (g & ~1);
            } else {
#pragma unroll
                for (int t = 0; t < 4; ++t) { vf[t][0] = trfrag_a<0>(Vu, 4 * half + t, lane); vf[t][1] = trfrag_a<1>(Vu, 4 * half + t, lane); }
                kr_[0] = trfrag_a<0>(Ku, wave, lane); kr_[1] = trfrag_a<1>(Ku, wave, lane);
                ML_LGKM0_8(vf[0][0], vf[1][0], vf[2][0], vf[3][0], vf[0][1], vf[1][1], vf[2][1], vf[3][1]);
                ML_VM0();
            }
            ML_CVT_STEP();
            if (isx) {
                const u32x2 p0 = __builtin_amdgcn_permlane16_swap(ow[0].x, ow[1].x, false, false), p1 = __builtin_amdgcn_permlane16_swap(ow[0].y, ow[1].y, false, false);
                const u32x2 p2 = __builtin_amdgcn_permlane16_swap(ow[2].x, ow[3].x, false, false), p3 = __builtin_amdgcn_permlane16_swap(ow[2].y, ow[3].y, false, false);
                st_b128o<0>(optr, (u32x4){p0.x, p1.x, p0.y, p1.y}); st_b128o<64>(optr, (u32x4){p2.x, p3.x, p2.y, p3.y}); }
            {   const float dn = ga[SC_];
                ML_LGKM0_2(kr_[0], kr_[1]);
                bf16x8 kf[2];
#pragma unroll
                for (int ks = 0; ks < 2; ++ks) { const bf16x8 kr = kr_[ks]; const f32x4 w0 = *(const LAS f32x4*)(ga + WA_ + 32 * ks + 8 * g), w1 = *(const LAS f32x4*)(ga + WA_ + 32 * ks + 8 * g + 4);
                    u32x4 pkd; pkd.x = pk2(bf1((bf16)kr[0]) * w0[0], bf1((bf16)kr[1]) * w0[1]); pkd.y = pk2(bf1((bf16)kr[2]) * w0[2], bf1((bf16)kr[3]) * w0[3]);
                    pkd.z = pk2(bf1((bf16)kr[4]) * w1[0], bf1((bf16)kr[5]) * w1[1]); pkd.w = pk2(bf1((bf16)kr[6]) * w1[2], bf1((bf16)kr[7]) * w1[3]);
                    kf[ks] = __builtin_bit_cast(bf16x8, pkd); }
#pragma unroll
                for (int t = 0; t < 4; ++t) { f32x4 c = Cown[t] * dn;
#pragma unroll
                    for (int ks = 0; ks < 2; ++ks) c = __builtin_amdgcn_mfma_f32_16x16x32_bf16(kf[ks], vf[t][ks], c, 0, 0, 0);
                    Cown[t] = c; }
                bf16x8 vo[4][2];
#pragma unroll
                for (int t = 0; t < 4; ++t) { vo[t][0] = trfrag_a<0>(Vu, 4 * (half ^ 1) + t, lane); vo[t][1] = trfrag_a<1>(Vu, 4 * (half ^ 1) + t, lane); }
                ML_LGKM0_8(vo[0][0], vo[1][0], vo[2][0], vo[3][0], vo[0][1], vo[1][1], vo[2][1], vo[3][1]);
#pragma unroll
                for (int t = 0; t < 4; ++t) { f32x4 c = Coth[t] * dn;
#pragma unroll
                    for (int ks = 0; ks < 2; ++ks) c = __builtin_amdgcn_mfma_f32_16x16x32_bf16(kf[ks], vo[t][ks], c, 0, 0, 0);
                    Coth[t] = c; }
                {   f32x4 c = Cext * dn;
#pragma unroll
                    for (int ks = 0; ks < 2; ++ks) c = __builtin_amdgcn_mfma_f32_16x16x32_bf16(kf[ks], onesf, c, 0, 0, 0);
                    Cext = c; }
            }
            ML_BAR();
#pragma unroll
            for (int t = 0; t < 4; ++t) { { const f32x4 c = Cown[t]; u32x2 w; w.x = pk2(c[0], c[1]); w.y = pk2(c[2], c[3]); *(LAS u32x2*)(lds + CT + off_b(16 * (4 * half + t) + li, 2 * wave + (g >> 1)) + (g & 1) * 8) = w; }
                { const f32x4 c = Coth[t]; u32x2 w; w.x = pk2(c[0], c[1]); w.y = pk2(c[2], c[3]); *(LAS u32x2*)(lds + CT + off_b(16 * (4 * (half ^ 1) + t) + li, 2 * wave + (g >> 1)) + (g & 1) * 8) = w; } }
            { const f32x4 c = Cext; u32x2 w; w.x = pk2(c[0], c[1]); w.y = pk2(c[2], c[3]); *(LAS u32x2*)(lds + CT + off_b(128 + li, 2 * wave + (g >> 1)) + (g & 1) * 8) = w; }
            if (step + 2 < 36) ML_DMA(step + 2, p);
            if (wave == 0 && step + 3 < 36) ML_GDMA(step + 3);
        }
        ML_VM0();
        if (cvt_tp < cvt_np) { u32x4 _o; ML_CVT_PACK(_o); const float* _s; unsigned char* _d; ML_CVT_ADDR(cvt_tp, _s, _d); (void)_s; st_b128(_d, _o); }
        ++cvt_tp;
        __syncthreads();
    }
    if (cvt_tp > cvt_np) cvt_tp = cvt_np;
    for (; cvt_tp < cvt_np; ++cvt_tp) { const float* _s; unsigned char* _d; ML_CVT_ADDR(cvt_tp, _s, _d); ML_CVT_LOAD(_s); u32x4 _o; ML_CVT_PACK(_o); *(u32x4*)_d = _o; }
#undef ML_CVT_ADDR
#undef ML_CVT_LOAD
#undef ML_CVT_PACK
#undef ML_CVT_STEP
#undef ML_CVT_ISSUE
#undef ML_CC
#undef ML_GDMA
#undef ML_GATE
#undef ML_DMA
}
}
constexpr int N_PHASES = 13;
#ifndef PROBE_PH
#define PROBE_PH 0
#endif
struct Args { const float* in[19]; float* out; unsigned char* ws; int ph_lo, ph_hi, probe, pad; };
static_assert(sizeof(Args) == 19 * 8 + 8 + 8 + 16, "Args has no padding");

__global__ void __launch_bounds__(512, 2) mk_fwd(Args a) {
    extern __shared__ __attribute__((aligned(16))) unsigned char lds_raw[];
    LAS unsigned char* lds = (LAS unsigned char*)lds_raw;
    const int tid = threadIdx.x, lane = tid & 63, wave = __builtin_amdgcn_readfirstlane(tid >> 6), G = gridDim.x;
    Ctx C;
    C.x = a.in[0]; C.c = a.in[1]; C.ctx = a.in[2]; C.c_ctx = a.in[3]; C.w_ada = a.in[4]; C.b_ada = a.in[5]; C.g_norm1 = a.in[6]; C.w_in = a.in[7]; C.b_gates = a.in[8]; C.w_conv = a.in[9];
    C.w_fourier = a.in[10]; C.w_mlstm = a.in[11]; C.w_out = a.in[12]; C.g_norm2 = a.in[13]; C.w_router = a.in[14]; C.w_gate_e = a.in[15]; C.w_up_e = a.in[16]; C.w_down_e = a.in[17]; C.g_final = a.in[18];
    C.out = a.out; C.ws = a.ws;
    const int lo = a.ph_lo, hi = a.ph_hi;
#if MK_XCD_BAR
    volatile LAS unsigned* bst = (volatile LAS unsigned*)(lds + LDS_PHASE_BYTES);
    if (tid < 4) bst[tid] = 0u;
    __syncthreads();
    XcdBarrier bar = xcd_barrier_post((unsigned*)(a.ws + WS_CTL) + 4096, bst);
#endif
    int nsync = 0;
    if (a.pad == 0x7fffffff) cg::this_grid().sync();
#define IN(k) (lo <= (k) && (k) < hi)
#if MK_XCD_BAR
#ifdef PROBE_BAR2
#define GRIDBAR() do { xcd_barrier(bar); xcd_barrier(bar); ++nsync; } while (0)
#else
#define GRIDBAR() do { xcd_barrier(bar); ++nsync; } while (0)
#endif
#else
#define GRIDBAR() do { cg::this_grid().sync(); ++nsync; } while (0)
#endif
#define SEAM(k) do { if (IN(k) && IN((k) + 1)) GRIDBAR(); } while (0)
#define PHASE(k, ...) do { if (IN(k)) { __VA_ARGS__ } SEAM(k); } while (0)
    PHASE(0, { for (int _r = 0; _r < 1 + (a.probe & 1); ++_r) { p0_prep(C, lds, tid, lane, wave, G); __syncthreads();
            p0_wtf(C, lds, tid, (int)blockIdx.x, G);
            __syncthreads(); p0_tt(C, lds, tid, (int)blockIdx.x, G); __syncthreads(); } });
    PHASE(1, { p0_weights(C, lds, tid, lane, wave, G); __syncthreads(); p1a_norm_gates(C, lds, tid, lane, wave, G, (a.probe >> 1) & 1); __syncthreads(); });
#ifndef MK_STAGGER
#define MK_STAGGER 0
#endif
#define STAGGER(ticks) do { if (MK_STAGGER) { const unsigned long long _t0 = wall_clock64(); const unsigned long long _w = (unsigned long long)((blockIdx.x >> 3) & 7) * (ticks); while (wall_clock64() - _t0 < _w) __builtin_amdgcn_s_sleep(32); } } while (0)
    PHASE(2, { STAGGER(400); SchedP1 S{C.ws, G, (int)blockIdx.x, 1 + ((a.probe >> 2) & 1), 1 + ((a.probe >> 16) & 1)}; EpiP1 E{C.ws}; mg::gemm_phase<EpiP1, SchedP1, false>(lds, 1024, S, E);
            convert_experts(C, lds, lane, wave, G, 1, 0); __syncthreads(); });
    PHASE(3, { SchedF2 S{C.ws, G, (int)blockIdx.x, 1 + ((a.probe >> 3) & 1)}; EpiF2 E{C.ws}; mg::gemm_phase<EpiF2, SchedF2, false>(lds, 4096, S, E); p2_conv(C, lane, wave, G, (a.probe >> 13) & 1); });
    PHASE(4, { ml::mlstm_phase(C, lds, tid, lane, wave, G, (a.probe >> 4) & 1); });
    PHASE(5, { p3b_combine(C, tid, G, (a.probe >> 5) & 1); });
    PHASE(6, { SchedMerge S{C.ws, G, (int)blockIdx.x, 1 + ((a.probe >> 6) & 1)}; EpiMerge E{C.ws}; mg::gemm_phase<EpiMerge, SchedMerge, false, false, true>(lds, 512, S, E); });
    PHASE(7, { SchedOut S{C.ws, G, (int)blockIdx.x, 1 + ((a.probe >> 7) & 1), 1 + ((a.probe >> 17) & 1)}; EpiOut E{C.x, (const float*)(C.ws + WS_MOD), C.ws}; mg::gemm_phase<EpiOut, SchedOut, false>(lds, 1024, S, E); });
    PHASE(8, { p6_norm_router(C, lds, tid, lane, wave, G, (a.probe >> 8) & 1); __syncthreads(); });
    PHASE(9, { const int NGW = G * 8; const int rp9 = 1 + ((a.probe >> 9) & 1); for (int it = wave * G + blockIdx.x; it < NB * NE * rp9; it += NGW) topk_item(C, it % (NB * NE), lane);        if (ML_CVT_ON != 1) convert_experts(C, lds, lane, wave, G, rp9 + ((a.probe >> 18) & 1), 1); for (int i = blockIdx.x * 512 + tid; i < NE * NB * CAP; i += G * 512) ((int*)(C.ws + WS_IDENT))[i] = i; __syncthreads(); });
    PHASE(10, { SchedUp S{C.ws, G, (int)blockIdx.x, 1 + ((a.probe >> 10) & 1), 1 + ((a.probe >> 14) & 1)}; EpiSwiglu E{C.ws}; mg::gemm_phase<EpiSwiglu, SchedUp, true, true>(lds, 1024, S, E); });
    PHASE(11, { SchedDown S{C.ws, G, (int)blockIdx.x, 1 + ((a.probe >> 11) & 1), 1 + ((a.probe >> 15) & 1)}; EpiDown E{C.ws}; mg::gemm_phase<EpiDown, SchedDown, true, true>(lds, 1024, S, E); });
    if (IN(12)) {
#pragma unroll 1
        for (int r12 = 0; r12 <= ((a.probe >> 12) & 1); ++r12) p10_final(C, lane, wave, G); }

#undef PHASE
#undef PHASE_L
#undef IN
#undef SEAM
#undef GRIDBAR
}

static void mk_launch(void* const* d_in, void* d_out, void* d_ws, hipStream_t stream, int lo, int hi, bool coop) {
    static int grid = 0;
    if (grid == 0) {
        int dev = 0, cus = 0, per_cu = 0;
        (void)hipGetDevice(&dev); (void)hipDeviceGetAttribute(&cus, hipDeviceAttributeMultiprocessorCount, dev);
        (void)hipFuncSetAttribute((const void*)mk_fwd, hipFuncAttributeMaxDynamicSharedMemorySize, LDS_BYTES);
        (void)hipOccupancyMaxActiveBlocksPerMultiprocessor(&per_cu, (const void*)mk_fwd, 512, LDS_BYTES);
        if (per_cu < 1) fprintf(stderr, "mk_launch: occupancy query says %d blocks/CU\n", per_cu);
        grid = cus > 0 ? cus : 256;
    }
    Args a{};
    for (int i = 0; i < 19; ++i) a.in[i] = (const float*)d_in[i];
    a.out = (float*)d_out; a.ws = (unsigned char*)d_ws; a.ph_lo = lo; a.ph_hi = hi; a.probe = PROBE_PH; a.pad = 0;
    if (coop) { void* args[] = {&a}; hipError_t e = hipLaunchCooperativeKernel((const void*)mk_fwd, dim3(grid), dim3(512), args, LDS_BYTES, stream);
        if (e != hipSuccess) fprintf(stderr, "cooperative launch failed: %s (grid %d)\n", hipGetErrorString(e), grid); }
    else hipLaunchKernelGGL(mk_fwd, dim3(grid), dim3(512), LDS_BYTES, stream, a);
}
extern "C" void kernel_launch(void* const* d_in, const int* in_sizes, int n_in, void* d_out, int out_size, void* d_ws, size_t ws_size, hipStream_t stream) {
    (void)hipMemsetAsync((char*)d_ws + WS_CTL, 0, 65536, stream);
    mk_launch(d_in, d_out, d_ws, stream, 0, N_PHASES, true);
}
```
